# Optimizing an MI355X kernel written in HIP

```python
import math
import jax, jax.numpy as jnp
from jax import lax
import numpy as np

D_MODEL = 2048
BATCH = 4
SEQ = 2048
DEPTH = 1
DEC_BATCH = 128
DEC_SEQ = 8
PAST_LEN = 16384
PAGE_SIZE = 128

MIX_WIDTH = D_MODEL
H_A = 8
DK_A = MIX_WIDTH // 2 // H_A
DV_A = MIX_WIDTH // 2 // H_A
H_B = 8
DK_B = MIX_WIDTH // 2 // H_B
DV_B = MIX_WIDTH // 2 // H_B
CONV_W = 4
C_CONV = 2 * H_B * DK_B + H_B * DV_B
D_FF = 4 * D_MODEL
CHUNK = 64
EPS = 1e-6
COL_SIZES = (H_A * DK_A, H_A * DK_A, H_A * DV_A, H_A, H_A, H_A * DV_A,
             H_B * DK_B, H_B * DK_B, H_B * DV_B, H_B, H_B, H_B * DV_B)
P_IN = sum(COL_SIZES)

kernel_name = "hymba_mlstm_gdn_adaln_decoder_step"


def _rmsnorm(x, g):
    x32 = x.astype(jnp.float32)
    y = x32 * lax.rsqrt(jnp.mean(x32 * x32, axis=-1, keepdims=True) + EPS)
    return y.astype(x.dtype) * g


def _head_rmsnorm(h, g):
    B, T, H, E = h.shape
    y = h * lax.rsqrt(jnp.mean(h * h, axis=-1, keepdims=True) + EPS)
    return (y * g.astype(jnp.float32).reshape(H, E)).reshape(B, T, H * E)


def _l2norm(x):
    return x * lax.rsqrt(jnp.sum(x * x, axis=-1, keepdims=True) + EPS)


def _modulate(h, shift, scale):
    return h * (1.0 + scale[:, None, :]) + shift[:, None, :]


def _split_cols(p):
    idx = []
    acc = 0
    for s in COL_SIZES[:-1]:
        acc += s
        idx.append(acc)
    return jnp.split(p, idx, axis=-1)


def _to_chunks(a, L):
    B, T, H = a.shape[:3]
    rest = a.shape[3:]
    a = a.reshape((B, T // L, L, H) + rest)
    return a.transpose((1, 0, 3, 2) + tuple(range(4, a.ndim)))


def _from_chunks(a):
    N, B, H, L, E = a.shape
    return a.transpose(1, 0, 3, 2, 4).reshape(B, N * L, H, E)


def _causal_conv(u, buf, w):
    T = u.shape[1]
    full = jnp.concatenate([buf.astype(u.dtype), u], axis=1)
    out = full[:, 0:T] * w[0]
    for j in range(1, CONV_W):
        out = out + full[:, j:j + T] * w[j]
    return out, full[:, -(CONV_W - 1):]


def _mlstm_scan(q, k, v, li, lf, C0, n0, m0):
    T = q.shape[1]
    L = math.gcd(T, CHUNK)
    xs = (_to_chunks(q, L), _to_chunks(k, L), _to_chunks(v, L),
          _to_chunks(li, L), _to_chunks(lf, L))
    causal = jnp.tril(jnp.ones((L, L), dtype=bool))

    def step(carry, xc):
        C, n, m = carry
        qc, kc, vc, lic, lfc = xc
        b = jnp.cumsum(lfc, axis=-1)
        d = jnp.where(causal, b[..., :, None] - b[..., None, :] + lic[..., None, :], -jnp.inf)
        inter = b + m[..., None]
        m_t = jnp.maximum(inter, jnp.max(d, axis=-1))
        w = jnp.exp(d - m_t[..., None])
        dec = jnp.exp(inter - m_t)
        s = jnp.einsum('bhtd,bhsd->bhts', qc, kc) * w
        numer = dec[..., None] * jnp.einsum('bhtd,bhde->bhte', qc, C) + jnp.einsum('bhts,bhse->bhte', s, vc)
        dd = dec * jnp.einsum('bhtd,bhd->bht', qc, n) + jnp.sum(s, axis=-1)
        h = numer / jnp.maximum(jnp.abs(dd), jnp.exp(-m_t))[..., None]
        m_new = m_t[..., -1]
        wl = jnp.exp(b[..., -1:] - b + lic - m_new[..., None])
        dC = jnp.exp(b[..., -1] + m - m_new)
        C_new = dC[..., None, None] * C + jnp.einsum('bhs,bhsd,bhse->bhde', wl, kc, vc)
        n_new = dC[..., None] * n + jnp.einsum('bhs,bhsd->bhd', wl, kc)
        return (C_new, n_new, m_new), h

    (C, n, m), hs = lax.scan(step, (C0, n0, m0), xs)
    return _from_chunks(hs), C, n, m


def _gdn_scan(q, k, v, logg, beta, S0):
    T = q.shape[1]
    L = math.gcd(T, CHUNK)
    xs = (_to_chunks(q, L), _to_chunks(k, L), _to_chunks(v, L),
          _to_chunks(logg, L), _to_chunks(beta, L))
    incl = jnp.tril(jnp.ones((L, L), dtype=bool))
    strict = jnp.tril(jnp.ones((L, L), dtype=bool), -1)
    eye = jnp.eye(L, dtype=jnp.float32)

    def step(S, xc):
        qc, kc, vc, gc, bc = xc
        G = jnp.cumsum(gc, axis=-1)
        decay = jnp.exp(jnp.where(incl, G[..., :, None] - G[..., None, :], -jnp.inf))
        kk = jnp.einsum('bhtd,bhsd->bhts', kc, kc)
        a = jnp.where(strict, bc[..., None] * decay * kk, 0.0)
        gam = jnp.exp(G)
        rhs = bc[..., None] * (vc - gam[..., None] * jnp.einsum('bhtd,bhde->bhte', kc, S))
        u = lax.linalg.triangular_solve(a + eye, rhs, left_side=True, lower=True, unit_diagonal=True)
        qk = jnp.einsum('bhtd,bhsd->bhts', qc, kc) * decay
        o = gam[..., None] * jnp.einsum('bhtd,bhde->bhte', qc, S) + jnp.einsum('bhts,bhse->bhte', qk, u)
        S_new = jnp.exp(G[..., -1])[..., None, None] * S + jnp.einsum(
            'bhs,bhsd,bhse->bhde', jnp.exp(G[..., -1:] - G), kc, u)
        return S_new, o

    S, os_ = lax.scan(step, S0, xs)
    return _from_chunks(os_), S


def _layer(x, c, C0, n0, m0, S0, conv0, ada_w, ada_b, norm1, w_in, gate_b, mlstm_g,
           conv_w, A_log, dt_bias, gdn_g, w_out, norm2, w_up, w_down):
    f32 = jnp.float32
    B, T, _ = x.shape
    mod = jax.nn.silu(c) @ ada_w + ada_b
    sh1, sc1, g1, sh2, sc2, g2 = jnp.split(mod, 6, axis=-1)
    h = _modulate(_rmsnorm(x, norm1), sh1, sc1)
    proj = h @ w_in
    qa, ka, va, ia, fa, oa, qb, kb, vb, ab, bb, zb = _split_cols(proj)

    qa = qa.astype(f32).reshape(B, T, H_A, DK_A)
    ka = ka.astype(f32).reshape(B, T, H_A, DK_A) * (DK_A ** -0.5)
    va = va.astype(f32).reshape(B, T, H_A, DV_A)
    gb = gate_b.astype(f32)
    li = ia.astype(f32) + gb[:H_A]
    lf = jax.nn.log_sigmoid(fa.astype(f32) + gb[H_A:])
    ha, C1, n1, m1 = _mlstm_scan(qa, ka, va, li, lf, C0.astype(f32), n0.astype(f32), m0.astype(f32))
    ha = _head_rmsnorm(ha, mlstm_g) * jax.nn.sigmoid(oa.astype(f32))

    qkv = jnp.concatenate([qb, kb, vb], axis=-1)
    qkv, conv1 = _causal_conv(qkv, conv0, conv_w)
    qkv = jax.nn.silu(qkv.astype(f32))
    qb, kb, vb = jnp.split(qkv, [H_B * DK_B, 2 * H_B * DK_B], axis=-1)
    qb = _l2norm(qb.reshape(B, T, H_B, DK_B)) * (DK_B ** -0.5)
    kb = _l2norm(kb.reshape(B, T, H_B, DK_B))
    vb = vb.reshape(B, T, H_B, DV_B)
    logg = -jnp.exp(A_log.astype(f32)) * jax.nn.softplus(ab.astype(f32) + dt_bias.astype(f32))
    beta = jax.nn.sigmoid(bb.astype(f32))
    hb, S1 = _gdn_scan(qb, kb, vb, logg, beta, S0.astype(f32))
    hb = _head_rmsnorm(hb, gdn_g) * jax.nn.silu(zb.astype(f32))

    mix = jnp.concatenate([ha, hb], axis=-1).astype(x.dtype) @ w_out
    x = x + g1[:, None, :] * mix
    h2 = _modulate(_rmsnorm(x, norm2), sh2, sc2)
    x = x + g2[:, None, :] * (jnp.square(jax.nn.relu(h2 @ w_up)) @ w_down)
    return x, C1, n1, m1, S1, conv1


def _final(x, c, w, b, g):
    sh, sc = jnp.split(jax.nn.silu(c) @ w + b, 2, axis=-1)
    return _modulate(_rmsnorm(x, g), sh, sc)


def setup_inputs(seed: int = 0) -> dict:
    key = jax.random.key(seed)
    ks = jax.random.split(key, 32)
    nrm = jax.random.normal
    D = D_MODEL
    f_bias = jnp.linspace(3.0, 6.0, H_A)[None, :] + 0.1 * nrm(ks[14], (DEPTH, H_A))
    i_bias = 0.1 * nrm(ks[15], (DEPTH, H_A))
    dt = jnp.exp(jax.random.uniform(ks[18], (DEPTH, H_B), minval=math.log(1e-3), maxval=math.log(1e-1)))
    return {
        "x_prompt": nrm(ks[0], (BATCH, SEQ, D)),
        "x_sample": nrm(ks[1], (DEC_BATCH, DEC_SEQ, D)),
        "state_mlstm_C": nrm(ks[2], (DEPTH, DEC_BATCH, H_A, DK_A, DV_A)) * DK_A ** -0.5,
        "state_mlstm_n": nrm(ks[3], (DEPTH, DEC_BATCH, H_A, DK_A)) * 0.5,
        "state_mlstm_m": nrm(ks[4], (DEPTH, DEC_BATCH, H_A)),
        "state_gdn_S": nrm(ks[5], (DEPTH, DEC_BATCH, H_B, DK_B, DV_B)) * DK_B ** -0.5,
        "state_gdn_conv": nrm(ks[6], (DEPTH, DEC_BATCH, CONV_W - 1, C_CONV)),
        "c_prompt": nrm(ks[7], (BATCH, D)),
        "c_sample": nrm(ks[8], (DEC_BATCH, D)),
        "ada_w": nrm(ks[9], (DEPTH, D, 6 * D)) * (0.5 * D ** -0.5),
        "ada_b": nrm(ks[10], (DEPTH, 6 * D)) * 0.02,
        "norm1": 1.0 + 0.01 * nrm(ks[11], (DEPTH, D)),
        "w_in": nrm(ks[12], (DEPTH, D, P_IN)) * D ** -0.5,
        "mlstm_gate_bias": jnp.concatenate([i_bias, f_bias], axis=-1),
        "mlstm_norm": 1.0 + 0.01 * nrm(ks[13], (DEPTH, H_A * DV_A)),
        "gdn_conv_w": nrm(ks[16], (DEPTH, CONV_W, C_CONV)) * CONV_W ** -0.5,
        "gdn_A_log": jnp.log(jax.random.uniform(ks[17], (DEPTH, H_B), minval=1.0, maxval=16.0)),
        "gdn_dt_bias": dt + jnp.log(-jnp.expm1(-dt)),
        "gdn_norm": 1.0 + 0.01 * nrm(ks[19], (DEPTH, H_B * DV_B)),
        "w_out": nrm(ks[20], (DEPTH, MIX_WIDTH, D)) * MIX_WIDTH ** -0.5,
        "norm2": 1.0 + 0.01 * nrm(ks[21], (DEPTH, D)),
        "w_up": nrm(ks[22], (DEPTH, D, D_FF)) * D ** -0.5,
        "w_down": nrm(ks[23], (DEPTH, D_FF, D)) * D_FF ** -0.5,
        "ada_final_w": nrm(ks[24], (D, 2 * D)) * (0.5 * D ** -0.5),
        "ada_final_b": nrm(ks[25], (2 * D,)) * 0.02,
        "norm_final": 1.0 + 0.01 * nrm(ks[26], (D,)),
    }


def reference(x_prompt, x_sample, state_mlstm_C, state_mlstm_n, state_mlstm_m, state_gdn_S,
              state_gdn_conv, c_prompt, c_sample, ada_w, ada_b, norm1, w_in, mlstm_gate_bias,
              mlstm_norm, gdn_conv_w, gdn_A_log, gdn_dt_bias, gdn_norm, w_out, norm2, w_up,
              w_down, ada_final_w, ada_final_b, norm_final):
    f32 = jnp.float32
    Bp = x_prompt.shape[0]
    xp, xs = x_prompt, x_sample
    pC, pn, pm, pS, pconv = [], [], [], [], []
    sC, sn, sm, sS, sconv = [], [], [], [], []
    for l in range(DEPTH):
        w_l = (ada_w[l], ada_b[l], norm1[l], w_in[l], mlstm_gate_bias[l], mlstm_norm[l],
               gdn_conv_w[l], gdn_A_log[l], gdn_dt_bias[l], gdn_norm[l], w_out[l], norm2[l],
               w_up[l], w_down[l])
        xp, C1, n1, m1, S1, cv1 = _layer(
            xp, c_prompt,
            jnp.zeros((Bp, H_A, DK_A, DV_A), f32), jnp.zeros((Bp, H_A, DK_A), f32),
            jnp.zeros((Bp, H_A), f32), jnp.zeros((Bp, H_B, DK_B, DV_B), f32),
            jnp.zeros((Bp, CONV_W - 1, C_CONV), xp.dtype), *w_l)
        pC.append(C1); pn.append(n1); pm.append(m1); pS.append(S1); pconv.append(cv1)
        xs, C2, n2, m2, S2, cv2 = _layer(
            xs, c_sample, state_mlstm_C[l], state_mlstm_n[l], state_mlstm_m[l],
            state_gdn_S[l], state_gdn_conv[l], *w_l)
        sC.append(C2); sn.append(n2); sm.append(m2); sS.append(S2); sconv.append(cv2)
    y_prompt = _final(xp, c_prompt, ada_final_w, ada_final_b, norm_final)
    y_sample = _final(xs, c_sample, ada_final_w, ada_final_b, norm_final)
    return (y_prompt, y_sample,
            jnp.stack(pC), jnp.stack(pn), jnp.stack(pm), jnp.stack(pS), jnp.stack(pconv),
            jnp.stack(sC), jnp.stack(sn), jnp.stack(sm), jnp.stack(sS), jnp.stack(sconv))
```

```cpp
#include <hip/hip_runtime.h>
#include <cstdio>
#include <cstdint>

#define LAS __attribute__((address_space(3)))
#define GAS __attribute__((address_space(1)))
typedef unsigned short bf16_t;
typedef short bf16x8 __attribute__((ext_vector_type(8)));
typedef float f32x4 __attribute__((ext_vector_type(4)));
typedef float f32x2 __attribute__((ext_vector_type(2)));
typedef float f32x16 __attribute__((ext_vector_type(16)));
typedef unsigned u32x4 __attribute__((ext_vector_type(4)));
typedef unsigned u32x2 __attribute__((ext_vector_type(2)));

#ifndef MK_ONE_LAUNCH
#define MK_ONE_LAUNCH 0
#endif

constexpr int D = 2048, T_P = 2048, NB_P = 4, NB_S = 128, T_S = 8;
constexpr int M_P = NB_P * T_P, M_S = NB_S * T_S, M = M_P + M_S;
constexpr int NH = 8, HD = 128;
constexpr int P_IN = 8224, NPROJ = 8192, NGATE = 32, DFF = 8192, CCONV = 3072;
constexpr int NGB = NB_P + NB_S;
constexpr int MODW = 6 * D, MODFW = 2 * D;
constexpr float EPS = 1e-6f;
constexpr int NWAVES = 8, NTHREADS = 512, GRID = 256;

constexpr size_t O_Y = 0;
constexpr size_t O_PC = (size_t)M * D;
constexpr size_t O_PN = O_PC + (size_t)NB_P * NH * HD * HD;
constexpr size_t O_PM = O_PN + (size_t)NB_P * NH * HD;
constexpr size_t O_PS = O_PM + (size_t)NB_P * NH;
constexpr size_t O_PCONV = O_PS + (size_t)NB_P * NH * HD * HD;
constexpr size_t O_SC = O_PCONV + (size_t)NB_P * 3 * CCONV;
constexpr size_t O_SN = O_SC + (size_t)NB_S * NH * HD * HD;
constexpr size_t O_SM = O_SN + (size_t)NB_S * NH * HD;
constexpr size_t O_SS = O_SM + (size_t)NB_S * NH;
constexpr size_t O_SCONV = O_SS + (size_t)NB_S * NH * HD * HD;
constexpr size_t O_END = O_SCONV + (size_t)NB_S * 3 * CCONV;
static_assert(O_END == 54830112, "d_out size");

constexpr size_t MiB = 1u << 20;
constexpr size_t WS_CTL = 0, CTL_ZERO_BYTES = 64 * 1024;
constexpr size_t WS_SCB = 1 * MiB;
constexpr size_t WS_MOD = 2 * MiB;
constexpr size_t WS_MODF = 9 * MiB;
constexpr size_t WS_GATES = 12 * MiB;
constexpr size_t WS_WIN = 16 * MiB;
constexpr size_t WS_WOUT = 49 * MiB;
constexpr size_t WS_WUP = 57 * MiB;
constexpr size_t WS_WDOWN = 89 * MiB;
constexpr size_t WS_HB = 121 * MiB;
constexpr size_t WS_MIX = 157 * MiB;
constexpr size_t WS_X1 = 193 * MiB;
constexpr size_t WS_PROJ = 265 * MiB;
constexpr size_t WS_END = 409 * MiB;
static_assert(WS_WIN + (size_t)P_IN * D * 2 <= WS_WOUT && WS_PROJ + (size_t)M * NPROJ * 2 <= WS_END, "ws map");

constexpr int CW_BAR = 1024;

__device__ __forceinline__ unsigned f2bf(float f) { unsigned u = __builtin_bit_cast(unsigned, f); return (u + 0x7fffu + ((u >> 16) & 1u)) >> 16; }
__device__ __forceinline__ unsigned pk2(float lo, float hi) { return f2bf(lo) | (f2bf(hi) << 16); }
__device__ __forceinline__ float bf2f(bf16_t b) { return __builtin_bit_cast(float, (unsigned)b << 16); }
__device__ __forceinline__ float bflo(unsigned w) { return __builtin_bit_cast(float, w << 16); }
__device__ __forceinline__ float bfhi(unsigned w) { return __builtin_bit_cast(float, w & 0xffff0000u); }
__device__ __forceinline__ float wave_sum(float v) {
#pragma unroll
    for (int o = 1; o < 64; o <<= 1) v += __shfl_xor(v, o);
    return v;
}
__device__ __forceinline__ float sigmoidf_(float x) { return 1.0f / (1.0f + __expf(-x)); }
__device__ __forceinline__ float siluf_(float x) { return x / (1.0f + __expf(-x)); }
__device__ __forceinline__ float softplusf_(float x) { return fmaxf(x, 0.f) + log1pf(__expf(-fabsf(x))); }
__device__ __forceinline__ float logsigmoidf_(float x) { return fminf(x, 0.f) - log1pf(__expf(-fabsf(x))); }
__device__ __forceinline__ int row_gb(int r) { return r < M_P ? (r >> 11) : NB_P + ((r - M_P) >> 3); }
namespace pg8 {
#define PG8_LAS __attribute__((address_space(3)))
constexpr int BM = 256, BK = 64, HALF = 128, HTB = HALF * BK * 2  , STAGE_BYTES = 8 * HTB, NXCD = 8, WGM = 8;

__host__ __device__ __forceinline__ int lds_byte(int r, int c) { const int st = (r >> 4) * 2 + (c >> 5), rr = r & 15, cc = c & 31, ob = rr * 64 + cc * 2; return st * 1024 + (ob ^ (((ob >> 9) & 1) << 5)); }
__host__ __device__ __forceinline__ void stage_rc(int b, int& R, int& C) { const int st = b / 1024, sb = b % 1024, swz = sb ^ (((sb >> 9) & 1) << 5); R = (st >> 1) * 16 + swz / 64; C = (st & 1) * 32 + (swz % 64) / 2; }
__host__ __device__ __forceinline__ int perm32(int rho) { const int n = rho >> 4, i = rho & 15; return 8 * (i >> 2) + 4 * n + (i & 3); }

struct Unit { int pm, pn; };
struct Gemm { const bf16_t* A; const bf16_t* Bt; int M, N, K; };

struct StaticOrder {
    int nM, nN, nwg, G, c;
    __host__ __device__ void init(int M, int N, int G_, int c_) { nM = M / BM; nN = N / BM; nwg = nM * nN; G = G_; c = c_; }
    __host__ __device__ bool next(int i, Unit& u) const {
        const long L = (long)i * G + c; if (L >= nwg) return false;
        int wgid = (int)L; { const int q = nwg / NXCD, r = nwg % NXCD, xcd = wgid % NXCD, off = wgid / NXCD; wgid = (xcd < r ? xcd * (q + 1) : r * (q + 1) + (xcd - r) * q) + off; }
        const int nig = WGM * nN, gid = wgid / nig, fm = gid * WGM, gsz = (nM - fm) < WGM ? (nM - fm) : WGM;
        u.pm = fm + ((wgid % nig) % gsz); u.pn = (wgid % nig) / gsz; return true;
    }
    __device__ __forceinline__ void a_ready(const Unit&) const {}
    __device__ __forceinline__ void done(const Unit&) const {}
};


__device__ __forceinline__ unsigned cvt_pk_bf16(float lo, float hi) { unsigned r; asm volatile("v_cvt_pk_bf16_f32 %0, %1, %2" : "=v"(r) : "v"(lo), "v"(hi)); return r; }
template <int ACT  > struct EpiBf16 {
    static constexpr bool PERM = true, AFTER_DRAIN = false;
    bf16_t* O; int ldc;
    __device__ __forceinline__ void operator()(const f32x4 (&acc)[2][2][4][2], const Unit& u, int wr, int wc, int fr, int fq) const {
        const int row0 = u.pm * BM + wr * 64 + fr, col0 = u.pn * BM + wc * 32 + 8 * fq;
#pragma unroll
        for (int ai = 0; ai < 2; ++ai)
#pragma unroll
            for (int m = 0; m < 4; ++m) { bf16_t* rowp = O + (size_t)(row0 + ai * HALF + m * 16) * ldc + col0;
#pragma unroll
                for (int bj = 0; bj < 2; ++bj) { f32x4 v0 = acc[ai][bj][m][0], v1 = acc[ai][bj][m][1];
                    if (ACT == 1) {
#pragma unroll
                        for (int q = 0; q < 4; ++q) { const float a = fmaxf(v0[q], 0.f), b = fmaxf(v1[q], 0.f); v0[q] = a * a; v1[q] = b * b; } }
                    u32x4 w; w.x = cvt_pk_bf16(v0[0], v0[1]); w.y = cvt_pk_bf16(v0[2], v0[3]); w.z = cvt_pk_bf16(v1[0], v1[1]); w.w = cvt_pk_bf16(v1[2], v1[3]);
                    *(u32x4*)(rowp + bj * HALF) = w; } }
    }
};
struct EpiRes {
    static constexpr bool PERM = false, AFTER_DRAIN = false;
    const float* base0; const float* base1; int split; const float* gate; int ldg; float* out; int ldc;
    __device__ __forceinline__ void operator()(const f32x4 (&acc)[2][2][4][2], const Unit& u, int wr, int wc, int fr, int fq) const {
        const int row0 = u.pm * BM + wr * 64 + fr, col0 = u.pn * BM + wc * 32 + 4 * fq;
#pragma unroll
        for (int ai = 0; ai < 2; ++ai)
#pragma unroll
            for (int m = 0; m < 4; ++m) { const int r = row0 + ai * HALF + m * 16;
                const float* bp = (r < split ? base0 + (size_t)r * ldc : base1 + (size_t)(r - split) * ldc) + col0;
                const float* gp = gate + (size_t)row_gb(r) * ldg + col0; float* op = out + (size_t)r * ldc + col0;
#pragma unroll
                for (int bj = 0; bj < 2; ++bj)
#pragma unroll
                    for (int n = 0; n < 2; ++n) { const f32x4 bs = *(const f32x4*)(bp + bj * HALF + n * 16), g = *(const f32x4*)(gp + bj * HALF + n * 16);
                        *(f32x4*)(op + bj * HALF + n * 16) = bs + g * acc[ai][bj][m][n]; }
                if (m & 1) asm volatile("" ::: "memory"); }
    }
};

template <class Epi, class Sched, bool ALIGN_EPI = false, bool SP2 = false>
__device__ __forceinline__ void gemm_phase(PG8_LAS unsigned char* lds, const Gemm g, const Sched& S, const Epi& E) {
    const int tid = threadIdx.x, wid = __builtin_amdgcn_readfirstlane(tid >> 6), lane = tid & 63, wr = wid >> 2, wc = wid & 3, fr = lane & 15, fq = lane >> 4;
    const int K = g.K, nt = K / BK;
    unsigned voffA[2], voffB[2];
#pragma unroll
    for (int i = 0; i < 2; ++i) { int R, C; stage_rc(tid * 16 + i * 8192, R, C); const int Rb = Epi::PERM ? ((R & ~31) + perm32(R & 31)) : R;
        voffA[i] = (unsigned)(R * K + C) * 2u; voffB[i] = (unsigned)(Rb * K + C) * 2u; }
    const size_t kstep = (size_t)(BK * 2);
    const size_t hstep = (size_t)HALF * K * 2;
    const size_t tstep = 2 * hstep;
    const unsigned ldsw = (unsigned)wid * 1024u;
    const int aoff = lds_byte(wr * 64 + fr, fq * 8), boff = lds_byte(wc * 32 + fr, fq * 8);
#define PG8_SA(b, h) (((b) * 2 + (h)) * HTB)
#define PG8_SB(b, h) ((4 + (b) * 2 + (h)) * HTB)
#define PG8_STAGE(bufoff, gbase, voff) do { _Pragma("unroll") for (int _i = 0; _i < 2; ++_i) \
        __builtin_amdgcn_global_load_lds((const unsigned*)((const char*)(gbase) + (voff)[_i]), (PG8_LAS unsigned*)(lds + (bufoff) + ldsw + _i * 8192), 16, 0, 0); } while (0)
#define PG8_LDA(dst, b, h) do { _Pragma("unroll") for (int m = 0; m < 4; ++m) _Pragma("unroll") for (int k = 0; k < 2; ++k) dst[m][k] = *(const PG8_LAS bf16x8*)(lds + PG8_SA(b, h) + aoff + m * 2048 + k * 1024); } while (0)
#define PG8_LDB(dst, b, h) do { _Pragma("unroll") for (int n = 0; n < 2; ++n) _Pragma("unroll") for (int k = 0; k < 2; ++k) dst[n][k] = *(const PG8_LAS bf16x8*)(lds + PG8_SB(b, h) + boff + n * 2048 + k * 1024); } while (0)
#define PG8_MMA(ai, bj, At, Bt) do { __builtin_amdgcn_s_setprio(1); _Pragma("unroll") for (int m = 0; m < 4; ++m) _Pragma("unroll") for (int n = 0; n < 2; ++n) _Pragma("unroll") for (int k = 0; k < 2; ++k) \
        acc[ai][bj][m][n] = __builtin_amdgcn_mfma_f32_16x16x32_bf16(Bt[n][k], At[m][k], acc[ai][bj][m][n], 0, 0, 0); __builtin_amdgcn_s_setprio(0); } while (0)
#define PG8_WAIT_V(n) asm volatile("s_waitcnt vmcnt(" #n ")" ::: "memory")
#define PG8_WAIT_L(n) asm volatile("s_waitcnt lgkmcnt(" #n ")" ::: "memory")
#define PG8_BAR __builtin_amdgcn_s_barrier()
#define PG8_SCHED __builtin_amdgcn_sched_barrier(0)
    Unit cur, nxt; int ui = 0;
    if (!S.next(0, cur)) return;
    f32x4 acc[2][2][4][2];
#pragma unroll
    for (int a = 0; a < 2; ++a)
#pragma unroll
        for (int b = 0; b < 2; ++b)
#pragma unroll
            for (int m = 0; m < 4; ++m)
#pragma unroll
                for (int n = 0; n < 2; ++n) acc[a][b][m][n] = (f32x4){0.f, 0.f, 0.f, 0.f};
    bf16x8 At[4][2], B0[2][2], B1[2][2];
    const char* cA = (const char*)g.A + (size_t)cur.pm * tstep; const char* cB = (const char*)g.Bt + (size_t)cur.pn * tstep;
    S.a_ready(cur);
    if constexpr (SP2) {
        PG8_STAGE(PG8_SB(0, 0), cB, voffB); PG8_STAGE(PG8_SB(0, 1), cB + hstep, voffB); PG8_STAGE(PG8_SA(0, 0), cA, voffA); PG8_STAGE(PG8_SA(0, 1), cA + hstep, voffA);
        if (wr == 1) PG8_BAR;
        PG8_WAIT_V(2); PG8_BAR;
        PG8_STAGE(PG8_SB(1, 0), cB + kstep, voffB); PG8_STAGE(PG8_SA(1, 0), cA + kstep, voffA); PG8_STAGE(PG8_SB(1, 1), cB + hstep + kstep, voffB);
        PG8_WAIT_V(6); PG8_BAR;
    } else {
        PG8_STAGE(PG8_SB(0, 0), cB, voffB); PG8_STAGE(PG8_SA(0, 0), cA, voffA); PG8_STAGE(PG8_SB(0, 1), cB + hstep, voffB); PG8_STAGE(PG8_SA(0, 1), cA + hstep, voffA);
        if (wr == 1) PG8_BAR;
        PG8_WAIT_V(4); PG8_BAR;
        PG8_STAGE(PG8_SB(1, 0), cB + kstep, voffB); PG8_STAGE(PG8_SA(1, 0), cA + kstep, voffA); PG8_STAGE(PG8_SB(1, 1), cB + hstep + kstep, voffB);
        PG8_WAIT_V(6); PG8_BAR;
    }
    for (;;) {
        const bool has_next = S.next(ui + 1, nxt);
        const char* nA = has_next ? (const char*)g.A + (size_t)nxt.pm * tstep : cA; const char* nB = has_next ? (const char*)g.Bt + (size_t)nxt.pn * tstep : cB;
        for (int t = 0; t < nt; t += 2) {
            const bool last = (t == nt - 2);
            const char* a1 = cA + (size_t)(t + 1) * kstep;
            const char* a2 = last ? nA : cA + (size_t)(t + 2) * kstep; const char* b2 = last ? nB : cB + (size_t)(t + 2) * kstep;
            const char* a3 = a2 + kstep; const char* b3 = b2 + kstep;
            if (last && has_next) S.a_ready(nxt);
            if constexpr (SP2) {
            PG8_LDB(B0, 0, 0); PG8_LDB(B1, 0, 1); PG8_SCHED; PG8_LDA(At, 0, 0); PG8_STAGE(PG8_SA(1, 1), a1 + hstep, voffA);
            PG8_WAIT_V(8); PG8_WAIT_L(0); PG8_BAR; PG8_MMA(0, 0, At, B0); PG8_MMA(0, 1, At, B1); PG8_BAR; PG8_SCHED;
            PG8_LDA(At, 0, 1); PG8_STAGE(PG8_SB(0, 0), b2, voffB); PG8_STAGE(PG8_SB(0, 1), b2 + hstep, voffB); PG8_STAGE(PG8_SA(0, 0), a2, voffA);
            PG8_WAIT_V(8); PG8_WAIT_L(0); PG8_BAR; PG8_MMA(1, 0, At, B0); PG8_MMA(1, 1, At, B1); PG8_BAR; PG8_SCHED;
            PG8_LDB(B0, 1, 0); PG8_LDB(B1, 1, 1); PG8_SCHED; PG8_LDA(At, 1, 0); PG8_STAGE(PG8_SA(0, 1), a2 + hstep, voffA);
            PG8_WAIT_V(8); PG8_WAIT_L(0); PG8_BAR; PG8_MMA(0, 0, At, B0); PG8_MMA(0, 1, At, B1); PG8_BAR; PG8_SCHED;
            PG8_LDA(At, 1, 1); PG8_STAGE(PG8_SB(1, 0), b3, voffB); PG8_STAGE(PG8_SB(1, 1), b3 + hstep, voffB); PG8_STAGE(PG8_SA(1, 0), a3, voffA);
            PG8_WAIT_V(8); PG8_WAIT_L(0); PG8_BAR; PG8_MMA(1, 0, At, B0); PG8_MMA(1, 1, At, B1); PG8_BAR; PG8_SCHED;
            } else {
            PG8_LDB(B0, 0, 0); PG8_SCHED; PG8_LDA(At, 0, 0); PG8_STAGE(PG8_SA(1, 1), a1 + hstep, voffA);
            PG8_WAIT_L(8); PG8_BAR; PG8_WAIT_L(0); PG8_MMA(0, 0, At, B0); PG8_BAR; PG8_SCHED;
            PG8_LDB(B1, 0, 1); PG8_STAGE(PG8_SB(0, 0), b2, voffB);
            PG8_BAR; PG8_WAIT_L(0); PG8_MMA(0, 1, At, B1); PG8_BAR;
            PG8_LDA(At, 0, 1); PG8_STAGE(PG8_SA(0, 0), a2, voffA);
            PG8_BAR; PG8_WAIT_L(0); PG8_MMA(1, 0, At, B0); PG8_BAR; PG8_SCHED;
            PG8_STAGE(PG8_SB(0, 1), b2 + hstep, voffB);
            PG8_WAIT_V(6); PG8_BAR; PG8_MMA(1, 1, At, B1); PG8_BAR;
            PG8_LDB(B0, 1, 0); PG8_SCHED; PG8_LDA(At, 1, 0); PG8_STAGE(PG8_SA(0, 1), a2 + hstep, voffA);
            PG8_WAIT_L(8); PG8_BAR; PG8_WAIT_L(0); PG8_MMA(0, 0, At, B0); PG8_BAR; PG8_SCHED;
            PG8_LDB(B1, 1, 1); PG8_STAGE(PG8_SB(1, 0), b3, voffB);
            PG8_BAR; PG8_WAIT_L(0); PG8_MMA(0, 1, At, B1); PG8_BAR;
            PG8_LDA(At, 1, 1); PG8_STAGE(PG8_SA(1, 0), a3, voffA);
            PG8_BAR; PG8_WAIT_L(0); PG8_MMA(1, 0, At, B0); PG8_BAR; PG8_SCHED;
            PG8_STAGE(PG8_SB(1, 1), b3 + hstep, voffB);
            PG8_WAIT_V(6); PG8_BAR; PG8_MMA(1, 1, At, B1); PG8_BAR;
            }
        }
        if constexpr (ALIGN_EPI) { if (wr == 0) PG8_BAR; }
        if constexpr (!Epi::AFTER_DRAIN) { E(acc, cur, wr, wc, fr, fq); S.done(cur); }
        if (!has_next) break;
#pragma unroll
        for (int a = 0; a < 2; ++a)
#pragma unroll
            for (int b = 0; b < 2; ++b)
#pragma unroll
                for (int m = 0; m < 4; ++m)
#pragma unroll
                    for (int n = 0; n < 2; ++n) acc[a][b][m][n] = (f32x4){0.f, 0.f, 0.f, 0.f};
        cur = nxt; cA = nA; cB = nB; ++ui;
        if constexpr (ALIGN_EPI) { if (wr == 1) PG8_BAR; }
    }
    PG8_WAIT_V(0);
    if constexpr (!ALIGN_EPI) { if (wr == 0) PG8_BAR; }
    PG8_BAR;
    if constexpr (Epi::AFTER_DRAIN) { E.fused(acc, cur, wr, wc, fr, fq, lds, wid, lane); S.done(cur); }
#undef PG8_SA
#undef PG8_SB
#undef PG8_STAGE
#undef PG8_LDA
#undef PG8_LDB
#undef PG8_MMA
#undef PG8_WAIT_V
#undef PG8_WAIT_L
#undef PG8_BAR
#undef PG8_SCHED
}
}

constexpr int RING_OFF = 0, RING_BYTES = 131072;
constexpr int LDSCTL_OFF = RING_BYTES, MISC_OFF = LDSCTL_OFF + 320;
constexpr int LDS_BYTES = 147456;

typedef GAS unsigned gu32;
#define RLX_AGENT __ATOMIC_RELAXED, __HIP_MEMORY_SCOPE_AGENT
#define LDS_WAIT() asm volatile("s_waitcnt lgkmcnt(0)" ::: "memory")
#define VM_WAIT() asm volatile("s_waitcnt vmcnt(0)" ::: "memory")

#define XB_TMO      128
#define XB_XCNT(j)  (256  + 64 * (j))
#define XB_XSUB(j)  (1280 + 64 * (j))
#define XB_XGEN(j)  (2304 + 64 * (j))
#define XB_TOP      3328
#define XB_TOPGEN   3392
#define XCD_BAR_WORDS 3456
#define XB_SPIN_CAP (1u << 18)
__device__ __forceinline__ unsigned xb_ld(unsigned* p)              { return __hip_atomic_load(p, __ATOMIC_RELAXED, __HIP_MEMORY_SCOPE_AGENT); }
__device__ __forceinline__ unsigned xb_add(unsigned* p, unsigned v) { return __hip_atomic_fetch_add(p, v, __ATOMIC_RELAXED, __HIP_MEMORY_SCOPE_AGENT); }
__device__ __forceinline__ unsigned xb_xcc_id() { return (unsigned)__builtin_amdgcn_s_getreg((3 << 11) | 20) & 0xFu; }
#define XB_SPIN(cond, bar) do { unsigned _sp = 0; while (cond) { __builtin_amdgcn_s_sleep(1); \
    if ((++_sp & 255u) == 0u) { if (xb_ld(&(bar)[XB_TMO])) break; if (_sp > XB_SPIN_CAP) { atomicAdd(&(bar)[XB_TMO], 1u); break; } } } } while (0)
struct XcdBarrier { unsigned* bar; unsigned x; volatile LAS unsigned* st; };
__device__ __forceinline__ XcdBarrier xcd_barrier_post(unsigned* bar, volatile LAS unsigned* st) {
    XcdBarrier b; b.bar = bar; b.x = xb_xcc_id(); b.st = st;
    if (threadIdx.x == 0) (void)xb_add(&bar[XB_XCNT(b.x)], 1u);
    return b;
}
__device__ __forceinline__ void xcd_barrier_complete(unsigned* bar, unsigned x, unsigned& nloc, unsigned& nx) {
    const unsigned G = gridDim.x * gridDim.y * gridDim.z;
    unsigned sum, cnt, mine, sp = 0u;
    for (;;) {
        sum = 0u; cnt = 0u; mine = 0u;
#pragma unroll
        for (unsigned j = 0; j < 16; ++j) { const unsigned c = xb_ld(&bar[XB_XCNT(j)]); sum += c; cnt += (c > 0u) ? 1u : 0u; mine = (j == x) ? c : mine; }
        if (sum == G) break;
        __builtin_amdgcn_s_sleep(1);
        if ((++sp & 255u) == 0u) { if (xb_ld(&bar[XB_TMO])) break; if (sp > XB_SPIN_CAP) { atomicAdd(&bar[XB_TMO], 1u); break; } }
    }
    nloc = mine > 0u ? mine : 1u; nx = cnt > 0u ? cnt : 1u;
}
__device__ __forceinline__ void xcd_barrier(const XcdBarrier& b) {
    asm volatile("s_waitcnt vmcnt(0)" ::: "memory");
    __syncthreads();
    if (threadIdx.x == 0) {
        unsigned* bar = b.bar;
        __builtin_amdgcn_s_waitcnt(0);
        unsigned nloc = b.st[0], nx = b.st[1];
        if (nloc == 0u) { xcd_barrier_complete(bar, b.x, nloc, nx); b.st[0] = nloc; b.st[1] = nx; }
        const unsigned old = xb_add(&bar[XB_XSUB(b.x)], 1u);
        const unsigned gen = old / nloc;
        if (old + 1u == (gen + 1u) * nloc) {
            __builtin_amdgcn_fence(__ATOMIC_RELEASE, "agent");
            asm volatile("s_waitcnt vmcnt(0)" ::: "memory");
            const unsigned og = xb_add(&bar[XB_TOP], 1u);
            const unsigned tg = og / nx;
            if (og + 1u == (tg + 1u) * nx) xb_add(&bar[XB_TOPGEN], 1u);
            else XB_SPIN(xb_ld(&bar[XB_TOPGEN]) == tg, bar);
            __builtin_amdgcn_fence(__ATOMIC_ACQUIRE, "agent");
            xb_add(&bar[XB_XGEN(b.x)], 1u);
            asm volatile("s_waitcnt vmcnt(0)" ::: "memory");
        } else {
            XB_SPIN(xb_ld(&bar[XB_XGEN(b.x)]) == gen, bar);
            __builtin_amdgcn_fence(__ATOMIC_ACQUIRE, "agent");
            asm volatile("s_waitcnt vmcnt(0)" ::: "memory");
        }
    }
    __syncthreads();
}

struct Frame {
    LAS unsigned char* lds;
    int tid, lane, wave, gw, ngw;
    const float *xp, *xs, *stC, *stN, *stM, *stS, *stConv, *cp, *cs, *ada_w, *ada_b, *norm1, *w_in, *gate_b, *mlstm_g, *conv_w, *A_log, *dt_bias, *gdn_g,
                *w_out, *norm2, *w_up, *w_down, *adaf_w, *adaf_b, *normf;
    float* out;
    bf16_t *SCB, *WIN, *WOUT, *WUP, *WDOWN, *HB, *MIX, *PROJ;
    float *MOD, *MODF, *GATES, *X1;
};
__device__ __forceinline__ const float* xrow(const Frame& F, int r) { return r < M_P ? F.xp + (size_t)r * D : F.xs + (size_t)(r - M_P) * D; }

__device__ __forceinline__ void p0_silu(Frame& F) {
    const int gt = blockIdx.x * NTHREADS + F.tid, GT = gridDim.x * NTHREADS;
    for (int g = gt; g < 160 * 256; g += GT) {
        const int row = g >> 8, c8 = (g & 255) * 8; u32x4 o = (u32x4){0u, 0u, 0u, 0u};
        if (row < NGB) { const float* src = (row < NB_P ? F.cp + (size_t)row * D : F.cs + (size_t)(row - NB_P) * D) + c8;
            const f32x4 a = *(const f32x4*)src, b = *(const f32x4*)(src + 4);
            o.x = pk2(siluf_(a.x), siluf_(a.y)); o.y = pk2(siluf_(a.z), siluf_(a.w)); o.z = pk2(siluf_(b.x), siluf_(b.y)); o.w = pk2(siluf_(b.z), siluf_(b.w)); }
        *(u32x4*)(F.SCB + (size_t)row * D + c8) = o;
    }
}

__device__ __forceinline__ void p1_modgemv(Frame& F) {
    LAS float* red = (LAS float*)(F.lds + RING_OFF);
    const int lane = F.lane, r = lane & 31, hh = lane >> 5, cbi = F.wave >> 2, ks = F.wave & 3;
    for (int pair = blockIdx.x; pair < 256; pair += gridDim.x) {
        const int cb = 2 * pair + cbi;
        const float* W; const float* bias; float* outp; int ldw, n0;
        if (cb < 384) { W = F.ada_w; ldw = MODW; n0 = cb * 32; bias = F.ada_b; outp = F.MOD; }
        else { W = F.adaf_w; ldw = MODFW; n0 = (cb - 384) * 32; bias = F.adaf_b; outp = F.MODF; }
        f32x16 acc[5];
#pragma unroll
        for (int g = 0; g < 5; ++g)
#pragma unroll
            for (int i = 0; i < 16; ++i) acc[g][i] = 0.f;
        const float* wp = W + (size_t)(ks * 512 + 8 * hh) * ldw + n0 + r;
        const bf16_t* ap = F.SCB + (size_t)r * D + ks * 512 + 8 * hh;
        for (int s = 0; s < 32; s += 4) {
            float wv[4][8];
#pragma unroll
            for (int u = 0; u < 4; ++u)
#pragma unroll
                for (int j = 0; j < 8; ++j) wv[u][j] = wp[(size_t)((s + u) * 16 + j) * ldw];
#pragma unroll
            for (int u = 0; u < 4; ++u) {
                u32x4 bw; bw.x = pk2(wv[u][0], wv[u][1]); bw.y = pk2(wv[u][2], wv[u][3]); bw.z = pk2(wv[u][4], wv[u][5]); bw.w = pk2(wv[u][6], wv[u][7]);
                const bf16x8 b = __builtin_bit_cast(bf16x8, bw);
#pragma unroll
                for (int g = 0; g < 5; ++g) { const bf16x8 a = *(const bf16x8*)(ap + (size_t)g * 32 * D + (s + u) * 16);
                    acc[g] = __builtin_amdgcn_mfma_f32_32x32x16_bf16(a, b, acc[g], 0, 0, 0); }
            }
        }
        if (ks > 0) {
#pragma unroll
            for (int g = 0; g < 5; ++g)
#pragma unroll
                for (int i = 0; i < 16; ++i) red[(((ks - 1) * 2 + cbi) * 80 + g * 16 + i) * 64 + lane] = acc[g][i];
        }
        __syncthreads();
        if (ks == 0) {
            const float bv = bias[n0 + r];
#pragma unroll
            for (int g = 0; g < 5; ++g)
#pragma unroll
                for (int i = 0; i < 16; ++i) {
                    float v = acc[g][i];
#pragma unroll
                    for (int k2 = 0; k2 < 3; ++k2) v += red[((k2 * 2 + cbi) * 80 + g * 16 + i) * 64 + lane];
                    const int gb = 32 * g + (i & 3) + 8 * (i >> 2) + 4 * hh;
                    if (gb < NGB) outp[(size_t)gb * ldw + n0 + r] = v + bv;
                }
        }
        __syncthreads();
    }
}

__device__ __forceinline__ int win_dst_row(int n) {
    if (n < 3072) return n;
    if (n < 3088) return 8192 + (n - 3072);
    if (n < 7184) return n - 16;
    if (n < 7200) return 8208 + (n - 7184);
    return n - 32;
}
template <bool MAPWIN>
__device__ __forceinline__ void transpose_item(const float* W, int K, int N, bf16_t* WT, LAS float* scr, int item, int lane) {
    const int nblk = N / 32, kb = item / nblk, nb = item % nblk, k0 = 64 * kb, n0 = 32 * nb;
#pragma unroll 8
    for (int i = 0; i < 32; ++i) { const int kk = 2 * i + (lane >> 5); scr[kk * 33 + (lane & 31)] = W[(size_t)(k0 + kk) * N + n0 + (lane & 31)]; }
    LDS_WAIT(); asm volatile("" ::: "memory");
    const int c = lane & 7;
#pragma unroll
    for (int j = 0; j < 4; ++j) { const int n = (lane >> 3) + 8 * j; const LAS float* s = scr + (8 * c) * 33 + n;
        u32x4 o; o.x = pk2(s[0 * 33], s[1 * 33]); o.y = pk2(s[2 * 33], s[3 * 33]); o.z = pk2(s[4 * 33], s[5 * 33]); o.w = pk2(s[6 * 33], s[7 * 33]);
        const int dr = MAPWIN ? win_dst_row(n0 + n) : (n0 + n);
        *(u32x4*)(WT + (size_t)dr * K + k0 + 8 * c) = o; }
    LDS_WAIT(); asm volatile("" ::: "memory");
}
__device__ __forceinline__ void p1_transposes(Frame& F) {
    LAS float* scr = (LAS float*)(F.lds + RING_OFF + F.wave * 16384);
    constexpr int I_IN = (D / 64) * (P_IN / 32), I_OUT = (D / 64) * (D / 32), I_UP = (D / 64) * (DFF / 32), I_DOWN = (DFF / 64) * (D / 32);
    constexpr int NITEMS = I_IN + I_OUT + I_UP + I_DOWN;
    for (int it = F.gw; it < NITEMS; it += F.ngw) {
        int r = it;
        if (r < I_IN) { transpose_item<true>(F.w_in, D, P_IN, F.WIN, scr, r, F.lane); continue; } r -= I_IN;
        if (r < I_OUT) { transpose_item<false>(F.w_out, D, D, F.WOUT, scr, r, F.lane); continue; } r -= I_OUT;
        if (r < I_UP) { transpose_item<false>(F.w_up, D, DFF, F.WUP, scr, r, F.lane); continue; } r -= I_UP;
        transpose_item<false>(F.w_down, DFF, D, F.WDOWN, scr, r, F.lane);
    }
}

__device__ __forceinline__ void norm_mod_row_bf16(const float* xr_, const float* g, const float* shift, const float* scale, bf16_t* orow, int lane) {
    const f32x4* xr = (const f32x4*)xr_ + lane;
    f32x4 v[8]; float s = 0.f;
#pragma unroll
    for (int j = 0; j < 8; ++j) { v[j] = xr[64 * j]; s += (v[j].x * v[j].x + v[j].y * v[j].y) + (v[j].z * v[j].z + v[j].w * v[j].w); }
    const float rstd = 1.0f / sqrtf(wave_sum(s) * (1.0f / D) + EPS);
    u32x2* o8 = (u32x2*)orow + lane;
#pragma unroll
    for (int j = 0; j < 8; ++j) { const f32x4 gg = ((const f32x4*)g)[lane + 64 * j], sh = ((const f32x4*)shift)[lane + 64 * j], sc = ((const f32x4*)scale)[lane + 64 * j];
        const f32x4 y = (v[j] * rstd * gg) * (sc + 1.0f) + sh; u32x2 w; w.x = pk2(y.x, y.y); w.y = pk2(y.z, y.w); o8[64 * j] = w; }
}
__device__ __forceinline__ void norm_mod_row_f32(const float* xr_, const float* g, const float* shift, const float* scale, float* orow, int lane) {
    const f32x4* xr = (const f32x4*)xr_ + lane;
    f32x4 v[8]; float s = 0.f;
#pragma unroll
    for (int j = 0; j < 8; ++j) { v[j] = xr[64 * j]; s += (v[j].x * v[j].x + v[j].y * v[j].y) + (v[j].z * v[j].z + v[j].w * v[j].w); }
    const float rstd = 1.0f / sqrtf(wave_sum(s) * (1.0f / D) + EPS);
    f32x4* o = (f32x4*)orow + lane;
#pragma unroll
    for (int j = 0; j < 8; ++j) { const f32x4 gg = ((const f32x4*)g)[lane + 64 * j], sh = ((const f32x4*)shift)[lane + 64 * j], sc = ((const f32x4*)scale)[lane + 64 * j];
        o[64 * j] = (v[j] * rstd * gg) * (sc + 1.0f) + sh; }
}

__device__ __forceinline__ void p3_gates(Frame& F) {
    const int lane = F.lane, fr = lane & 15, fq = lane >> 4;
    for (int task = F.gw; task < M / 16; task += F.ngw) {
        const int r0 = task * 16;
        const bf16_t* ap = F.HB + (size_t)(r0 + fr) * D + 8 * fq;
        const bf16_t* bp = F.WIN + (size_t)(NPROJ + fr) * D + 8 * fq;
        f32x4 c0 = (f32x4){0.f, 0.f, 0.f, 0.f}, c1 = c0;
#pragma unroll 8
        for (int k0 = 0; k0 < D; k0 += 32) {
            const bf16x8 a = *(const bf16x8*)(ap + k0), b0 = *(const bf16x8*)(bp + k0), b1 = *(const bf16x8*)(bp + (size_t)16 * D + k0);
            c0 = __builtin_amdgcn_mfma_f32_16x16x32_bf16(a, b0, c0, 0, 0, 0);
            c1 = __builtin_amdgcn_mfma_f32_16x16x32_bf16(a, b1, c1, 0, 0, 0);
        }
#pragma unroll
        for (int i = 0; i < 4; ++i) { float* o = F.GATES + (size_t)(r0 + 4 * fq + i) * NGATE + fr; o[0] = c0[i]; o[16] = c1[i]; }
    }
}

__device__ __forceinline__ void scan_mlstm_simple(Frame& F, bool prompt, int b, int hd) {
    LAS float* sq = (LAS float*)(F.lds + RING_OFF); LAS float* sk = sq + 128; LAS float* sv = sk + 128; LAS float* spart = sv + 128; LAS float* sred = spart + 512; LAS float* sred2 = sred + 8;
    const int tid = F.tid, e = tid & 127, q4 = tid >> 7, lane = F.lane, wave = F.wave;
    const int T = prompt ? T_P : T_S, row0 = prompt ? b * T_P : M_P + b * T_S, bh = b * NH + hd;
    float C[32]; float nst = 0.f, m = 0.f;
    if (prompt) {
#pragma unroll
        for (int dd = 0; dd < 32; ++dd) C[dd] = 0.f;
    } else {
#pragma unroll
        for (int dd = 0; dd < 32; ++dd) C[dd] = F.stC[((size_t)bh * HD + 32 * q4 + dd) * HD + e];
        if (tid < 128) nst = F.stN[(size_t)bh * HD + tid];
        m = F.stM[bh];
    }
    const float bi = F.gate_b[hd], bfg = F.gate_b[NH + hd], gn = F.mlstm_g[hd * HD + e];
    for (int t = 0; t < T; ++t) {
        const int row = row0 + t; const bf16_t* pr = F.PROJ + (size_t)row * NPROJ + hd * HD;
        float oa = 0.f;
        if (tid < 128) { sq[tid] = bf2f(pr[tid]); sk[tid] = bf2f(pr[1024 + tid]) * 0.08838834764831845f; sv[tid] = bf2f(pr[2048 + tid]); oa = bf2f(pr[3072 + tid]); }
        const float ia = F.GATES[(size_t)row * NGATE + hd], fa = F.GATES[(size_t)row * NGATE + 8 + hd];
        __syncthreads();
        const float li = ia + bi, lf = logsigmoidf_(fa + bfg);
        const float mn = fmaxf(lf + m, li), fdec = expf(lf + m - mn), iin = expf(li - mn); m = mn;
        const float ve = sv[e]; float part = 0.f;
#pragma unroll
        for (int dd = 0; dd < 32; ++dd) { const int d = 32 * q4 + dd; C[dd] = fdec * C[dd] + (iin * sk[d]) * ve; part += sq[d] * C[dd]; }
        spart[q4 * 128 + e] = part;
        if (tid < 128) { nst = fdec * nst + iin * sk[tid]; const float pn = wave_sum(sq[tid] * nst); if (lane == 0) sred[wave] = pn; }
        __syncthreads();
        const float numer = (spart[e] + spart[128 + e]) + (spart[256 + e] + spart[384 + e]);
        const float ddn = sred[0] + sred[1];
        const float hval = numer / fmaxf(fabsf(ddn), expf(-m));
        const float ss = wave_sum(hval * hval);
        if (lane == 0) sred2[wave] = ss;
        __syncthreads();
        const float tot = sred2[wave] + sred2[wave ^ 1];
        if (tid < 128) { const float y = hval * (1.0f / sqrtf(tot * (1.0f / HD) + EPS)) * gn * sigmoidf_(oa); F.MIX[(size_t)row * D + hd * HD + e] = (bf16_t)f2bf(y); }
    }
    float* oC = F.out + (prompt ? O_PC : O_SC) + (size_t)bh * HD * HD;
#pragma unroll
    for (int dd = 0; dd < 32; ++dd) oC[(size_t)(32 * q4 + dd) * HD + e] = C[dd];
    if (tid < 128) F.out[(prompt ? O_PN : O_SN) + (size_t)bh * HD + tid] = nst;
    if (tid == 0) F.out[(prompt ? O_PM : O_SM) + bh] = m;
    __syncthreads();
}
__device__ __forceinline__ void scan_gdn_simple(Frame& F, bool prompt, int b, int hd) {
    LAS float* sq = (LAS float*)(F.lds + RING_OFF); LAS float* sk = sq + 128; LAS float* sv = sk + 128; LAS float* spart = sv + 128; LAS float* spart2 = spart + 512; LAS float* sred = spart2 + 512; LAS float* sred2 = sred + 8;
    const int tid = F.tid, e = tid & 127, q4 = tid >> 7, lane = F.lane, wave = F.wave;
    const int T = prompt ? T_P : T_S, row0 = prompt ? b * T_P : M_P + b * T_S, bh = b * NH + hd;
    float S[32];
    if (prompt) {
#pragma unroll
        for (int dd = 0; dd < 32; ++dd) S[dd] = 0.f;
    } else {
#pragma unroll
        for (int dd = 0; dd < 32; ++dd) S[dd] = F.stS[((size_t)bh * HD + 32 * q4 + dd) * HD + e];
    }
    const int cch = (q4 < 3 ? q4 : 0) * 1024 + hd * HD + e;
    float h0 = 0.f, h1 = 0.f, h2 = 0.f;
    if (!prompt && q4 < 3) { const float* cv = F.stConv + (size_t)b * 3 * CCONV + cch; h0 = cv[0]; h1 = cv[CCONV]; h2 = cv[2 * CCONV]; }
    const float w0 = F.conv_w[cch], w1 = F.conv_w[CCONV + cch], w2 = F.conv_w[2 * CCONV + cch], w3 = F.conv_w[3 * CCONV + cch];
    const float negA = -expf(F.A_log[hd]), dtb = F.dt_bias[hd], gn = F.gdn_g[hd * HD + e];
    for (int t = 0; t < T; ++t) {
        const int row = row0 + t; const bf16_t* pr = F.PROJ + (size_t)row * NPROJ + 4096;
        float a = 0.f, zb = 0.f;
        if (q4 < 3) { const float u = bf2f(pr[cch]); const float cvv = w0 * h0 + w1 * h1 + w2 * h2 + w3 * u; h0 = h1; h1 = h2; h2 = u; a = siluf_(cvv); }
        if (q4 == 0) zb = bf2f(pr[3072 + hd * HD + e]);
        if (q4 < 2) { const float ss = wave_sum(a * a); if (lane == 0) sred[wave] = ss; }
        if (q4 == 2) sv[e] = a;
        const float ab = F.GATES[(size_t)row * NGATE + 16 + hd], bb = F.GATES[(size_t)row * NGATE + 24 + hd];
        __syncthreads();
        if (q4 == 0) sq[e] = a * (1.0f / sqrtf(sred[0] + sred[1] + EPS)) * 0.08838834764831845f;
        if (q4 == 1) sk[e] = a * (1.0f / sqrtf(sred[2] + sred[3] + EPS));
        __syncthreads();
        const float g = expf(negA * softplusf_(ab + dtb)), beta = sigmoidf_(bb);
        float part = 0.f;
#pragma unroll
        for (int dd = 0; dd < 32; ++dd) part += sk[32 * q4 + dd] * S[dd];
        spart[q4 * 128 + e] = part;
        __syncthreads();
        const float kS = (spart[e] + spart[128 + e]) + (spart[256 + e] + spart[384 + e]);
        const float ue = beta * (sv[e] - g * kS);
        float opart = 0.f;
#pragma unroll
        for (int dd = 0; dd < 32; ++dd) { const int d = 32 * q4 + dd; S[dd] = g * S[dd] + sk[d] * ue; opart += sq[d] * S[dd]; }
        spart2[q4 * 128 + e] = opart;
        __syncthreads();
        const float o = (spart2[e] + spart2[128 + e]) + (spart2[256 + e] + spart2[384 + e]);
        const float ss2 = wave_sum(o * o);
        if (lane == 0) sred2[wave] = ss2;
        __syncthreads();
        const float tot = sred2[wave] + sred2[wave ^ 1];
        if (q4 == 0) { const float y = o * (1.0f / sqrtf(tot * (1.0f / HD) + EPS)) * gn * siluf_(zb); F.MIX[(size_t)row * D + 1024 + hd * HD + e] = (bf16_t)f2bf(y); }
    }
    float* oS = F.out + (prompt ? O_PS : O_SS) + (size_t)bh * HD * HD;
#pragma unroll
    for (int dd = 0; dd < 32; ++dd) oS[(size_t)(32 * q4 + dd) * HD + e] = S[dd];
    if (q4 < 3) { float* oc = F.out + (prompt ? O_PCONV : O_SCONV) + (size_t)b * 3 * CCONV + cch; oc[0] = h0; oc[CCONV] = h1; oc[2 * CCONV] = h2; }
    __syncthreads();
}
__device__ __forceinline__ void p4_scan_simple(Frame& F) {
    const int w = blockIdx.x;
    if (w < 64) { const int mixer = w >> 5, b = (w & 31) >> 3, hd = w & 7; if (mixer == 0) scan_mlstm_simple(F, true, b, hd); else scan_gdn_simple(F, true, b, hd); }
    else { for (int idx = w - 64; idx < 2048; idx += (int)gridDim.x - 64) { const int mixer = idx >> 10, b = (idx & 1023) >> 3, hd = idx & 7;
            if (mixer == 0) scan_mlstm_simple(F, false, b, hd); else scan_gdn_simple(F, false, b, hd); } }
}

struct Args { const float* in[26]; float* out; unsigned char* ws; int ph_lo, ph_hi; };
constexpr int NPHASE = 10;
__global__ void __launch_bounds__(NTHREADS, 2) fwd_kernel(Args args) {
    extern __shared__ __attribute__((aligned(16))) unsigned char lds[];
    Frame F;
    F.lds = (LAS unsigned char*)lds;
    F.tid = threadIdx.x; F.lane = F.tid & 63; F.wave = __builtin_amdgcn_readfirstlane(F.tid >> 6);
    F.gw = blockIdx.x * NWAVES + F.wave; F.ngw = gridDim.x * NWAVES;
    F.xp = args.in[0]; F.xs = args.in[1]; F.stC = args.in[2]; F.stN = args.in[3]; F.stM = args.in[4]; F.stS = args.in[5]; F.stConv = args.in[6]; F.cp = args.in[7]; F.cs = args.in[8];
    F.ada_w = args.in[9]; F.ada_b = args.in[10]; F.norm1 = args.in[11]; F.w_in = args.in[12]; F.gate_b = args.in[13]; F.mlstm_g = args.in[14]; F.conv_w = args.in[15]; F.A_log = args.in[16];
    F.dt_bias = args.in[17]; F.gdn_g = args.in[18]; F.w_out = args.in[19]; F.norm2 = args.in[20]; F.w_up = args.in[21]; F.w_down = args.in[22]; F.adaf_w = args.in[23]; F.adaf_b = args.in[24]; F.normf = args.in[25];
    F.out = args.out;
    unsigned char* ws = args.ws;
    F.SCB = (bf16_t*)(ws + WS_SCB); F.WIN = (bf16_t*)(ws + WS_WIN); F.WOUT = (bf16_t*)(ws + WS_WOUT); F.WUP = (bf16_t*)(ws + WS_WUP); F.WDOWN = (bf16_t*)(ws + WS_WDOWN);
    F.HB = (bf16_t*)(ws + WS_HB); F.MIX = (bf16_t*)(ws + WS_MIX); F.PROJ = (bf16_t*)(ws + WS_PROJ);
    F.MOD = (float*)(ws + WS_MOD); F.MODF = (float*)(ws + WS_MODF); F.GATES = (float*)(ws + WS_GATES); F.X1 = (float*)(ws + WS_X1);

    for (int u = F.tid; u < (LDS_BYTES - LDSCTL_OFF) / 4; u += NTHREADS) ((LAS unsigned*)(F.lds + LDSCTL_OFF))[u] = 0u;
    __syncthreads();
    XcdBarrier bar; bar.bar = (unsigned*)(ws + WS_CTL) + CW_BAR; bar.x = 0; bar.st = nullptr;
#if MK_ONE_LAUNCH
    bar = xcd_barrier_post((unsigned*)(ws + WS_CTL) + CW_BAR, (volatile LAS unsigned*)(F.lds + MISC_OFF) + 8);
#define GRID_BAR() xcd_barrier(bar)
#else
#define GRID_BAR() do { } while (0)
#endif
    const int lo = args.ph_lo, hi = args.ph_hi;
#define IN(k) (lo <= (k) && (k) < hi)
#define BOTH(k) (IN(k) && IN((k) + 1))

    if (IN(0)) { p0_silu(F); if (BOTH(0)) GRID_BAR(); }
    if (IN(1)) { p1_modgemv(F); p1_transposes(F); if (BOTH(1)) GRID_BAR(); }
    if (IN(2)) {
        for (int r = F.gw; r < M; r += F.ngw) { const float* md = F.MOD + (size_t)row_gb(r) * MODW; norm_mod_row_bf16(xrow(F, r), F.norm1, md, md + D, F.HB + (size_t)r * D, F.lane); }
        if (BOTH(2)) GRID_BAR();
    }
    if (IN(3)) {
        p3_gates(F);
        asm volatile("s_waitcnt vmcnt(0) lgkmcnt(0)" ::: "memory"); __syncthreads();
        pg8::Gemm g{F.HB, F.WIN, M, NPROJ, D}; pg8::StaticOrder S; S.init(M, NPROJ, gridDim.x, (int)blockIdx.x);
        pg8::EpiBf16<0> E{F.PROJ, NPROJ};
        pg8::gemm_phase<pg8::EpiBf16<0>, pg8::StaticOrder, true, true>(F.lds + RING_OFF, g, S, E);
        if (BOTH(3)) GRID_BAR();
    }
    if (IN(4)) { p4_scan_simple(F); if (BOTH(4)) GRID_BAR(); }
    if (IN(5)) {
        pg8::Gemm g{F.MIX, F.WOUT, M, D, D}; pg8::StaticOrder S; S.init(M, D, gridDim.x, (int)blockIdx.x);
        pg8::EpiRes E{F.xp, F.xs, M_P, F.MOD + 2 * D, MODW, F.X1, D};
        pg8::gemm_phase<pg8::EpiRes, pg8::StaticOrder, true, true>(F.lds + RING_OFF, g, S, E);
        if (BOTH(5)) GRID_BAR();
    }
    if (IN(6)) {
        for (int r = F.gw; r < M; r += F.ngw) { const float* md = F.MOD + (size_t)row_gb(r) * MODW; norm_mod_row_bf16(F.X1 + (size_t)r * D, F.norm2, md + 3 * D, md + 4 * D, F.HB + (size_t)r * D, F.lane); }
        if (BOTH(6)) GRID_BAR();
    }
    if (IN(7)) {
        pg8::Gemm g{F.HB, F.WUP, M, DFF, D}; pg8::StaticOrder S; S.init(M, DFF, gridDim.x, (int)blockIdx.x);
        pg8::EpiBf16<1> E{F.PROJ, DFF};
        pg8::gemm_phase<pg8::EpiBf16<1>, pg8::StaticOrder, true, true>(F.lds + RING_OFF, g, S, E);
        if (BOTH(7)) GRID_BAR();
    }
    if (IN(8)) {
        pg8::Gemm g{F.PROJ, F.WDOWN, M, D, DFF}; pg8::StaticOrder S; S.init(M, D, gridDim.x, (int)blockIdx.x);
        pg8::EpiRes E{F.X1, F.X1, M, F.MOD + 5 * D, MODW, F.out + O_Y, D};
        pg8::gemm_phase<pg8::EpiRes, pg8::StaticOrder, true, true>(F.lds + RING_OFF, g, S, E);
        if (BOTH(8)) GRID_BAR();
    }
    if (IN(9)) {
        for (int r = F.gw; r < M; r += F.ngw) { const float* md = F.MODF + (size_t)row_gb(r) * MODFW; float* yr = F.out + O_Y + (size_t)r * D; norm_mod_row_f32(yr, F.normf, md, md + D, yr, F.lane); }
    }
#undef IN
#undef BOTH
}

extern "C" void kernel_launch(void* const* d_in, const int* in_sizes, int n_in, void* d_out, int out_size, void* d_ws, size_t ws_size, hipStream_t stream) {
    static int ok = 0;
    if (ok == 0) {
        if (n_in != 26 || (size_t)out_size != O_END || ws_size < WS_END) { fprintf(stderr, "kernel_launch: unexpected shapes: n_in %d out %d ws %zu\n", n_in, out_size, ws_size); ok = -1; return; }
        if (hipFuncSetAttribute((const void*)fwd_kernel, hipFuncAttributeMaxDynamicSharedMemorySize, LDS_BYTES) != hipSuccess) { fprintf(stderr, "kernel_launch: hipFuncSetAttribute failed\n"); ok = -1; return; }
        int dev = 0, cus = 0, per_cu = 0;
        (void)hipGetDevice(&dev); (void)hipDeviceGetAttribute(&cus, hipDeviceAttributeMultiprocessorCount, dev);
        (void)hipOccupancyMaxActiveBlocksPerMultiprocessor(&per_cu, (const void*)fwd_kernel, NTHREADS, LDS_BYTES);
        if (cus != GRID || per_cu < 1) fprintf(stderr, "kernel_launch: note: %d CUs, %d blocks/CU reported; launching %d workgroups\n", cus, per_cu, GRID);
        (void)hipGetLastError();
        ok = 1;
    }
    if (ok < 0) return;
    (void)hipMemsetAsync((char*)d_ws + WS_CTL, 0, CTL_ZERO_BYTES, stream);
    Args a{};
    for (int i = 0; i < 26; ++i) a.in[i] = (const float*)d_in[i];
    a.out = (float*)d_out; a.ws = (unsigned char*)d_ws;
#if MK_ONE_LAUNCH
    a.ph_lo = 0; a.ph_hi = NPHASE;
    hipLaunchKernelGGL(fwd_kernel, dim3(GRID), dim3(NTHREADS), LDS_BYTES, stream, a);
#else
    for (int p = 0; p < NPHASE; ++p) { a.ph_lo = p; a.ph_hi = p + 1; hipLaunchKernelGGL(fwd_kernel, dim3(GRID), dim3(NTHREADS), LDS_BYTES, stream, a); }
#endif
}
```

```cpp
#include <hip/hip_runtime.h>
#include <cstdio>
#include <cstdint>

#define LAS __attribute__((address_space(3)))
#define GAS __attribute__((address_space(1)))
typedef unsigned short bf16_t;
typedef short bf16x8 __attribute__((ext_vector_type(8)));
typedef float f32x4 __attribute__((ext_vector_type(4)));
typedef float f32x2 __attribute__((ext_vector_type(2)));
typedef float f32x16 __attribute__((ext_vector_type(16)));
typedef unsigned u32x4 __attribute__((ext_vector_type(4)));
typedef unsigned u32x2 __attribute__((ext_vector_type(2)));

#ifndef MK_ONE_LAUNCH
#define MK_ONE_LAUNCH 1
#endif

constexpr int D = 2048, T_P = 2048, NB_P = 4, NB_S = 128, T_S = 8;
constexpr int M_P = NB_P * T_P, M_S = NB_S * T_S, M = M_P + M_S;
constexpr int NH = 8, HD = 128;
constexpr int P_IN = 8224, NPROJ = 8192, NGATE = 32, DFF = 8192, CCONV = 3072;
constexpr int NGB = NB_P + NB_S;
constexpr int MODW = 6 * D, MODFW = 2 * D;
constexpr float EPS = 1e-6f;
constexpr int NWAVES = 8, NTHREADS = 512, GRID = 256;

constexpr size_t O_Y = 0;
constexpr size_t O_PC = (size_t)M * D;
constexpr size_t O_PN = O_PC + (size_t)NB_P * NH * HD * HD;
constexpr size_t O_PM = O_PN + (size_t)NB_P * NH * HD;
constexpr size_t O_PS = O_PM + (size_t)NB_P * NH;
constexpr size_t O_PCONV = O_PS + (size_t)NB_P * NH * HD * HD;
constexpr size_t O_SC = O_PCONV + (size_t)NB_P * 3 * CCONV;
constexpr size_t O_SN = O_SC + (size_t)NB_S * NH * HD * HD;
constexpr size_t O_SM = O_SN + (size_t)NB_S * NH * HD;
constexpr size_t O_SS = O_SM + (size_t)NB_S * NH;
constexpr size_t O_SCONV = O_SS + (size_t)NB_S * NH * HD * HD;
constexpr size_t O_END = O_SCONV + (size_t)NB_S * 3 * CCONV;
static_assert(O_END == 54830112, "d_out size");

constexpr size_t MiB = 1u << 20;
constexpr size_t WS_CTL = 0, CTL_ZERO_BYTES = 64 * 1024;
constexpr size_t WS_SCB = 1 * MiB;
constexpr size_t WS_MOD = 2 * MiB;
constexpr size_t WS_MODF = 9 * MiB;
constexpr size_t WS_GATES = 12 * MiB;
constexpr size_t WS_WIN = 16 * MiB;
constexpr size_t WS_WOUT = 49 * MiB;
constexpr size_t WS_WUP = 57 * MiB;
constexpr size_t WS_WDOWN = 89 * MiB;
constexpr size_t WS_HB = 121 * MiB;
constexpr size_t WS_MIX = 157 * MiB;
constexpr size_t WS_X1 = 193 * MiB;
constexpr size_t WS_PROJ = 265 * MiB;
constexpr size_t WS_END = 409 * MiB;
static_assert(WS_WIN + (size_t)P_IN * D * 2 <= WS_WOUT && WS_PROJ + (size_t)M * NPROJ * 2 <= WS_END, "ws map");

constexpr int CW_BAR = 1024;

__device__ __forceinline__ unsigned f2bf(float f) { unsigned u = __builtin_bit_cast(unsigned, f); return (u + 0x7fffu + ((u >> 16) & 1u)) >> 16; }
__device__ __forceinline__ unsigned pk2(float lo, float hi) { return f2bf(lo) | (f2bf(hi) << 16); }
__device__ __forceinline__ float bf2f(bf16_t b) { return __builtin_bit_cast(float, (unsigned)b << 16); }
__device__ __forceinline__ float bflo(unsigned w) { return __builtin_bit_cast(float, w << 16); }
__device__ __forceinline__ float bfhi(unsigned w) { return __builtin_bit_cast(float, w & 0xffff0000u); }
__device__ __forceinline__ float wave_sum(float v) {
#pragma unroll
    for (int o = 1; o < 64; o <<= 1) v += __shfl_xor(v, o);
    return v;
}
__device__ __forceinline__ float sigmoidf_(float x) { return 1.0f / (1.0f + __expf(-x)); }
__device__ __forceinline__ float siluf_(float x) { return x / (1.0f + __expf(-x)); }
__device__ __forceinline__ float softplusf_(float x) { return fmaxf(x, 0.f) + log1pf(__expf(-fabsf(x))); }
__device__ __forceinline__ float logsigmoidf_(float x) { return fminf(x, 0.f) - log1pf(__expf(-fabsf(x))); }
__device__ __forceinline__ int row_gb(int r) { return r < M_P ? (r >> 11) : NB_P + ((r - M_P) >> 3); }
namespace pg8 {
#define PG8_LAS __attribute__((address_space(3)))
constexpr int BM = 256, BK = 64, HALF = 128, HTB = HALF * BK * 2  , STAGE_BYTES = 8 * HTB, NXCD = 8, WGM = 8;

__host__ __device__ __forceinline__ int lds_byte(int r, int c) { const int st = (r >> 4) * 2 + (c >> 5), rr = r & 15, cc = c & 31, ob = rr * 64 + cc * 2; return st * 1024 + (ob ^ (((ob >> 9) & 1) << 5)); }
__host__ __device__ __forceinline__ void stage_rc(int b, int& R, int& C) { const int st = b / 1024, sb = b % 1024, swz = sb ^ (((sb >> 9) & 1) << 5); R = (st >> 1) * 16 + swz / 64; C = (st & 1) * 32 + (swz % 64) / 2; }
__host__ __device__ __forceinline__ int perm32(int rho) { const int n = rho >> 4, i = rho & 15; return 8 * (i >> 2) + 4 * n + (i & 3); }

struct Unit { int pm, pn; };
struct Gemm { const bf16_t* A; const bf16_t* Bt; int M, N, K; };

struct StaticOrder {
    int nM, nN, nwg, G, c;
    __host__ __device__ void init(int M, int N, int G_, int c_) { nM = M / BM; nN = N / BM; nwg = nM * nN; G = G_; c = c_; }
    __host__ __device__ bool next(int i, Unit& u) const {
        const long L = (long)i * G + c; if (L >= nwg) return false;
        int wgid = (int)L; { const int q = nwg / NXCD, r = nwg % NXCD, xcd = wgid % NXCD, off = wgid / NXCD; wgid = (xcd < r ? xcd * (q + 1) : r * (q + 1) + (xcd - r) * q) + off; }
        const int nig = WGM * nN, gid = wgid / nig, fm = gid * WGM, gsz = (nM - fm) < WGM ? (nM - fm) : WGM;
        u.pm = fm + ((wgid % nig) % gsz); u.pn = (wgid % nig) / gsz; return true;
    }
    __device__ __forceinline__ void a_ready(const Unit&) const {}
    __device__ __forceinline__ void done(const Unit&) const {}
};


__device__ __forceinline__ unsigned cvt_pk_bf16(float lo, float hi) { unsigned r; asm volatile("v_cvt_pk_bf16_f32 %0, %1, %2" : "=v"(r) : "v"(lo), "v"(hi)); return r; }
template <int ACT  > struct EpiBf16 {
    static constexpr bool PERM = true, AFTER_DRAIN = false;
    bf16_t* O; int ldc;
    __device__ __forceinline__ void operator()(const f32x4 (&acc)[2][2][4][2], const Unit& u, int wr, int wc, int fr, int fq) const {
        const int row0 = u.pm * BM + wr * 64 + fr, col0 = u.pn * BM + wc * 32 + 8 * fq;
#pragma unroll
        for (int ai = 0; ai < 2; ++ai)
#pragma unroll
            for (int m = 0; m < 4; ++m) { bf16_t* rowp = O + (size_t)(row0 + ai * HALF + m * 16) * ldc + col0;
#pragma unroll
                for (int bj = 0; bj < 2; ++bj) { f32x4 v0 = acc[ai][bj][m][0], v1 = acc[ai][bj][m][1];
                    if (ACT == 1) {
#pragma unroll
                        for (int q = 0; q < 4; ++q) { const float a = fmaxf(v0[q], 0.f), b = fmaxf(v1[q], 0.f); v0[q] = a * a; v1[q] = b * b; } }
                    u32x4 w; w.x = cvt_pk_bf16(v0[0], v0[1]); w.y = cvt_pk_bf16(v0[2], v0[3]); w.z = cvt_pk_bf16(v1[0], v1[1]); w.w = cvt_pk_bf16(v1[2], v1[3]);
                    *(u32x4*)(rowp + bj * HALF) = w; } }
    }
};
struct EpiRes {
    static constexpr bool PERM = false, AFTER_DRAIN = false;
    const float* base0; const float* base1; int split; const float* gate; int ldg; float* out; int ldc;
    __device__ __forceinline__ void operator()(const f32x4 (&acc)[2][2][4][2], const Unit& u, int wr, int wc, int fr, int fq) const {
        const int row0 = u.pm * BM + wr * 64 + fr, col0 = u.pn * BM + wc * 32 + 4 * fq;
#pragma unroll
        for (int ai = 0; ai < 2; ++ai)
#pragma unroll
            for (int m = 0; m < 4; ++m) { const int r = row0 + ai * HALF + m * 16;
                const float* bp = (r < split ? base0 + (size_t)r * ldc : base1 + (size_t)(r - split) * ldc) + col0;
                const float* gp = gate + (size_t)row_gb(r) * ldg + col0; float* op = out + (size_t)r * ldc + col0;
#pragma unroll
                for (int bj = 0; bj < 2; ++bj)
#pragma unroll
                    for (int n = 0; n < 2; ++n) { const f32x4 bs = *(const f32x4*)(bp + bj * HALF + n * 16), g = *(const f32x4*)(gp + bj * HALF + n * 16);
                        *(f32x4*)(op + bj * HALF + n * 16) = bs + g * acc[ai][bj][m][n]; }
                if (m & 1) asm volatile("" ::: "memory"); }
    }
};

template <class Epi, class Sched, bool ALIGN_EPI = false, bool SP2 = false>
__device__ __forceinline__ void gemm_phase(PG8_LAS unsigned char* lds, const Gemm g, const Sched& S, const Epi& E) {
    const int tid = threadIdx.x, wid = __builtin_amdgcn_readfirstlane(tid >> 6), lane = tid & 63, wr = wid >> 2, wc = wid & 3, fr = lane & 15, fq = lane >> 4;
    const int K = g.K, nt = K / BK;
    unsigned voffA[2], voffB[2];
#pragma unroll
    for (int i = 0; i < 2; ++i) { int R, C; stage_rc(tid * 16 + i * 8192, R, C); const int Rb = Epi::PERM ? ((R & ~31) + perm32(R & 31)) : R;
        voffA[i] = (unsigned)(R * K + C) * 2u; voffB[i] = (unsigned)(Rb * K + C) * 2u; }
    const size_t kstep = (size_t)(BK * 2);
    const size_t hstep = (size_t)HALF * K * 2;
    const size_t tstep = 2 * hstep;
    const unsigned ldsw = (unsigned)wid * 1024u;
    const int aoff = lds_byte(wr * 64 + fr, fq * 8), boff = lds_byte(wc * 32 + fr, fq * 8);
#define PG8_SA(b, h) (((b) * 2 + (h)) * HTB)
#define PG8_SB(b, h) ((4 + (b) * 2 + (h)) * HTB)
#define PG8_STAGE(bufoff, gbase, voff) do { _Pragma("unroll") for (int _i = 0; _i < 2; ++_i) \
        __builtin_amdgcn_global_load_lds((const unsigned*)((const char*)(gbase) + (voff)[_i]), (PG8_LAS unsigned*)(lds + (bufoff) + ldsw + _i * 8192), 16, 0, 0); } while (0)
#define PG8_LDA(dst, b, h) do { _Pragma("unroll") for (int m = 0; m < 4; ++m) _Pragma("unroll") for (int k = 0; k < 2; ++k) dst[m][k] = *(const PG8_LAS bf16x8*)(lds + PG8_SA(b, h) + aoff + m * 2048 + k * 1024); } while (0)
#define PG8_LDB(dst, b, h) do { _Pragma("unroll") for (int n = 0; n < 2; ++n) _Pragma("unroll") for (int k = 0; k < 2; ++k) dst[n][k] = *(const PG8_LAS bf16x8*)(lds + PG8_SB(b, h) + boff + n * 2048 + k * 1024); } while (0)
#define PG8_MMA(ai, bj, At, Bt) do { __builtin_amdgcn_s_setprio(1); _Pragma("unroll") for (int m = 0; m < 4; ++m) _Pragma("unroll") for (int n = 0; n < 2; ++n) _Pragma("unroll") for (int k = 0; k < 2; ++k) \
        acc[ai][bj][m][n] = __builtin_amdgcn_mfma_f32_16x16x32_bf16(Bt[n][k], At[m][k], acc[ai][bj][m][n], 0, 0, 0); __builtin_amdgcn_s_setprio(0); } while (0)
#define PG8_WAIT_V(n) asm volatile("s_waitcnt vmcnt(" #n ")" ::: "memory")
#define PG8_WAIT_L(n) asm volatile("s_waitcnt lgkmcnt(" #n ")" ::: "memory")
#define PG8_BAR __builtin_amdgcn_s_barrier()
#define PG8_SCHED __builtin_amdgcn_sched_barrier(0)
    Unit cur, nxt; int ui = 0;
    if (!S.next(0, cur)) return;
    f32x4 acc[2][2][4][2];
#pragma unroll
    for (int a = 0; a < 2; ++a)
#pragma unroll
        for (int b = 0; b < 2; ++b)
#pragma unroll
            for (int m = 0; m < 4; ++m)
#pragma unroll
                for (int n = 0; n < 2; ++n) acc[a][b][m][n] = (f32x4){0.f, 0.f, 0.f, 0.f};
    bf16x8 At[4][2], B0[2][2], B1[2][2];
    const char* cA = (const char*)g.A + (size_t)cur.pm * tstep; const char* cB = (const char*)g.Bt + (size_t)cur.pn * tstep;
    S.a_ready(cur);
    if constexpr (SP2) {
        PG8_STAGE(PG8_SB(0, 0), cB, voffB); PG8_STAGE(PG8_SB(0, 1), cB + hstep, voffB); PG8_STAGE(PG8_SA(0, 0), cA, voffA); PG8_STAGE(PG8_SA(0, 1), cA + hstep, voffA);
        if (wr == 1) PG8_BAR;
        PG8_WAIT_V(2); PG8_BAR;
        PG8_STAGE(PG8_SB(1, 0), cB + kstep, voffB); PG8_STAGE(PG8_SA(1, 0), cA + kstep, voffA); PG8_STAGE(PG8_SB(1, 1), cB + hstep + kstep, voffB);
        PG8_WAIT_V(6); PG8_BAR;
    } else {
        PG8_STAGE(PG8_SB(0, 0), cB, voffB); PG8_STAGE(PG8_SA(0, 0), cA, voffA); PG8_STAGE(PG8_SB(0, 1), cB + hstep, voffB); PG8_STAGE(PG8_SA(0, 1), cA + hstep, voffA);
        if (wr == 1) PG8_BAR;
        PG8_WAIT_V(4); PG8_BAR;
        PG8_STAGE(PG8_SB(1, 0), cB + kstep, voffB); PG8_STAGE(PG8_SA(1, 0), cA + kstep, voffA); PG8_STAGE(PG8_SB(1, 1), cB + hstep + kstep, voffB);
        PG8_WAIT_V(6); PG8_BAR;
    }
    for (;;) {
        const bool has_next = S.next(ui + 1, nxt);
        const char* nA = has_next ? (const char*)g.A + (size_t)nxt.pm * tstep : cA; const char* nB = has_next ? (const char*)g.Bt + (size_t)nxt.pn * tstep : cB;
        for (int t = 0; t < nt; t += 2) {
            const bool last = (t == nt - 2);
            const char* a1 = cA + (size_t)(t + 1) * kstep;
            const char* a2 = last ? nA : cA + (size_t)(t + 2) * kstep; const char* b2 = last ? nB : cB + (size_t)(t + 2) * kstep;
            const char* a3 = a2 + kstep; const char* b3 = b2 + kstep;
            if (last && has_next) S.a_ready(nxt);
            if constexpr (SP2) {
            PG8_LDB(B0, 0, 0); PG8_LDB(B1, 0, 1); PG8_SCHED; PG8_LDA(At, 0, 0); PG8_STAGE(PG8_SA(1, 1), a1 + hstep, voffA);
            PG8_WAIT_V(8); PG8_WAIT_L(0); PG8_BAR; PG8_MMA(0, 0, At, B0); PG8_MMA(0, 1, At, B1); PG8_BAR; PG8_SCHED;
            PG8_LDA(At, 0, 1); PG8_STAGE(PG8_SB(0, 0), b2, voffB); PG8_STAGE(PG8_SB(0, 1), b2 + hstep, voffB); PG8_STAGE(PG8_SA(0, 0), a2, voffA);
            PG8_WAIT_V(8); PG8_WAIT_L(0); PG8_BAR; PG8_MMA(1, 0, At, B0); PG8_MMA(1, 1, At, B1); PG8_BAR; PG8_SCHED;
            PG8_LDB(B0, 1, 0); PG8_LDB(B1, 1, 1); PG8_SCHED; PG8_LDA(At, 1, 0); PG8_STAGE(PG8_SA(0, 1), a2 + hstep, voffA);
            PG8_WAIT_V(8); PG8_WAIT_L(0); PG8_BAR; PG8_MMA(0, 0, At, B0); PG8_MMA(0, 1, At, B1); PG8_BAR; PG8_SCHED;
            PG8_LDA(At, 1, 1); PG8_STAGE(PG8_SB(1, 0), b3, voffB); PG8_STAGE(PG8_SB(1, 1), b3 + hstep, voffB); PG8_STAGE(PG8_SA(1, 0), a3, voffA);
            PG8_WAIT_V(8); PG8_WAIT_L(0); PG8_BAR; PG8_MMA(1, 0, At, B0); PG8_MMA(1, 1, At, B1); PG8_BAR; PG8_SCHED;
            } else {
            PG8_LDB(B0, 0, 0); PG8_SCHED; PG8_LDA(At, 0, 0); PG8_STAGE(PG8_SA(1, 1), a1 + hstep, voffA);
            PG8_WAIT_L(8); PG8_BAR; PG8_WAIT_L(0); PG8_MMA(0, 0, At, B0); PG8_BAR; PG8_SCHED;
            PG8_LDB(B1, 0, 1); PG8_STAGE(PG8_SB(0, 0), b2, voffB);
            PG8_BAR; PG8_WAIT_L(0); PG8_MMA(0, 1, At, B1); PG8_BAR;
            PG8_LDA(At, 0, 1); PG8_STAGE(PG8_SA(0, 0), a2, voffA);
            PG8_BAR; PG8_WAIT_L(0); PG8_MMA(1, 0, At, B0); PG8_BAR; PG8_SCHED;
            PG8_STAGE(PG8_SB(0, 1), b2 + hstep, voffB);
            PG8_WAIT_V(6); PG8_BAR; PG8_MMA(1, 1, At, B1); PG8_BAR;
            PG8_LDB(B0, 1, 0); PG8_SCHED; PG8_LDA(At, 1, 0); PG8_STAGE(PG8_SA(0, 1), a2 + hstep, voffA);
            PG8_WAIT_L(8); PG8_BAR; PG8_WAIT_L(0); PG8_MMA(0, 0, At, B0); PG8_BAR; PG8_SCHED;
            PG8_LDB(B1, 1, 1); PG8_STAGE(PG8_SB(1, 0), b3, voffB);
            PG8_BAR; PG8_WAIT_L(0); PG8_MMA(0, 1, At, B1); PG8_BAR;
            PG8_LDA(At, 1, 1); PG8_STAGE(PG8_SA(1, 0), a3, voffA);
            PG8_BAR; PG8_WAIT_L(0); PG8_MMA(1, 0, At, B0); PG8_BAR; PG8_SCHED;
            PG8_STAGE(PG8_SB(1, 1), b3 + hstep, voffB);
            PG8_WAIT_V(6); PG8_BAR; PG8_MMA(1, 1, At, B1); PG8_BAR;
            }
        }
        if constexpr (ALIGN_EPI) { if (wr == 0) PG8_BAR; }
        if constexpr (!Epi::AFTER_DRAIN) { E(acc, cur, wr, wc, fr, fq); S.done(cur); }
        if (!has_next) break;
#pragma unroll
        for (int a = 0; a < 2; ++a)
#pragma unroll
            for (int b = 0; b < 2; ++b)
#pragma unroll
                for (int m = 0; m < 4; ++m)
#pragma unroll
                    for (int n = 0; n < 2; ++n) acc[a][b][m][n] = (f32x4){0.f, 0.f, 0.f, 0.f};
        cur = nxt; cA = nA; cB = nB; ++ui;
        if constexpr (ALIGN_EPI) { if (wr == 1) PG8_BAR; }
    }
    PG8_WAIT_V(0);
    if constexpr (!ALIGN_EPI) { if (wr == 0) PG8_BAR; }
    PG8_BAR;
    if constexpr (Epi::AFTER_DRAIN) { E.fused(acc, cur, wr, wc, fr, fq, lds, wid, lane); S.done(cur); }
#undef PG8_SA
#undef PG8_SB
#undef PG8_STAGE
#undef PG8_LDA
#undef PG8_LDB
#undef PG8_MMA
#undef PG8_WAIT_V
#undef PG8_WAIT_L
#undef PG8_BAR
#undef PG8_SCHED
}
}

constexpr int RING_OFF = 0, RING_BYTES = 131072;
constexpr int LDSCTL_OFF = RING_BYTES, MISC_OFF = LDSCTL_OFF + 320;
constexpr int LDS_BYTES = 147456;

typedef GAS unsigned gu32;
#define RLX_AGENT __ATOMIC_RELAXED, __HIP_MEMORY_SCOPE_AGENT
#define LDS_WAIT() asm volatile("s_waitcnt lgkmcnt(0)" ::: "memory")
#define VM_WAIT() asm volatile("s_waitcnt vmcnt(0)" ::: "memory")

#define XB_TMO      128
#define XB_XCNT(j)  (256  + 64 * (j))
#define XB_XSUB(j)  (1280 + 64 * (j))
#define XB_XGEN(j)  (2304 + 64 * (j))
#define XB_TOP      3328
#define XB_TOPGEN   3392
#define XCD_BAR_WORDS 3456
#define XB_SPIN_CAP (1u << 18)
__device__ __forceinline__ unsigned xb_ld(unsigned* p)              { return __hip_atomic_load(p, __ATOMIC_RELAXED, __HIP_MEMORY_SCOPE_AGENT); }
__device__ __forceinline__ unsigned xb_add(unsigned* p, unsigned v) { return __hip_atomic_fetch_add(p, v, __ATOMIC_RELAXED, __HIP_MEMORY_SCOPE_AGENT); }
__device__ __forceinline__ unsigned xb_xcc_id() { return (unsigned)__builtin_amdgcn_s_getreg((3 << 11) | 20) & 0xFu; }
#define XB_SPIN(cond, bar) do { unsigned _sp = 0; while (cond) { __builtin_amdgcn_s_sleep(1); \
    if ((++_sp & 255u) == 0u) { if (xb_ld(&(bar)[XB_TMO])) break; if (_sp > XB_SPIN_CAP) { atomicAdd(&(bar)[XB_TMO], 1u); break; } } } } while (0)
struct XcdBarrier { unsigned* bar; unsigned x; volatile LAS unsigned* st; };
__device__ __forceinline__ XcdBarrier xcd_barrier_post(unsigned* bar, volatile LAS unsigned* st) {
    XcdBarrier b; b.bar = bar; b.x = xb_xcc_id(); b.st = st;
    if (threadIdx.x == 0) (void)xb_add(&bar[XB_XCNT(b.x)], 1u);
    return b;
}
__device__ __forceinline__ void xcd_barrier_complete(unsigned* bar, unsigned x, unsigned& nloc, unsigned& nx) {
    const unsigned G = gridDim.x * gridDim.y * gridDim.z;
    unsigned sum, cnt, mine, sp = 0u;
    for (;;) {
        sum = 0u; cnt = 0u; mine = 0u;
#pragma unroll
        for (unsigned j = 0; j < 16; ++j) { const unsigned c = xb_ld(&bar[XB_XCNT(j)]); sum += c; cnt += (c > 0u) ? 1u : 0u; mine = (j == x) ? c : mine; }
        if (sum == G) break;
        __builtin_amdgcn_s_sleep(1);
        if ((++sp & 255u) == 0u) { if (xb_ld(&bar[XB_TMO])) break; if (sp > XB_SPIN_CAP) { atomicAdd(&bar[XB_TMO], 1u); break; } }
    }
    nloc = mine > 0u ? mine : 1u; nx = cnt > 0u ? cnt : 1u;
}
__device__ __forceinline__ void xcd_barrier(const XcdBarrier& b) {
    asm volatile("s_waitcnt vmcnt(0)" ::: "memory");
    __syncthreads();
    if (threadIdx.x == 0) {
        unsigned* bar = b.bar;
        __builtin_amdgcn_s_waitcnt(0);
        unsigned nloc = b.st[0], nx = b.st[1];
        if (nloc == 0u) { xcd_barrier_complete(bar, b.x, nloc, nx); b.st[0] = nloc; b.st[1] = nx; }
        const unsigned old = xb_add(&bar[XB_XSUB(b.x)], 1u);
        const unsigned gen = old / nloc;
        if (old + 1u == (gen + 1u) * nloc) {
            __builtin_amdgcn_fence(__ATOMIC_RELEASE, "agent");
            asm volatile("s_waitcnt vmcnt(0)" ::: "memory");
            const unsigned og = xb_add(&bar[XB_TOP], 1u);
            const unsigned tg = og / nx;
            if (og + 1u == (tg + 1u) * nx) xb_add(&bar[XB_TOPGEN], 1u);
            else XB_SPIN(xb_ld(&bar[XB_TOPGEN]) == tg, bar);
            __builtin_amdgcn_fence(__ATOMIC_ACQUIRE, "agent");
            xb_add(&bar[XB_XGEN(b.x)], 1u);
            asm volatile("s_waitcnt vmcnt(0)" ::: "memory");
        } else {
            XB_SPIN(xb_ld(&bar[XB_XGEN(b.x)]) == gen, bar);
            __builtin_amdgcn_fence(__ATOMIC_ACQUIRE, "agent");
            asm volatile("s_waitcnt vmcnt(0)" ::: "memory");
        }
    }
    __syncthreads();
}

struct Frame {
    LAS unsigned char* lds;
    int tid, lane, wave, gw, ngw;
    const float *xp, *xs, *stC, *stN, *stM, *stS, *stConv, *cp, *cs, *ada_w, *ada_b, *norm1, *w_in, *gate_b, *mlstm_g, *conv_w, *A_log, *dt_bias, *gdn_g,
                *w_out, *norm2, *w_up, *w_down, *adaf_w, *adaf_b, *normf;
    float* out;
    bf16_t *SCB, *WIN, *WOUT, *WUP, *WDOWN, *HB, *MIX, *PROJ;
    float *MOD, *MODF, *GATES, *X1;
};
__device__ __forceinline__ const float* xrow(const Frame& F, int r) { return r < M_P ? F.xp + (size_t)r * D : F.xs + (size_t)(r - M_P) * D; }

__device__ __forceinline__ void p0_silu(Frame& F) {
    const int gt = blockIdx.x * NTHREADS + F.tid, GT = gridDim.x * NTHREADS;
    for (int g = gt; g < 160 * 256; g += GT) {
        const int row = g >> 8, c8 = (g & 255) * 8; u32x4 o = (u32x4){0u, 0u, 0u, 0u};
        if (row < NGB) { const float* src = (row < NB_P ? F.cp + (size_t)row * D : F.cs + (size_t)(row - NB_P) * D) + c8;
            const f32x4 a = *(const f32x4*)src, b = *(const f32x4*)(src + 4);
            o.x = pk2(siluf_(a.x), siluf_(a.y)); o.y = pk2(siluf_(a.z), siluf_(a.w)); o.z = pk2(siluf_(b.x), siluf_(b.y)); o.w = pk2(siluf_(b.z), siluf_(b.w)); }
        *(u32x4*)(F.SCB + (size_t)row * D + c8) = o;
    }
}

__device__ __forceinline__ void p1_modgemv(Frame& F) {
    LAS float* red = (LAS float*)(F.lds + RING_OFF);
    const int lane = F.lane, r = lane & 31, hh = lane >> 5, cbi = F.wave >> 2, ks = F.wave & 3;
    for (int pair = blockIdx.x; pair < 256; pair += gridDim.x) {
        const int cb = 2 * pair + cbi;
        const float* W; const float* bias; float* outp; int ldw, n0;
        if (cb < 384) { W = F.ada_w; ldw = MODW; n0 = cb * 32; bias = F.ada_b; outp = F.MOD; }
        else { W = F.adaf_w; ldw = MODFW; n0 = (cb - 384) * 32; bias = F.adaf_b; outp = F.MODF; }
        f32x16 acc[5];
#pragma unroll
        for (int g = 0; g < 5; ++g)
#pragma unroll
            for (int i = 0; i < 16; ++i) acc[g][i] = 0.f;
        const float* wp = W + (size_t)(ks * 512 + 8 * hh) * ldw + n0 + r;
        const bf16_t* ap = F.SCB + (size_t)r * D + ks * 512 + 8 * hh;
        for (int s = 0; s < 32; s += 4) {
            float wv[4][8];
#pragma unroll
            for (int u = 0; u < 4; ++u)
#pragma unroll
                for (int j = 0; j < 8; ++j) wv[u][j] = wp[(size_t)((s + u) * 16 + j) * ldw];
#pragma unroll
            for (int u = 0; u < 4; ++u) {
                u32x4 bw; bw.x = pk2(wv[u][0], wv[u][1]); bw.y = pk2(wv[u][2], wv[u][3]); bw.z = pk2(wv[u][4], wv[u][5]); bw.w = pk2(wv[u][6], wv[u][7]);
                const bf16x8 b = __builtin_bit_cast(bf16x8, bw);
#pragma unroll
                for (int g = 0; g < 5; ++g) { const bf16x8 a = *(const bf16x8*)(ap + (size_t)g * 32 * D + (s + u) * 16);
                    acc[g] = __builtin_amdgcn_mfma_f32_32x32x16_bf16(a, b, acc[g], 0, 0, 0); }
            }
        }
        if (ks > 0) {
#pragma unroll
            for (int g = 0; g < 5; ++g)
#pragma unroll
                for (int i = 0; i < 16; ++i) red[(((ks - 1) * 2 + cbi) * 80 + g * 16 + i) * 64 + lane] = acc[g][i];
        }
        __syncthreads();
        if (ks == 0) {
            const float bv = bias[n0 + r];
#pragma unroll
            for (int g = 0; g < 5; ++g)
#pragma unroll
                for (int i = 0; i < 16; ++i) {
                    float v = acc[g][i];
#pragma unroll
                    for (int k2 = 0; k2 < 3; ++k2) v += red[((k2 * 2 + cbi) * 80 + g * 16 + i) * 64 + lane];
                    const int gb = 32 * g + (i & 3) + 8 * (i >> 2) + 4 * hh;
                    if (gb < NGB) outp[(size_t)gb * ldw + n0 + r] = v + bv;
                }
        }
        __syncthreads();
    }
}

__device__ __forceinline__ int win_dst_row(int n) {
    if (n < 3072) return n;
    if (n < 3088) return 8192 + (n - 3072);
    if (n < 7184) return n - 16;
    if (n < 7200) return 8208 + (n - 7184);
    return n - 32;
}
template <bool MAPWIN>
__device__ __forceinline__ void transpose_item(const float* W, int K, int N, bf16_t* WT, LAS float* scr, int item, int lane) {
    const int nblk = N / 32, kb = item / nblk, nb = item % nblk, k0 = 64 * kb, n0 = 32 * nb;
#pragma unroll 8
    for (int i = 0; i < 32; ++i) { const int kk = 2 * i + (lane >> 5); scr[kk * 33 + (lane & 31)] = W[(size_t)(k0 + kk) * N + n0 + (lane & 31)]; }
    LDS_WAIT(); asm volatile("" ::: "memory");
    const int c = lane & 7;
#pragma unroll
    for (int j = 0; j < 4; ++j) { const int n = (lane >> 3) + 8 * j; const LAS float* s = scr + (8 * c) * 33 + n;
        u32x4 o; o.x = pk2(s[0 * 33], s[1 * 33]); o.y = pk2(s[2 * 33], s[3 * 33]); o.z = pk2(s[4 * 33], s[5 * 33]); o.w = pk2(s[6 * 33], s[7 * 33]);
        const int dr = MAPWIN ? win_dst_row(n0 + n) : (n0 + n);
        *(u32x4*)(WT + (size_t)dr * K + k0 + 8 * c) = o; }
    LDS_WAIT(); asm volatile("" ::: "memory");
}
__device__ __forceinline__ void p1_transposes(Frame& F) {
    LAS float* scr = (LAS float*)(F.lds + RING_OFF + F.wave * 16384);
    constexpr int I_IN = (D / 64) * (P_IN / 32), I_OUT = (D / 64) * (D / 32), I_UP = (D / 64) * (DFF / 32), I_DOWN = (DFF / 64) * (D / 32);
    constexpr int NITEMS = I_IN + I_OUT + I_UP + I_DOWN;
    for (int it = F.gw; it < NITEMS; it += F.ngw) {
        int r = it;
        if (r < I_IN) { transpose_item<true>(F.w_in, D, P_IN, F.WIN, scr, r, F.lane); continue; } r -= I_IN;
        if (r < I_OUT) { transpose_item<false>(F.w_out, D, D, F.WOUT, scr, r, F.lane); continue; } r -= I_OUT;
        if (r < I_UP) { transpose_item<false>(F.w_up, D, DFF, F.WUP, scr, r, F.lane); continue; } r -= I_UP;
        transpose_item<false>(F.w_down, DFF, D, F.WDOWN, scr, r, F.lane);
    }
}

__device__ __forceinline__ void norm_mod_row_bf16(const float* xr_, const float* g, const float* shift, const float* scale, bf16_t* orow, int lane) {
    const f32x4* xr = (const f32x4*)xr_ + lane;
    f32x4 v[8]; float s = 0.f;
#pragma unroll
    for (int j = 0; j < 8; ++j) { v[j] = xr[64 * j]; s += (v[j].x * v[j].x + v[j].y * v[j].y) + (v[j].z * v[j].z + v[j].w * v[j].w); }
    const float rstd = 1.0f / sqrtf(wave_sum(s) * (1.0f / D) + EPS);
    u32x2* o8 = (u32x2*)orow + lane;
#pragma unroll
    for (int j = 0; j < 8; ++j) { const f32x4 gg = ((const f32x4*)g)[lane + 64 * j], sh = ((const f32x4*)shift)[lane + 64 * j], sc = ((const f32x4*)scale)[lane + 64 * j];
        const f32x4 y = (v[j] * rstd * gg) * (sc + 1.0f) + sh; u32x2 w; w.x = pk2(y.x, y.y); w.y = pk2(y.z, y.w); o8[64 * j] = w; }
}
__device__ __forceinline__ void norm_mod_row_f32(const float* xr_, const float* g, const float* shift, const float* scale, float* orow, int lane) {
    const f32x4* xr = (const f32x4*)xr_ + lane;
    f32x4 v[8]; float s = 0.f;
#pragma unroll
    for (int j = 0; j < 8; ++j) { v[j] = xr[64 * j]; s += (v[j].x * v[j].x + v[j].y * v[j].y) + (v[j].z * v[j].z + v[j].w * v[j].w); }
    const float rstd = 1.0f / sqrtf(wave_sum(s) * (1.0f / D) + EPS);
    f32x4* o = (f32x4*)orow + lane;
#pragma unroll
    for (int j = 0; j < 8; ++j) { const f32x4 gg = ((const f32x4*)g)[lane + 64 * j], sh = ((const f32x4*)shift)[lane + 64 * j], sc = ((const f32x4*)scale)[lane + 64 * j];
        o[64 * j] = (v[j] * rstd * gg) * (sc + 1.0f) + sh; }
}

__device__ __forceinline__ void p3_gates(Frame& F) {
    const int lane = F.lane, fr = lane & 15, fq = lane >> 4;
    for (int task = F.gw; task < M / 16; task += F.ngw) {
        const int r0 = task * 16;
        const bf16_t* ap = F.HB + (size_t)(r0 + fr) * D + 8 * fq;
        const bf16_t* bp = F.WIN + (size_t)(NPROJ + fr) * D + 8 * fq;
        f32x4 c0 = (f32x4){0.f, 0.f, 0.f, 0.f}, c1 = c0;
#pragma unroll 8
        for (int k0 = 0; k0 < D; k0 += 32) {
            const bf16x8 a = *(const bf16x8*)(ap + k0), b0 = *(const bf16x8*)(bp + k0), b1 = *(const bf16x8*)(bp + (size_t)16 * D + k0);
            c0 = __builtin_amdgcn_mfma_f32_16x16x32_bf16(a, b0, c0, 0, 0, 0);
            c1 = __builtin_amdgcn_mfma_f32_16x16x32_bf16(a, b1, c1, 0, 0, 0);
        }
#pragma unroll
        for (int i = 0; i < 4; ++i) { float* o = F.GATES + (size_t)(r0 + 4 * fq + i) * NGATE + fr; o[0] = c0[i]; o[16] = c1[i]; }
    }
}

__device__ __forceinline__ void scan_mlstm_simple(Frame& F, bool prompt, int b, int hd) {
    LAS float* sq = (LAS float*)(F.lds + RING_OFF); LAS float* sk = sq + 128; LAS float* sv = sk + 128; LAS float* spart = sv + 128; LAS float* sred = spart + 512; LAS float* sred2 = sred + 8;
    const int tid = F.tid, e = tid & 127, q4 = tid >> 7, lane = F.lane, wave = F.wave;
    const int T = prompt ? T_P : T_S, row0 = prompt ? b * T_P : M_P + b * T_S, bh = b * NH + hd;
    float C[32]; float nst = 0.f, m = 0.f;
    if (prompt) {
#pragma unroll
        for (int dd = 0; dd < 32; ++dd) C[dd] = 0.f;
    } else {
#pragma unroll
        for (int dd = 0; dd < 32; ++dd) C[dd] = F.stC[((size_t)bh * HD + 32 * q4 + dd) * HD + e];
        if (tid < 128) nst = F.stN[(size_t)bh * HD + tid];
        m = F.stM[bh];
    }
    const float bi = F.gate_b[hd], bfg = F.gate_b[NH + hd], gn = F.mlstm_g[hd * HD + e];
    for (int t = 0; t < T; ++t) {
        const int row = row0 + t; const bf16_t* pr = F.PROJ + (size_t)row * NPROJ + hd * HD;
        float oa = 0.f;
        if (tid < 128) { sq[tid] = bf2f(pr[tid]); sk[tid] = bf2f(pr[1024 + tid]) * 0.08838834764831845f; sv[tid] = bf2f(pr[2048 + tid]); oa = bf2f(pr[3072 + tid]); }
        const float ia = F.GATES[(size_t)row * NGATE + hd], fa = F.GATES[(size_t)row * NGATE + 8 + hd];
        __syncthreads();
        const float li = ia + bi, lf = logsigmoidf_(fa + bfg);
        const float mn = fmaxf(lf + m, li), fdec = expf(lf + m - mn), iin = expf(li - mn); m = mn;
        const float ve = sv[e]; float part = 0.f;
#pragma unroll
        for (int dd = 0; dd < 32; ++dd) { const int d = 32 * q4 + dd; C[dd] = fdec * C[dd] + (iin * sk[d]) * ve; part += sq[d] * C[dd]; }
        spart[q4 * 128 + e] = part;
        if (tid < 128) { nst = fdec * nst + iin * sk[tid]; const float pn = wave_sum(sq[tid] * nst); if (lane == 0) sred[wave] = pn; }
        __syncthreads();
        const float numer = (spart[e] + spart[128 + e]) + (spart[256 + e] + spart[384 + e]);
        const float ddn = sred[0] + sred[1];
        const float hval = numer / fmaxf(fabsf(ddn), expf(-m));
        const float ss = wave_sum(hval * hval);
        if (lane == 0) sred2[wave] = ss;
        __syncthreads();
        const float tot = sred2[wave] + sred2[wave ^ 1];
        if (tid < 128) { const float y = hval * (1.0f / sqrtf(tot * (1.0f / HD) + EPS)) * gn * sigmoidf_(oa); F.MIX[(size_t)row * D + hd * HD + e] = (bf16_t)f2bf(y); }
    }
    float* oC = F.out + (prompt ? O_PC : O_SC) + (size_t)bh * HD * HD;
#pragma unroll
    for (int dd = 0; dd < 32; ++dd) oC[(size_t)(32 * q4 + dd) * HD + e] = C[dd];
    if (tid < 128) F.out[(prompt ? O_PN : O_SN) + (size_t)bh * HD + tid] = nst;
    if (tid == 0) F.out[(prompt ? O_PM : O_SM) + bh] = m;
    __syncthreads();
}
__device__ __forceinline__ void scan_gdn_simple(Frame& F, bool prompt, int b, int hd) {
    LAS float* sq = (LAS float*)(F.lds + RING_OFF); LAS float* sk = sq + 128; LAS float* sv = sk + 128; LAS float* spart = sv + 128; LAS float* spart2 = spart + 512; LAS float* sred = spart2 + 512; LAS float* sred2 = sred + 8;
    const int tid = F.tid, e = tid & 127, q4 = tid >> 7, lane = F.lane, wave = F.wave;
    const int T = prompt ? T_P : T_S, row0 = prompt ? b * T_P : M_P + b * T_S, bh = b * NH + hd;
    float S[32];
    if (prompt) {
#pragma unroll
        for (int dd = 0; dd < 32; ++dd) S[dd] = 0.f;
    } else {
#pragma unroll
        for (int dd = 0; dd < 32; ++dd) S[dd] = F.stS[((size_t)bh * HD + 32 * q4 + dd) * HD + e];
    }
    const int cch = (q4 < 3 ? q4 : 0) * 1024 + hd * HD + e;
    float h0 = 0.f, h1 = 0.f, h2 = 0.f;
    if (!prompt && q4 < 3) { const float* cv = F.stConv + (size_t)b * 3 * CCONV + cch; h0 = cv[0]; h1 = cv[CCONV]; h2 = cv[2 * CCONV]; }
    const float w0 = F.conv_w[cch], w1 = F.conv_w[CCONV + cch], w2 = F.conv_w[2 * CCONV + cch], w3 = F.conv_w[3 * CCONV + cch];
    const float negA = -expf(F.A_log[hd]), dtb = F.dt_bias[hd], gn = F.gdn_g[hd * HD + e];
    for (int t = 0; t < T; ++t) {
        const int row = row0 + t; const bf16_t* pr = F.PROJ + (size_t)row * NPROJ + 4096;
        float a = 0.f, zb = 0.f;
        if (q4 < 3) { const float u = bf2f(pr[cch]); const float cvv = w0 * h0 + w1 * h1 + w2 * h2 + w3 * u; h0 = h1; h1 = h2; h2 = u; a = siluf_(cvv); }
        if (q4 == 0) zb = bf2f(pr[3072 + hd * HD + e]);
        if (q4 < 2) { const float ss = wave_sum(a * a); if (lane == 0) sred[wave] = ss; }
        if (q4 == 2) sv[e] = a;
        const float ab = F.GATES[(size_t)row * NGATE + 16 + hd], bb = F.GATES[(size_t)row * NGATE + 24 + hd];
        __syncthreads();
        if (q4 == 0) sq[e] = a * (1.0f / sqrtf(sred[0] + sred[1] + EPS)) * 0.08838834764831845f;
        if (q4 == 1) sk[e] = a * (1.0f / sqrtf(sred[2] + sred[3] + EPS));
        __syncthreads();
        const float g = expf(negA * softplusf_(ab + dtb)), beta = sigmoidf_(bb);
        float part = 0.f;
#pragma unroll
        for (int dd = 0; dd < 32; ++dd) part += sk[32 * q4 + dd] * S[dd];
        spart[q4 * 128 + e] = part;
        __syncthreads();
        const float kS = (spart[e] + spart[128 + e]) + (spart[256 + e] + spart[384 + e]);
        const float ue = beta * (sv[e] - g * kS);
        float opart = 0.f;
#pragma unroll
        for (int dd = 0; dd < 32; ++dd) { const int d = 32 * q4 + dd; S[dd] = g * S[dd] + sk[d] * ue; opart += sq[d] * S[dd]; }
        spart2[q4 * 128 + e] = opart;
        __syncthreads();
        const float o = (spart2[e] + spart2[128 + e]) + (spart2[256 + e] + spart2[384 + e]);
        const float ss2 = wave_sum(o * o);
        if (lane == 0) sred2[wave] = ss2;
        __syncthreads();
        const float tot = sred2[wave] + sred2[wave ^ 1];
        if (q4 == 0) { const float y = o * (1.0f / sqrtf(tot * (1.0f / HD) + EPS)) * gn * siluf_(zb); F.MIX[(size_t)row * D + 1024 + hd * HD + e] = (bf16_t)f2bf(y); }
    }
    float* oS = F.out + (prompt ? O_PS : O_SS) + (size_t)bh * HD * HD;
#pragma unroll
    for (int dd = 0; dd < 32; ++dd) oS[(size_t)(32 * q4 + dd) * HD + e] = S[dd];
    if (q4 < 3) { float* oc = F.out + (prompt ? O_PCONV : O_SCONV) + (size_t)b * 3 * CCONV + cch; oc[0] = h0; oc[CCONV] = h1; oc[2 * CCONV] = h2; }
    __syncthreads();
}
__device__ __forceinline__ void p4_scan_simple(Frame& F) {
    const int w = blockIdx.x;
    if (w < 64) { const int mixer = w >> 5, b = (w & 31) >> 3, hd = w & 7; if (mixer == 0) scan_mlstm_simple(F, true, b, hd); else scan_gdn_simple(F, true, b, hd); }
    else { for (int idx = w - 64; idx < 2048; idx += (int)gridDim.x - 64) { const int mixer = idx >> 10, b = (idx & 1023) >> 3, hd = idx & 7;
            if (mixer == 0) scan_mlstm_simple(F, false, b, hd); else scan_gdn_simple(F, false, b, hd); } }
}

struct Args { const float* in[26]; float* out; unsigned char* ws; int ph_lo, ph_hi; };
constexpr int NPHASE = 10;
__global__ void __launch_bounds__(NTHREADS, 2) fwd_kernel(Args args) {
    extern __shared__ __attribute__((aligned(16))) unsigned char lds[];
    Frame F;
    F.lds = (LAS unsigned char*)lds;
    F.tid = threadIdx.x; F.lane = F.tid & 63; F.wave = __builtin_amdgcn_readfirstlane(F.tid >> 6);
    F.gw = blockIdx.x * NWAVES + F.wave; F.ngw = gridDim.x * NWAVES;
    F.xp = args.in[0]; F.xs = args.in[1]; F.stC = args.in[2]; F.stN = args.in[3]; F.stM = args.in[4]; F.stS = args.in[5]; F.stConv = args.in[6]; F.cp = args.in[7]; F.cs = args.in[8];
    F.ada_w = args.in[9]; F.ada_b = args.in[10]; F.norm1 = args.in[11]; F.w_in = args.in[12]; F.gate_b = args.in[13]; F.mlstm_g = args.in[14]; F.conv_w = args.in[15]; F.A_log = args.in[16];
    F.dt_bias = args.in[17]; F.gdn_g = args.in[18]; F.w_out = args.in[19]; F.norm2 = args.in[20]; F.w_up = args.in[21]; F.w_down = args.in[22]; F.adaf_w = args.in[23]; F.adaf_b = args.in[24]; F.normf = args.in[25];
    F.out = args.out;
    unsigned char* ws = args.ws;
    F.SCB = (bf16_t*)(ws + WS_SCB); F.WIN = (bf16_t*)(ws + WS_WIN); F.WOUT = (bf16_t*)(ws + WS_WOUT); F.WUP = (bf16_t*)(ws + WS_WUP); F.WDOWN = (bf16_t*)(ws + WS_WDOWN);
    F.HB = (bf16_t*)(ws + WS_HB); F.MIX = (bf16_t*)(ws + WS_MIX); F.PROJ = (bf16_t*)(ws + WS_PROJ);
    F.MOD = (float*)(ws + WS_MOD); F.MODF = (float*)(ws + WS_MODF); F.GATES = (float*)(ws + WS_GATES); F.X1 = (float*)(ws + WS_X1);

    for (int u = F.tid; u < (LDS_BYTES - LDSCTL_OFF) / 4; u += NTHREADS) ((LAS unsigned*)(F.lds + LDSCTL_OFF))[u] = 0u;
    __syncthreads();
    XcdBarrier bar; bar.bar = (unsigned*)(ws + WS_CTL) + CW_BAR; bar.x = 0; bar.st = nullptr;
#if MK_ONE_LAUNCH
    bar = xcd_barrier_post((unsigned*)(ws + WS_CTL) + CW_BAR, (volatile LAS unsigned*)(F.lds + MISC_OFF) + 8);
#define GRID_BAR() xcd_barrier(bar)
#else
#define GRID_BAR() do { } while (0)
#endif
    const int lo = args.ph_lo, hi = args.ph_hi;
#define IN(k) (lo <= (k) && (k) < hi)
#define BOTH(k) (IN(k) && IN((k) + 1))

    if (IN(0)) { p0_silu(F); if (BOTH(0)) GRID_BAR(); }
    if (IN(1)) { p1_modgemv(F); p1_transposes(F); if (BOTH(1)) GRID_BAR(); }
    if (IN(2)) {
        for (int r = F.gw; r < M; r += F.ngw) { const float* md = F.MOD + (size_t)row_gb(r) * MODW; norm_mod_row_bf16(xrow(F, r), F.norm1, md, md + D, F.HB + (size_t)r * D, F.lane); }
        if (BOTH(2)) GRID_BAR();
    }
    if (IN(3)) {
        p3_gates(F);
        asm volatile("s_waitcnt vmcnt(0) lgkmcnt(0)" ::: "memory"); __syncthreads();
        pg8::Gemm g{F.HB, F.WIN, M, NPROJ, D}; pg8::StaticOrder S; S.init(M, NPROJ, gridDim.x, (int)blockIdx.x);
        pg8::EpiBf16<0> E{F.PROJ, NPROJ};
        pg8::gemm_phase<pg8::EpiBf16<0>, pg8::StaticOrder, true, true>(F.lds + RING_OFF, g, S, E);
        if (BOTH(3)) GRID_BAR();
    }
    if (IN(4)) { p4_scan_simple(F); if (BOTH(4)) GRID_BAR(); }
    if (IN(5)) {
        pg8::Gemm g{F.MIX, F.WOUT, M, D, D}; pg8::StaticOrder S; S.init(M, D, gridDim.x, (int)blockIdx.x);
        pg8::EpiRes E{F.xp, F.xs, M_P, F.MOD + 2 * D, MODW, F.X1, D};
        pg8::gemm_phase<pg8::EpiRes, pg8::StaticOrder, true, true>(F.lds + RING_OFF, g, S, E);
        if (BOTH(5)) GRID_BAR();
    }
    if (IN(6)) {
        for (int r = F.gw; r < M; r += F.ngw) { const float* md = F.MOD + (size_t)row_gb(r) * MODW; norm_mod_row_bf16(F.X1 + (size_t)r * D, F.norm2, md + 3 * D, md + 4 * D, F.HB + (size_t)r * D, F.lane); }
        if (BOTH(6)) GRID_BAR();
    }
    if (IN(7)) {
        pg8::Gemm g{F.HB, F.WUP, M, DFF, D}; pg8::StaticOrder S; S.init(M, DFF, gridDim.x, (int)blockIdx.x);
        pg8::EpiBf16<1> E{F.PROJ, DFF};
        pg8::gemm_phase<pg8::EpiBf16<1>, pg8::StaticOrder, true, true>(F.lds + RING_OFF, g, S, E);
        if (BOTH(7)) GRID_BAR();
    }
    if (IN(8)) {
        pg8::Gemm g{F.PROJ, F.WDOWN, M, D, DFF}; pg8::StaticOrder S; S.init(M, D, gridDim.x, (int)blockIdx.x);
        pg8::EpiRes E{F.X1, F.X1, M, F.MOD + 5 * D, MODW, F.out + O_Y, D};
        pg8::gemm_phase<pg8::EpiRes, pg8::StaticOrder, true, true>(F.lds + RING_OFF, g, S, E);
        if (BOTH(8)) GRID_BAR();
    }
    if (IN(9)) {
        for (int r = F.gw; r < M; r += F.ngw) { const float* md = F.MODF + (size_t)row_gb(r) * MODFW; float* yr = F.out + O_Y + (size_t)r * D; norm_mod_row_f32(yr, F.normf, md, md + D, yr, F.lane); }
    }
#undef IN
#undef BOTH
}

extern "C" void kernel_launch(void* const* d_in, const int* in_sizes, int n_in, void* d_out, int out_size, void* d_ws, size_t ws_size, hipStream_t stream) {
    static int ok = 0;
    if (ok == 0) {
        if (n_in != 26 || (size_t)out_size != O_END || ws_size < WS_END) { fprintf(stderr, "kernel_launch: unexpected shapes: n_in %d out %d ws %zu\n", n_in, out_size, ws_size); ok = -1; return; }
        if (hipFuncSetAttribute((const void*)fwd_kernel, hipFuncAttributeMaxDynamicSharedMemorySize, LDS_BYTES) != hipSuccess) { fprintf(stderr, "kernel_launch: hipFuncSetAttribute failed\n"); ok = -1; return; }
        int dev = 0, cus = 0, per_cu = 0;
        (void)hipGetDevice(&dev); (void)hipDeviceGetAttribute(&cus, hipDeviceAttributeMultiprocessorCount, dev);
        (void)hipOccupancyMaxActiveBlocksPerMultiprocessor(&per_cu, (const void*)fwd_kernel, NTHREADS, LDS_BYTES);
        if (cus != GRID || per_cu < 1) fprintf(stderr, "kernel_launch: note: %d CUs, %d blocks/CU reported; launching %d workgroups\n", cus, per_cu, GRID);
        (void)hipGetLastError();
        ok = 1;
    }
    if (ok < 0) return;
    (void)hipMemsetAsync((char*)d_ws + WS_CTL, 0, CTL_ZERO_BYTES, stream);
    Args a{};
    for (int i = 0; i < 26; ++i) a.in[i] = (const float*)d_in[i];
    a.out = (float*)d_out; a.ws = (unsigned char*)d_ws;
#if MK_ONE_LAUNCH
    a.ph_lo = 0; a.ph_hi = NPHASE;
    hipLaunchKernelGGL(fwd_kernel, dim3(GRID), dim3(NTHREADS), LDS_BYTES, stream, a);
#else
    for (int p = 0; p < NPHASE; ++p) { a.ph_lo = p; a.ph_hi = p + 1; hipLaunchKernelGGL(fwd_kernel, dim3(GRID), dim3(NTHREADS), LDS_BYTES, stream, a); }
#endif
}
```

```cpp
#include <hip/hip_runtime.h>
#include <cstdio>
#include <cstdint>

#define LAS __attribute__((address_space(3)))
#define GAS __attribute__((address_space(1)))
typedef unsigned short bf16_t;
typedef short bf16x8 __attribute__((ext_vector_type(8)));
typedef float f32x4 __attribute__((ext_vector_type(4)));
typedef float f32x2 __attribute__((ext_vector_type(2)));
typedef float f32x16 __attribute__((ext_vector_type(16)));
typedef unsigned u32x4 __attribute__((ext_vector_type(4)));
typedef unsigned u32x2 __attribute__((ext_vector_type(2)));

#ifndef MK_ONE_LAUNCH
#define MK_ONE_LAUNCH 1
#endif

constexpr int D = 2048, T_P = 2048, NB_P = 4, NB_S = 128, T_S = 8;
constexpr int M_P = NB_P * T_P, M_S = NB_S * T_S, M = M_P + M_S;
constexpr int NH = 8, HD = 128;
constexpr int P_IN = 8224, NPROJ = 8192, NGATE = 32, DFF = 8192, CCONV = 3072;
constexpr int NGB = NB_P + NB_S;
constexpr int MODW = 6 * D, MODFW = 2 * D;
constexpr float EPS = 1e-6f;
constexpr int NWAVES = 8, NTHREADS = 512, GRID = 256;

constexpr size_t O_Y = 0;
constexpr size_t O_PC = (size_t)M * D;
constexpr size_t O_PN = O_PC + (size_t)NB_P * NH * HD * HD;
constexpr size_t O_PM = O_PN + (size_t)NB_P * NH * HD;
constexpr size_t O_PS = O_PM + (size_t)NB_P * NH;
constexpr size_t O_PCONV = O_PS + (size_t)NB_P * NH * HD * HD;
constexpr size_t O_SC = O_PCONV + (size_t)NB_P * 3 * CCONV;
constexpr size_t O_SN = O_SC + (size_t)NB_S * NH * HD * HD;
constexpr size_t O_SM = O_SN + (size_t)NB_S * NH * HD;
constexpr size_t O_SS = O_SM + (size_t)NB_S * NH;
constexpr size_t O_SCONV = O_SS + (size_t)NB_S * NH * HD * HD;
constexpr size_t O_END = O_SCONV + (size_t)NB_S * 3 * CCONV;
static_assert(O_END == 54830112, "d_out size");

constexpr size_t MiB = 1u << 20;
constexpr size_t WS_CTL = 0, CTL_ZERO_BYTES = 64 * 1024;
constexpr size_t WS_SCB = 1 * MiB;
constexpr size_t WS_MOD = 2 * MiB;
constexpr size_t WS_MODF = 9 * MiB;
constexpr size_t WS_GATES = 12 * MiB;
constexpr size_t WS_WIN = 16 * MiB;
constexpr size_t WS_WOUT = 49 * MiB;
constexpr size_t WS_WUP = 57 * MiB;
constexpr size_t WS_WDOWN = 89 * MiB;
constexpr size_t WS_HB = 121 * MiB;
constexpr size_t WS_MIX = 157 * MiB;
constexpr size_t WS_X1 = 193 * MiB;
constexpr size_t WS_PROJ = 265 * MiB;
constexpr size_t WS_IMGM = 409 * MiB;
constexpr size_t WS_IMGG = 467 * MiB;
constexpr size_t WS_END = 540 * MiB;
constexpr int MREC = 59392, MR_QI = 0, MR_SP = 16384, MR_KW = 24576, MR_VT = 40960, MR_SC = 57344, MR_DN = 58368;
static_assert(WS_WIN + (size_t)P_IN * D * 2 <= WS_WOUT && WS_PROJ + (size_t)M * NPROJ * 2 <= WS_IMGM && WS_IMGM + (size_t)1024 * MREC <= WS_IMGG && WS_IMGG + (size_t)1024 * 74752 <= WS_END, "ws map");
constexpr int GREC = 74752, GR_QG = 0, GR_WI = 16384, GR_KT = 32768, GR_QK = 49152, GR_SC = 57344, GR_UP = 58368, GDMA_BYTES = 58368;

constexpr int CW_BAR = 1024;

__device__ __forceinline__ unsigned f2bf(float f) { unsigned u = __builtin_bit_cast(unsigned, f); return (u + 0x7fffu + ((u >> 16) & 1u)) >> 16; }
__device__ __forceinline__ unsigned pk2(float lo, float hi) { return f2bf(lo) | (f2bf(hi) << 16); }
__device__ __forceinline__ float bf2f(bf16_t b) { return __builtin_bit_cast(float, (unsigned)b << 16); }
__device__ __forceinline__ float bflo(unsigned w) { return __builtin_bit_cast(float, w << 16); }
__device__ __forceinline__ float bfhi(unsigned w) { return __builtin_bit_cast(float, w & 0xffff0000u); }
__device__ __forceinline__ float wave_sum(float v) {
#pragma unroll
    for (int o = 1; o < 64; o <<= 1) v += __shfl_xor(v, o);
    return v;
}
__device__ __forceinline__ float sigmoidf_(float x) { return 1.0f / (1.0f + __expf(-x)); }
__device__ __forceinline__ float siluf_(float x) { return x / (1.0f + __expf(-x)); }
__device__ __forceinline__ float softplusf_(float x) { return fmaxf(x, 0.f) + log1pf(__expf(-fabsf(x))); }
__device__ __forceinline__ float logsigmoidf_(float x) { return fminf(x, 0.f) - log1pf(__expf(-fabsf(x))); }
__device__ __forceinline__ int row_gb(int r) { return r < M_P ? (r >> 11) : NB_P + ((r - M_P) >> 3); }
namespace pg8 {
#define PG8_LAS __attribute__((address_space(3)))
constexpr int BM = 256, BK = 64, HALF = 128, HTB = HALF * BK * 2  , STAGE_BYTES = 8 * HTB, NXCD = 8, WGM = 8;

__host__ __device__ __forceinline__ int lds_byte(int r, int c) { const int st = (r >> 4) * 2 + (c >> 5), rr = r & 15, cc = c & 31, ob = rr * 64 + cc * 2; return st * 1024 + (ob ^ (((ob >> 9) & 1) << 5)); }
__host__ __device__ __forceinline__ void stage_rc(int b, int& R, int& C) { const int st = b / 1024, sb = b % 1024, swz = sb ^ (((sb >> 9) & 1) << 5); R = (st >> 1) * 16 + swz / 64; C = (st & 1) * 32 + (swz % 64) / 2; }
__host__ __device__ __forceinline__ int perm32(int rho) { const int n = rho >> 4, i = rho & 15; return 8 * (i >> 2) + 4 * n + (i & 3); }

struct Unit { int pm, pn; };
struct Gemm { const bf16_t* A; const bf16_t* Bt; int M, N, K; };

struct StaticOrder {
    int nM, nN, nwg, G, c;
    __host__ __device__ void init(int M, int N, int G_, int c_) { nM = M / BM; nN = N / BM; nwg = nM * nN; G = G_; c = c_; }
    __host__ __device__ bool next(int i, Unit& u) const {
        const long L = (long)i * G + c; if (L >= nwg) return false;
        int wgid = (int)L; { const int q = nwg / NXCD, r = nwg % NXCD, xcd = wgid % NXCD, off = wgid / NXCD; wgid = (xcd < r ? xcd * (q + 1) : r * (q + 1) + (xcd - r) * q) + off; }
        const int nig = WGM * nN, gid = wgid / nig, fm = gid * WGM, gsz = (nM - fm) < WGM ? (nM - fm) : WGM;
        u.pm = fm + ((wgid % nig) % gsz); u.pn = (wgid % nig) / gsz; return true;
    }
    __device__ __forceinline__ void a_ready(const Unit&) const {}
    __device__ __forceinline__ void done(const Unit&) const {}
};


__device__ __forceinline__ unsigned cvt_pk_bf16(float lo, float hi) { unsigned r; asm volatile("v_cvt_pk_bf16_f32 %0, %1, %2" : "=v"(r) : "v"(lo), "v"(hi)); return r; }
template <int ACT  > struct EpiBf16 {
    static constexpr bool PERM = true, AFTER_DRAIN = false;
    bf16_t* O; int ldc;
    __device__ __forceinline__ void operator()(const f32x4 (&acc)[2][2][4][2], const Unit& u, int wr, int wc, int fr, int fq) const {
        const int row0 = u.pm * BM + wr * 64 + fr, col0 = u.pn * BM + wc * 32 + 8 * fq;
#pragma unroll
        for (int ai = 0; ai < 2; ++ai)
#pragma unroll
            for (int m = 0; m < 4; ++m) { bf16_t* rowp = O + (size_t)(row0 + ai * HALF + m * 16) * ldc + col0;
#pragma unroll
                for (int bj = 0; bj < 2; ++bj) { f32x4 v0 = acc[ai][bj][m][0], v1 = acc[ai][bj][m][1];
                    if (ACT == 1) {
#pragma unroll
                        for (int q = 0; q < 4; ++q) { const float a = fmaxf(v0[q], 0.f), b = fmaxf(v1[q], 0.f); v0[q] = a * a; v1[q] = b * b; } }
                    u32x4 w; w.x = cvt_pk_bf16(v0[0], v0[1]); w.y = cvt_pk_bf16(v0[2], v0[3]); w.z = cvt_pk_bf16(v1[0], v1[1]); w.w = cvt_pk_bf16(v1[2], v1[3]);
                    *(u32x4*)(rowp + bj * HALF) = w; } }
    }
};
struct EpiRes {
    static constexpr bool PERM = false, AFTER_DRAIN = false;
    const float* base0; const float* base1; int split; const float* gate; int ldg; float* out; int ldc;
    __device__ __forceinline__ void operator()(const f32x4 (&acc)[2][2][4][2], const Unit& u, int wr, int wc, int fr, int fq) const {
        const int row0 = u.pm * BM + wr * 64 + fr, col0 = u.pn * BM + wc * 32 + 4 * fq;
#pragma unroll
        for (int ai = 0; ai < 2; ++ai)
#pragma unroll
            for (int m = 0; m < 4; ++m) { const int r = row0 + ai * HALF + m * 16;
                const float* bp = (r < split ? base0 + (size_t)r * ldc : base1 + (size_t)(r - split) * ldc) + col0;
                const float* gp = gate + (size_t)row_gb(r) * ldg + col0; float* op = out + (size_t)r * ldc + col0;
#pragma unroll
                for (int bj = 0; bj < 2; ++bj)
#pragma unroll
                    for (int n = 0; n < 2; ++n) { const f32x4 bs = *(const f32x4*)(bp + bj * HALF + n * 16), g = *(const f32x4*)(gp + bj * HALF + n * 16);
                        *(f32x4*)(op + bj * HALF + n * 16) = bs + g * acc[ai][bj][m][n]; }
                if (m & 1) asm volatile("" ::: "memory"); }
    }
};

template <class Epi, class Sched, bool ALIGN_EPI = false, bool SP2 = false>
__device__ __forceinline__ void gemm_phase(PG8_LAS unsigned char* lds, const Gemm g, const Sched& S, const Epi& E) {
    const int tid = threadIdx.x, wid = __builtin_amdgcn_readfirstlane(tid >> 6), lane = tid & 63, wr = wid >> 2, wc = wid & 3, fr = lane & 15, fq = lane >> 4;
    const int K = g.K, nt = K / BK;
    unsigned voffA[2], voffB[2];
#pragma unroll
    for (int i = 0; i < 2; ++i) { int R, C; stage_rc(tid * 16 + i * 8192, R, C); const int Rb = Epi::PERM ? ((R & ~31) + perm32(R & 31)) : R;
        voffA[i] = (unsigned)(R * K + C) * 2u; voffB[i] = (unsigned)(Rb * K + C) * 2u; }
    const size_t kstep = (size_t)(BK * 2);
    const size_t hstep = (size_t)HALF * K * 2;
    const size_t tstep = 2 * hstep;
    const unsigned ldsw = (unsigned)wid * 1024u;
    const int aoff = lds_byte(wr * 64 + fr, fq * 8), boff = lds_byte(wc * 32 + fr, fq * 8);
#define PG8_SA(b, h) (((b) * 2 + (h)) * HTB)
#define PG8_SB(b, h) ((4 + (b) * 2 + (h)) * HTB)
#define PG8_STAGE(bufoff, gbase, voff) do { _Pragma("unroll") for (int _i = 0; _i < 2; ++_i) \
        __builtin_amdgcn_global_load_lds((const unsigned*)((const char*)(gbase) + (voff)[_i]), (PG8_LAS unsigned*)(lds + (bufoff) + ldsw + _i * 8192), 16, 0, 0); } while (0)
#define PG8_LDA(dst, b, h) do { _Pragma("unroll") for (int m = 0; m < 4; ++m) _Pragma("unroll") for (int k = 0; k < 2; ++k) dst[m][k] = *(const PG8_LAS bf16x8*)(lds + PG8_SA(b, h) + aoff + m * 2048 + k * 1024); } while (0)
#define PG8_LDB(dst, b, h) do { _Pragma("unroll") for (int n = 0; n < 2; ++n) _Pragma("unroll") for (int k = 0; k < 2; ++k) dst[n][k] = *(const PG8_LAS bf16x8*)(lds + PG8_SB(b, h) + boff + n * 2048 + k * 1024); } while (0)
#define PG8_MMA(ai, bj, At, Bt) do { __builtin_amdgcn_s_setprio(1); _Pragma("unroll") for (int m = 0; m < 4; ++m) _Pragma("unroll") for (int n = 0; n < 2; ++n) _Pragma("unroll") for (int k = 0; k < 2; ++k) \
        acc[ai][bj][m][n] = __builtin_amdgcn_mfma_f32_16x16x32_bf16(Bt[n][k], At[m][k], acc[ai][bj][m][n], 0, 0, 0); __builtin_amdgcn_s_setprio(0); } while (0)
#define PG8_WAIT_V(n) asm volatile("s_waitcnt vmcnt(" #n ")" ::: "memory")
#define PG8_WAIT_L(n) asm volatile("s_waitcnt lgkmcnt(" #n ")" ::: "memory")
#define PG8_BAR __builtin_amdgcn_s_barrier()
#define PG8_SCHED __builtin_amdgcn_sched_barrier(0)
    Unit cur, nxt; int ui = 0;
    if (!S.next(0, cur)) return;
    f32x4 acc[2][2][4][2];
#pragma unroll
    for (int a = 0; a < 2; ++a)
#pragma unroll
        for (int b = 0; b < 2; ++b)
#pragma unroll
            for (int m = 0; m < 4; ++m)
#pragma unroll
                for (int n = 0; n < 2; ++n) acc[a][b][m][n] = (f32x4){0.f, 0.f, 0.f, 0.f};
    bf16x8 At[4][2], B0[2][2], B1[2][2];
    const char* cA = (const char*)g.A + (size_t)cur.pm * tstep; const char* cB = (const char*)g.Bt + (size_t)cur.pn * tstep;
    S.a_ready(cur);
    if constexpr (SP2) {
        PG8_STAGE(PG8_SB(0, 0), cB, voffB); PG8_STAGE(PG8_SB(0, 1), cB + hstep, voffB); PG8_STAGE(PG8_SA(0, 0), cA, voffA); PG8_STAGE(PG8_SA(0, 1), cA + hstep, voffA);
        if (wr == 1) PG8_BAR;
        PG8_WAIT_V(2); PG8_BAR;
        PG8_STAGE(PG8_SB(1, 0), cB + kstep, voffB); PG8_STAGE(PG8_SA(1, 0), cA + kstep, voffA); PG8_STAGE(PG8_SB(1, 1), cB + hstep + kstep, voffB);
        PG8_WAIT_V(6); PG8_BAR;
    } else {
        PG8_STAGE(PG8_SB(0, 0), cB, voffB); PG8_STAGE(PG8_SA(0, 0), cA, voffA); PG8_STAGE(PG8_SB(0, 1), cB + hstep, voffB); PG8_STAGE(PG8_SA(0, 1), cA + hstep, voffA);
        if (wr == 1) PG8_BAR;
        PG8_WAIT_V(4); PG8_BAR;
        PG8_STAGE(PG8_SB(1, 0), cB + kstep, voffB); PG8_STAGE(PG8_SA(1, 0), cA + kstep, voffA); PG8_STAGE(PG8_SB(1, 1), cB + hstep + kstep, voffB);
        PG8_WAIT_V(6); PG8_BAR;
    }
    for (;;) {
        const bool has_next = S.next(ui + 1, nxt);
        const char* nA = has_next ? (const char*)g.A + (size_t)nxt.pm * tstep : cA; const char* nB = has_next ? (const char*)g.Bt + (size_t)nxt.pn * tstep : cB;
        for (int t = 0; t < nt; t += 2) {
            const bool last = (t == nt - 2);
            const char* a1 = cA + (size_t)(t + 1) * kstep;
            const char* a2 = last ? nA : cA + (size_t)(t + 2) * kstep; const char* b2 = last ? nB : cB + (size_t)(t + 2) * kstep;
            const char* a3 = a2 + kstep; const char* b3 = b2 + kstep;
            if (last && has_next) S.a_ready(nxt);
            if constexpr (SP2) {
            PG8_LDB(B0, 0, 0); PG8_LDB(B1, 0, 1); PG8_SCHED; PG8_LDA(At, 0, 0); PG8_STAGE(PG8_SA(1, 1), a1 + hstep, voffA);
            PG8_WAIT_V(8); PG8_WAIT_L(0); PG8_BAR; PG8_MMA(0, 0, At, B0); PG8_MMA(0, 1, At, B1); PG8_BAR; PG8_SCHED;
            PG8_LDA(At, 0, 1); PG8_STAGE(PG8_SB(0, 0), b2, voffB); PG8_STAGE(PG8_SB(0, 1), b2 + hstep, voffB); PG8_STAGE(PG8_SA(0, 0), a2, voffA);
            PG8_WAIT_V(8); PG8_WAIT_L(0); PG8_BAR; PG8_MMA(1, 0, At, B0); PG8_MMA(1, 1, At, B1); PG8_BAR; PG8_SCHED;
            PG8_LDB(B0, 1, 0); PG8_LDB(B1, 1, 1); PG8_SCHED; PG8_LDA(At, 1, 0); PG8_STAGE(PG8_SA(0, 1), a2 + hstep, voffA);
            PG8_WAIT_V(8); PG8_WAIT_L(0); PG8_BAR; PG8_MMA(0, 0, At, B0); PG8_MMA(0, 1, At, B1); PG8_BAR; PG8_SCHED;
            PG8_LDA(At, 1, 1); PG8_STAGE(PG8_SB(1, 0), b3, voffB); PG8_STAGE(PG8_SB(1, 1), b3 + hstep, voffB); PG8_STAGE(PG8_SA(1, 0), a3, voffA);
            PG8_WAIT_V(8); PG8_WAIT_L(0); PG8_BAR; PG8_MMA(1, 0, At, B0); PG8_MMA(1, 1, At, B1); PG8_BAR; PG8_SCHED;
            } else {
            PG8_LDB(B0, 0, 0); PG8_SCHED; PG8_LDA(At, 0, 0); PG8_STAGE(PG8_SA(1, 1), a1 + hstep, voffA);
            PG8_WAIT_L(8); PG8_BAR; PG8_WAIT_L(0); PG8_MMA(0, 0, At, B0); PG8_BAR; PG8_SCHED;
            PG8_LDB(B1, 0, 1); PG8_STAGE(PG8_SB(0, 0), b2, voffB);
            PG8_BAR; PG8_WAIT_L(0); PG8_MMA(0, 1, At, B1); PG8_BAR;
            PG8_LDA(At, 0, 1); PG8_STAGE(PG8_SA(0, 0), a2, voffA);
            PG8_BAR; PG8_WAIT_L(0); PG8_MMA(1, 0, At, B0); PG8_BAR; PG8_SCHED;
            PG8_STAGE(PG8_SB(0, 1), b2 + hstep, voffB);
            PG8_WAIT_V(6); PG8_BAR; PG8_MMA(1, 1, At, B1); PG8_BAR;
            PG8_LDB(B0, 1, 0); PG8_SCHED; PG8_LDA(At, 1, 0); PG8_STAGE(PG8_SA(0, 1), a2 + hstep, voffA);
            PG8_WAIT_L(8); PG8_BAR; PG8_WAIT_L(0); PG8_MMA(0, 0, At, B0); PG8_BAR; PG8_SCHED;
            PG8_LDB(B1, 1, 1); PG8_STAGE(PG8_SB(1, 0), b3, voffB);
            PG8_BAR; PG8_WAIT_L(0); PG8_MMA(0, 1, At, B1); PG8_BAR;
            PG8_LDA(At, 1, 1); PG8_STAGE(PG8_SA(1, 0), a3, voffA);
            PG8_BAR; PG8_WAIT_L(0); PG8_MMA(1, 0, At, B0); PG8_BAR; PG8_SCHED;
            PG8_STAGE(PG8_SB(1, 1), b3 + hstep, voffB);
            PG8_WAIT_V(6); PG8_BAR; PG8_MMA(1, 1, At, B1); PG8_BAR;
            }
        }
        if constexpr (ALIGN_EPI) { if (wr == 0) PG8_BAR; }
        if constexpr (!Epi::AFTER_DRAIN) { E(acc, cur, wr, wc, fr, fq); S.done(cur); }
        if (!has_next) break;
#pragma unroll
        for (int a = 0; a < 2; ++a)
#pragma unroll
            for (int b = 0; b < 2; ++b)
#pragma unroll
                for (int m = 0; m < 4; ++m)
#pragma unroll
                    for (int n = 0; n < 2; ++n) acc[a][b][m][n] = (f32x4){0.f, 0.f, 0.f, 0.f};
        cur = nxt; cA = nA; cB = nB; ++ui;
        if constexpr (ALIGN_EPI) { if (wr == 1) PG8_BAR; }
    }
    PG8_WAIT_V(0);
    if constexpr (!ALIGN_EPI) { if (wr == 0) PG8_BAR; }
    PG8_BAR;
    if constexpr (Epi::AFTER_DRAIN) { E.fused(acc, cur, wr, wc, fr, fq, lds, wid, lane); S.done(cur); }
#undef PG8_SA
#undef PG8_SB
#undef PG8_STAGE
#undef PG8_LDA
#undef PG8_LDB
#undef PG8_MMA
#undef PG8_WAIT_V
#undef PG8_WAIT_L
#undef PG8_BAR
#undef PG8_SCHED
}
}

constexpr int RING_OFF = 0, RING_BYTES = 131072;
constexpr int LDSCTL_OFF = RING_BYTES, MISC_OFF = LDSCTL_OFF + 320;
constexpr int LDS_BYTES = 147456;

typedef GAS unsigned gu32;
#define RLX_AGENT __ATOMIC_RELAXED, __HIP_MEMORY_SCOPE_AGENT
#define LDS_WAIT() asm volatile("s_waitcnt lgkmcnt(0)" ::: "memory")
#define VM_WAIT() asm volatile("s_waitcnt vmcnt(0)" ::: "memory")

#define XB_TMO      128
#define XB_XCNT(j)  (256  + 64 * (j))
#define XB_XSUB(j)  (1280 + 64 * (j))
#define XB_XGEN(j)  (2304 + 64 * (j))
#define XB_TOP      3328
#define XB_TOPGEN   3392
#define XCD_BAR_WORDS 3456
#define XB_SPIN_CAP (1u << 18)
__device__ __forceinline__ unsigned xb_ld(unsigned* p)              { return __hip_atomic_load(p, __ATOMIC_RELAXED, __HIP_MEMORY_SCOPE_AGENT); }
__device__ __forceinline__ unsigned xb_add(unsigned* p, unsigned v) { return __hip_atomic_fetch_add(p, v, __ATOMIC_RELAXED, __HIP_MEMORY_SCOPE_AGENT); }
__device__ __forceinline__ unsigned xb_xcc_id() { return (unsigned)__builtin_amdgcn_s_getreg((3 << 11) | 20) & 0xFu; }
#define XB_SPIN(cond, bar) do { unsigned _sp = 0; while (cond) { __builtin_amdgcn_s_sleep(1); \
    if ((++_sp & 255u) == 0u) { if (xb_ld(&(bar)[XB_TMO])) break; if (_sp > XB_SPIN_CAP) { atomicAdd(&(bar)[XB_TMO], 1u); break; } } } } while (0)
struct XcdBarrier { unsigned* bar; unsigned x; volatile LAS unsigned* st; };
__device__ __forceinline__ XcdBarrier xcd_barrier_post(unsigned* bar, volatile LAS unsigned* st) {
    XcdBarrier b; b.bar = bar; b.x = xb_xcc_id(); b.st = st;
    if (threadIdx.x == 0) (void)xb_add(&bar[XB_XCNT(b.x)], 1u);
    return b;
}
__device__ __forceinline__ void xcd_barrier_complete(unsigned* bar, unsigned x, unsigned& nloc, unsigned& nx) {
    const unsigned G = gridDim.x * gridDim.y * gridDim.z;
    unsigned sum, cnt, mine, sp = 0u;
    for (;;) {
        sum = 0u; cnt = 0u; mine = 0u;
#pragma unroll
        for (unsigned j = 0; j < 16; ++j) { const unsigned c = xb_ld(&bar[XB_XCNT(j)]); sum += c; cnt += (c > 0u) ? 1u : 0u; mine = (j == x) ? c : mine; }
        if (sum == G) break;
        __builtin_amdgcn_s_sleep(1);
        if ((++sp & 255u) == 0u) { if (xb_ld(&bar[XB_TMO])) break; if (sp > XB_SPIN_CAP) { atomicAdd(&bar[XB_TMO], 1u); break; } }
    }
    nloc = mine > 0u ? mine : 1u; nx = cnt > 0u ? cnt : 1u;
}
__device__ __forceinline__ void xcd_barrier(const XcdBarrier& b) {
    asm volatile("s_waitcnt vmcnt(0)" ::: "memory");
    __syncthreads();
    if (threadIdx.x == 0) {
        unsigned* bar = b.bar;
        __builtin_amdgcn_s_waitcnt(0);
        unsigned nloc = b.st[0], nx = b.st[1];
        if (nloc == 0u) { xcd_barrier_complete(bar, b.x, nloc, nx); b.st[0] = nloc; b.st[1] = nx; }
        const unsigned old = xb_add(&bar[XB_XSUB(b.x)], 1u);
        const unsigned gen = old / nloc;
        if (old + 1u == (gen + 1u) * nloc) {
            __builtin_amdgcn_fence(__ATOMIC_RELEASE, "agent");
            asm volatile("s_waitcnt vmcnt(0)" ::: "memory");
            const unsigned og = xb_add(&bar[XB_TOP], 1u);
            const unsigned tg = og / nx;
            if (og + 1u == (tg + 1u) * nx) xb_add(&bar[XB_TOPGEN], 1u);
            else XB_SPIN(xb_ld(&bar[XB_TOPGEN]) == tg, bar);
            __builtin_amdgcn_fence(__ATOMIC_ACQUIRE, "agent");
            xb_add(&bar[XB_XGEN(b.x)], 1u);
            asm volatile("s_waitcnt vmcnt(0)" ::: "memory");
        } else {
            XB_SPIN(xb_ld(&bar[XB_XGEN(b.x)]) == gen, bar);
            __builtin_amdgcn_fence(__ATOMIC_ACQUIRE, "agent");
            asm volatile("s_waitcnt vmcnt(0)" ::: "memory");
        }
    }
    __syncthreads();
}

struct Frame {
    LAS unsigned char* lds;
    int tid, lane, wave, gw, ngw;
    const float *xp, *xs, *stC, *stN, *stM, *stS, *stConv, *cp, *cs, *ada_w, *ada_b, *norm1, *w_in, *gate_b, *mlstm_g, *conv_w, *A_log, *dt_bias, *gdn_g,
                *w_out, *norm2, *w_up, *w_down, *adaf_w, *adaf_b, *normf;
    float* out;
    bf16_t *SCB, *WIN, *WOUT, *WUP, *WDOWN, *HB, *MIX, *PROJ;
    float *MOD, *MODF, *GATES, *X1;
    unsigned char* IMGM; unsigned char* IMGG;
};
__device__ __forceinline__ const float* xrow(const Frame& F, int r) { return r < M_P ? F.xp + (size_t)r * D : F.xs + (size_t)(r - M_P) * D; }

__device__ __forceinline__ void p0_silu(Frame& F) {
    const int gt = blockIdx.x * NTHREADS + F.tid, GT = gridDim.x * NTHREADS;
    for (int g = gt; g < 160 * 256; g += GT) {
        const int row = g >> 8, c8 = (g & 255) * 8; u32x4 o = (u32x4){0u, 0u, 0u, 0u};
        if (row < NGB) { const float* src = (row < NB_P ? F.cp + (size_t)row * D : F.cs + (size_t)(row - NB_P) * D) + c8;
            const f32x4 a = *(const f32x4*)src, b = *(const f32x4*)(src + 4);
            o.x = pk2(siluf_(a.x), siluf_(a.y)); o.y = pk2(siluf_(a.z), siluf_(a.w)); o.z = pk2(siluf_(b.x), siluf_(b.y)); o.w = pk2(siluf_(b.z), siluf_(b.w)); }
        *(u32x4*)(F.SCB + (size_t)row * D + c8) = o;
    }
}

__device__ __forceinline__ void p1_modgemv(Frame& F) {
    LAS float* red = (LAS float*)(F.lds + RING_OFF);
    const int lane = F.lane, r = lane & 31, hh = lane >> 5, cbi = F.wave >> 2, ks = F.wave & 3;
    for (int pair = blockIdx.x; pair < 256; pair += gridDim.x) {
        const int cb = 2 * pair + cbi;
        const float* W; const float* bias; float* outp; int ldw, n0;
        if (cb < 384) { W = F.ada_w; ldw = MODW; n0 = cb * 32; bias = F.ada_b; outp = F.MOD; }
        else { W = F.adaf_w; ldw = MODFW; n0 = (cb - 384) * 32; bias = F.adaf_b; outp = F.MODF; }
        f32x16 acc[5];
#pragma unroll
        for (int g = 0; g < 5; ++g)
#pragma unroll
            for (int i = 0; i < 16; ++i) acc[g][i] = 0.f;
        const float* wp = W + (size_t)(ks * 512 + 8 * hh) * ldw + n0 + r;
        const bf16_t* ap = F.SCB + (size_t)r * D + ks * 512 + 8 * hh;
        for (int s = 0; s < 32; s += 4) {
            float wv[4][8];
#pragma unroll
            for (int u = 0; u < 4; ++u)
#pragma unroll
                for (int j = 0; j < 8; ++j) wv[u][j] = wp[(size_t)((s + u) * 16 + j) * ldw];
#pragma unroll
            for (int u = 0; u < 4; ++u) {
                u32x4 bw; bw.x = pk2(wv[u][0], wv[u][1]); bw.y = pk2(wv[u][2], wv[u][3]); bw.z = pk2(wv[u][4], wv[u][5]); bw.w = pk2(wv[u][6], wv[u][7]);
                const bf16x8 b = __builtin_bit_cast(bf16x8, bw);
#pragma unroll
                for (int g = 0; g < 5; ++g) { const bf16x8 a = *(const bf16x8*)(ap + (size_t)g * 32 * D + (s + u) * 16);
                    acc[g] = __builtin_amdgcn_mfma_f32_32x32x16_bf16(a, b, acc[g], 0, 0, 0); }
            }
        }
        if (ks > 0) {
#pragma unroll
            for (int g = 0; g < 5; ++g)
#pragma unroll
                for (int i = 0; i < 16; ++i) red[(((ks - 1) * 2 + cbi) * 80 + g * 16 + i) * 64 + lane] = acc[g][i];
        }
        __syncthreads();
        if (ks == 0) {
            const float bv = bias[n0 + r];
#pragma unroll
            for (int g = 0; g < 5; ++g)
#pragma unroll
                for (int i = 0; i < 16; ++i) {
                    float v = acc[g][i];
#pragma unroll
                    for (int k2 = 0; k2 < 3; ++k2) v += red[((k2 * 2 + cbi) * 80 + g * 16 + i) * 64 + lane];
                    const int gb = 32 * g + (i & 3) + 8 * (i >> 2) + 4 * hh;
                    if (gb < NGB) outp[(size_t)gb * ldw + n0 + r] = v + bv;
                }
        }
        __syncthreads();
    }
}

__device__ __forceinline__ int win_dst_row(int n) {
    if (n < 3072) return n;
    if (n < 3088) return 8192 + (n - 3072);
    if (n < 7184) return n - 16;
    if (n < 7200) return 8208 + (n - 7184);
    return n - 32;
}
template <bool MAPWIN>
__device__ __forceinline__ void transpose_item(const float* W, int K, int N, bf16_t* WT, LAS float* scr, int item, int lane) {
    const int nblk = N / 32, kb = item / nblk, nb = item % nblk, k0 = 64 * kb, n0 = 32 * nb;
#pragma unroll 8
    for (int i = 0; i < 32; ++i) { const int kk = 2 * i + (lane >> 5); scr[kk * 33 + (lane & 31)] = W[(size_t)(k0 + kk) * N + n0 + (lane & 31)]; }
    LDS_WAIT(); asm volatile("" ::: "memory");
    const int c = lane & 7;
#pragma unroll
    for (int j = 0; j < 4; ++j) { const int n = (lane >> 3) + 8 * j; const LAS float* s = scr + (8 * c) * 33 + n;
        u32x4 o; o.x = pk2(s[0 * 33], s[1 * 33]); o.y = pk2(s[2 * 33], s[3 * 33]); o.z = pk2(s[4 * 33], s[5 * 33]); o.w = pk2(s[6 * 33], s[7 * 33]);
        const int dr = MAPWIN ? win_dst_row(n0 + n) : (n0 + n);
        *(u32x4*)(WT + (size_t)dr * K + k0 + 8 * c) = o; }
    LDS_WAIT(); asm volatile("" ::: "memory");
}
__device__ __forceinline__ void p1_transposes(Frame& F) {
    LAS float* scr = (LAS float*)(F.lds + RING_OFF + F.wave * 16384);
    constexpr int I_IN = (D / 64) * (P_IN / 32), I_OUT = (D / 64) * (D / 32), I_UP = (D / 64) * (DFF / 32), I_DOWN = (DFF / 64) * (D / 32);
    constexpr int NITEMS = I_IN + I_OUT + I_UP + I_DOWN;
    for (int it = F.gw; it < NITEMS; it += F.ngw) {
        int r = it;
        if (r < I_IN) { transpose_item<true>(F.w_in, D, P_IN, F.WIN, scr, r, F.lane); continue; } r -= I_IN;
        if (r < I_OUT) { transpose_item<false>(F.w_out, D, D, F.WOUT, scr, r, F.lane); continue; } r -= I_OUT;
        if (r < I_UP) { transpose_item<false>(F.w_up, D, DFF, F.WUP, scr, r, F.lane); continue; } r -= I_UP;
        transpose_item<false>(F.w_down, DFF, D, F.WDOWN, scr, r, F.lane);
    }
}

__device__ __forceinline__ void norm_mod_row_bf16(const float* xr_, const float* g, const float* shift, const float* scale, bf16_t* orow, int lane) {
    const f32x4* xr = (const f32x4*)xr_ + lane;
    f32x4 v[8]; float s = 0.f;
#pragma unroll
    for (int j = 0; j < 8; ++j) { v[j] = xr[64 * j]; s += (v[j].x * v[j].x + v[j].y * v[j].y) + (v[j].z * v[j].z + v[j].w * v[j].w); }
    const float rstd = 1.0f / sqrtf(wave_sum(s) * (1.0f / D) + EPS);
    u32x2* o8 = (u32x2*)orow + lane;
#pragma unroll
    for (int j = 0; j < 8; ++j) { const f32x4 gg = ((const f32x4*)g)[lane + 64 * j], sh = ((const f32x4*)shift)[lane + 64 * j], sc = ((const f32x4*)scale)[lane + 64 * j];
        const f32x4 y = (v[j] * rstd * gg) * (sc + 1.0f) + sh; u32x2 w; w.x = pk2(y.x, y.y); w.y = pk2(y.z, y.w); o8[64 * j] = w; }
}
__device__ __forceinline__ void norm_mod_row_f32(const float* xr_, const float* g, const float* shift, const float* scale, float* orow, int lane) {
    const f32x4* xr = (const f32x4*)xr_ + lane;
    f32x4 v[8]; float s = 0.f;
#pragma unroll
    for (int j = 0; j < 8; ++j) { v[j] = xr[64 * j]; s += (v[j].x * v[j].x + v[j].y * v[j].y) + (v[j].z * v[j].z + v[j].w * v[j].w); }
    const float rstd = 1.0f / sqrtf(wave_sum(s) * (1.0f / D) + EPS);
    f32x4* o = (f32x4*)orow + lane;
#pragma unroll
    for (int j = 0; j < 8; ++j) { const f32x4 gg = ((const f32x4*)g)[lane + 64 * j], sh = ((const f32x4*)shift)[lane + 64 * j], sc = ((const f32x4*)scale)[lane + 64 * j];
        o[64 * j] = (v[j] * rstd * gg) * (sc + 1.0f) + sh; }
}

__device__ __forceinline__ void p3_gates(Frame& F) {
    const int lane = F.lane, fr = lane & 15, fq = lane >> 4;
    for (int task = F.gw; task < M / 16; task += F.ngw) {
        const int r0 = task * 16;
        const bf16_t* ap = F.HB + (size_t)(r0 + fr) * D + 8 * fq;
        const bf16_t* bp = F.WIN + (size_t)(NPROJ + fr) * D + 8 * fq;
        f32x4 c0 = (f32x4){0.f, 0.f, 0.f, 0.f}, c1 = c0;
#pragma unroll 8
        for (int k0 = 0; k0 < D; k0 += 32) {
            const bf16x8 a = *(const bf16x8*)(ap + k0), b0 = *(const bf16x8*)(bp + k0), b1 = *(const bf16x8*)(bp + (size_t)16 * D + k0);
            c0 = __builtin_amdgcn_mfma_f32_16x16x32_bf16(a, b0, c0, 0, 0, 0);
            c1 = __builtin_amdgcn_mfma_f32_16x16x32_bf16(a, b1, c1, 0, 0, 0);
        }
#pragma unroll
        for (int i = 0; i < 4; ++i) { float* o = F.GATES + (size_t)(r0 + 4 * fq + i) * NGATE + fr; o[0] = c0[i]; o[16] = c1[i]; }
    }
}

__device__ __forceinline__ void scan_mlstm_simple(Frame& F, bool prompt, int b, int hd) {
    LAS float* sq = (LAS float*)(F.lds + RING_OFF); LAS float* sk = sq + 128; LAS float* sv = sk + 128; LAS float* spart = sv + 128; LAS float* sred = spart + 512; LAS float* sred2 = sred + 8;
    const int tid = F.tid, e = tid & 127, q4 = tid >> 7, lane = F.lane, wave = F.wave;
    const int T = prompt ? T_P : T_S, row0 = prompt ? b * T_P : M_P + b * T_S, bh = b * NH + hd;
    float C[32]; float nst = 0.f, m = 0.f;
    if (prompt) {
#pragma unroll
        for (int dd = 0; dd < 32; ++dd) C[dd] = 0.f;
    } else {
#pragma unroll
        for (int dd = 0; dd < 32; ++dd) C[dd] = F.stC[((size_t)bh * HD + 32 * q4 + dd) * HD + e];
        if (tid < 128) nst = F.stN[(size_t)bh * HD + tid];
        m = F.stM[bh];
    }
    const float bi = F.gate_b[hd], bfg = F.gate_b[NH + hd], gn = F.mlstm_g[hd * HD + e];
    for (int t = 0; t < T; ++t) {
        const int row = row0 + t; const bf16_t* pr = F.PROJ + (size_t)row * NPROJ + hd * HD;
        float oa = 0.f;
        if (tid < 128) { sq[tid] = bf2f(pr[tid]); sk[tid] = bf2f(pr[1024 + tid]) * 0.08838834764831845f; sv[tid] = bf2f(pr[2048 + tid]); oa = bf2f(pr[3072 + tid]); }
        const float ia = F.GATES[(size_t)row * NGATE + hd], fa = F.GATES[(size_t)row * NGATE + 8 + hd];
        __syncthreads();
        const float li = ia + bi, lf = logsigmoidf_(fa + bfg);
        const float mn = fmaxf(lf + m, li), fdec = expf(lf + m - mn), iin = expf(li - mn); m = mn;
        const float ve = sv[e]; float part = 0.f;
#pragma unroll
        for (int dd = 0; dd < 32; ++dd) { const int d = 32 * q4 + dd; C[dd] = fdec * C[dd] + (iin * sk[d]) * ve; part += sq[d] * C[dd]; }
        spart[q4 * 128 + e] = part;
        if (tid < 128) { nst = fdec * nst + iin * sk[tid]; const float pn = wave_sum(sq[tid] * nst); if (lane == 0) sred[wave] = pn; }
        __syncthreads();
        const float numer = (spart[e] + spart[128 + e]) + (spart[256 + e] + spart[384 + e]);
        const float ddn = sred[0] + sred[1];
        const float hval = numer / fmaxf(fabsf(ddn), expf(-m));
        const float ss = wave_sum(hval * hval);
        if (lane == 0) sred2[wave] = ss;
        __syncthreads();
        const float tot = sred2[wave] + sred2[wave ^ 1];
        if (tid < 128) { const float y = hval * (1.0f / sqrtf(tot * (1.0f / HD) + EPS)) * gn * sigmoidf_(oa); F.MIX[(size_t)row * D + hd * HD + e] = (bf16_t)f2bf(y); }
    }
    float* oC = F.out + (prompt ? O_PC : O_SC) + (size_t)bh * HD * HD;
#pragma unroll
    for (int dd = 0; dd < 32; ++dd) oC[(size_t)(32 * q4 + dd) * HD + e] = C[dd];
    if (tid < 128) F.out[(prompt ? O_PN : O_SN) + (size_t)bh * HD + tid] = nst;
    if (tid == 0) F.out[(prompt ? O_PM : O_SM) + bh] = m;
    __syncthreads();
}
__device__ __forceinline__ void scan_gdn_simple(Frame& F, bool prompt, int b, int hd) {
    LAS float* sq = (LAS float*)(F.lds + RING_OFF); LAS float* sk = sq + 128; LAS float* sv = sk + 128; LAS float* spart = sv + 128; LAS float* spart2 = spart + 512; LAS float* sred = spart2 + 512; LAS float* sred2 = sred + 8;
    const int tid = F.tid, e = tid & 127, q4 = tid >> 7, lane = F.lane, wave = F.wave;
    const int T = prompt ? T_P : T_S, row0 = prompt ? b * T_P : M_P + b * T_S, bh = b * NH + hd;
    float S[32];
    if (prompt) {
#pragma unroll
        for (int dd = 0; dd < 32; ++dd) S[dd] = 0.f;
    } else {
#pragma unroll
        for (int dd = 0; dd < 32; ++dd) S[dd] = F.stS[((size_t)bh * HD + 32 * q4 + dd) * HD + e];
    }
    const int cch = (q4 < 3 ? q4 : 0) * 1024 + hd * HD + e;
    float h0 = 0.f, h1 = 0.f, h2 = 0.f;
    if (!prompt && q4 < 3) { const float* cv = F.stConv + (size_t)b * 3 * CCONV + cch; h0 = cv[0]; h1 = cv[CCONV]; h2 = cv[2 * CCONV]; }
    const float w0 = F.conv_w[cch], w1 = F.conv_w[CCONV + cch], w2 = F.conv_w[2 * CCONV + cch], w3 = F.conv_w[3 * CCONV + cch];
    const float negA = -expf(F.A_log[hd]), dtb = F.dt_bias[hd], gn = F.gdn_g[hd * HD + e];
    for (int t = 0; t < T; ++t) {
        const int row = row0 + t; const bf16_t* pr = F.PROJ + (size_t)row * NPROJ + 4096;
        float a = 0.f, zb = 0.f;
        if (q4 < 3) { const float u = bf2f(pr[cch]); const float cvv = w0 * h0 + w1 * h1 + w2 * h2 + w3 * u; h0 = h1; h1 = h2; h2 = u; a = siluf_(cvv); }
        if (q4 == 0) zb = bf2f(pr[3072 + hd * HD + e]);
        if (q4 < 2) { const float ss = wave_sum(a * a); if (lane == 0) sred[wave] = ss; }
        if (q4 == 2) sv[e] = a;
        const float ab = F.GATES[(size_t)row * NGATE + 16 + hd], bb = F.GATES[(size_t)row * NGATE + 24 + hd];
        __syncthreads();
        if (q4 == 0) sq[e] = a * (1.0f / sqrtf(sred[0] + sred[1] + EPS)) * 0.08838834764831845f;
        if (q4 == 1) sk[e] = a * (1.0f / sqrtf(sred[2] + sred[3] + EPS));
        __syncthreads();
        const float g = expf(negA * softplusf_(ab + dtb)), beta = sigmoidf_(bb);
        float part = 0.f;
#pragma unroll
        for (int dd = 0; dd < 32; ++dd) part += sk[32 * q4 + dd] * S[dd];
        spart[q4 * 128 + e] = part;
        __syncthreads();
        const float kS = (spart[e] + spart[128 + e]) + (spart[256 + e] + spart[384 + e]);
        const float ue = beta * (sv[e] - g * kS);
        float opart = 0.f;
#pragma unroll
        for (int dd = 0; dd < 32; ++dd) { const int d = 32 * q4 + dd; S[dd] = g * S[dd] + sk[d] * ue; opart += sq[d] * S[dd]; }
        spart2[q4 * 128 + e] = opart;
        __syncthreads();
        const float o = (spart2[e] + spart2[128 + e]) + (spart2[256 + e] + spart2[384 + e]);
        const float ss2 = wave_sum(o * o);
        if (lane == 0) sred2[wave] = ss2;
        __syncthreads();
        const float tot = sred2[wave] + sred2[wave ^ 1];
        if (q4 == 0) { const float y = o * (1.0f / sqrtf(tot * (1.0f / HD) + EPS)) * gn * siluf_(zb); F.MIX[(size_t)row * D + 1024 + hd * HD + e] = (bf16_t)f2bf(y); }
    }
    float* oS = F.out + (prompt ? O_PS : O_SS) + (size_t)bh * HD * HD;
#pragma unroll
    for (int dd = 0; dd < 32; ++dd) oS[(size_t)(32 * q4 + dd) * HD + e] = S[dd];
    if (q4 < 3) { float* oc = F.out + (prompt ? O_PCONV : O_SCONV) + (size_t)b * 3 * CCONV + cch; oc[0] = h0; oc[CCONV] = h1; oc[2 * CCONV] = h2; }
    __syncthreads();
}

__device__ __forceinline__ float wave_scan_add(float v, int lane) {
#pragma unroll
    for (int o = 1; o < 64; o <<= 1) { const float t = __shfl_up(v, o); if (lane >= o) v += t; }
    return v;
}
__device__ __forceinline__ float wave_scan_max(float v, int lane) {
#pragma unroll
    for (int o = 1; o < 64; o <<= 1) { const float t = __shfl_up(v, o); if (lane >= o) v = fmaxf(v, t); }
    return v;
}
__device__ __forceinline__ float wave_max(float v) {
#pragma unroll
    for (int o = 1; o < 64; o <<= 1) v = fmaxf(v, __shfl_xor(v, o));
    return v;
}
#define QK_SCALE 0.08838834764831845f
__device__ __forceinline__ void s1_mlstm_unit(Frame& F, int unit, LAS float* scr) {
    const int lane = F.lane, r = lane & 31, h = lane >> 5;
    const int c = unit & 31, bh = unit >> 5, hd = bh & 7, b = bh >> 3;
    const int rowb = b * T_P, row0 = rowb + 64 * c;
    unsigned char* rec = F.IMGM + (size_t)unit * MREC;
    const float bi = F.gate_b[hd], bfg = F.gate_b[NH + hd];
    float m_prev = 0.f;
    for (int cc = 0; cc < c; ++cc) {
        const float* gp = F.GATES + (size_t)(rowb + 64 * cc + lane) * NGATE;
        const float lfv = logsigmoidf_(gp[8 + hd] + bfg), liv = gp[hd] + bi;
        const float bb = wave_scan_add(lfv, lane); const float amax = wave_max(liv - bb); const float b63 = __shfl(bb, 63);
        m_prev = b63 + fmaxf(m_prev, amax);
    }
    float* sc = (float*)(rec + MR_SC);
    {
        const float* gp = F.GATES + (size_t)(row0 + lane) * NGATE;
        const float lfv = logsigmoidf_(gp[8 + hd] + bfg), liv = gp[hd] + bi;
        const float bb = wave_scan_add(lfv, lane); const float a = liv - bb; const float cm = wave_scan_max(a, lane);
        const float Mi = fmaxf(m_prev, cm), mi = bb + Mi; const float M63 = __shfl(Mi, 63), m_new = __shfl(mi, 63);
        scr[lane] = a; scr[64 + lane] = Mi; scr[128 + lane] = expf(a - M63) * QK_SCALE;
        sc[lane] = expf(m_prev - Mi); sc[64 + lane] = expf(-mi);
        if (lane == 0) { sc[192] = expf(m_prev - M63); sc[193] = m_new; if (c == 31) F.out[O_PM + bh] = m_new; }
    }
    asm volatile("s_waitcnt lgkmcnt(0)" ::: "memory");
    bf16x8 Qf[2][8], Kf[2][8];
    const bf16_t* pq = F.PROJ + (size_t)(row0 + r) * NPROJ + hd * HD + 8 * h;
#pragma unroll
    for (int rb = 0; rb < 2; ++rb)
#pragma unroll
        for (int s = 0; s < 8; ++s) { Qf[rb][s] = *(const bf16x8*)(pq + (size_t)(32 * rb) * NPROJ + 16 * s); Kf[rb][s] = *(const bf16x8*)(pq + (size_t)(32 * rb) * NPROJ + 1024 + 16 * s); }
#pragma unroll
    for (int rb = 0; rb < 2; ++rb)
#pragma unroll
        for (int s = 0; s < 8; ++s) { const int i = 32 * rb + r; const u32x4 wv = __builtin_bit_cast(u32x4, Qf[rb][s]);
            unsigned char* o0 = rec + MR_QI + ((((i >> 4) * 4 + (s >> 1)) * 64 + (2 * h) * 16 + (i & 15)) * 16) + 8 * (s & 1);
            *(u32x2*)o0 = (u32x2){wv.x, wv.y}; *(u32x2*)(o0 + 256) = (u32x2){wv.z, wv.w}; }
    float rs[2] = {0.f, 0.f};
#pragma unroll
    for (int blk = 0; blk < 3; ++blk) {
        const int jb = blk >> 1, ib = (blk + 1) >> 1;
        f32x16 Dm;
#pragma unroll
        for (int x = 0; x < 16; ++x) Dm[x] = 0.f;
#pragma unroll
        for (int s = 0; s < 8; ++s) Dm = __builtin_amdgcn_mfma_f32_32x32x16_bf16(Kf[jb][s], Qf[ib][s], Dm, 0, 0, 0);
        const int i = 32 * ib + r; const float Mi_i = scr[64 + i];
#pragma unroll
        for (int g = 0; g < 4; ++g) {
            const f32x4 aj = *(const LAS f32x4*)(scr + 32 * jb + 8 * g + 4 * h);
            float v[4];
#pragma unroll
            for (int ip = 0; ip < 4; ++ip) { const int j = 32 * jb + 8 * g + 4 * h + ip; const float x = Dm[4 * g + ip] * QK_SCALE * __expf(aj[ip] - Mi_i); v[ip] = (j <= i) ? x : 0.f; }
            rs[ib] += (v[0] + v[1]) + (v[2] + v[3]);
            *(u32x2*)(rec + MR_SP + ((((i >> 4) * 2 + jb) * 64 + g * 16 + (i & 15)) * 16) + 8 * h) = (u32x2){pk2(v[0], v[1]), pk2(v[2], v[3])};
        }
    }
    rs[0] += __shfl_xor(rs[0], 32); rs[1] += __shfl_xor(rs[1], 32);
    if (h == 0) { sc[128 + r] = rs[0]; sc[160 + r] = rs[1]; }
    const bf16_t* pk = F.PROJ + (size_t)row0 * NPROJ + 1024 + hd * HD;
    const bf16_t* pv = pk + 1024;
#pragma unroll 1
    for (int blk = 0; blk < 4; ++blk) {
        const int d = 32 * blk + r; float dn = 0.f;
#pragma unroll
        for (int s = 0; s < 4; ++s) {
            unsigned kv[8], vv[8];
#pragma unroll
            for (int j = 0; j < 8; ++j) { const size_t ro = (size_t)(16 * s + 8 * h + j) * NPROJ + d; kv[j] = pk[ro]; vv[j] = pv[ro]; }
            const f32x4 w0 = *(const LAS f32x4*)(scr + 128 + 16 * s + 8 * h), w1 = *(const LAS f32x4*)(scr + 128 + 16 * s + 8 * h + 4);
            float x[8];
#pragma unroll
            for (int j = 0; j < 4; ++j) { x[j] = bflo(kv[j]) * w0[j]; x[4 + j] = bflo(kv[4 + j]) * w1[j]; }
            dn += ((x[0] + x[1]) + (x[2] + x[3])) + ((x[4] + x[5]) + (x[6] + x[7]));
            const size_t off = ((((d >> 4) * 2 + (s >> 1)) * 64 + (2 * (s & 1) + h) * 16 + (d & 15)) * 16);
            *(u32x4*)(rec + MR_KW + off) = (u32x4){pk2(x[0], x[1]), pk2(x[2], x[3]), pk2(x[4], x[5]), pk2(x[6], x[7])};
            *(u32x4*)(rec + MR_VT + off) = (u32x4){vv[0] | (vv[1] << 16), vv[2] | (vv[3] << 16), vv[4] | (vv[5] << 16), vv[6] | (vv[7] << 16)};
        }
        dn += __shfl_xor(dn, 32);
        if (h == 0) ((float*)(rec + MR_DN))[d] = dn;
    }
}
__device__ __forceinline__ void s2_mlstm_chain(Frame& F, int bh) {
    const int lane = F.lane, w = F.wave, cl = lane & 15, q = lane >> 4, hd = bh & 7, b = bh >> 3;
    LAS unsigned char* const buf0 = F.lds; LAS unsigned char* const buf1 = F.lds + MREC;
    LAS float* const s_qn = (LAS float*)(F.lds + 2 * MREC); LAS float* const s_n = s_qn + 64; LAS float* const s_part = s_n + 128;
    const unsigned char* recs = F.IMGM + (size_t)bh * 32 * MREC;
    f32x4 C[8];
#pragma unroll
    for (int db = 0; db < 8; ++db) C[db] = (f32x4){0.f, 0.f, 0.f, 0.f};
    if (F.tid < 128) s_n[F.tid] = 0.f;
    for (int piece = w; piece < MREC / 1024; piece += 8)
        __builtin_amdgcn_global_load_lds((const unsigned*)(recs + piece * 1024 + lane * 16), (LAS unsigned*)(buf0 + piece * 1024), 16, 0, 0);
    asm volatile("s_waitcnt vmcnt(0)" ::: "memory"); __syncthreads();
    const float gn = F.mlstm_g[hd * HD + 16 * w + cl];
    for (int c = 0; c < 32; ++c) {
        LAS unsigned char* const cur = (c & 1) ? buf1 : buf0; LAS unsigned char* const nxt = (c & 1) ? buf0 : buf1;
        if (c + 1 < 32) { const unsigned char* src = recs + (size_t)(c + 1) * MREC;
            for (int piece = w; piece < MREC / 1024; piece += 8)
                __builtin_amdgcn_global_load_lds((const unsigned*)(src + piece * 1024 + lane * 16), (LAS unsigned*)(nxt + piece * 1024), 16, 0, 0); }
        const int row0 = b * T_P + 64 * c;
        unsigned oa[16];
#pragma unroll
        for (int x = 0; x < 16; ++x) oa[x] = F.PROJ[(size_t)(row0 + 16 * (x >> 2) + 4 * q + (x & 3)) * NPROJ + 3072 + hd * HD + 16 * w + cl];
        const LAS float* sc = (const LAS float*)(cur + MR_SC);
        {
            const int t = 8 * w + (lane >> 3), p = lane & 7, s = p >> 1; float acc = 0.f;
#pragma unroll
            for (int qq = 0; qq < 4; ++qq) {
                const u32x2 qv = *(const LAS u32x2*)(cur + MR_QI + ((((t >> 4) * 4 + s) * 64 + qq * 16 + (t & 15)) * 16) + 8 * (p & 1));
                const f32x4 nv = *(const LAS f32x4*)(s_n + 32 * s + 16 * (p & 1) + 4 * qq);
                acc += (bflo(qv.x) * nv.x + bfhi(qv.x) * nv.y) + (bflo(qv.y) * nv.z + bfhi(qv.y) * nv.w);
            }
            acc += __shfl_xor(acc, 1); acc += __shfl_xor(acc, 2); acc += __shfl_xor(acc, 4);
            if (p == 0) s_qn[t] = acc;
        }
        bf16x8 Cb[4];
#pragma unroll
        for (int s = 0; s < 4; ++s) Cb[s] = __builtin_bit_cast(bf16x8, (u32x4){pk2(C[2 * s][0], C[2 * s][1]), pk2(C[2 * s][2], C[2 * s][3]), pk2(C[2 * s + 1][0], C[2 * s + 1][1]), pk2(C[2 * s + 1][2], C[2 * s + 1][3])});
        const bf16x8 VB0 = *(const LAS bf16x8*)(cur + MR_VT + (w * 2 + 0) * 1024 + lane * 16), VB1 = *(const LAS bf16x8*)(cur + MR_VT + (w * 2 + 1) * 1024 + lane * 16);
        f32x4 num[4];
#pragma unroll
        for (int tb = 0; tb < 4; ++tb) {
            f32x4 acc = (f32x4){0.f, 0.f, 0.f, 0.f};
#pragma unroll
            for (int s = 0; s < 4; ++s) acc = __builtin_amdgcn_mfma_f32_16x16x32_bf16(*(const LAS bf16x8*)(cur + MR_QI + (tb * 4 + s) * 1024 + lane * 16), Cb[s], acc, 0, 0, 0);
            acc = acc * *(const LAS f32x4*)(sc + 16 * tb + 4 * q);
            acc = __builtin_amdgcn_mfma_f32_16x16x32_bf16(*(const LAS bf16x8*)(cur + MR_SP + (tb * 2 + 0) * 1024 + lane * 16), VB0, acc, 0, 0, 0);
            if (tb >= 2) acc = __builtin_amdgcn_mfma_f32_16x16x32_bf16(*(const LAS bf16x8*)(cur + MR_SP + (tb * 2 + 1) * 1024 + lane * 16), VB1, acc, 0, 0, 0);
            num[tb] = acc;
        }
        const float dC = sc[192];
#pragma unroll
        for (int db = 0; db < 8; ++db) {
            f32x4 acc = C[db] * dC;
            acc = __builtin_amdgcn_mfma_f32_16x16x32_bf16(*(const LAS bf16x8*)(cur + MR_KW + (db * 2 + 0) * 1024 + lane * 16), VB0, acc, 0, 0, 0);
            acc = __builtin_amdgcn_mfma_f32_16x16x32_bf16(*(const LAS bf16x8*)(cur + MR_KW + (db * 2 + 1) * 1024 + lane * 16), VB1, acc, 0, 0, 0);
            C[db] = acc;
        }
        __syncthreads();
        if (F.tid < 128) s_n[F.tid] = dC * s_n[F.tid] + ((const LAS float*)(cur + MR_DN))[F.tid];
        float hv[16];
#pragma unroll
        for (int tb = 0; tb < 4; ++tb) {
            const f32x4 dv = *(const LAS f32x4*)(sc + 16 * tb + 4 * q), ev = *(const LAS f32x4*)(sc + 64 + 16 * tb + 4 * q), rv = *(const LAS f32x4*)(sc + 128 + 16 * tb + 4 * q), qn = *(const LAS f32x4*)(s_qn + 16 * tb + 4 * q);
            f32x4 ss;
#pragma unroll
            for (int i = 0; i < 4; ++i) { const float dd = dv[i] * qn[i] + rv[i]; const float hh = num[tb][i] / fmaxf(fabsf(dd), ev[i]); hv[tb * 4 + i] = hh; ss[i] = hh * hh; }
#pragma unroll
            for (int o = 1; o < 16; o <<= 1) { ss.x += __shfl_xor(ss.x, o); ss.y += __shfl_xor(ss.y, o); ss.z += __shfl_xor(ss.z, o); ss.w += __shfl_xor(ss.w, o); }
            if (cl == 0) *(LAS f32x4*)(s_part + w * 64 + 16 * tb + 4 * q) = ss;
        }
        __syncthreads();
#pragma unroll
        for (int tb = 0; tb < 4; ++tb) {
            f32x4 tot = (f32x4){0.f, 0.f, 0.f, 0.f};
#pragma unroll
            for (int ww = 0; ww < 8; ++ww) tot += *(const LAS f32x4*)(s_part + ww * 64 + 16 * tb + 4 * q);
#pragma unroll
            for (int i = 0; i < 4; ++i) { const float y = hv[tb * 4 + i] * (1.0f / sqrtf(tot[i] * (1.0f / HD) + EPS)) * gn * sigmoidf_(bflo(oa[tb * 4 + i]));
                F.MIX[(size_t)(row0 + 16 * tb + 4 * q + i) * D + hd * HD + 16 * w + cl] = (bf16_t)f2bf(y); }
        }
        asm volatile("s_waitcnt vmcnt(0)" ::: "memory"); __syncthreads();
    }
    float* oC = F.out + O_PC + (size_t)bh * HD * HD;
#pragma unroll
    for (int db = 0; db < 8; ++db)
#pragma unroll
        for (int i = 0; i < 4; ++i) oC[(size_t)(16 * db + 4 * q + i) * HD + 16 * w + cl] = C[db][i];
    if (F.tid < 128) F.out[O_PN + (size_t)bh * HD + F.tid] = s_n[F.tid];
    __syncthreads();
}


__device__ __forceinline__ float silu_fast(float x) { return __fdividef(x, 1.0f + __expf(-x)); }
__device__ __forceinline__ void s1_gdn_unit(Frame& F, int unit, LAS float* scr) {
    const int lane = F.lane, r = lane & 31, h = lane >> 5;
    const int c = unit & 31, bh = unit >> 5, hd = bh & 7, b = bh >> 3;
    const int rowb = b * T_P, row0 = rowb + 64 * c;
    unsigned char* rec = F.IMGG + (size_t)unit * GREC;
    LAS float* scrA = scr; LAS float* sG = scr + 4352; LAS float* sBe = sG + 64; LAS float* sRk = sBe + 64; LAS float* sRq = sRk + 64; LAS float* sF1 = sRq + 64; LAS float* sF2 = sF1 + 64;
    const float* gp = F.GATES + (size_t)(row0 + lane) * NGATE;
    const float lgv = -expf(F.A_log[hd]) * softplusf_(gp[16 + hd] + F.dt_bias[hd]);
    const float G = wave_scan_add(lgv, lane); const float be = sigmoidf_(gp[24 + hd]); const float G63 = __shfl(G, 63);
    sG[lane] = G; sBe[lane] = be;
    f32x16 Dk[3], Dq[3];
#pragma unroll
    for (int x = 0; x < 3; ++x)
#pragma unroll
        for (int y = 0; y < 16; ++y) { Dk[x][y] = 0.f; Dq[x][y] = 0.f; }
    float ssq[2][2] = {{0.f, 0.f}, {0.f, 0.f}};
    const bf16_t* pp = F.PROJ + (size_t)row0 * NPROJ + 4096 + hd * HD + 8 * h;
    const float* cw = F.conv_w + hd * HD + 8 * h;
#pragma unroll 1
    for (int s = 0; s < 8; ++s) {
        bf16x8 fr[2][2];
#pragma unroll
        for (int mt = 0; mt < 2; ++mt) {
            asm volatile("" ::: "memory");
            f32x4 wa[4], wb[4];
#pragma unroll
            for (int tap = 0; tap < 4; ++tap) { wa[tap] = *(const f32x4*)(cw + tap * CCONV + mt * 1024 + 16 * s); wb[tap] = *(const f32x4*)(cw + tap * CCONV + mt * 1024 + 16 * s + 4); }
#pragma unroll
            for (int rb = 0; rb < 2; ++rb) {
                const int i = 32 * rb + r; f32x4 a0 = (f32x4){0.f, 0.f, 0.f, 0.f}, a1 = a0;
#pragma unroll
                for (int tap = 0; tap < 4; ++tap) { const int ti = i - 3 + tap; const bool dead = (c == 0) && (ti < 0); const int tl = dead ? 0 : ti;
                    const u32x4 uv = *(const u32x4*)(pp + (ptrdiff_t)tl * NPROJ + mt * 1024 + 16 * s); const float mk = dead ? 0.f : 1.f;
                    a0 += (f32x4){bflo(uv.x), bfhi(uv.x), bflo(uv.y), bfhi(uv.y)} * (wa[tap] * mk); a1 += (f32x4){bflo(uv.z), bfhi(uv.z), bflo(uv.w), bfhi(uv.w)} * (wb[tap] * mk); }
                float y[8];
#pragma unroll
                for (int j = 0; j < 4; ++j) { y[j] = silu_fast(a0[j]); y[4 + j] = silu_fast(a1[j]); }
                ssq[rb][mt] += ((y[0] * y[0] + y[1] * y[1]) + (y[2] * y[2] + y[3] * y[3])) + ((y[4] * y[4] + y[5] * y[5]) + (y[6] * y[6] + y[7] * y[7]));
                const u32x4 wv = (u32x4){pk2(y[0], y[1]), pk2(y[2], y[3]), pk2(y[4], y[5]), pk2(y[6], y[7])};
                fr[mt][rb] = __builtin_bit_cast(bf16x8, wv);
                if (mt == 0) { unsigned char* o0 = rec + GR_QG + ((((i >> 4) * 4 + (s >> 1)) * 64 + (2 * h) * 16 + (i & 15)) * 16) + 8 * (s & 1);
                    *(u32x2*)o0 = (u32x2){wv.x, wv.y}; *(u32x2*)(o0 + 256) = (u32x2){wv.z, wv.w}; }
            }
        }
#pragma unroll
        for (int blk = 0; blk < 3; ++blk) { const int jb = blk >> 1, ib = (blk + 1) >> 1;
            Dk[blk] = __builtin_amdgcn_mfma_f32_32x32x16_bf16(fr[1][jb], fr[1][ib], Dk[blk], 0, 0, 0);
            Dq[blk] = __builtin_amdgcn_mfma_f32_32x32x16_bf16(fr[1][jb], fr[0][ib], Dq[blk], 0, 0, 0); }
    }
#pragma unroll
    for (int rb = 0; rb < 2; ++rb) {
        const float sq = ssq[rb][0] + __shfl_xor(ssq[rb][0], 32), sk = ssq[rb][1] + __shfl_xor(ssq[rb][1], 32);
        if (h == 0) { sRq[32 * rb + r] = 1.0f / sqrtf(sq + EPS); sRk[32 * rb + r] = 1.0f / sqrtf(sk + EPS); }
    }
    asm volatile("s_waitcnt lgkmcnt(0)" ::: "memory");
#pragma unroll
    for (int blk = 0; blk < 3; ++blk) {
        const int jb = blk >> 1, ib = (blk + 1) >> 1;
        const int i = 32 * ib + r; const float Gi = sG[i], bei = sBe[i], rki = sRk[i], rqi = sRq[i] * QK_SCALE;
#pragma unroll
        for (int g = 0; g < 4; ++g) {
            const int j0 = 32 * jb + 8 * g + 4 * h; const f32x4 Gj = *(const LAS f32x4*)(sG + j0), rkj = *(const LAS f32x4*)(sRk + j0);
            f32x4 av; float qv[4];
#pragma unroll
            for (int ip = 0; ip < 4; ++ip) { const float e = __expf(Gi - Gj[ip]); av[ip] = bei * e * rki * rkj[ip] * Dk[blk][4 * g + ip];
                qv[ip] = (j0 + ip <= i) ? -(rqi * rkj[ip] * e * Dq[blk][4 * g + ip]) : 0.f; }
            *(LAS f32x4*)(scrA + i * 68 + j0) = av;
            *(u32x2*)(rec + GR_QK + ((((i >> 4) * 2 + jb) * 64 + (2 * (g & 1) + h) * 16 + (i & 15)) * 16) + 8 * (g >> 1)) = (u32x2){pk2(qv[0], qv[1]), pk2(qv[2], qv[3])};
        }
    }
    asm volatile("s_waitcnt lgkmcnt(0)" ::: "memory");
#ifndef NO_SUBST
    {
        float tc[64];
#pragma unroll
        for (int i = 0; i < 64; ++i) {
            float acc0 = (lane == i) ? 1.f : 0.f, acc1 = 0.f;
#pragma unroll
            for (int j4 = 0; j4 < i; j4 += 4) { const f32x4 av = *(const LAS f32x4*)(scrA + i * 68 + j4);
                acc0 -= av.x * tc[j4]; if (j4 + 1 < i) acc1 -= av.y * tc[j4 + 1]; if (j4 + 2 < i) acc0 -= av.z * tc[j4 + 2]; if (j4 + 3 < i) acc1 -= av.w * tc[j4 + 3]; }
            tc[i] = acc0 + acc1;
            scrA[i * 68 + lane] = tc[i];
            asm volatile("" ::: "memory");
        }
    }
#endif
    const float gam = expf(G), rkl = sRk[lane], rql = sRq[lane];
    sF1[lane] = be * gam * rkl; sF2[lane] = be;
    { float* sc = (float*)(rec + GR_SC); sc[lane] = gam * rql * QK_SCALE; sc[64 + lane] = expf(G63 - G) * rkl; if (lane == 0) sc[128] = expf(G63); }
    asm volatile("s_waitcnt lgkmcnt(0)" ::: "memory");
    bf16x8 Tp[6], Tpp[6];
#pragma unroll
    for (int x = 0; x < 6; ++x) { const int ib = x < 2 ? 0 : 1, s = x < 2 ? x : x - 2;
        const LAS float* tp = scrA + (32 * ib + r) * 68 + 16 * s + 8 * h; const f32x4 t0 = *(const LAS f32x4*)tp, t1 = *(const LAS f32x4*)(tp + 4);
        const f32x4 f1a = *(const LAS f32x4*)(sF1 + 16 * s + 8 * h), f1b = *(const LAS f32x4*)(sF1 + 16 * s + 8 * h + 4), f2a = *(const LAS f32x4*)(sF2 + 16 * s + 8 * h), f2b = *(const LAS f32x4*)(sF2 + 16 * s + 8 * h + 4);
        const f32x4 p0 = t0 * f1a, p1 = t1 * f1b, q0 = t0 * f2a, q1 = t1 * f2b;
        Tp[x] = __builtin_bit_cast(bf16x8, (u32x4){pk2(p0.x, p0.y), pk2(p0.z, p0.w), pk2(p1.x, p1.y), pk2(p1.z, p1.w)});
        Tpp[x] = __builtin_bit_cast(bf16x8, (u32x4){pk2(q0.x, q0.y), pk2(q0.z, q0.w), pk2(q1.x, q1.y), pk2(q1.z, q1.w)}); }
#ifndef NO_CHMAJ
#pragma unroll 1
    for (int mt = 0; mt < 2; ++mt) {
        const bf16_t* pc = F.PROJ + (size_t)row0 * NPROJ + 4096 + (mt + 1) * 1024 + hd * HD;
#pragma unroll 1
        for (int blk = 0; blk < 4; ++blk) {
            const int d = 32 * blk + r; const float* cwc = F.conv_w + (mt + 1) * 1024 + hd * HD + d;
            const float w0 = cwc[0], w1 = cwc[CCONV], w2 = cwc[2 * CCONV], w3 = cwc[3 * CCONV];
            bf16x8 Xc[4];
#pragma unroll
            for (int s = 0; s < 4; ++s) {
                asm volatile("" ::: "memory");
                float u[11];
#pragma unroll
                for (int x = 0; x < 11; ++x) { const int ti = 16 * s + 8 * h - 3 + x; const bool dead = (c == 0) && (ti < 0); const int tl = dead ? 0 : ti;
                    const float val = bf2f(pc[(ptrdiff_t)tl * NPROJ + d]); u[x] = dead ? 0.f : val; }
                float y[8];
#pragma unroll
                for (int j = 0; j < 8; ++j) y[j] = silu_fast(((w0 * u[j] + w1 * u[j + 1]) + w2 * u[j + 2]) + w3 * u[j + 3]);
                const u32x4 xw = (u32x4){pk2(y[0], y[1]), pk2(y[2], y[3]), pk2(y[4], y[5]), pk2(y[6], y[7])};
                Xc[s] = __builtin_bit_cast(bf16x8, xw);
                if (mt == 0) { unsigned char* o0 = rec + GR_KT + ((((d >> 4) * 2 + (s >> 1)) * 64 + (2 * h) * 16 + (d & 15)) * 16) + 8 * (s & 1);
                    *(u32x2*)o0 = (u32x2){xw.x ^ 0x80008000u, xw.y ^ 0x80008000u}; *(u32x2*)(o0 + 256) = (u32x2){xw.z ^ 0x80008000u, xw.w ^ 0x80008000u}; }
            }
#pragma unroll
            for (int ib = 0; ib < 2; ++ib) {
                f32x16 Dm;
#pragma unroll
                for (int x = 0; x < 16; ++x) Dm[x] = 0.f;
                if (mt == 0) {
                    if (ib == 0) { Dm = __builtin_amdgcn_mfma_f32_32x32x16_bf16(Xc[0], Tp[0], Dm, 0, 0, 0); Dm = __builtin_amdgcn_mfma_f32_32x32x16_bf16(Xc[1], Tp[1], Dm, 0, 0, 0); }
                    else {
#pragma unroll
                        for (int s = 0; s < 4; ++s) Dm = __builtin_amdgcn_mfma_f32_32x32x16_bf16(Xc[s], Tp[2 + s], Dm, 0, 0, 0); }
                    const int i = 32 * ib + r;
#pragma unroll
                    for (int g = 0; g < 4; ++g)
                        *(u32x2*)(rec + GR_WI + ((((i >> 4) * 4 + blk) * 64 + (2 * (g & 1) + h) * 16 + (i & 15)) * 16) + 8 * (g >> 1)) = (u32x2){pk2(Dm[4 * g], Dm[4 * g + 1]), pk2(Dm[4 * g + 2], Dm[4 * g + 3])};
                } else {
                    if (ib == 0) { Dm = __builtin_amdgcn_mfma_f32_32x32x16_bf16(Tpp[0], Xc[0], Dm, 0, 0, 0); Dm = __builtin_amdgcn_mfma_f32_32x32x16_bf16(Tpp[1], Xc[1], Dm, 0, 0, 0); }
                    else {
#pragma unroll
                        for (int s = 0; s < 4; ++s) Dm = __builtin_amdgcn_mfma_f32_32x32x16_bf16(Tpp[2 + s], Xc[s], Dm, 0, 0, 0); }
#pragma unroll
                    for (int g = 0; g < 4; ++g)
                        *(u32x2*)(rec + GR_UP + ((((d >> 4) * 4 + (2 * ib + (g >> 1))) * 64 + (2 * (g & 1) + h) * 16 + (d & 15)) * 8)) = (u32x2){pk2(Dm[4 * g], Dm[4 * g + 1]), pk2(Dm[4 * g + 2], Dm[4 * g + 3])};
                }
            }
        }
    }
#endif
    if (c == 31) {
        for (int x = lane; x < 3 * 384; x += 64) { const int jr = x / 384, cc = x % 384, ch = (cc >> 7) * 1024 + hd * HD + (cc & 127);
            F.out[O_PCONV + (size_t)(b * 3 + jr) * CCONV + ch] = bf2f(F.PROJ[(size_t)(rowb + T_P - 3 + jr) * NPROJ + 4096 + ch]); }
    }
}
__device__ __forceinline__ void s2_gdn_chain(Frame& F, int bh) {
    const int lane = F.lane, w = F.wave, cl = lane & 15, q = lane >> 4, hd = bh & 7, b = bh >> 3;
    LAS unsigned char* const buf0 = F.lds; LAS unsigned char* const buf1 = F.lds + GDMA_BYTES;
    LAS float* const s_part = (LAS float*)(F.lds + 2 * GDMA_BYTES);
    const unsigned char* recs = F.IMGG + (size_t)bh * 32 * GREC;
    f32x4 S[8];
#pragma unroll
    for (int db = 0; db < 8; ++db) S[db] = (f32x4){0.f, 0.f, 0.f, 0.f};
    u32x2 upn[4];
#pragma unroll
    for (int tb = 0; tb < 4; ++tb) upn[tb] = *(const u32x2*)(recs + GR_UP + ((w * 4 + tb) * 64 + lane) * 8);
    for (int piece = w; piece < GDMA_BYTES / 1024; piece += 8)
        __builtin_amdgcn_global_load_lds((const unsigned*)(recs + piece * 1024 + lane * 16), (LAS unsigned*)(buf0 + piece * 1024), 16, 0, 0);
    asm volatile("s_waitcnt vmcnt(0)" ::: "memory"); __syncthreads();
    const float gn = F.gdn_g[hd * HD + 16 * w + cl];
    for (int c = 0; c < 32; ++c) {
        LAS unsigned char* const cur = (c & 1) ? buf1 : buf0; LAS unsigned char* const nxt = (c & 1) ? buf0 : buf1;
        u32x2 up[4];
#pragma unroll
        for (int tb = 0; tb < 4; ++tb) up[tb] = upn[tb];
        const int row0 = b * T_P + 64 * c;
        unsigned zb[16];
#pragma unroll
        for (int x = 0; x < 16; ++x) zb[x] = F.PROJ[(size_t)(row0 + 16 * (x >> 2) + 4 * q + (x & 3)) * NPROJ + 7168 + hd * HD + 16 * w + cl];
        if (c + 1 < 32) { const unsigned char* src = recs + (size_t)(c + 1) * GREC;
#pragma unroll
            for (int tb = 0; tb < 4; ++tb) upn[tb] = *(const u32x2*)(src + GR_UP + ((w * 4 + tb) * 64 + lane) * 8);
            for (int piece = w; piece < GDMA_BYTES / 1024; piece += 8)
                __builtin_amdgcn_global_load_lds((const unsigned*)(src + piece * 1024 + lane * 16), (LAS unsigned*)(nxt + piece * 1024), 16, 0, 0); }
        const LAS float* sc = (const LAS float*)(cur + GR_SC);
        bf16x8 Sb[4];
#pragma unroll
        for (int s = 0; s < 4; ++s) Sb[s] = __builtin_bit_cast(bf16x8, (u32x4){pk2(S[2 * s][0], S[2 * s][1]), pk2(S[2 * s][2], S[2 * s][3]), pk2(S[2 * s + 1][0], S[2 * s + 1][1]), pk2(S[2 * s + 1][2], S[2 * s + 1][3])});
        f32x4 P[4];
#pragma unroll
        for (int tb = 0; tb < 4; ++tb) {
            f32x4 acc = (f32x4){-bflo(up[tb].x), -bfhi(up[tb].x), -bflo(up[tb].y), -bfhi(up[tb].y)};
#pragma unroll
            for (int s = 0; s < 4; ++s) acc = __builtin_amdgcn_mfma_f32_16x16x32_bf16(*(const LAS bf16x8*)(cur + GR_WI + (tb * 4 + s) * 1024 + lane * 16), Sb[s], acc, 0, 0, 0);
            P[tb] = acc;
        }
        bf16x8 Pb[2], Pbs[2];
#pragma unroll
        for (int sp = 0; sp < 2; ++sp) {
            const f32x4 k0 = *(const LAS f32x4*)(sc + 64 + 16 * (2 * sp) + 4 * q), k1 = *(const LAS f32x4*)(sc + 64 + 16 * (2 * sp + 1) + 4 * q);
            const f32x4 a = P[2 * sp], bq = P[2 * sp + 1], as = a * k0, bs = bq * k1;
            Pb[sp] = __builtin_bit_cast(bf16x8, (u32x4){pk2(a[0], a[1]), pk2(a[2], a[3]), pk2(bq[0], bq[1]), pk2(bq[2], bq[3])});
            Pbs[sp] = __builtin_bit_cast(bf16x8, (u32x4){pk2(as[0], as[1]), pk2(as[2], as[3]), pk2(bs[0], bs[1]), pk2(bs[2], bs[3])});
        }
        f32x4 o[4];
#pragma unroll
        for (int tb = 0; tb < 4; ++tb) {
            f32x4 acc = (f32x4){0.f, 0.f, 0.f, 0.f};
#pragma unroll
            for (int s = 0; s < 4; ++s) acc = __builtin_amdgcn_mfma_f32_16x16x32_bf16(*(const LAS bf16x8*)(cur + GR_QG + (tb * 4 + s) * 1024 + lane * 16), Sb[s], acc, 0, 0, 0);
            acc = acc * *(const LAS f32x4*)(sc + 16 * tb + 4 * q);
            acc = __builtin_amdgcn_mfma_f32_16x16x32_bf16(*(const LAS bf16x8*)(cur + GR_QK + (tb * 2 + 0) * 1024 + lane * 16), Pb[0], acc, 0, 0, 0);
            if (tb >= 2) acc = __builtin_amdgcn_mfma_f32_16x16x32_bf16(*(const LAS bf16x8*)(cur + GR_QK + (tb * 2 + 1) * 1024 + lane * 16), Pb[1], acc, 0, 0, 0);
            o[tb] = acc;
        }
        const float gL = sc[128];
#pragma unroll
        for (int db = 0; db < 8; ++db) {
            f32x4 acc = S[db] * gL;
            acc = __builtin_amdgcn_mfma_f32_16x16x32_bf16(*(const LAS bf16x8*)(cur + GR_KT + (db * 2 + 0) * 1024 + lane * 16), Pbs[0], acc, 0, 0, 0);
            acc = __builtin_amdgcn_mfma_f32_16x16x32_bf16(*(const LAS bf16x8*)(cur + GR_KT + (db * 2 + 1) * 1024 + lane * 16), Pbs[1], acc, 0, 0, 0);
            S[db] = acc;
        }
#pragma unroll
        for (int tb = 0; tb < 4; ++tb) {
            f32x4 ss = o[tb] * o[tb];
#pragma unroll
            for (int x = 1; x < 16; x <<= 1) { ss.x += __shfl_xor(ss.x, x); ss.y += __shfl_xor(ss.y, x); ss.z += __shfl_xor(ss.z, x); ss.w += __shfl_xor(ss.w, x); }
            if (cl == 0) *(LAS f32x4*)(s_part + w * 64 + 16 * tb + 4 * q) = ss;
        }
        __syncthreads();
#pragma unroll
        for (int tb = 0; tb < 4; ++tb) {
            f32x4 tot = (f32x4){0.f, 0.f, 0.f, 0.f};
#pragma unroll
            for (int ww = 0; ww < 8; ++ww) tot += *(const LAS f32x4*)(s_part + ww * 64 + 16 * tb + 4 * q);
#pragma unroll
            for (int i = 0; i < 4; ++i) { const float y = o[tb][i] * (1.0f / sqrtf(tot[i] * (1.0f / HD) + EPS)) * gn * siluf_(bflo(zb[tb * 4 + i]));
                F.MIX[(size_t)(row0 + 16 * tb + 4 * q + i) * D + 1024 + hd * HD + 16 * w + cl] = (bf16_t)f2bf(y); }
        }
        asm volatile("s_waitcnt vmcnt(0)" ::: "memory"); __syncthreads();
    }
    float* oS = F.out + O_PS + (size_t)bh * HD * HD;
#pragma unroll
    for (int db = 0; db < 8; ++db)
#pragma unroll
        for (int i = 0; i < 4; ++i) oS[(size_t)(16 * db + 4 * q + i) * HD + 16 * w + cl] = S[db][i];
    __syncthreads();
}

__device__ __forceinline__ void p4_scan_s1(Frame& F) {
    LAS float* scr = (LAS float*)(F.lds + F.wave * 19456);
    if (F.wave >= 4) { const int u = 4 * (int)blockIdx.x + (F.wave - 4); if (u < 1024) s1_mlstm_unit(F, u, scr); }
    else { const int u = 4 * (int)blockIdx.x + F.wave; if (u < 1024) s1_gdn_unit(F, u, scr); }
}
__device__ __forceinline__ void p4_scan_s2(Frame& F) {
    const int w = blockIdx.x;
    if (w < 32) s2_mlstm_chain(F, w);
    else if (w < 64) s2_gdn_chain(F, w - 32);
    else { for (int idx = w - 64; idx < 2048; idx += (int)gridDim.x - 64) { const int mixer = idx >> 10, b = (idx & 1023) >> 3, hd = idx & 7;
            if (mixer == 0) scan_mlstm_simple(F, false, b, hd); else scan_gdn_simple(F, false, b, hd); } }
}

struct Args { const float* in[26]; float* out; unsigned char* ws; int ph_lo, ph_hi; };
constexpr int NPHASE = 11;
__global__ void __launch_bounds__(NTHREADS, 2) fwd_kernel(Args args) {
    extern __shared__ __attribute__((aligned(16))) unsigned char lds[];
    Frame F;
    F.lds = (LAS unsigned char*)lds;
    F.tid = threadIdx.x; F.lane = F.tid & 63; F.wave = __builtin_amdgcn_readfirstlane(F.tid >> 6);
    F.gw = blockIdx.x * NWAVES + F.wave; F.ngw = gridDim.x * NWAVES;
    F.xp = args.in[0]; F.xs = args.in[1]; F.stC = args.in[2]; F.stN = args.in[3]; F.stM = args.in[4]; F.stS = args.in[5]; F.stConv = args.in[6]; F.cp = args.in[7]; F.cs = args.in[8];
    F.ada_w = args.in[9]; F.ada_b = args.in[10]; F.norm1 = args.in[11]; F.w_in = args.in[12]; F.gate_b = args.in[13]; F.mlstm_g = args.in[14]; F.conv_w = args.in[15]; F.A_log = args.in[16];
    F.dt_bias = args.in[17]; F.gdn_g = args.in[18]; F.w_out = args.in[19]; F.norm2 = args.in[20]; F.w_up = args.in[21]; F.w_down = args.in[22]; F.adaf_w = args.in[23]; F.adaf_b = args.in[24]; F.normf = args.in[25];
    F.out = args.out;
    unsigned char* ws = args.ws;
    F.SCB = (bf16_t*)(ws + WS_SCB); F.WIN = (bf16_t*)(ws + WS_WIN); F.WOUT = (bf16_t*)(ws + WS_WOUT); F.WUP = (bf16_t*)(ws + WS_WUP); F.WDOWN = (bf16_t*)(ws + WS_WDOWN);
    F.HB = (bf16_t*)(ws + WS_HB); F.MIX = (bf16_t*)(ws + WS_MIX); F.PROJ = (bf16_t*)(ws + WS_PROJ);
    F.IMGM = ws + WS_IMGM; F.IMGG = ws + WS_IMGG; F.MOD = (float*)(ws + WS_MOD); F.MODF = (float*)(ws + WS_MODF); F.GATES = (float*)(ws + WS_GATES); F.X1 = (float*)(ws + WS_X1);

    for (int u = F.tid; u < (LDS_BYTES - LDSCTL_OFF) / 4; u += NTHREADS) ((LAS unsigned*)(F.lds + LDSCTL_OFF))[u] = 0u;
    __syncthreads();
    XcdBarrier bar; bar.bar = (unsigned*)(ws + WS_CTL) + CW_BAR; bar.x = 0; bar.st = nullptr;
#if MK_ONE_LAUNCH
    bar = xcd_barrier_post((unsigned*)(ws + WS_CTL) + CW_BAR, (volatile LAS unsigned*)(F.lds + MISC_OFF) + 8);
#define GRID_BAR() xcd_barrier(bar)
#else
#define GRID_BAR() do { } while (0)
#endif
    const int lo = args.ph_lo, hi = args.ph_hi;
#define IN(k) (lo <= (k) && (k) < hi)
#define BOTH(k) (IN(k) && IN((k) + 1))

    if (IN(0)) { p0_silu(F); if (BOTH(0)) GRID_BAR(); }
    if (IN(1)) { p1_modgemv(F); p1_transposes(F); if (BOTH(1)) GRID_BAR(); }
    if (IN(2)) {
        for (int r = F.gw; r < M; r += F.ngw) { const float* md = F.MOD + (size_t)row_gb(r) * MODW; norm_mod_row_bf16(xrow(F, r), F.norm1, md, md + D, F.HB + (size_t)r * D, F.lane); }
        if (BOTH(2)) GRID_BAR();
    }
    if (IN(3)) {
        p3_gates(F);
        asm volatile("s_waitcnt vmcnt(0) lgkmcnt(0)" ::: "memory"); __syncthreads();
        pg8::Gemm g{F.HB, F.WIN, M, NPROJ, D}; pg8::StaticOrder S; S.init(M, NPROJ, gridDim.x, (int)blockIdx.x);
        pg8::EpiBf16<0> E{F.PROJ, NPROJ};
        pg8::gemm_phase<pg8::EpiBf16<0>, pg8::StaticOrder, true, true>(F.lds + RING_OFF, g, S, E);
        if (BOTH(3)) GRID_BAR();
    }
    if (IN(4)) { p4_scan_s1(F); if (BOTH(4)) GRID_BAR(); }
    if (IN(5)) { p4_scan_s2(F); if (BOTH(5)) GRID_BAR(); }
    if (IN(6)) {
        pg8::Gemm g{F.MIX, F.WOUT, M, D, D}; pg8::StaticOrder S; S.init(M, D, gridDim.x, (int)blockIdx.x);
        pg8::EpiRes E{F.xp, F.xs, M_P, F.MOD + 2 * D, MODW, F.X1, D};
        pg8::gemm_phase<pg8::EpiRes, pg8::StaticOrder, true, true>(F.lds + RING_OFF, g, S, E);
        if (BOTH(6)) GRID_BAR();
    }
    if (IN(7)) {
        for (int r = F.gw; r < M; r += F.ngw) { const float* md = F.MOD + (size_t)row_gb(r) * MODW; norm_mod_row_bf16(F.X1 + (size_t)r * D, F.norm2, md + 3 * D, md + 4 * D, F.HB + (size_t)r * D, F.lane); }
        if (BOTH(7)) GRID_BAR();
    }
    if (IN(8)) {
        pg8::Gemm g{F.HB, F.WUP, M, DFF, D}; pg8::StaticOrder S; S.init(M, DFF, gridDim.x, (int)blockIdx.x);
        pg8::EpiBf16<1> E{F.PROJ, DFF};
        pg8::gemm_phase<pg8::EpiBf16<1>, pg8::StaticOrder, true, true>(F.lds + RING_OFF, g, S, E);
        if (BOTH(8)) GRID_BAR();
    }
    if (IN(9)) {
        pg8::Gemm g{F.PROJ, F.WDOWN, M, D, DFF}; pg8::StaticOrder S; S.init(M, D, gridDim.x, (int)blockIdx.x);
        pg8::EpiRes E{F.X1, F.X1, M, F.MOD + 5 * D, MODW, F.out + O_Y, D};
        pg8::gemm_phase<pg8::EpiRes, pg8::StaticOrder, true, true>(F.lds + RING_OFF, g, S, E);
        if (BOTH(9)) GRID_BAR();
    }
    if (IN(10)) {
        for (int r = F.gw; r < M; r += F.ngw) { const float* md = F.MODF + (size_t)row_gb(r) * MODFW; float* yr = F.out + O_Y + (size_t)r * D; norm_mod_row_f32(yr, F.normf, md, md + D, yr, F.lane); }
    }
#undef IN
#undef BOTH
}

extern "C" void kernel_launch(void* const* d_in, const int* in_sizes, int n_in, void* d_out, int out_size, void* d_ws, size_t ws_size, hipStream_t stream) {
    static int ok = 0;
    if (ok == 0) {
        if (n_in != 26 || (size_t)out_size != O_END || ws_size < WS_END) { fprintf(stderr, "kernel_launch: unexpected shapes: n_in %d out %d ws %zu\n", n_in, out_size, ws_size); ok = -1; return; }
        if (hipFuncSetAttribute((const void*)fwd_kernel, hipFuncAttributeMaxDynamicSharedMemorySize, LDS_BYTES) != hipSuccess) { fprintf(stderr, "kernel_launch: hipFuncSetAttribute failed\n"); ok = -1; return; }
        int dev = 0, cus = 0, per_cu = 0;
        (void)hipGetDevice(&dev); (void)hipDeviceGetAttribute(&cus, hipDeviceAttributeMultiprocessorCount, dev);
        (void)hipOccupancyMaxActiveBlocksPerMultiprocessor(&per_cu, (const void*)fwd_kernel, NTHREADS, LDS_BYTES);
        if (cus != GRID || per_cu < 1) fprintf(stderr, "kernel_launch: note: %d CUs, %d blocks/CU reported; launching %d workgroups\n", cus, per_cu, GRID);
        (void)hipGetLastError();
        ok = 1;
    }
    if (ok < 0) return;
    (void)hipMemsetAsync((char*)d_ws + WS_CTL, 0, CTL_ZERO_BYTES, stream);
    Args a{};
    for (int i = 0; i < 26; ++i) a.in[i] = (const float*)d_in[i];
    a.out = (float*)d_out; a.ws = (unsigned char*)d_ws;
#if MK_ONE_LAUNCH
    a.ph_lo = 0; a.ph_hi = NPHASE;
    hipLaunchKernelGGL(fwd_kernel, dim3(GRID), dim3(NTHREADS), LDS_BYTES, stream, a);
#else
    for (int p = 0; p < NPHASE; ++p) { a.ph_lo = p; a.ph_hi = p + 1; hipLaunchKernelGGL(fwd_kernel, dim3(GRID), dim3(NTHREADS), LDS_BYTES, stream, a); }
#endif
}
```

```cpp
#include <hip/hip_runtime.h>
#include <cstdio>
#include <cstdint>

#define LAS __attribute__((address_space(3)))
#define GAS __attribute__((address_space(1)))
typedef unsigned short bf16_t;
typedef short bf16x8 __attribute__((ext_vector_type(8)));
typedef float f32x4 __attribute__((ext_vector_type(4)));
typedef float f32x2 __attribute__((ext_vector_type(2)));
typedef float f32x16 __attribute__((ext_vector_type(16)));
typedef unsigned u32x4 __attribute__((ext_vector_type(4)));
typedef unsigned u32x2 __attribute__((ext_vector_type(2)));

#ifndef MK_ONE_LAUNCH
#define MK_ONE_LAUNCH 1
#endif

constexpr int D = 2048, T_P = 2048, NB_P = 4, NB_S = 128, T_S = 8;
constexpr int M_P = NB_P * T_P, M_S = NB_S * T_S, M = M_P + M_S;
constexpr int NH = 8, HD = 128;
constexpr int P_IN = 8224, NPROJ = 8192, NGATE = 32, DFF = 8192, CCONV = 3072;
constexpr int NGB = NB_P + NB_S;
constexpr int MODW = 6 * D, MODFW = 2 * D;
constexpr float EPS = 1e-6f;
constexpr int NWAVES = 8, NTHREADS = 512, GRID = 256;

constexpr size_t O_Y = 0;
constexpr size_t O_PC = (size_t)M * D;
constexpr size_t O_PN = O_PC + (size_t)NB_P * NH * HD * HD;
constexpr size_t O_PM = O_PN + (size_t)NB_P * NH * HD;
constexpr size_t O_PS = O_PM + (size_t)NB_P * NH;
constexpr size_t O_PCONV = O_PS + (size_t)NB_P * NH * HD * HD;
constexpr size_t O_SC = O_PCONV + (size_t)NB_P * 3 * CCONV;
constexpr size_t O_SN = O_SC + (size_t)NB_S * NH * HD * HD;
constexpr size_t O_SM = O_SN + (size_t)NB_S * NH * HD;
constexpr size_t O_SS = O_SM + (size_t)NB_S * NH;
constexpr size_t O_SCONV = O_SS + (size_t)NB_S * NH * HD * HD;
constexpr size_t O_END = O_SCONV + (size_t)NB_S * 3 * CCONV;
static_assert(O_END == 54830112, "d_out size");

constexpr size_t MiB = 1u << 20;
constexpr size_t WS_CTL = 0, CTL_ZERO_BYTES = 64 * 1024;
constexpr size_t WS_SCB = 1 * MiB;
constexpr size_t WS_MOD = 2 * MiB;
constexpr size_t WS_MODF = 9 * MiB;
constexpr size_t WS_GATES = 12 * MiB;
constexpr size_t WS_WIN = 16 * MiB;
constexpr size_t WS_WOUT = 49 * MiB;
constexpr size_t WS_WUP = 57 * MiB;
constexpr size_t WS_WDOWN = 89 * MiB;
constexpr size_t WS_HB = 121 * MiB;
constexpr size_t WS_MIX = 157 * MiB;
constexpr size_t WS_X1 = 193 * MiB;
constexpr size_t WS_PROJ = 265 * MiB;
constexpr size_t WS_IMGM = 409 * MiB;
constexpr size_t WS_IMGG = 467 * MiB;
constexpr size_t WS_END = 540 * MiB;
constexpr int MREC = 59392, MR_QI = 0, MR_SP = 16384, MR_KW = 24576, MR_VT = 40960, MR_SC = 57344, MR_DN = 58368;
static_assert(WS_WIN + (size_t)P_IN * D * 2 <= WS_WOUT && WS_PROJ + (size_t)M * NPROJ * 2 <= WS_IMGM && WS_IMGM + (size_t)1024 * MREC <= WS_IMGG && WS_IMGG + (size_t)1024 * 74752 <= WS_END, "ws map");
constexpr int GREC = 74752, GR_QG = 0, GR_WI = 16384, GR_KT = 32768, GR_QK = 49152, GR_SC = 57344, GR_UP = 58368, GDMA_BYTES = 58368;

constexpr int CW_BAR = 1024;

__device__ __forceinline__ unsigned f2bf(float f) { unsigned u = __builtin_bit_cast(unsigned, f); return (u + 0x7fffu + ((u >> 16) & 1u)) >> 16; }
typedef __bf16 bf16x2_t __attribute__((ext_vector_type(2)));
__device__ __forceinline__ unsigned pk2(float lo, float hi) { const f32x2 v = {lo, hi}; return __builtin_bit_cast(unsigned, __builtin_convertvector(v, bf16x2_t)); }
__device__ __forceinline__ float bf2f(bf16_t b) { return __builtin_bit_cast(float, (unsigned)b << 16); }
__device__ __forceinline__ float bflo(unsigned w) { return __builtin_bit_cast(float, w << 16); }
__device__ __forceinline__ float bfhi(unsigned w) { return __builtin_bit_cast(float, w & 0xffff0000u); }
__device__ __forceinline__ float wave_sum(float v) {
#pragma unroll
    for (int o = 1; o < 64; o <<= 1) v += __shfl_xor(v, o);
    return v;
}
__device__ __forceinline__ float sigmoidf_(float x) { return 1.0f / (1.0f + __expf(-x)); }
__device__ __forceinline__ float siluf_(float x) { return x / (1.0f + __expf(-x)); }
__device__ __forceinline__ float softplusf_(float x) { return fmaxf(x, 0.f) + log1pf(__expf(-fabsf(x))); }
__device__ __forceinline__ float logsigmoidf_(float x) { return fminf(x, 0.f) - log1pf(__expf(-fabsf(x))); }
__device__ __forceinline__ int row_gb(int r) { return r < M_P ? (r >> 11) : NB_P + ((r - M_P) >> 3); }
namespace pg8 {
#define PG8_LAS __attribute__((address_space(3)))
constexpr int BM = 256, BK = 64, HALF = 128, HTB = HALF * BK * 2  , STAGE_BYTES = 8 * HTB, NXCD = 8, WGM = 8;

__host__ __device__ __forceinline__ int lds_byte(int r, int c) { const int st = (r >> 4) * 2 + (c >> 5), rr = r & 15, cc = c & 31, ob = rr * 64 + cc * 2; return st * 1024 + (ob ^ (((ob >> 9) & 1) << 5)); }
__host__ __device__ __forceinline__ void stage_rc(int b, int& R, int& C) { const int st = b / 1024, sb = b % 1024, swz = sb ^ (((sb >> 9) & 1) << 5); R = (st >> 1) * 16 + swz / 64; C = (st & 1) * 32 + (swz % 64) / 2; }
__host__ __device__ __forceinline__ int perm32(int rho) { const int n = rho >> 4, i = rho & 15; return 8 * (i >> 2) + 4 * n + (i & 3); }

struct Unit { int pm, pn, k0, nt, part, ks, xt; };
struct Gemm { const bf16_t* A; const bf16_t* Bt; int M, N, K; };

struct StaticOrder {
    int nM, nN, nwg, G, c, ntk;
    __host__ __device__ void init(int M, int N, int K, int G_, int c_) { nM = M / BM; nN = N / BM; nwg = nM * nN; G = G_; c = c_; ntk = K / BK; }
    __host__ __device__ bool next(int i, Unit& u) const {
        const long L = (long)i * G + c; if (L >= nwg) return false;
        int wgid = (int)L; { const int q = nwg / NXCD, r = nwg % NXCD, xcd = wgid % NXCD, off = wgid / NXCD; wgid = (xcd < r ? xcd * (q + 1) : r * (q + 1) + (xcd - r) * q) + off; }
        const int nig = WGM * nN, gid = wgid / nig, fm = gid * WGM, gsz = (nM - fm) < WGM ? (nM - fm) : WGM;
        u.pm = fm + ((wgid % nig) % gsz); u.pn = (wgid % nig) / gsz; u.k0 = 0; u.nt = ntk; u.part = 0; u.ks = 0; u.xt = 0; return true;
    }
    __device__ __forceinline__ void a_ready(const Unit&) const {}
    __device__ __forceinline__ void done(const Unit&) const {}
};
struct SplitOrder {
    int c, ntk;
    __host__ __device__ void init(int K, int c_) { c = c_; ntk = K / BK; }
    __host__ __device__ bool next(int i, Unit& u) const {
        if (i == 0) { const int wgid = (c % NXCD) * 32 + c / NXCD; u.pm = (wgid >> 6) * 8 + (wgid & 7); u.pn = (wgid & 63) >> 3; u.k0 = 0; u.nt = ntk; u.part = 0; u.ks = 0; u.xt = 0; return true; }
        if (i == 1) { const int xt = c >> 3, ks = c & 7; u.pm = 32 + (xt >> 3); u.pn = xt & 7; u.nt = ntk / 8; u.k0 = ks * (ntk / 8) * BK; u.part = 1; u.ks = ks; u.xt = xt; return true; }
        return false;
    }
    __device__ __forceinline__ void a_ready(const Unit&) const {}
    __device__ __forceinline__ void done(const Unit&) const {}
};


__device__ __forceinline__ unsigned cvt_pk_bf16(float lo, float hi) { unsigned r; asm volatile("v_cvt_pk_bf16_f32 %0, %1, %2" : "=v"(r) : "v"(lo), "v"(hi)); return r; }
template <int ACT  > struct EpiBf16 {
    static constexpr bool PERM = true, AFTER_DRAIN = false;
    bf16_t* O; int ldc;
    __device__ __forceinline__ void operator()(const f32x4 (&acc)[2][2][4][2], const Unit& u, int wr, int wc, int fr, int fq) const {
        const int row0 = u.pm * BM + wr * 64 + fr, col0 = u.pn * BM + wc * 32 + 8 * fq;
#pragma unroll
        for (int ai = 0; ai < 2; ++ai)
#pragma unroll
            for (int m = 0; m < 4; ++m) { bf16_t* rowp = O + (size_t)(row0 + ai * HALF + m * 16) * ldc + col0;
#pragma unroll
                for (int bj = 0; bj < 2; ++bj) { f32x4 v0 = acc[ai][bj][m][0], v1 = acc[ai][bj][m][1];
                    if (ACT == 1) {
#pragma unroll
                        for (int q = 0; q < 4; ++q) { const float a = fmaxf(v0[q], 0.f), b = fmaxf(v1[q], 0.f); v0[q] = a * a; v1[q] = b * b; } }
                    u32x4 w; w.x = cvt_pk_bf16(v0[0], v0[1]); w.y = cvt_pk_bf16(v0[2], v0[3]); w.z = cvt_pk_bf16(v1[0], v1[1]); w.w = cvt_pk_bf16(v1[2], v1[3]);
                    *(u32x4*)(rowp + bj * HALF) = w; } }
    }
};
struct EpiRes {
    static constexpr bool PERM = false, AFTER_DRAIN = false;
    const float* base0; const float* base1; int split; const float* gate; int ldg; float* out; int ldc; float* part;
    __device__ __forceinline__ void operator()(const f32x4 (&acc)[2][2][4][2], const Unit& u, int wr, int wc, int fr, int fq) const {
        if (u.part) {
            float* pb = part + ((size_t)(u.ks * 32 + u.xt) * 256 + wr * 64 + fr) * 256 + wc * 32 + 4 * fq;
#pragma unroll
            for (int ai = 0; ai < 2; ++ai)
#pragma unroll
                for (int m = 0; m < 4; ++m)
#pragma unroll
                    for (int bj = 0; bj < 2; ++bj)
#pragma unroll
                        for (int n = 0; n < 2; ++n) *(f32x4*)(pb + (size_t)(ai * HALF + m * 16) * 256 + bj * HALF + n * 16) = acc[ai][bj][m][n];
            return;
        }
        const int row0 = u.pm * BM + wr * 64 + fr, col0 = u.pn * BM + wc * 32 + 4 * fq;
#pragma unroll
        for (int ai = 0; ai < 2; ++ai)
#pragma unroll
            for (int m = 0; m < 4; ++m) { const int r = row0 + ai * HALF + m * 16;
                const float* bp = (r < split ? base0 + (size_t)r * ldc : base1 + (size_t)(r - split) * ldc) + col0;
                const float* gp = gate + (size_t)row_gb(r) * ldg + col0; float* op = out + (size_t)r * ldc + col0;
#pragma unroll
                for (int bj = 0; bj < 2; ++bj)
#pragma unroll
                    for (int n = 0; n < 2; ++n) { const f32x4 bs = *(const f32x4*)(bp + bj * HALF + n * 16), g = *(const f32x4*)(gp + bj * HALF + n * 16);
                        *(f32x4*)(op + bj * HALF + n * 16) = bs + g * acc[ai][bj][m][n]; }
                if (m & 1) asm volatile("" ::: "memory"); }
    }
};
template <class Epi, class Sched, bool ALIGN_EPI = false, bool SP2 = false>
__device__ __forceinline__ void gemm_phase(PG8_LAS unsigned char* lds, const Gemm g, const Sched& S, const Epi& E) {
    const int tid = threadIdx.x, wid = __builtin_amdgcn_readfirstlane(tid >> 6), lane = tid & 63, wr = wid >> 2, wc = wid & 3, fr = lane & 15, fq = lane >> 4;
    const int K = g.K;
    unsigned voffA[2], voffB[2];
#pragma unroll
    for (int i = 0; i < 2; ++i) { int R, C; stage_rc(tid * 16 + i * 8192, R, C); const int Rb = Epi::PERM ? ((R & ~31) + perm32(R & 31)) : R;
        voffA[i] = (unsigned)(R * K + C) * 2u; voffB[i] = (unsigned)(Rb * K + C) * 2u; }
    const size_t kstep = (size_t)(BK * 2);
    const size_t hstep = (size_t)HALF * K * 2;
    const size_t tstep = 2 * hstep;
    const unsigned ldsw = (unsigned)wid * 1024u;
    const int aoff = lds_byte(wr * 64 + fr, fq * 8), boff = lds_byte(wc * 32 + fr, fq * 8);
#define PG8_SA(b, h) (((b) * 2 + (h)) * HTB)
#define PG8_SB(b, h) ((4 + (b) * 2 + (h)) * HTB)
#define PG8_STAGE(bufoff, gbase, voff) do { _Pragma("unroll") for (int _i = 0; _i < 2; ++_i) \
        __builtin_amdgcn_global_load_lds((const unsigned*)((const char*)(gbase) + (voff)[_i]), (PG8_LAS unsigned*)(lds + (bufoff) + ldsw + _i * 8192), 16, 0, 0); } while (0)
#define PG8_LDA(dst, b, h) do { _Pragma("unroll") for (int m = 0; m < 4; ++m) _Pragma("unroll") for (int k = 0; k < 2; ++k) dst[m][k] = *(const PG8_LAS bf16x8*)(lds + PG8_SA(b, h) + aoff + m * 2048 + k * 1024); } while (0)
#define PG8_LDB(dst, b, h) do { _Pragma("unroll") for (int n = 0; n < 2; ++n) _Pragma("unroll") for (int k = 0; k < 2; ++k) dst[n][k] = *(const PG8_LAS bf16x8*)(lds + PG8_SB(b, h) + boff + n * 2048 + k * 1024); } while (0)
#define PG8_MMA(ai, bj, At, Bt) do { __builtin_amdgcn_s_setprio(1); _Pragma("unroll") for (int m = 0; m < 4; ++m) _Pragma("unroll") for (int n = 0; n < 2; ++n) _Pragma("unroll") for (int k = 0; k < 2; ++k) \
        acc[ai][bj][m][n] = __builtin_amdgcn_mfma_f32_16x16x32_bf16(Bt[n][k], At[m][k], acc[ai][bj][m][n], 0, 0, 0); __builtin_amdgcn_s_setprio(0); } while (0)
#define PG8_WAIT_V(n) asm volatile("s_waitcnt vmcnt(" #n ")" ::: "memory")
#define PG8_WAIT_L(n) asm volatile("s_waitcnt lgkmcnt(" #n ")" ::: "memory")
#define PG8_BAR __builtin_amdgcn_s_barrier()
#define PG8_SCHED __builtin_amdgcn_sched_barrier(0)
    Unit cur, nxt; int ui = 0;
    if (!S.next(0, cur)) return;
    f32x4 acc[2][2][4][2];
#pragma unroll
    for (int a = 0; a < 2; ++a)
#pragma unroll
        for (int b = 0; b < 2; ++b)
#pragma unroll
            for (int m = 0; m < 4; ++m)
#pragma unroll
                for (int n = 0; n < 2; ++n) acc[a][b][m][n] = (f32x4){0.f, 0.f, 0.f, 0.f};
    bf16x8 At[4][2], B0[2][2], B1[2][2];
    const char* cA = (const char*)g.A + (size_t)cur.pm * tstep + (size_t)cur.k0 * 2; const char* cB = (const char*)g.Bt + (size_t)cur.pn * tstep + (size_t)cur.k0 * 2;
    S.a_ready(cur);
    if constexpr (SP2) {
        PG8_STAGE(PG8_SB(0, 0), cB, voffB); PG8_STAGE(PG8_SB(0, 1), cB + hstep, voffB); PG8_STAGE(PG8_SA(0, 0), cA, voffA); PG8_STAGE(PG8_SA(0, 1), cA + hstep, voffA);
        if (wr == 1) PG8_BAR;
        PG8_WAIT_V(2); PG8_BAR;
        PG8_STAGE(PG8_SB(1, 0), cB + kstep, voffB); PG8_STAGE(PG8_SA(1, 0), cA + kstep, voffA); PG8_STAGE(PG8_SB(1, 1), cB + hstep + kstep, voffB);
        PG8_WAIT_V(6); PG8_BAR;
    } else {
        PG8_STAGE(PG8_SB(0, 0), cB, voffB); PG8_STAGE(PG8_SA(0, 0), cA, voffA); PG8_STAGE(PG8_SB(0, 1), cB + hstep, voffB); PG8_STAGE(PG8_SA(0, 1), cA + hstep, voffA);
        if (wr == 1) PG8_BAR;
        PG8_WAIT_V(4); PG8_BAR;
        PG8_STAGE(PG8_SB(1, 0), cB + kstep, voffB); PG8_STAGE(PG8_SA(1, 0), cA + kstep, voffA); PG8_STAGE(PG8_SB(1, 1), cB + hstep + kstep, voffB);
        PG8_WAIT_V(6); PG8_BAR;
    }
    for (;;) {
        const bool has_next = S.next(ui + 1, nxt);
        const char* nA = has_next ? (const char*)g.A + (size_t)nxt.pm * tstep + (size_t)nxt.k0 * 2 : cA; const char* nB = has_next ? (const char*)g.Bt + (size_t)nxt.pn * tstep + (size_t)nxt.k0 * 2 : cB;
        const int nt = cur.nt;
        for (int t = 0; t < nt; t += 2) {
            const bool last = (t == nt - 2);
            const char* a1 = cA + (size_t)(t + 1) * kstep;
            const char* a2 = last ? nA : cA + (size_t)(t + 2) * kstep; const char* b2 = last ? nB : cB + (size_t)(t + 2) * kstep;
            const char* a3 = a2 + kstep; const char* b3 = b2 + kstep;
            if (last && has_next) S.a_ready(nxt);
            if constexpr (SP2) {
            PG8_LDB(B0, 0, 0); PG8_LDB(B1, 0, 1); PG8_SCHED; PG8_LDA(At, 0, 0); PG8_STAGE(PG8_SA(1, 1), a1 + hstep, voffA);
            PG8_WAIT_V(8); PG8_WAIT_L(0); PG8_BAR; PG8_MMA(0, 0, At, B0); PG8_MMA(0, 1, At, B1); PG8_BAR; PG8_SCHED;
            PG8_LDA(At, 0, 1); PG8_STAGE(PG8_SB(0, 0), b2, voffB); PG8_STAGE(PG8_SB(0, 1), b2 + hstep, voffB); PG8_STAGE(PG8_SA(0, 0), a2, voffA);
            PG8_WAIT_V(8); PG8_WAIT_L(0); PG8_BAR; PG8_MMA(1, 0, At, B0); PG8_MMA(1, 1, At, B1); PG8_BAR; PG8_SCHED;
            PG8_LDB(B0, 1, 0); PG8_LDB(B1, 1, 1); PG8_SCHED; PG8_LDA(At, 1, 0); PG8_STAGE(PG8_SA(0, 1), a2 + hstep, voffA);
            PG8_WAIT_V(8); PG8_WAIT_L(0); PG8_BAR; PG8_MMA(0, 0, At, B0); PG8_MMA(0, 1, At, B1); PG8_BAR; PG8_SCHED;
            PG8_LDA(At, 1, 1); PG8_STAGE(PG8_SB(1, 0), b3, voffB); PG8_STAGE(PG8_SB(1, 1), b3 + hstep, voffB); PG8_STAGE(PG8_SA(1, 0), a3, voffA);
            PG8_WAIT_V(8); PG8_WAIT_L(0); PG8_BAR; PG8_MMA(1, 0, At, B0); PG8_MMA(1, 1, At, B1); PG8_BAR; PG8_SCHED;
            } else {
            PG8_LDB(B0, 0, 0); PG8_SCHED; PG8_LDA(At, 0, 0); PG8_STAGE(PG8_SA(1, 1), a1 + hstep, voffA);
            PG8_WAIT_L(8); PG8_BAR; PG8_WAIT_L(0); PG8_MMA(0, 0, At, B0); PG8_BAR; PG8_SCHED;
            PG8_LDB(B1, 0, 1); PG8_STAGE(PG8_SB(0, 0), b2, voffB);
            PG8_BAR; PG8_WAIT_L(0); PG8_MMA(0, 1, At, B1); PG8_BAR;
            PG8_LDA(At, 0, 1); PG8_STAGE(PG8_SA(0, 0), a2, voffA);
            PG8_BAR; PG8_WAIT_L(0); PG8_MMA(1, 0, At, B0); PG8_BAR; PG8_SCHED;
            PG8_STAGE(PG8_SB(0, 1), b2 + hstep, voffB);
            PG8_WAIT_V(6); PG8_BAR; PG8_MMA(1, 1, At, B1); PG8_BAR;
            PG8_LDB(B0, 1, 0); PG8_SCHED; PG8_LDA(At, 1, 0); PG8_STAGE(PG8_SA(0, 1), a2 + hstep, voffA);
            PG8_WAIT_L(8); PG8_BAR; PG8_WAIT_L(0); PG8_MMA(0, 0, At, B0); PG8_BAR; PG8_SCHED;
            PG8_LDB(B1, 1, 1); PG8_STAGE(PG8_SB(1, 0), b3, voffB);
            PG8_BAR; PG8_WAIT_L(0); PG8_MMA(0, 1, At, B1); PG8_BAR;
            PG8_LDA(At, 1, 1); PG8_STAGE(PG8_SA(1, 0), a3, voffA);
            PG8_BAR; PG8_WAIT_L(0); PG8_MMA(1, 0, At, B0); PG8_BAR; PG8_SCHED;
            PG8_STAGE(PG8_SB(1, 1), b3 + hstep, voffB);
            PG8_WAIT_V(6); PG8_BAR; PG8_MMA(1, 1, At, B1); PG8_BAR;
            }
        }
        if constexpr (ALIGN_EPI) { if (wr == 0) PG8_BAR; }
        if constexpr (!Epi::AFTER_DRAIN) { E(acc, cur, wr, wc, fr, fq); S.done(cur); }
        if (!has_next) break;
#pragma unroll
        for (int a = 0; a < 2; ++a)
#pragma unroll
            for (int b = 0; b < 2; ++b)
#pragma unroll
                for (int m = 0; m < 4; ++m)
#pragma unroll
                    for (int n = 0; n < 2; ++n) acc[a][b][m][n] = (f32x4){0.f, 0.f, 0.f, 0.f};
        cur = nxt; cA = nA; cB = nB; ++ui;
        if constexpr (ALIGN_EPI) { if (wr == 1) PG8_BAR; }
    }
    PG8_WAIT_V(0);
    if constexpr (!ALIGN_EPI) { if (wr == 0) PG8_BAR; }
    PG8_BAR;
    if constexpr (Epi::AFTER_DRAIN) { E.fused(acc, cur, wr, wc, fr, fq, lds, wid, lane); S.done(cur); }
#undef PG8_SA
#undef PG8_SB
#undef PG8_STAGE
#undef PG8_LDA
#undef PG8_LDB
#undef PG8_MMA
#undef PG8_WAIT_V
#undef PG8_WAIT_L
#undef PG8_BAR
#undef PG8_SCHED
}
}

constexpr int RING_OFF = 0, RING_BYTES = 131072;
constexpr int LDSCTL_OFF = RING_BYTES, MISC_OFF = LDSCTL_OFF + 320;
constexpr int LDS_BYTES = 147456;

typedef GAS unsigned gu32;
#define RLX_AGENT __ATOMIC_RELAXED, __HIP_MEMORY_SCOPE_AGENT
#define LDS_WAIT() asm volatile("s_waitcnt lgkmcnt(0)" ::: "memory")
#define VM_WAIT() asm volatile("s_waitcnt vmcnt(0)" ::: "memory")

#define XB_TMO      128
#define XB_XCNT(j)  (256  + 64 * (j))
#define XB_XSUB(j)  (1280 + 64 * (j))
#define XB_XGEN(j)  (2304 + 64 * (j))
#define XB_TOP      3328
#define XB_TOPGEN   3392
#define XCD_BAR_WORDS 3456
#define XB_SPIN_CAP (1u << 18)
__device__ __forceinline__ unsigned xb_ld(unsigned* p)              { return __hip_atomic_load(p, __ATOMIC_RELAXED, __HIP_MEMORY_SCOPE_AGENT); }
__device__ __forceinline__ unsigned xb_add(unsigned* p, unsigned v) { return __hip_atomic_fetch_add(p, v, __ATOMIC_RELAXED, __HIP_MEMORY_SCOPE_AGENT); }
__device__ __forceinline__ unsigned xb_xcc_id() { return (unsigned)__builtin_amdgcn_s_getreg((3 << 11) | 20) & 0xFu; }
#define XB_SPIN(cond, bar) do { unsigned _sp = 0; while (cond) { __builtin_amdgcn_s_sleep(1); \
    if ((++_sp & 255u) == 0u) { if (xb_ld(&(bar)[XB_TMO])) break; if (_sp > XB_SPIN_CAP) { atomicAdd(&(bar)[XB_TMO], 1u); break; } } } } while (0)
struct XcdBarrier { unsigned* bar; unsigned x; volatile LAS unsigned* st; };
__device__ __forceinline__ XcdBarrier xcd_barrier_post(unsigned* bar, volatile LAS unsigned* st) {
    XcdBarrier b; b.bar = bar; b.x = xb_xcc_id(); b.st = st;
    if (threadIdx.x == 0) (void)xb_add(&bar[XB_XCNT(b.x)], 1u);
    return b;
}
__device__ __forceinline__ void xcd_barrier_complete(unsigned* bar, unsigned x, unsigned& nloc, unsigned& nx) {
    const unsigned G = gridDim.x * gridDim.y * gridDim.z;
    unsigned sum, cnt, mine, sp = 0u;
    for (;;) {
        sum = 0u; cnt = 0u; mine = 0u;
#pragma unroll
        for (unsigned j = 0; j < 16; ++j) { const unsigned c = xb_ld(&bar[XB_XCNT(j)]); sum += c; cnt += (c > 0u) ? 1u : 0u; mine = (j == x) ? c : mine; }
        if (sum == G) break;
        __builtin_amdgcn_s_sleep(1);
        if ((++sp & 255u) == 0u) { if (xb_ld(&bar[XB_TMO])) break; if (sp > XB_SPIN_CAP) { atomicAdd(&bar[XB_TMO], 1u); break; } }
    }
    nloc = mine > 0u ? mine : 1u; nx = cnt > 0u ? cnt : 1u;
}
__device__ __forceinline__ void xcd_barrier(const XcdBarrier& b) {
    asm volatile("s_waitcnt vmcnt(0)" ::: "memory");
    __syncthreads();
    if (threadIdx.x == 0) {
        unsigned* bar = b.bar;
        __builtin_amdgcn_s_waitcnt(0);
        unsigned nloc = b.st[0], nx = b.st[1];
        if (nloc == 0u) { xcd_barrier_complete(bar, b.x, nloc, nx); b.st[0] = nloc; b.st[1] = nx; }
        const unsigned old = xb_add(&bar[XB_XSUB(b.x)], 1u);
        const unsigned gen = old / nloc;
        if (old + 1u == (gen + 1u) * nloc) {
            __builtin_amdgcn_fence(__ATOMIC_RELEASE, "agent");
            asm volatile("s_waitcnt vmcnt(0)" ::: "memory");
            const unsigned og = xb_add(&bar[XB_TOP], 1u);
            const unsigned tg = og / nx;
            if (og + 1u == (tg + 1u) * nx) xb_add(&bar[XB_TOPGEN], 1u);
            else XB_SPIN(xb_ld(&bar[XB_TOPGEN]) == tg, bar);
            __builtin_amdgcn_fence(__ATOMIC_ACQUIRE, "agent");
            xb_add(&bar[XB_XGEN(b.x)], 1u);
            asm volatile("s_waitcnt vmcnt(0)" ::: "memory");
        } else {
            XB_SPIN(xb_ld(&bar[XB_XGEN(b.x)]) == gen, bar);
            __builtin_amdgcn_fence(__ATOMIC_ACQUIRE, "agent");
            asm volatile("s_waitcnt vmcnt(0)" ::: "memory");
        }
    }
    __syncthreads();
}

struct Frame {
    LAS unsigned char* lds;
    int tid, lane, wave, gw, ngw;
    const float *xp, *xs, *stC, *stN, *stM, *stS, *stConv, *cp, *cs, *ada_w, *ada_b, *norm1, *w_in, *gate_b, *mlstm_g, *conv_w, *A_log, *dt_bias, *gdn_g,
                *w_out, *norm2, *w_up, *w_down, *adaf_w, *adaf_b, *normf;
    float* out;
    bf16_t *SCB, *WIN, *WOUT, *WUP, *WDOWN, *HB, *MIX, *PROJ;
    float *MOD, *MODF, *GATES, *X1;
    unsigned char* IMGM; unsigned char* IMGG;
};
__device__ __forceinline__ const float* xrow(const Frame& F, int r) { return r < M_P ? F.xp + (size_t)r * D : F.xs + (size_t)(r - M_P) * D; }

__device__ __forceinline__ void p0_silu(Frame& F) {
    const int gt = blockIdx.x * NTHREADS + F.tid, GT = gridDim.x * NTHREADS;
    for (int g = gt; g < 160 * 256; g += GT) {
        const int row = g >> 8, c8 = (g & 255) * 8; u32x4 o = (u32x4){0u, 0u, 0u, 0u};
        if (row < NGB) { const float* src = (row < NB_P ? F.cp + (size_t)row * D : F.cs + (size_t)(row - NB_P) * D) + c8;
            const f32x4 a = *(const f32x4*)src, b = *(const f32x4*)(src + 4);
            o.x = pk2(siluf_(a.x), siluf_(a.y)); o.y = pk2(siluf_(a.z), siluf_(a.w)); o.z = pk2(siluf_(b.x), siluf_(b.y)); o.w = pk2(siluf_(b.z), siluf_(b.w)); }
        *(u32x4*)(F.SCB + (size_t)row * D + c8) = o;
    }
}

__device__ __forceinline__ void p1_modgemv(Frame& F) {
    LAS float* red = (LAS float*)(F.lds + RING_OFF);
    const int lane = F.lane, r = lane & 31, hh = lane >> 5, cbi = F.wave >> 2, ks = F.wave & 3;
    for (int pair = blockIdx.x; pair < 256; pair += gridDim.x) {
        const int cb = 2 * pair + cbi;
        const float* W; const float* bias; float* outp; int ldw, n0;
        if (cb < 384) { W = F.ada_w; ldw = MODW; n0 = cb * 32; bias = F.ada_b; outp = F.MOD; }
        else { W = F.adaf_w; ldw = MODFW; n0 = (cb - 384) * 32; bias = F.adaf_b; outp = F.MODF; }
        f32x16 acc[5];
#pragma unroll
        for (int g = 0; g < 5; ++g)
#pragma unroll
            for (int i = 0; i < 16; ++i) acc[g][i] = 0.f;
        const float* wp = W + (size_t)(ks * 512 + 8 * hh) * ldw + n0 + r;
        const bf16_t* ap = F.SCB + (size_t)r * D + ks * 512 + 8 * hh;
        for (int s = 0; s < 32; s += 4) {
            float wv[4][8];
#pragma unroll
            for (int u = 0; u < 4; ++u)
#pragma unroll
                for (int j = 0; j < 8; ++j) wv[u][j] = wp[(size_t)((s + u) * 16 + j) * ldw];
#pragma unroll
            for (int u = 0; u < 4; ++u) {
                u32x4 bw; bw.x = pk2(wv[u][0], wv[u][1]); bw.y = pk2(wv[u][2], wv[u][3]); bw.z = pk2(wv[u][4], wv[u][5]); bw.w = pk2(wv[u][6], wv[u][7]);
                const bf16x8 b = __builtin_bit_cast(bf16x8, bw);
#pragma unroll
                for (int g = 0; g < 5; ++g) { const bf16x8 a = *(const bf16x8*)(ap + (size_t)g * 32 * D + (s + u) * 16);
                    acc[g] = __builtin_amdgcn_mfma_f32_32x32x16_bf16(a, b, acc[g], 0, 0, 0); }
            }
        }
        if (ks > 0) {
#pragma unroll
            for (int g = 0; g < 5; ++g)
#pragma unroll
                for (int i = 0; i < 16; ++i) red[(((ks - 1) * 2 + cbi) * 80 + g * 16 + i) * 64 + lane] = acc[g][i];
        }
        __syncthreads();
        if (ks == 0) {
            const float bv = bias[n0 + r];
#pragma unroll
            for (int g = 0; g < 5; ++g)
#pragma unroll
                for (int i = 0; i < 16; ++i) {
                    float v = acc[g][i];
#pragma unroll
                    for (int k2 = 0; k2 < 3; ++k2) v += red[((k2 * 2 + cbi) * 80 + g * 16 + i) * 64 + lane];
                    const int gb = 32 * g + (i & 3) + 8 * (i >> 2) + 4 * hh;
                    if (gb < NGB) outp[(size_t)gb * ldw + n0 + r] = v + bv;
                }
        }
        __syncthreads();
    }
}

__device__ __forceinline__ int win_dst_row(int n) {
    if (n < 3072) return n;
    if (n < 3088) return 8192 + (n - 3072);
    if (n < 7184) return n - 16;
    if (n < 7200) return 8208 + (n - 7184);
    return n - 32;
}
template <bool MAPWIN>
__device__ __forceinline__ void transpose_item(const float* W, int K, int N, bf16_t* WT, LAS float* scr, int item, int lane) {
    const int nblk = N / 32, kb = item / nblk, nb = item % nblk, k0 = 64 * kb, n0 = 32 * nb;
#pragma unroll 8
    for (int i = 0; i < 32; ++i) { const int kk = 2 * i + (lane >> 5); scr[kk * 33 + (lane & 31)] = W[(size_t)(k0 + kk) * N + n0 + (lane & 31)]; }
    LDS_WAIT(); asm volatile("" ::: "memory");
    const int c = lane & 7;
#pragma unroll
    for (int j = 0; j < 4; ++j) { const int n = (lane >> 3) + 8 * j; const LAS float* s = scr + (8 * c) * 33 + n;
        u32x4 o; o.x = pk2(s[0 * 33], s[1 * 33]); o.y = pk2(s[2 * 33], s[3 * 33]); o.z = pk2(s[4 * 33], s[5 * 33]); o.w = pk2(s[6 * 33], s[7 * 33]);
        const int dr = MAPWIN ? win_dst_row(n0 + n) : (n0 + n);
        *(u32x4*)(WT + (size_t)dr * K + k0 + 8 * c) = o; }
    LDS_WAIT(); asm volatile("" ::: "memory");
}
__device__ __forceinline__ void p1_transposes(Frame& F) {
    LAS float* scr = (LAS float*)(F.lds + RING_OFF + F.wave * 16384);
    constexpr int I_IN = (D / 64) * (P_IN / 32), I_OUT = (D / 64) * (D / 32), I_UP = (D / 64) * (DFF / 32), I_DOWN = (DFF / 64) * (D / 32);
    constexpr int NITEMS = I_IN + I_OUT + I_UP + I_DOWN;
    for (int it = F.gw; it < NITEMS; it += F.ngw) {
        int r = it;
        if (r < I_IN) { transpose_item<true>(F.w_in, D, P_IN, F.WIN, scr, r, F.lane); continue; } r -= I_IN;
        if (r < I_OUT) { transpose_item<false>(F.w_out, D, D, F.WOUT, scr, r, F.lane); continue; } r -= I_OUT;
        if (r < I_UP) { transpose_item<false>(F.w_up, D, DFF, F.WUP, scr, r, F.lane); continue; } r -= I_UP;
        transpose_item<false>(F.w_down, DFF, D, F.WDOWN, scr, r, F.lane);
    }
}

__device__ __forceinline__ void norm_mod_row_bf16(const float* xr_, const float* g, const float* shift, const float* scale, bf16_t* orow, int lane) {
    const f32x4* xr = (const f32x4*)xr_ + lane;
    f32x4 v[8]; float s = 0.f;
#pragma unroll
    for (int j = 0; j < 8; ++j) { v[j] = xr[64 * j]; s += (v[j].x * v[j].x + v[j].y * v[j].y) + (v[j].z * v[j].z + v[j].w * v[j].w); }
    const float rstd = 1.0f / sqrtf(wave_sum(s) * (1.0f / D) + EPS);
    u32x2* o8 = (u32x2*)orow + lane;
#pragma unroll
    for (int j = 0; j < 8; ++j) { const f32x4 gg = ((const f32x4*)g)[lane + 64 * j], sh = ((const f32x4*)shift)[lane + 64 * j], sc = ((const f32x4*)scale)[lane + 64 * j];
        const f32x4 y = (v[j] * rstd * gg) * (sc + 1.0f) + sh; u32x2 w; w.x = pk2(y.x, y.y); w.y = pk2(y.z, y.w); o8[64 * j] = w; }
}
__device__ __forceinline__ void norm_mod_row_f32(const float* xr_, const float* g, const float* shift, const float* scale, float* orow, int lane) {
    const f32x4* xr = (const f32x4*)xr_ + lane;
    f32x4 v[8]; float s = 0.f;
#pragma unroll
    for (int j = 0; j < 8; ++j) { v[j] = xr[64 * j]; s += (v[j].x * v[j].x + v[j].y * v[j].y) + (v[j].z * v[j].z + v[j].w * v[j].w); }
    const float rstd = 1.0f / sqrtf(wave_sum(s) * (1.0f / D) + EPS);
    f32x4* o = (f32x4*)orow + lane;
#pragma unroll
    for (int j = 0; j < 8; ++j) { const f32x4 gg = ((const f32x4*)g)[lane + 64 * j], sh = ((const f32x4*)shift)[lane + 64 * j], sc = ((const f32x4*)scale)[lane + 64 * j];
        o[64 * j] = (v[j] * rstd * gg) * (sc + 1.0f) + sh; }
}

__device__ __forceinline__ void p3_gates(Frame& F) {
    const int lane = F.lane, fr = lane & 15, fq = lane >> 4;
    for (int task = F.gw; task < M / 16; task += F.ngw) {
        const int r0 = task * 16;
        const bf16_t* ap = F.HB + (size_t)(r0 + fr) * D + 8 * fq;
        const bf16_t* bp = F.WIN + (size_t)(NPROJ + fr) * D + 8 * fq;
        f32x4 c0 = (f32x4){0.f, 0.f, 0.f, 0.f}, c1 = c0;
#pragma unroll 8
        for (int k0 = 0; k0 < D; k0 += 32) {
            const bf16x8 a = *(const bf16x8*)(ap + k0), b0 = *(const bf16x8*)(bp + k0), b1 = *(const bf16x8*)(bp + (size_t)16 * D + k0);
            c0 = __builtin_amdgcn_mfma_f32_16x16x32_bf16(a, b0, c0, 0, 0, 0);
            c1 = __builtin_amdgcn_mfma_f32_16x16x32_bf16(a, b1, c1, 0, 0, 0);
        }
#pragma unroll
        for (int i = 0; i < 4; ++i) { float* o = F.GATES + (size_t)(r0 + 4 * fq + i) * NGATE + fr; o[0] = c0[i]; o[16] = c1[i]; }
    }
}

__device__ __forceinline__ void scan_mlstm_simple(Frame& F, bool prompt, int b, int hd) {
    LAS float* sq = (LAS float*)(F.lds + RING_OFF); LAS float* sk = sq + 128; LAS float* sv = sk + 128; LAS float* spart = sv + 128; LAS float* sred = spart + 512; LAS float* sred2 = sred + 8;
    const int tid = F.tid, e = tid & 127, q4 = tid >> 7, lane = F.lane, wave = F.wave;
    const int T = prompt ? T_P : T_S, row0 = prompt ? b * T_P : M_P + b * T_S, bh = b * NH + hd;
    float C[32]; float nst = 0.f, m = 0.f;
    if (prompt) {
#pragma unroll
        for (int dd = 0; dd < 32; ++dd) C[dd] = 0.f;
    } else {
#pragma unroll
        for (int dd = 0; dd < 32; ++dd) C[dd] = F.stC[((size_t)bh * HD + 32 * q4 + dd) * HD + e];
        if (tid < 128) nst = F.stN[(size_t)bh * HD + tid];
        m = F.stM[bh];
    }
    const float bi = F.gate_b[hd], bfg = F.gate_b[NH + hd], gn = F.mlstm_g[hd * HD + e];
    for (int t = 0; t < T; ++t) {
        const int row = row0 + t; const bf16_t* pr = F.PROJ + (size_t)row * NPROJ + hd * HD;
        float oa = 0.f;
        if (tid < 128) { sq[tid] = bf2f(pr[tid]); sk[tid] = bf2f(pr[1024 + tid]) * 0.08838834764831845f; sv[tid] = bf2f(pr[2048 + tid]); oa = bf2f(pr[3072 + tid]); }
        const float ia = F.GATES[(size_t)row * NGATE + hd], fa = F.GATES[(size_t)row * NGATE + 8 + hd];
        __syncthreads();
        const float li = ia + bi, lf = logsigmoidf_(fa + bfg);
        const float mn = fmaxf(lf + m, li), fdec = expf(lf + m - mn), iin = expf(li - mn); m = mn;
        const float ve = sv[e]; float part = 0.f;
#pragma unroll
        for (int dd = 0; dd < 32; ++dd) { const int d = 32 * q4 + dd; C[dd] = fdec * C[dd] + (iin * sk[d]) * ve; part += sq[d] * C[dd]; }
        spart[q4 * 128 + e] = part;
        if (tid < 128) { nst = fdec * nst + iin * sk[tid]; const float pn = wave_sum(sq[tid] * nst); if (lane == 0) sred[wave] = pn; }
        __syncthreads();
        const float numer = (spart[e] + spart[128 + e]) + (spart[256 + e] + spart[384 + e]);
        const float ddn = sred[0] + sred[1];
        const float hval = numer / fmaxf(fabsf(ddn), expf(-m));
        const float ss = wave_sum(hval * hval);
        if (lane == 0) sred2[wave] = ss;
        __syncthreads();
        const float tot = sred2[wave] + sred2[wave ^ 1];
        if (tid < 128) { const float y = hval * (1.0f / sqrtf(tot * (1.0f / HD) + EPS)) * gn * sigmoidf_(oa); F.MIX[(size_t)row * D + hd * HD + e] = (bf16_t)f2bf(y); }
    }
    float* oC = F.out + (prompt ? O_PC : O_SC) + (size_t)bh * HD * HD;
#pragma unroll
    for (int dd = 0; dd < 32; ++dd) oC[(size_t)(32 * q4 + dd) * HD + e] = C[dd];
    if (tid < 128) F.out[(prompt ? O_PN : O_SN) + (size_t)bh * HD + tid] = nst;
    if (tid == 0) F.out[(prompt ? O_PM : O_SM) + bh] = m;
    __syncthreads();
}
__device__ __forceinline__ void scan_gdn_simple(Frame& F, bool prompt, int b, int hd) {
    LAS float* sq = (LAS float*)(F.lds + RING_OFF); LAS float* sk = sq + 128; LAS float* sv = sk + 128; LAS float* spart = sv + 128; LAS float* spart2 = spart + 512; LAS float* sred = spart2 + 512; LAS float* sred2 = sred + 8;
    const int tid = F.tid, e = tid & 127, q4 = tid >> 7, lane = F.lane, wave = F.wave;
    const int T = prompt ? T_P : T_S, row0 = prompt ? b * T_P : M_P + b * T_S, bh = b * NH + hd;
    float S[32];
    if (prompt) {
#pragma unroll
        for (int dd = 0; dd < 32; ++dd) S[dd] = 0.f;
    } else {
#pragma unroll
        for (int dd = 0; dd < 32; ++dd) S[dd] = F.stS[((size_t)bh * HD + 32 * q4 + dd) * HD + e];
    }
    const int cch = (q4 < 3 ? q4 : 0) * 1024 + hd * HD + e;
    float h0 = 0.f, h1 = 0.f, h2 = 0.f;
    if (!prompt && q4 < 3) { const float* cv = F.stConv + (size_t)b * 3 * CCONV + cch; h0 = cv[0]; h1 = cv[CCONV]; h2 = cv[2 * CCONV]; }
    const float w0 = F.conv_w[cch], w1 = F.conv_w[CCONV + cch], w2 = F.conv_w[2 * CCONV + cch], w3 = F.conv_w[3 * CCONV + cch];
    const float negA = -expf(F.A_log[hd]), dtb = F.dt_bias[hd], gn = F.gdn_g[hd * HD + e];
    for (int t = 0; t < T; ++t) {
        const int row = row0 + t; const bf16_t* pr = F.PROJ + (size_t)row * NPROJ + 4096;
        float a = 0.f, zb = 0.f;
        if (q4 < 3) { const float u = bf2f(pr[cch]); const float cvv = w0 * h0 + w1 * h1 + w2 * h2 + w3 * u; h0 = h1; h1 = h2; h2 = u; a = siluf_(cvv); }
        if (q4 == 0) zb = bf2f(pr[3072 + hd * HD + e]);
        if (q4 < 2) { const float ss = wave_sum(a * a); if (lane == 0) sred[wave] = ss; }
        if (q4 == 2) sv[e] = a;
        const float ab = F.GATES[(size_t)row * NGATE + 16 + hd], bb = F.GATES[(size_t)row * NGATE + 24 + hd];
        __syncthreads();
        if (q4 == 0) sq[e] = a * (1.0f / sqrtf(sred[0] + sred[1] + EPS)) * 0.08838834764831845f;
        if (q4 == 1) sk[e] = a * (1.0f / sqrtf(sred[2] + sred[3] + EPS));
        __syncthreads();
        const float g = expf(negA * softplusf_(ab + dtb)), beta = sigmoidf_(bb);
        float part = 0.f;
#pragma unroll
        for (int dd = 0; dd < 32; ++dd) part += sk[32 * q4 + dd] * S[dd];
        spart[q4 * 128 + e] = part;
        __syncthreads();
        const float kS = (spart[e] + spart[128 + e]) + (spart[256 + e] + spart[384 + e]);
        const float ue = beta * (sv[e] - g * kS);
        float opart = 0.f;
#pragma unroll
        for (int dd = 0; dd < 32; ++dd) { const int d = 32 * q4 + dd; S[dd] = g * S[dd] + sk[d] * ue; opart += sq[d] * S[dd]; }
        spart2[q4 * 128 + e] = opart;
        __syncthreads();
        const float o = (spart2[e] + spart2[128 + e]) + (spart2[256 + e] + spart2[384 + e]);
        const float ss2 = wave_sum(o * o);
        if (lane == 0) sred2[wave] = ss2;
        __syncthreads();
        const float tot = sred2[wave] + sred2[wave ^ 1];
        if (q4 == 0) { const float y = o * (1.0f / sqrtf(tot * (1.0f / HD) + EPS)) * gn * siluf_(zb); F.MIX[(size_t)row * D + 1024 + hd * HD + e] = (bf16_t)f2bf(y); }
    }
    float* oS = F.out + (prompt ? O_PS : O_SS) + (size_t)bh * HD * HD;
#pragma unroll
    for (int dd = 0; dd < 32; ++dd) oS[(size_t)(32 * q4 + dd) * HD + e] = S[dd];
    if (q4 < 3) { float* oc = F.out + (prompt ? O_PCONV : O_SCONV) + (size_t)b * 3 * CCONV + cch; oc[0] = h0; oc[CCONV] = h1; oc[2 * CCONV] = h2; }
    __syncthreads();
}

__device__ __forceinline__ float wave_scan_add(float v, int lane) {
#pragma unroll
    for (int o = 1; o < 64; o <<= 1) { const float t = __shfl_up(v, o); if (lane >= o) v += t; }
    return v;
}
__device__ __forceinline__ float wave_scan_max(float v, int lane) {
#pragma unroll
    for (int o = 1; o < 64; o <<= 1) { const float t = __shfl_up(v, o); if (lane >= o) v = fmaxf(v, t); }
    return v;
}
__device__ __forceinline__ float wave_max(float v) {
#pragma unroll
    for (int o = 1; o < 64; o <<= 1) v = fmaxf(v, __shfl_xor(v, o));
    return v;
}
#define QK_SCALE 0.08838834764831845f
__device__ __forceinline__ void s1_mlstm_unit(Frame& F, int unit, LAS float* scr) {
    const int lane = F.lane, r = lane & 31, h = lane >> 5;
    const int c = unit & 31, bh = unit >> 5, hd = bh & 7, b = bh >> 3;
    const int rowb = b * T_P, row0 = rowb + 64 * c;
    unsigned char* rec = F.IMGM + (size_t)unit * MREC;
    const float bi = F.gate_b[hd], bfg = F.gate_b[NH + hd];
    float m_prev = 0.f;
    for (int cc = 0; cc < c; ++cc) {
        const float* gp = F.GATES + (size_t)(rowb + 64 * cc + lane) * NGATE;
        const float lfv = logsigmoidf_(gp[8 + hd] + bfg), liv = gp[hd] + bi;
        const float bb = wave_scan_add(lfv, lane); const float amax = wave_max(liv - bb); const float b63 = __shfl(bb, 63);
        m_prev = b63 + fmaxf(m_prev, amax);
    }
    float* sc = (float*)(rec + MR_SC);
    {
        const float* gp = F.GATES + (size_t)(row0 + lane) * NGATE;
        const float lfv = logsigmoidf_(gp[8 + hd] + bfg), liv = gp[hd] + bi;
        const float bb = wave_scan_add(lfv, lane); const float a = liv - bb; const float cm = wave_scan_max(a, lane);
        const float Mi = fmaxf(m_prev, cm), mi = bb + Mi; const float M63 = __shfl(Mi, 63), m_new = __shfl(mi, 63);
        scr[lane] = a; scr[64 + lane] = Mi; scr[128 + lane] = expf(a - M63) * QK_SCALE;
        sc[lane] = expf(m_prev - Mi); sc[64 + lane] = expf(-mi);
        if (lane == 0) { sc[192] = expf(m_prev - M63); sc[193] = m_new; if (c == 31) F.out[O_PM + bh] = m_new; }
    }
    asm volatile("s_waitcnt lgkmcnt(0)" ::: "memory");
    bf16x8 Qf[2][8], Kf[2][8];
    const bf16_t* pq = F.PROJ + (size_t)(row0 + r) * NPROJ + hd * HD + 8 * h;
#pragma unroll
    for (int rb = 0; rb < 2; ++rb)
#pragma unroll
        for (int s = 0; s < 8; ++s) { Qf[rb][s] = *(const bf16x8*)(pq + (size_t)(32 * rb) * NPROJ + 16 * s); Kf[rb][s] = *(const bf16x8*)(pq + (size_t)(32 * rb) * NPROJ + 1024 + 16 * s); }
#pragma unroll
    for (int rb = 0; rb < 2; ++rb)
#pragma unroll
        for (int s = 0; s < 8; ++s) { const int i = 32 * rb + r; const u32x4 wv = __builtin_bit_cast(u32x4, Qf[rb][s]);
            unsigned char* o0 = rec + MR_QI + ((((i >> 4) * 4 + (s >> 1)) * 64 + (2 * h) * 16 + (i & 15)) * 16) + 8 * (s & 1);
            *(u32x2*)o0 = (u32x2){wv.x, wv.y}; *(u32x2*)(o0 + 256) = (u32x2){wv.z, wv.w}; }
    float rs[2] = {0.f, 0.f};
#pragma unroll
    for (int blk = 0; blk < 3; ++blk) {
        const int jb = blk >> 1, ib = (blk + 1) >> 1;
        f32x16 Dm;
#pragma unroll
        for (int x = 0; x < 16; ++x) Dm[x] = 0.f;
#pragma unroll
        for (int s = 0; s < 8; ++s) Dm = __builtin_amdgcn_mfma_f32_32x32x16_bf16(Kf[jb][s], Qf[ib][s], Dm, 0, 0, 0);
        const int i = 32 * ib + r; const float Mi_i = scr[64 + i];
#pragma unroll
        for (int g = 0; g < 4; ++g) {
            const f32x4 aj = *(const LAS f32x4*)(scr + 32 * jb + 8 * g + 4 * h);
            float v[4];
#pragma unroll
            for (int ip = 0; ip < 4; ++ip) { const int j = 32 * jb + 8 * g + 4 * h + ip; const float x = Dm[4 * g + ip] * QK_SCALE * __expf(aj[ip] - Mi_i); v[ip] = (j <= i) ? x : 0.f; }
            rs[ib] += (v[0] + v[1]) + (v[2] + v[3]);
            *(u32x2*)(rec + MR_SP + ((((i >> 4) * 2 + jb) * 64 + g * 16 + (i & 15)) * 16) + 8 * h) = (u32x2){pk2(v[0], v[1]), pk2(v[2], v[3])};
        }
    }
    rs[0] += __shfl_xor(rs[0], 32); rs[1] += __shfl_xor(rs[1], 32);
    if (h == 0) { sc[128 + r] = rs[0]; sc[160 + r] = rs[1]; }
    const bf16_t* pk = F.PROJ + (size_t)row0 * NPROJ + 1024 + hd * HD;
    const bf16_t* pv = pk + 1024;
#pragma unroll 1
    for (int blk = 0; blk < 4; ++blk) {
        const int d = 32 * blk + r; float dn = 0.f;
#pragma unroll
        for (int s = 0; s < 4; ++s) {
            unsigned kv[8], vv[8];
#pragma unroll
            for (int j = 0; j < 8; ++j) { const size_t ro = (size_t)(16 * s + 8 * h + j) * NPROJ + d; kv[j] = pk[ro]; vv[j] = pv[ro]; }
            const f32x4 w0 = *(const LAS f32x4*)(scr + 128 + 16 * s + 8 * h), w1 = *(const LAS f32x4*)(scr + 128 + 16 * s + 8 * h + 4);
            float x[8];
#pragma unroll
            for (int j = 0; j < 4; ++j) { x[j] = bflo(kv[j]) * w0[j]; x[4 + j] = bflo(kv[4 + j]) * w1[j]; }
            dn += ((x[0] + x[1]) + (x[2] + x[3])) + ((x[4] + x[5]) + (x[6] + x[7]));
            const size_t off = ((((d >> 4) * 2 + (s >> 1)) * 64 + (2 * (s & 1) + h) * 16 + (d & 15)) * 16);
            *(u32x4*)(rec + MR_KW + off) = (u32x4){pk2(x[0], x[1]), pk2(x[2], x[3]), pk2(x[4], x[5]), pk2(x[6], x[7])};
            *(u32x4*)(rec + MR_VT + off) = (u32x4){vv[0] | (vv[1] << 16), vv[2] | (vv[3] << 16), vv[4] | (vv[5] << 16), vv[6] | (vv[7] << 16)};
        }
        dn += __shfl_xor(dn, 32);
        if (h == 0) ((float*)(rec + MR_DN))[d] = dn;
    }
}
__device__ __forceinline__ void s2_mlstm_chain(Frame& F, int bh) {
    const int lane = F.lane, w = F.wave, cl = lane & 15, q = lane >> 4, hd = bh & 7, b = bh >> 3;
    LAS unsigned char* const buf0 = F.lds; LAS unsigned char* const buf1 = F.lds + MREC;
    LAS float* const s_qn = (LAS float*)(F.lds + 2 * MREC); LAS float* const s_n = s_qn + 64; LAS float* const s_part = s_n + 128;
    const unsigned char* recs = F.IMGM + (size_t)bh * 32 * MREC;
    f32x4 C[8];
#pragma unroll
    for (int db = 0; db < 8; ++db) C[db] = (f32x4){0.f, 0.f, 0.f, 0.f};
    if (F.tid < 128) s_n[F.tid] = 0.f;
    for (int piece = w; piece < MREC / 1024; piece += 8)
        __builtin_amdgcn_global_load_lds((const unsigned*)(recs + piece * 1024 + lane * 16), (LAS unsigned*)(buf0 + piece * 1024), 16, 0, 0);
    asm volatile("s_waitcnt vmcnt(0)" ::: "memory"); __syncthreads();
    const float gn = F.mlstm_g[hd * HD + 16 * w + cl];
    for (int c = 0; c < 32; ++c) {
        LAS unsigned char* const cur = (c & 1) ? buf1 : buf0; LAS unsigned char* const nxt = (c & 1) ? buf0 : buf1;
        if (c + 1 < 32) { const unsigned char* src = recs + (size_t)(c + 1) * MREC;
            for (int piece = w; piece < MREC / 1024; piece += 8)
                __builtin_amdgcn_global_load_lds((const unsigned*)(src + piece * 1024 + lane * 16), (LAS unsigned*)(nxt + piece * 1024), 16, 0, 0); }
        const int row0 = b * T_P + 64 * c;
        unsigned oa[16];
#pragma unroll
        for (int x = 0; x < 16; ++x) oa[x] = F.PROJ[(size_t)(row0 + 16 * (x >> 2) + 4 * q + (x & 3)) * NPROJ + 3072 + hd * HD + 16 * w + cl];
        const LAS float* sc = (const LAS float*)(cur + MR_SC);
        {
            const int t = 8 * w + (lane >> 3), p = lane & 7, s = p >> 1; float acc = 0.f;
#pragma unroll
            for (int qq = 0; qq < 4; ++qq) {
                const u32x2 qv = *(const LAS u32x2*)(cur + MR_QI + ((((t >> 4) * 4 + s) * 64 + qq * 16 + (t & 15)) * 16) + 8 * (p & 1));
                const f32x4 nv = *(const LAS f32x4*)(s_n + 32 * s + 16 * (p & 1) + 4 * qq);
                acc += (bflo(qv.x) * nv.x + bfhi(qv.x) * nv.y) + (bflo(qv.y) * nv.z + bfhi(qv.y) * nv.w);
            }
            acc += __shfl_xor(acc, 1); acc += __shfl_xor(acc, 2); acc += __shfl_xor(acc, 4);
            if (p == 0) s_qn[t] = acc;
        }
        bf16x8 Cb[4];
#pragma unroll
        for (int s = 0; s < 4; ++s) Cb[s] = __builtin_bit_cast(bf16x8, (u32x4){pk2(C[2 * s][0], C[2 * s][1]), pk2(C[2 * s][2], C[2 * s][3]), pk2(C[2 * s + 1][0], C[2 * s + 1][1]), pk2(C[2 * s + 1][2], C[2 * s + 1][3])});
#define FRAG(off, f) (*(const LAS bf16x8*)(cur + (off) + (f) * 1024 + lane * 16))
        const bf16x8 VB0 = FRAG(MR_VT, w * 2 + 0), VB1 = FRAG(MR_VT, w * 2 + 1);
        f32x4 num[4];
#pragma unroll
        for (int tp = 0; tp < 2; ++tp) {
            bf16x8 fq[8], fs[4];
#pragma unroll
            for (int x = 0; x < 8; ++x) fq[x] = FRAG(MR_QI, tp * 8 + x);
#pragma unroll
            for (int x = 0; x < 4; ++x) fs[x] = FRAG(MR_SP, tp * 4 + x);
            const f32x4 dv0 = *(const LAS f32x4*)(sc + 16 * (2 * tp) + 4 * q), dv1 = *(const LAS f32x4*)(sc + 16 * (2 * tp + 1) + 4 * q);
            f32x4 a0 = (f32x4){0.f, 0.f, 0.f, 0.f}, a1 = a0;
#pragma unroll
            for (int s = 0; s < 4; ++s) { a0 = __builtin_amdgcn_mfma_f32_16x16x32_bf16(fq[s], Cb[s], a0, 0, 0, 0); a1 = __builtin_amdgcn_mfma_f32_16x16x32_bf16(fq[4 + s], Cb[s], a1, 0, 0, 0); }
            a0 = a0 * dv0; a1 = a1 * dv1;
            a0 = __builtin_amdgcn_mfma_f32_16x16x32_bf16(fs[0], VB0, a0, 0, 0, 0); a1 = __builtin_amdgcn_mfma_f32_16x16x32_bf16(fs[2], VB0, a1, 0, 0, 0);
            if (tp == 1) { a0 = __builtin_amdgcn_mfma_f32_16x16x32_bf16(fs[1], VB1, a0, 0, 0, 0); a1 = __builtin_amdgcn_mfma_f32_16x16x32_bf16(fs[3], VB1, a1, 0, 0, 0); }
            num[2 * tp] = a0; num[2 * tp + 1] = a1;
        }
        const float dC = sc[192];
#pragma unroll
        for (int dp = 0; dp < 2; ++dp) {
            bf16x8 fk[8];
#pragma unroll
            for (int x = 0; x < 8; ++x) fk[x] = FRAG(MR_KW, dp * 8 + x);
#pragma unroll
            for (int x = 0; x < 4; ++x) { const int db = dp * 4 + x; f32x4 acc = C[db] * dC;
                acc = __builtin_amdgcn_mfma_f32_16x16x32_bf16(fk[2 * x], VB0, acc, 0, 0, 0);
                acc = __builtin_amdgcn_mfma_f32_16x16x32_bf16(fk[2 * x + 1], VB1, acc, 0, 0, 0);
                C[db] = acc; }
        }
#undef FRAG
        __syncthreads();
        if (F.tid < 128) s_n[F.tid] = dC * s_n[F.tid] + ((const LAS float*)(cur + MR_DN))[F.tid];
        float hv[16];
#pragma unroll
        for (int tb = 0; tb < 4; ++tb) {
            const f32x4 dv = *(const LAS f32x4*)(sc + 16 * tb + 4 * q), ev = *(const LAS f32x4*)(sc + 64 + 16 * tb + 4 * q), rv = *(const LAS f32x4*)(sc + 128 + 16 * tb + 4 * q), qn = *(const LAS f32x4*)(s_qn + 16 * tb + 4 * q);
            f32x4 ss;
#pragma unroll
            for (int i = 0; i < 4; ++i) { const float dd = dv[i] * qn[i] + rv[i]; const float hh = __fdividef(num[tb][i], fmaxf(fabsf(dd), ev[i])); hv[tb * 4 + i] = hh; ss[i] = hh * hh; }
#pragma unroll
            for (int o = 1; o < 16; o <<= 1) { ss.x += __shfl_xor(ss.x, o); ss.y += __shfl_xor(ss.y, o); ss.z += __shfl_xor(ss.z, o); ss.w += __shfl_xor(ss.w, o); }
            if (cl == 0) *(LAS f32x4*)(s_part + w * 64 + 16 * tb + 4 * q) = ss;
        }
        __syncthreads();
        unsigned yv[16];
#pragma unroll
        for (int tb = 0; tb < 4; ++tb) {
            f32x4 tot = (f32x4){0.f, 0.f, 0.f, 0.f};
#pragma unroll
            for (int ww = 0; ww < 8; ++ww) tot += *(const LAS f32x4*)(s_part + ww * 64 + 16 * tb + 4 * q);
#pragma unroll
            for (int i = 0; i < 4; ++i) yv[tb * 4 + i] = f2bf(hv[tb * 4 + i] * __frsqrt_rn(tot[i] * (1.0f / HD) + EPS) * gn * sigmoidf_(bflo(oa[tb * 4 + i])));
        }
        asm volatile("s_waitcnt vmcnt(0)" ::: "memory"); __syncthreads();
#pragma unroll
        for (int x = 0; x < 16; ++x) F.MIX[(size_t)(row0 + 16 * (x >> 2) + 4 * q + (x & 3)) * D + hd * HD + 16 * w + cl] = (bf16_t)yv[x];
    }
    float* oC = F.out + O_PC + (size_t)bh * HD * HD;
#pragma unroll
    for (int db = 0; db < 8; ++db)
#pragma unroll
        for (int i = 0; i < 4; ++i) oC[(size_t)(16 * db + 4 * q + i) * HD + 16 * w + cl] = C[db][i];
    if (F.tid < 128) F.out[O_PN + (size_t)bh * HD + F.tid] = s_n[F.tid];
    __syncthreads();
}


__device__ __forceinline__ float silu_fast(float x) { return __fdividef(x, 1.0f + __expf(-x)); }
__device__ __forceinline__ void s1_gdn_unit(Frame& F, int unit, LAS float* scr) {
    const int lane = F.lane, r = lane & 31, h = lane >> 5;
    const int c = unit & 31, bh = unit >> 5, hd = bh & 7, b = bh >> 3;
    const int rowb = b * T_P, row0 = rowb + 64 * c;
    unsigned char* rec = F.IMGG + (size_t)unit * GREC;
    LAS float* scrA = scr; LAS float* sG = scr + 4352; LAS float* sBe = sG + 64; LAS float* sRk = sBe + 64; LAS float* sRq = sRk + 64; LAS float* sF1 = sRq + 64; LAS float* sF2 = sF1 + 64;
    const float* gp = F.GATES + (size_t)(row0 + lane) * NGATE;
    const float lgv = -expf(F.A_log[hd]) * softplusf_(gp[16 + hd] + F.dt_bias[hd]);
    const float G = wave_scan_add(lgv, lane); const float be = sigmoidf_(gp[24 + hd]); const float G63 = __shfl(G, 63);
    sG[lane] = G; sBe[lane] = be;
    f32x16 Dk[3], Dq[3];
#pragma unroll
    for (int x = 0; x < 3; ++x)
#pragma unroll
        for (int y = 0; y < 16; ++y) { Dk[x][y] = 0.f; Dq[x][y] = 0.f; }
    float ssq[2][2] = {{0.f, 0.f}, {0.f, 0.f}};
    const bf16_t* pp = F.PROJ + (size_t)row0 * NPROJ + 4096 + hd * HD + 8 * h;
    const float* cw = F.conv_w + hd * HD + 8 * h;
#pragma unroll 1
    for (int s = 0; s < 8; ++s) {
        bf16x8 fr[2][2];
#pragma unroll
        for (int mt = 0; mt < 2; ++mt) {
            asm volatile("" ::: "memory");
            f32x4 wa[4], wb[4];
#pragma unroll
            for (int tap = 0; tap < 4; ++tap) { wa[tap] = *(const f32x4*)(cw + tap * CCONV + mt * 1024 + 16 * s); wb[tap] = *(const f32x4*)(cw + tap * CCONV + mt * 1024 + 16 * s + 4); }
#pragma unroll
            for (int rb = 0; rb < 2; ++rb) {
                const int i = 32 * rb + r; f32x4 a0 = (f32x4){0.f, 0.f, 0.f, 0.f}, a1 = a0;
#pragma unroll
                for (int tap = 0; tap < 4; ++tap) { const int ti = i - 3 + tap; const bool dead = (c == 0) && (ti < 0); const int tl = dead ? 0 : ti;
                    const u32x4 uv = *(const u32x4*)(pp + (ptrdiff_t)tl * NPROJ + mt * 1024 + 16 * s); const float mk = dead ? 0.f : 1.f;
                    a0 += (f32x4){bflo(uv.x), bfhi(uv.x), bflo(uv.y), bfhi(uv.y)} * (wa[tap] * mk); a1 += (f32x4){bflo(uv.z), bfhi(uv.z), bflo(uv.w), bfhi(uv.w)} * (wb[tap] * mk); }
                float y[8];
#pragma unroll
                for (int j = 0; j < 4; ++j) { y[j] = silu_fast(a0[j]); y[4 + j] = silu_fast(a1[j]); }
                ssq[rb][mt] += ((y[0] * y[0] + y[1] * y[1]) + (y[2] * y[2] + y[3] * y[3])) + ((y[4] * y[4] + y[5] * y[5]) + (y[6] * y[6] + y[7] * y[7]));
                const u32x4 wv = (u32x4){pk2(y[0], y[1]), pk2(y[2], y[3]), pk2(y[4], y[5]), pk2(y[6], y[7])};
                fr[mt][rb] = __builtin_bit_cast(bf16x8, wv);
                if (mt == 0) { unsigned char* o0 = rec + GR_QG + ((((i >> 4) * 4 + (s >> 1)) * 64 + (2 * h) * 16 + (i & 15)) * 16) + 8 * (s & 1);
                    *(u32x2*)o0 = (u32x2){wv.x, wv.y}; *(u32x2*)(o0 + 256) = (u32x2){wv.z, wv.w}; }
            }
        }
#pragma unroll
        for (int blk = 0; blk < 3; ++blk) { const int jb = blk >> 1, ib = (blk + 1) >> 1;
            Dk[blk] = __builtin_amdgcn_mfma_f32_32x32x16_bf16(fr[1][jb], fr[1][ib], Dk[blk], 0, 0, 0);
            Dq[blk] = __builtin_amdgcn_mfma_f32_32x32x16_bf16(fr[1][jb], fr[0][ib], Dq[blk], 0, 0, 0); }
    }
#pragma unroll
    for (int rb = 0; rb < 2; ++rb) {
        const float sq = ssq[rb][0] + __shfl_xor(ssq[rb][0], 32), sk = ssq[rb][1] + __shfl_xor(ssq[rb][1], 32);
        if (h == 0) { sRq[32 * rb + r] = 1.0f / sqrtf(sq + EPS); sRk[32 * rb + r] = 1.0f / sqrtf(sk + EPS); }
    }
    asm volatile("s_waitcnt lgkmcnt(0)" ::: "memory");
#pragma unroll
    for (int blk = 0; blk < 3; ++blk) {
        const int jb = blk >> 1, ib = (blk + 1) >> 1;
        const int i = 32 * ib + r; const float Gi = sG[i], bei = sBe[i], rki = sRk[i], rqi = sRq[i] * QK_SCALE;
#pragma unroll
        for (int g = 0; g < 4; ++g) {
            const int j0 = 32 * jb + 8 * g + 4 * h; const f32x4 Gj = *(const LAS f32x4*)(sG + j0), rkj = *(const LAS f32x4*)(sRk + j0);
            f32x4 av; float qv[4];
#pragma unroll
            for (int ip = 0; ip < 4; ++ip) { const float e = __expf(Gi - Gj[ip]); av[ip] = bei * e * rki * rkj[ip] * Dk[blk][4 * g + ip];
                qv[ip] = (j0 + ip <= i) ? -(rqi * rkj[ip] * e * Dq[blk][4 * g + ip]) : 0.f; }
            *(LAS f32x4*)(scrA + i * 68 + j0) = av;
            *(u32x2*)(rec + GR_QK + ((((i >> 4) * 2 + jb) * 64 + (2 * (g & 1) + h) * 16 + (i & 15)) * 16) + 8 * (g >> 1)) = (u32x2){pk2(qv[0], qv[1]), pk2(qv[2], qv[3])};
        }
    }
    asm volatile("s_waitcnt lgkmcnt(0)" ::: "memory");
#ifndef NO_SUBST
    {
        float tc[64];
#pragma unroll
        for (int i = 0; i < 64; ++i) {
            float acc0 = (lane == i) ? 1.f : 0.f, acc1 = 0.f;
#pragma unroll
            for (int j4 = 0; j4 < i; j4 += 4) { const f32x4 av = *(const LAS f32x4*)(scrA + i * 68 + j4);
                acc0 -= av.x * tc[j4]; if (j4 + 1 < i) acc1 -= av.y * tc[j4 + 1]; if (j4 + 2 < i) acc0 -= av.z * tc[j4 + 2]; if (j4 + 3 < i) acc1 -= av.w * tc[j4 + 3]; }
            tc[i] = acc0 + acc1;
            scrA[i * 68 + lane] = tc[i];
            asm volatile("" ::: "memory");
        }
    }
#endif
    const float gam = expf(G), rkl = sRk[lane], rql = sRq[lane];
    sF1[lane] = be * gam * rkl; sF2[lane] = be;
    { float* sc = (float*)(rec + GR_SC); sc[lane] = gam * rql * QK_SCALE; sc[64 + lane] = expf(G63 - G) * rkl; if (lane == 0) sc[128] = expf(G63); }
    asm volatile("s_waitcnt lgkmcnt(0)" ::: "memory");
    bf16x8 Tp[6], Tpp[6];
#pragma unroll
    for (int x = 0; x < 6; ++x) { const int ib = x < 2 ? 0 : 1, s = x < 2 ? x : x - 2;
        const LAS float* tp = scrA + (32 * ib + r) * 68 + 16 * s + 8 * h; const f32x4 t0 = *(const LAS f32x4*)tp, t1 = *(const LAS f32x4*)(tp + 4);
        const f32x4 f1a = *(const LAS f32x4*)(sF1 + 16 * s + 8 * h), f1b = *(const LAS f32x4*)(sF1 + 16 * s + 8 * h + 4), f2a = *(const LAS f32x4*)(sF2 + 16 * s + 8 * h), f2b = *(const LAS f32x4*)(sF2 + 16 * s + 8 * h + 4);
        const f32x4 p0 = t0 * f1a, p1 = t1 * f1b, q0 = t0 * f2a, q1 = t1 * f2b;
        Tp[x] = __builtin_bit_cast(bf16x8, (u32x4){pk2(p0.x, p0.y), pk2(p0.z, p0.w), pk2(p1.x, p1.y), pk2(p1.z, p1.w)});
        Tpp[x] = __builtin_bit_cast(bf16x8, (u32x4){pk2(q0.x, q0.y), pk2(q0.z, q0.w), pk2(q1.x, q1.y), pk2(q1.z, q1.w)}); }
#ifndef NO_CHMAJ
#pragma unroll 1
    for (int mt = 0; mt < 2; ++mt) {
        const bf16_t* pc = F.PROJ + (size_t)row0 * NPROJ + 4096 + (mt + 1) * 1024 + hd * HD;
#pragma unroll 1
        for (int blk = 0; blk < 4; ++blk) {
            const int d = 32 * blk + r; const float* cwc = F.conv_w + (mt + 1) * 1024 + hd * HD + d;
            const float w0 = cwc[0], w1 = cwc[CCONV], w2 = cwc[2 * CCONV], w3 = cwc[3 * CCONV];
            bf16x8 Xc[4];
#pragma unroll
            for (int s = 0; s < 4; ++s) {
                asm volatile("" ::: "memory");
                float u[11];
#pragma unroll
                for (int x = 0; x < 11; ++x) { const int ti = 16 * s + 8 * h - 3 + x; const bool dead = (c == 0) && (ti < 0); const int tl = dead ? 0 : ti;
                    const float val = bf2f(pc[(ptrdiff_t)tl * NPROJ + d]); u[x] = dead ? 0.f : val; }
                float y[8];
#pragma unroll
                for (int j = 0; j < 8; ++j) y[j] = silu_fast(((w0 * u[j] + w1 * u[j + 1]) + w2 * u[j + 2]) + w3 * u[j + 3]);
                const u32x4 xw = (u32x4){pk2(y[0], y[1]), pk2(y[2], y[3]), pk2(y[4], y[5]), pk2(y[6], y[7])};
                Xc[s] = __builtin_bit_cast(bf16x8, xw);
                if (mt == 0) { unsigned char* o0 = rec + GR_KT + ((((d >> 4) * 2 + (s >> 1)) * 64 + (2 * h) * 16 + (d & 15)) * 16) + 8 * (s & 1);
                    *(u32x2*)o0 = (u32x2){xw.x ^ 0x80008000u, xw.y ^ 0x80008000u}; *(u32x2*)(o0 + 256) = (u32x2){xw.z ^ 0x80008000u, xw.w ^ 0x80008000u}; }
            }
#pragma unroll
            for (int ib = 0; ib < 2; ++ib) {
                f32x16 Dm;
#pragma unroll
                for (int x = 0; x < 16; ++x) Dm[x] = 0.f;
                if (mt == 0) {
                    if (ib == 0) { Dm = __builtin_amdgcn_mfma_f32_32x32x16_bf16(Xc[0], Tp[0], Dm, 0, 0, 0); Dm = __builtin_amdgcn_mfma_f32_32x32x16_bf16(Xc[1], Tp[1], Dm, 0, 0, 0); }
                    else {
#pragma unroll
                        for (int s = 0; s < 4; ++s) Dm = __builtin_amdgcn_mfma_f32_32x32x16_bf16(Xc[s], Tp[2 + s], Dm, 0, 0, 0); }
                    const int i = 32 * ib + r;
#pragma unroll
                    for (int g = 0; g < 4; ++g)
                        *(u32x2*)(rec + GR_WI + ((((i >> 4) * 4 + blk) * 64 + (2 * (g & 1) + h) * 16 + (i & 15)) * 16) + 8 * (g >> 1)) = (u32x2){pk2(Dm[4 * g], Dm[4 * g + 1]), pk2(Dm[4 * g + 2], Dm[4 * g + 3])};
                } else {
                    if (ib == 0) { Dm = __builtin_amdgcn_mfma_f32_32x32x16_bf16(Tpp[0], Xc[0], Dm, 0, 0, 0); Dm = __builtin_amdgcn_mfma_f32_32x32x16_bf16(Tpp[1], Xc[1], Dm, 0, 0, 0); }
                    else {
#pragma unroll
                        for (int s = 0; s < 4; ++s) Dm = __builtin_amdgcn_mfma_f32_32x32x16_bf16(Tpp[2 + s], Xc[s], Dm, 0, 0, 0); }
#pragma unroll
                    for (int g = 0; g < 4; ++g)
                        *(u32x2*)(rec + GR_UP + ((((d >> 4) * 4 + (2 * ib + (g >> 1))) * 64 + (2 * (g & 1) + h) * 16 + (d & 15)) * 8)) = (u32x2){pk2(Dm[4 * g], Dm[4 * g + 1]), pk2(Dm[4 * g + 2], Dm[4 * g + 3])};
                }
            }
        }
    }
#endif
    if (c == 31) {
        for (int x = lane; x < 3 * 384; x += 64) { const int jr = x / 384, cc = x % 384, ch = (cc >> 7) * 1024 + hd * HD + (cc & 127);
            F.out[O_PCONV + (size_t)(b * 3 + jr) * CCONV + ch] = bf2f(F.PROJ[(size_t)(rowb + T_P - 3 + jr) * NPROJ + 4096 + ch]); }
    }
}
__device__ __forceinline__ void s2_gdn_chain(Frame& F, int bh) {
    const int lane = F.lane, w = F.wave, cl = lane & 15, q = lane >> 4, hd = bh & 7, b = bh >> 3;
    LAS unsigned char* const buf0 = F.lds; LAS unsigned char* const buf1 = F.lds + GDMA_BYTES;
    LAS float* const s_part = (LAS float*)(F.lds + 2 * GDMA_BYTES);
    const unsigned char* recs = F.IMGG + (size_t)bh * 32 * GREC;
    f32x4 S[8];
#pragma unroll
    for (int db = 0; db < 8; ++db) S[db] = (f32x4){0.f, 0.f, 0.f, 0.f};
    u32x2 upn[4];
#pragma unroll
    for (int tb = 0; tb < 4; ++tb) upn[tb] = *(const u32x2*)(recs + GR_UP + ((w * 4 + tb) * 64 + lane) * 8);
    for (int piece = w; piece < GDMA_BYTES / 1024; piece += 8)
        __builtin_amdgcn_global_load_lds((const unsigned*)(recs + piece * 1024 + lane * 16), (LAS unsigned*)(buf0 + piece * 1024), 16, 0, 0);
    asm volatile("s_waitcnt vmcnt(0)" ::: "memory"); __syncthreads();
    const float gn = F.gdn_g[hd * HD + 16 * w + cl];
    for (int c = 0; c < 32; ++c) {
        LAS unsigned char* const cur = (c & 1) ? buf1 : buf0; LAS unsigned char* const nxt = (c & 1) ? buf0 : buf1;
        u32x2 up[4];
#pragma unroll
        for (int tb = 0; tb < 4; ++tb) up[tb] = upn[tb];
        const int row0 = b * T_P + 64 * c;
        unsigned zb[16];
#pragma unroll
        for (int x = 0; x < 16; ++x) zb[x] = F.PROJ[(size_t)(row0 + 16 * (x >> 2) + 4 * q + (x & 3)) * NPROJ + 7168 + hd * HD + 16 * w + cl];
        if (c + 1 < 32) { const unsigned char* src = recs + (size_t)(c + 1) * GREC;
#pragma unroll
            for (int tb = 0; tb < 4; ++tb) upn[tb] = *(const u32x2*)(src + GR_UP + ((w * 4 + tb) * 64 + lane) * 8);
            for (int piece = w; piece < GDMA_BYTES / 1024; piece += 8)
                __builtin_amdgcn_global_load_lds((const unsigned*)(src + piece * 1024 + lane * 16), (LAS unsigned*)(nxt + piece * 1024), 16, 0, 0); }
        const LAS float* sc = (const LAS float*)(cur + GR_SC);
        bf16x8 Sb[4];
#pragma unroll
        for (int s = 0; s < 4; ++s) Sb[s] = __builtin_bit_cast(bf16x8, (u32x4){pk2(S[2 * s][0], S[2 * s][1]), pk2(S[2 * s][2], S[2 * s][3]), pk2(S[2 * s + 1][0], S[2 * s + 1][1]), pk2(S[2 * s + 1][2], S[2 * s + 1][3])});
#define FRAG(off, f) (*(const LAS bf16x8*)(cur + (off) + (f) * 1024 + lane * 16))
        f32x4 P[4];
#pragma unroll
        for (int tp = 0; tp < 2; ++tp) {
            bf16x8 fw[8];
#pragma unroll
            for (int x = 0; x < 8; ++x) fw[x] = FRAG(GR_WI, tp * 8 + x);
            f32x4 a0 = (f32x4){-bflo(up[2 * tp].x), -bfhi(up[2 * tp].x), -bflo(up[2 * tp].y), -bfhi(up[2 * tp].y)};
            f32x4 a1 = (f32x4){-bflo(up[2 * tp + 1].x), -bfhi(up[2 * tp + 1].x), -bflo(up[2 * tp + 1].y), -bfhi(up[2 * tp + 1].y)};
#pragma unroll
            for (int s = 0; s < 4; ++s) { a0 = __builtin_amdgcn_mfma_f32_16x16x32_bf16(fw[s], Sb[s], a0, 0, 0, 0); a1 = __builtin_amdgcn_mfma_f32_16x16x32_bf16(fw[4 + s], Sb[s], a1, 0, 0, 0); }
            P[2 * tp] = a0; P[2 * tp + 1] = a1;
        }
        f32x4 o[4];
#pragma unroll
        for (int tp = 0; tp < 2; ++tp) {
            bf16x8 fq[8];
#pragma unroll
            for (int x = 0; x < 8; ++x) fq[x] = FRAG(GR_QG, tp * 8 + x);
            f32x4 a0 = (f32x4){0.f, 0.f, 0.f, 0.f}, a1 = a0;
#pragma unroll
            for (int s = 0; s < 4; ++s) { a0 = __builtin_amdgcn_mfma_f32_16x16x32_bf16(fq[s], Sb[s], a0, 0, 0, 0); a1 = __builtin_amdgcn_mfma_f32_16x16x32_bf16(fq[4 + s], Sb[s], a1, 0, 0, 0); }
            o[2 * tp] = a0 * *(const LAS f32x4*)(sc + 16 * (2 * tp) + 4 * q); o[2 * tp + 1] = a1 * *(const LAS f32x4*)(sc + 16 * (2 * tp + 1) + 4 * q);
        }
        bf16x8 Pb[2], Pbs[2];
#pragma unroll
        for (int sp = 0; sp < 2; ++sp) {
            const f32x4 k0 = *(const LAS f32x4*)(sc + 64 + 16 * (2 * sp) + 4 * q), k1 = *(const LAS f32x4*)(sc + 64 + 16 * (2 * sp + 1) + 4 * q);
            const f32x4 a = P[2 * sp], bq = P[2 * sp + 1], as = a * k0, bs = bq * k1;
            Pb[sp] = __builtin_bit_cast(bf16x8, (u32x4){pk2(a[0], a[1]), pk2(a[2], a[3]), pk2(bq[0], bq[1]), pk2(bq[2], bq[3])});
            Pbs[sp] = __builtin_bit_cast(bf16x8, (u32x4){pk2(as[0], as[1]), pk2(as[2], as[3]), pk2(bs[0], bs[1]), pk2(bs[2], bs[3])});
        }
        {
            bf16x8 fk[6];
            fk[0] = FRAG(GR_QK, 0); fk[1] = FRAG(GR_QK, 2); fk[2] = FRAG(GR_QK, 4); fk[3] = FRAG(GR_QK, 5); fk[4] = FRAG(GR_QK, 6); fk[5] = FRAG(GR_QK, 7);
            o[0] = __builtin_amdgcn_mfma_f32_16x16x32_bf16(fk[0], Pb[0], o[0], 0, 0, 0); o[1] = __builtin_amdgcn_mfma_f32_16x16x32_bf16(fk[1], Pb[0], o[1], 0, 0, 0);
            o[2] = __builtin_amdgcn_mfma_f32_16x16x32_bf16(fk[2], Pb[0], o[2], 0, 0, 0); o[3] = __builtin_amdgcn_mfma_f32_16x16x32_bf16(fk[4], Pb[0], o[3], 0, 0, 0);
            o[2] = __builtin_amdgcn_mfma_f32_16x16x32_bf16(fk[3], Pb[1], o[2], 0, 0, 0); o[3] = __builtin_amdgcn_mfma_f32_16x16x32_bf16(fk[5], Pb[1], o[3], 0, 0, 0);
        }
        const float gL = sc[128];
#pragma unroll
        for (int dp = 0; dp < 2; ++dp) {
            bf16x8 fk[8];
#pragma unroll
            for (int x = 0; x < 8; ++x) fk[x] = FRAG(GR_KT, dp * 8 + x);
#pragma unroll
            for (int x = 0; x < 4; ++x) { const int db = dp * 4 + x; f32x4 acc = S[db] * gL;
                acc = __builtin_amdgcn_mfma_f32_16x16x32_bf16(fk[2 * x], Pbs[0], acc, 0, 0, 0);
                acc = __builtin_amdgcn_mfma_f32_16x16x32_bf16(fk[2 * x + 1], Pbs[1], acc, 0, 0, 0);
                S[db] = acc; }
        }
#undef FRAG
#pragma unroll
        for (int tb = 0; tb < 4; ++tb) {
            f32x4 ss = o[tb] * o[tb];
#pragma unroll
            for (int x = 1; x < 16; x <<= 1) { ss.x += __shfl_xor(ss.x, x); ss.y += __shfl_xor(ss.y, x); ss.z += __shfl_xor(ss.z, x); ss.w += __shfl_xor(ss.w, x); }
            if (cl == 0) *(LAS f32x4*)(s_part + w * 64 + 16 * tb + 4 * q) = ss;
        }
        __syncthreads();
        unsigned yv[16];
#pragma unroll
        for (int tb = 0; tb < 4; ++tb) {
            f32x4 tot = (f32x4){0.f, 0.f, 0.f, 0.f};
#pragma unroll
            for (int ww = 0; ww < 8; ++ww) tot += *(const LAS f32x4*)(s_part + ww * 64 + 16 * tb + 4 * q);
#pragma unroll
            for (int i = 0; i < 4; ++i) yv[tb * 4 + i] = f2bf(o[tb][i] * __frsqrt_rn(tot[i] * (1.0f / HD) + EPS) * gn * siluf_(bflo(zb[tb * 4 + i])));
        }
        asm volatile("s_waitcnt vmcnt(0)" ::: "memory"); __syncthreads();
#pragma unroll
        for (int x = 0; x < 16; ++x) F.MIX[(size_t)(row0 + 16 * (x >> 2) + 4 * q + (x & 3)) * D + 1024 + hd * HD + 16 * w + cl] = (bf16_t)yv[x];
    }
    float* oS = F.out + O_PS + (size_t)bh * HD * HD;
#pragma unroll
    for (int db = 0; db < 8; ++db)
#pragma unroll
        for (int i = 0; i < 4; ++i) oS[(size_t)(16 * db + 4 * q + i) * HD + 16 * w + cl] = S[db][i];
    __syncthreads();
}


__device__ __forceinline__ void sample_mlstm(Frame& F, int b, int hd) {
    LAS float* sQ = (LAS float*)(F.lds); LAS float* sK = sQ + 1024; LAS float* sV = sK + 1024; LAS float* sOA = sV + 1024; LAS float* sKW = sOA + 1024;
    LAS float* sPart = sKW + 1024;
    LAS float* sN0 = sPart + 4096;
    LAS float* sQK = sN0 + 128;
    LAS float* sQN = sQK + 64;
    LAS float* sW = sQN + 8;
    LAS float* sSc = sW + 64;
    LAS float* sNorm = sSc + 32;
    const int tid = F.tid, e = tid & 127, q4 = tid >> 7, lane = F.lane, w = F.wave;
    const int row0 = M_P + b * T_S, bh = b * NH + hd;
    float C[32];
#pragma unroll
    for (int dd = 0; dd < 32; ++dd) C[dd] = F.stC[((size_t)bh * HD + 32 * q4 + dd) * HD + e];
    {
        const int t = tid >> 6, arr = (tid >> 4) & 3, c8 = (tid & 15) * 8;
        const u32x4 uv = *(const u32x4*)(F.PROJ + (size_t)(row0 + t) * NPROJ + arr * 1024 + hd * HD + c8);
        const float sc = (arr == 1) ? QK_SCALE : 1.0f;
        LAS float* dst = sQ + arr * 1024 + t * 128 + c8;
        *(LAS f32x4*)dst = (f32x4){bflo(uv.x) * sc, bfhi(uv.x) * sc, bflo(uv.y) * sc, bfhi(uv.y) * sc};
        *(LAS f32x4*)(dst + 4) = (f32x4){bflo(uv.z) * sc, bfhi(uv.z) * sc, bflo(uv.w) * sc, bfhi(uv.w) * sc};
    }
    float n0 = 0.f;
    if (tid < 128) { n0 = F.stN[(size_t)bh * HD + tid]; sN0[tid] = n0; }
    if (w == 0) {
        const int t = lane & 7; const float* gp = F.GATES + (size_t)(row0 + t) * NGATE;
        const float m0 = F.stM[bh];
        const float lfv = logsigmoidf_(gp[8 + hd] + F.gate_b[NH + hd]), liv = gp[hd] + F.gate_b[hd];
        float bb = lfv;
#pragma unroll
        for (int o = 1; o < 8; o <<= 1) { const float x = __shfl_up(bb, o); if (t >= o) bb += x; }
        const float a = liv - bb; float cm = a;
#pragma unroll
        for (int o = 1; o < 8; o <<= 1) { const float x = __shfl_up(cm, o); if (t >= o) cm = fmaxf(cm, x); }
        const float Mi = fmaxf(m0, cm), mi = bb + Mi; const float M7 = __shfl(Mi, 7), m7 = __shfl(mi, 7);
        if (lane < 8) { sSc[t] = expf(m0 - Mi); sSc[8 + t] = expf(-mi); sSc[16 + t] = expf(a - M7); if (t == 0) { sSc[24] = expf(m0 - M7); sSc[25] = m7; } }
#pragma unroll
        for (int s = 0; s < 8; ++s) { const float as = __shfl(a, s); if (lane < 8) sW[t * 8 + s] = (s <= t) ? expf(as - Mi) : 0.f; }
    }
    __syncthreads();
    {
        const float q0 = sQ[w * 128 + lane], q1 = sQ[w * 128 + 64 + lane];
#pragma unroll
        for (int s = 0; s < 8; ++s) { if (s <= w) { const float d = wave_sum(q0 * sK[s * 128 + lane] + q1 * sK[s * 128 + 64 + lane]); if (lane == 0) sQK[w * 8 + s] = d * sW[w * 8 + s]; } else if (lane == 0) sQK[w * 8 + s] = 0.f; }
        const float dn = wave_sum(q0 * sN0[lane] + q1 * sN0[64 + lane]); if (lane == 0) sQN[w] = dn;
    }
    {
#pragma unroll
        for (int x = 0; x < 2; ++x) { const int idx = tid + 512 * x; sKW[idx] = sK[idx] * sSc[16 + (idx >> 7)]; }
    }
    {
        float part[8];
#pragma unroll
        for (int t = 0; t < 8; ++t) part[t] = 0.f;
#pragma unroll
        for (int d4 = 0; d4 < 8; ++d4)
#pragma unroll
            for (int t = 0; t < 8; ++t) { const f32x4 qv = *(const LAS f32x4*)(sQ + t * 128 + 32 * q4 + 4 * d4);
                part[t] += (qv.x * C[4 * d4] + qv.y * C[4 * d4 + 1]) + (qv.z * C[4 * d4 + 2] + qv.w * C[4 * d4 + 3]); }
#pragma unroll
        for (int t = 0; t < 8; ++t) sPart[(q4 * 8 + t) * 128 + e] = part[t];
    }
    __syncthreads();
    float hv[2];
#pragma unroll
    for (int tt = 0; tt < 2; ++tt) {
        const int t = 2 * q4 + tt;
        float numer = ((sPart[(0 * 8 + t) * 128 + e] + sPart[(1 * 8 + t) * 128 + e]) + (sPart[(2 * 8 + t) * 128 + e] + sPart[(3 * 8 + t) * 128 + e])) * sSc[t];
        float dd = sSc[t] * sQN[t];
#pragma unroll
        for (int s = 0; s < 8; ++s) { const float wq = sQK[t * 8 + s]; numer += wq * sV[s * 128 + e]; dd += wq; }
        hv[tt] = numer / fmaxf(fabsf(dd), sSc[8 + t]);
        const float ss = wave_sum(hv[tt] * hv[tt]);
        if (lane == 0) sNorm[w * 2 + tt] = ss;
    }
    {
        const float dC = sSc[24];
        float vv[8];
#pragma unroll
        for (int s = 0; s < 8; ++s) vv[s] = sV[s * 128 + e];
#pragma unroll
        for (int d4 = 0; d4 < 8; ++d4) {
            f32x4 acc = (f32x4){C[4 * d4], C[4 * d4 + 1], C[4 * d4 + 2], C[4 * d4 + 3]} * dC;
#pragma unroll
            for (int s = 0; s < 8; ++s) acc += *(const LAS f32x4*)(sKW + s * 128 + 32 * q4 + 4 * d4) * vv[s];
            C[4 * d4] = acc.x; C[4 * d4 + 1] = acc.y; C[4 * d4 + 2] = acc.z; C[4 * d4 + 3] = acc.w;
        }
        float* oC = F.out + O_SC + (size_t)bh * HD * HD;
#pragma unroll
        for (int dd = 0; dd < 32; ++dd) oC[(size_t)(32 * q4 + dd) * HD + e] = C[dd];
        if (tid < 128) { float nn = dC * n0;
#pragma unroll
            for (int s = 0; s < 8; ++s) nn += sKW[s * 128 + tid];
            F.out[O_SN + (size_t)bh * HD + tid] = nn; }
        if (tid == 0) F.out[O_SM + bh] = sSc[25];
    }
    __syncthreads();
    const float gn = F.mlstm_g[hd * HD + e];
#pragma unroll
    for (int tt = 0; tt < 2; ++tt) {
        const int t = 2 * q4 + tt; const float tot = sNorm[(w & ~1) * 2 + tt] + sNorm[(w | 1) * 2 + tt];
        const float y = hv[tt] * (1.0f / sqrtf(tot * (1.0f / HD) + EPS)) * gn * sigmoidf_(sOA[t * 128 + e]);
        F.MIX[(size_t)(row0 + t) * D + hd * HD + e] = (bf16_t)f2bf(y);
    }
    __syncthreads();
}
__device__ __forceinline__ void sample_gdn(Frame& F, int b, int hd) {
    LAS float* sQ = (LAS float*)(F.lds); LAS float* sK = sQ + 1024; LAS float* sV = sK + 1024; LAS float* sZ = sV + 1024; LAS float* sKs = sZ + 1024; LAS float* sU = sKs + 1024;
    LAS float* sPartK = sU + 1024;
    LAS float* sPartQ = sPartK + 4096;
    LAS float* sKK = sPartQ + 4096;
    LAS float* sQKr = sKK + 64;
    LAS float* sA = sQKr + 64;
    LAS float* sQKd = sA + 64;
    LAS float* sSc = sQKd + 64;
    LAS float* sNorm = sSc + 64;
    const int tid = F.tid, e = tid & 127, q4 = tid >> 7, lane = F.lane, w = F.wave;
    const int row0 = M_P + b * T_S, bh = b * NH + hd;
    float S[32];
#pragma unroll
    for (int dd = 0; dd < 32; ++dd) S[dd] = F.stS[((size_t)bh * HD + 32 * q4 + dd) * HD + e];
    if (tid < 384) {
        const int arr = tid >> 7, ch = arr * 1024 + hd * HD + e;
        const float* cv = F.stConv + (size_t)b * 3 * CCONV + ch; float h0 = cv[0], h1 = cv[CCONV], h2 = cv[2 * CCONV];
        const float w0 = F.conv_w[ch], w1 = F.conv_w[CCONV + ch], w2 = F.conv_w[2 * CCONV + ch], w3 = F.conv_w[3 * CCONV + ch];
        float u[8];
#pragma unroll
        for (int t = 0; t < 8; ++t) u[t] = bf2f(F.PROJ[(size_t)(row0 + t) * NPROJ + 4096 + ch]);
        LAS float* dst = sQ + arr * 1024 + e;
#pragma unroll
        for (int t = 0; t < 8; ++t) { const float cvv = ((w0 * h0 + w1 * h1) + w2 * h2) + w3 * u[t]; h0 = h1; h1 = h2; h2 = u[t]; dst[t * 128] = siluf_(cvv); }
        float* oc = F.out + O_SCONV + (size_t)b * 3 * CCONV + ch; oc[0] = h0; oc[CCONV] = h1; oc[2 * CCONV] = h2;
    } else {
#pragma unroll
        for (int t = 0; t < 8; ++t) sZ[t * 128 + e] = bf2f(F.PROJ[(size_t)(row0 + t) * NPROJ + 7168 + hd * HD + e]);
    }
    if (w == 0) {
        const int t = lane & 7; const float* gp = F.GATES + (size_t)(row0 + t) * NGATE;
        float G = -expf(F.A_log[hd]) * softplusf_(gp[16 + hd] + F.dt_bias[hd]);
#pragma unroll
        for (int o = 1; o < 8; o <<= 1) { const float x = __shfl_up(G, o); if (t >= o) G += x; }
        if (lane < 8) { sSc[t] = G; sSc[8 + t] = sigmoidf_(gp[24 + hd]); sSc[16 + t] = expf(G); }
    }
    __syncthreads();
    {
        const float q0 = sQ[w * 128 + lane], q1 = sQ[w * 128 + 64 + lane], k0 = sK[w * 128 + lane], k1 = sK[w * 128 + 64 + lane];
        const float sq = wave_sum(q0 * q0 + q1 * q1), sk = wave_sum(k0 * k0 + k1 * k1);
        if (lane == 0) { sSc[24 + w] = 1.0f / sqrtf(sq + EPS); sSc[32 + w] = 1.0f / sqrtf(sk + EPS); }
#pragma unroll
        for (int s = 0; s < 8; ++s) { if (s <= w) { const float ks0 = sK[s * 128 + lane], ks1 = sK[s * 128 + 64 + lane];
                const float dk = wave_sum(k0 * ks0 + k1 * ks1), dq = wave_sum(q0 * ks0 + q1 * ks1); if (lane == 0) { sKK[w * 8 + s] = dk; sQKr[w * 8 + s] = dq; } } }
    }
    {
        float pk[8], pq[8];
#pragma unroll
        for (int t = 0; t < 8; ++t) { pk[t] = 0.f; pq[t] = 0.f; }
#pragma unroll
        for (int d4 = 0; d4 < 8; ++d4)
#pragma unroll
            for (int t = 0; t < 8; ++t) { const f32x4 kv = *(const LAS f32x4*)(sK + t * 128 + 32 * q4 + 4 * d4), qv = *(const LAS f32x4*)(sQ + t * 128 + 32 * q4 + 4 * d4);
                pk[t] += (kv.x * S[4 * d4] + kv.y * S[4 * d4 + 1]) + (kv.z * S[4 * d4 + 2] + kv.w * S[4 * d4 + 3]);
                pq[t] += (qv.x * S[4 * d4] + qv.y * S[4 * d4 + 1]) + (qv.z * S[4 * d4 + 2] + qv.w * S[4 * d4 + 3]); }
#pragma unroll
        for (int t = 0; t < 8; ++t) { sPartK[(q4 * 8 + t) * 128 + e] = pk[t]; sPartQ[(q4 * 8 + t) * 128 + e] = pq[t]; }
    }
    __syncthreads();
    if (w == 0) {
        const int t = lane >> 3, s = lane & 7; const float dec = expf(sSc[t] - sSc[s]);
        sA[lane] = (s < t) ? sSc[8 + t] * dec * sSc[32 + t] * sSc[32 + s] * sKK[lane] : 0.f;
        sQKd[lane] = (s <= t) ? sSc[24 + t] * QK_SCALE * sSc[32 + s] * dec * sQKr[lane] : 0.f;
    }
    {
        const float G7 = sSc[7];
#pragma unroll
        for (int x = 0; x < 2; ++x) { const int idx = tid + 512 * x, s = idx >> 7; sKs[idx] = sK[idx] * (expf(G7 - sSc[s]) * sSc[32 + s]); }
    }
    __syncthreads();
    float ov[8];
    if (tid < 128) {
        float u[8];
#pragma unroll
        for (int t = 0; t < 8; ++t) {
            const float kS = ((sPartK[(0 * 8 + t) * 128 + e] + sPartK[(1 * 8 + t) * 128 + e]) + (sPartK[(2 * 8 + t) * 128 + e] + sPartK[(3 * 8 + t) * 128 + e])) * sSc[32 + t];
            float ut = sSc[8 + t] * (sV[t * 128 + e] - sSc[16 + t] * kS);
#pragma unroll
            for (int s = 0; s < 8; ++s) if (s < t) ut -= sA[t * 8 + s] * u[s];
            u[t] = ut; sU[t * 128 + e] = ut;
            float o = ((sPartQ[(0 * 8 + t) * 128 + e] + sPartQ[(1 * 8 + t) * 128 + e]) + (sPartQ[(2 * 8 + t) * 128 + e] + sPartQ[(3 * 8 + t) * 128 + e])) * (sSc[16 + t] * sSc[24 + t] * QK_SCALE);
#pragma unroll
            for (int s = 0; s < 8; ++s) if (s <= t) o += sQKd[t * 8 + s] * u[s];
            ov[t] = o;
            const float ss = wave_sum(o * o);
            if (lane == 0) sNorm[w * 8 + t] = ss;
        }
    }
    __syncthreads();
    {
        const float gL = sSc[23];
        float uu[8];
#pragma unroll
        for (int s = 0; s < 8; ++s) uu[s] = sU[s * 128 + e];
#pragma unroll
        for (int d4 = 0; d4 < 8; ++d4) {
            f32x4 acc = (f32x4){S[4 * d4], S[4 * d4 + 1], S[4 * d4 + 2], S[4 * d4 + 3]} * gL;
#pragma unroll
            for (int s = 0; s < 8; ++s) acc += *(const LAS f32x4*)(sKs + s * 128 + 32 * q4 + 4 * d4) * uu[s];
            S[4 * d4] = acc.x; S[4 * d4 + 1] = acc.y; S[4 * d4 + 2] = acc.z; S[4 * d4 + 3] = acc.w;
        }
        float* oS = F.out + O_SS + (size_t)bh * HD * HD;
#pragma unroll
        for (int dd = 0; dd < 32; ++dd) oS[(size_t)(32 * q4 + dd) * HD + e] = S[dd];
    }
    if (tid < 128) {
        const float gn = F.gdn_g[hd * HD + e];
#pragma unroll
        for (int t = 0; t < 8; ++t) { const float tot = sNorm[t] + sNorm[8 + t];
            const float y = ov[t] * (1.0f / sqrtf(tot * (1.0f / HD) + EPS)) * gn * siluf_(sZ[t * 128 + e]);
            F.MIX[(size_t)(row0 + t) * D + 1024 + hd * HD + e] = (bf16_t)f2bf(y); }
    }
    __syncthreads();
}

__device__ __forceinline__ void p4_scan_s1(Frame& F) {
    LAS float* scr = (LAS float*)(F.lds + F.wave * 19456);
    if (F.wave >= 4) { const int u = 4 * (int)blockIdx.x + (F.wave - 4); if (u < 1024) s1_mlstm_unit(F, u, scr); }
    else { const int u = 4 * (int)blockIdx.x + F.wave; if (u < 1024) s1_gdn_unit(F, u, scr); }
}
__device__ __forceinline__ void p4_scan_s2(Frame& F) {
    const int w = blockIdx.x;
    if (w < 32) s2_mlstm_chain(F, w);
    else if (w < 64) s2_gdn_chain(F, w - 32);
    else { for (int idx = w - 64; idx < 2048; idx += (int)gridDim.x - 64) { const int mixer = idx >> 10, b = (idx & 1023) >> 3, hd = idx & 7;
            if (mixer == 0) sample_mlstm(F, b, hd); else sample_gdn(F, b, hd); } }
}

#ifndef PROBE_REPEAT
#define PROBE_REPEAT -1
#endif
__device__ __forceinline__ void ph1(Frame& F) { p1_modgemv(F); p1_transposes(F); }
__device__ __forceinline__ void ph2(Frame& F) {
    for (int r = F.gw; r < M; r += F.ngw) { const float* md = F.MOD + (size_t)row_gb(r) * MODW; norm_mod_row_bf16(xrow(F, r), F.norm1, md, md + D, F.HB + (size_t)r * D, F.lane); }
}
__device__ __forceinline__ void ph3(Frame& F) {
    p3_gates(F);
    asm volatile("s_waitcnt vmcnt(0) lgkmcnt(0)" ::: "memory"); __syncthreads();
    pg8::Gemm g{F.HB, F.WIN, M, NPROJ, D}; pg8::StaticOrder S; S.init(M, NPROJ, D, gridDim.x, (int)blockIdx.x);
    pg8::EpiBf16<0> E{F.PROJ, NPROJ};
    pg8::gemm_phase<pg8::EpiBf16<0>, pg8::StaticOrder, true, true>(F.lds + RING_OFF, g, S, E);
}
__device__ __forceinline__ void ph6(Frame& F) {
    pg8::Gemm g{F.MIX, F.WOUT, M, D, D}; pg8::SplitOrder S; S.init(D, (int)blockIdx.x);
    pg8::EpiRes E{F.xp, F.xs, M_P, F.MOD + 2 * D, MODW, F.X1, D, (float*)F.IMGM};
    pg8::gemm_phase<pg8::EpiRes, pg8::SplitOrder, true, true>(F.lds + RING_OFF, g, S, E);
}
__device__ __forceinline__ void combine_slab_row(const Frame& F, int r, const float* base, const float* gate, float* dst) {
    const float* part = (const float*)F.IMGM; const int rp = r - M_P, pmx = rp >> 8, rr = rp & 255;
#pragma unroll
    for (int j = 0; j < 8; ++j) {
        f32x4 s = (f32x4){0.f, 0.f, 0.f, 0.f};
#pragma unroll
        for (int ks = 0; ks < 8; ++ks) s += *(const f32x4*)(part + ((size_t)(ks * 32 + pmx * 8 + j) * 256 + rr) * 256 + 4 * F.lane);
        const f32x4 bs = ((const f32x4*)base)[F.lane + 64 * j], g = ((const f32x4*)gate)[F.lane + 64 * j];
        ((f32x4*)dst)[F.lane + 64 * j] = bs + g * s;
    }
    asm volatile("s_waitcnt vmcnt(0)" ::: "memory");
}
__device__ __forceinline__ void ph7(Frame& F) {
    for (int r = F.gw; r < M; r += F.ngw) {
        if (r >= M_P) combine_slab_row(F, r, xrow(F, r), F.MOD + (size_t)row_gb(r) * MODW + 2 * D, F.X1 + (size_t)r * D); const float* md = F.MOD + (size_t)row_gb(r) * MODW; norm_mod_row_bf16(F.X1 + (size_t)r * D, F.norm2, md + 3 * D, md + 4 * D, F.HB + (size_t)r * D, F.lane); }
}
__device__ __forceinline__ void ph8(Frame& F) {
    pg8::Gemm g{F.HB, F.WUP, M, DFF, D}; pg8::StaticOrder S; S.init(M, DFF, D, gridDim.x, (int)blockIdx.x);
    pg8::EpiBf16<1> E{F.PROJ, DFF};
    pg8::gemm_phase<pg8::EpiBf16<1>, pg8::StaticOrder, true, true>(F.lds + RING_OFF, g, S, E);
}
__device__ __forceinline__ void ph9(Frame& F) {
    pg8::Gemm g{F.PROJ, F.WDOWN, M, D, DFF}; pg8::SplitOrder S; S.init(DFF, (int)blockIdx.x);
    pg8::EpiRes E{F.X1, F.X1, M, F.MOD + 5 * D, MODW, F.out + O_Y, D, (float*)F.IMGM};
    pg8::gemm_phase<pg8::EpiRes, pg8::SplitOrder, true, true>(F.lds + RING_OFF, g, S, E);
}
__device__ __forceinline__ void ph10(Frame& F) {
    for (int r = F.gw; r < M; r += F.ngw) { const float* md = F.MODF + (size_t)row_gb(r) * MODFW; float* yr = F.out + O_Y + (size_t)r * D;
        if (r >= M_P) combine_slab_row(F, r, F.X1 + (size_t)r * D, F.MOD + (size_t)row_gb(r) * MODW + 5 * D, yr);
        norm_mod_row_f32(yr, F.normf, md, md + D, yr, F.lane); }
}

struct Args { const float* in[26]; float* out; unsigned char* ws; int ph_lo, ph_hi; };
constexpr int NPHASE = 11;
__global__ void __launch_bounds__(NTHREADS, 2) fwd_kernel(Args args) {
    extern __shared__ __attribute__((aligned(16))) unsigned char lds[];
    Frame F;
    F.lds = (LAS unsigned char*)lds;
    F.tid = threadIdx.x; F.lane = F.tid & 63; F.wave = __builtin_amdgcn_readfirstlane(F.tid >> 6);
    F.gw = blockIdx.x * NWAVES + F.wave; F.ngw = gridDim.x * NWAVES;
    F.xp = args.in[0]; F.xs = args.in[1]; F.stC = args.in[2]; F.stN = args.in[3]; F.stM = args.in[4]; F.stS = args.in[5]; F.stConv = args.in[6]; F.cp = args.in[7]; F.cs = args.in[8];
    F.ada_w = args.in[9]; F.ada_b = args.in[10]; F.norm1 = args.in[11]; F.w_in = args.in[12]; F.gate_b = args.in[13]; F.mlstm_g = args.in[14]; F.conv_w = args.in[15]; F.A_log = args.in[16];
    F.dt_bias = args.in[17]; F.gdn_g = args.in[18]; F.w_out = args.in[19]; F.norm2 = args.in[20]; F.w_up = args.in[21]; F.w_down = args.in[22]; F.adaf_w = args.in[23]; F.adaf_b = args.in[24]; F.normf = args.in[25];
    F.out = args.out;
    unsigned char* ws = args.ws;
    F.SCB = (bf16_t*)(ws + WS_SCB); F.WIN = (bf16_t*)(ws + WS_WIN); F.WOUT = (bf16_t*)(ws + WS_WOUT); F.WUP = (bf16_t*)(ws + WS_WUP); F.WDOWN = (bf16_t*)(ws + WS_WDOWN);
    F.HB = (bf16_t*)(ws + WS_HB); F.MIX = (bf16_t*)(ws + WS_MIX); F.PROJ = (bf16_t*)(ws + WS_PROJ);
    F.IMGM = ws + WS_IMGM; F.IMGG = ws + WS_IMGG; F.MOD = (float*)(ws + WS_MOD); F.MODF = (float*)(ws + WS_MODF); F.GATES = (float*)(ws + WS_GATES); F.X1 = (float*)(ws + WS_X1);

    for (int u = F.tid; u < (LDS_BYTES - LDSCTL_OFF) / 4; u += NTHREADS) ((LAS unsigned*)(F.lds + LDSCTL_OFF))[u] = 0u;
    __syncthreads();
    XcdBarrier bar; bar.bar = (unsigned*)(ws + WS_CTL) + CW_BAR; bar.x = 0; bar.st = nullptr;
#if MK_ONE_LAUNCH
    bar = xcd_barrier_post((unsigned*)(ws + WS_CTL) + CW_BAR, (volatile LAS unsigned*)(F.lds + MISC_OFF) + 8);
#define GRID_BAR() xcd_barrier(bar)
#else
#define GRID_BAR() do { } while (0)
#endif
    const int lo = args.ph_lo, hi = args.ph_hi;
#define IN(k) (lo <= (k) && (k) < hi)
#define BOTH(k) (IN(k) && IN((k) + 1))

#define RUN(k, body) if (IN(k)) { body; if (PROBE_REPEAT == (k)) { GRID_BAR(); body; } if (BOTH(k)) GRID_BAR(); }
    RUN(0, p0_silu(F))
    RUN(1, ph1(F))
    RUN(2, ph2(F))
    RUN(3, ph3(F))
    RUN(4, p4_scan_s1(F))
    RUN(5, p4_scan_s2(F))
    RUN(6, ph6(F))
    RUN(7, ph7(F))
    RUN(8, ph8(F))
    RUN(9, ph9(F))
    RUN(10, ph10(F))
#undef RUN
#undef IN
#undef BOTH
}

extern "C" void kernel_launch(void* const* d_in, const int* in_sizes, int n_in, void* d_out, int out_size, void* d_ws, size_t ws_size, hipStream_t stream) {
    static int ok = 0;
    if (ok == 0) {
        if (n_in != 26 || (size_t)out_size != O_END || ws_size < WS_END) { fprintf(stderr, "kernel_launch: unexpected shapes: n_in %d out %d ws %zu\n", n_in, out_size, ws_size); ok = -1; return; }
        if (hipFuncSetAttribute((const void*)fwd_kernel, hipFuncAttributeMaxDynamicSharedMemorySize, LDS_BYTES) != hipSuccess) { fprintf(stderr, "kernel_launch: hipFuncSetAttribute failed\n"); ok = -1; return; }
        int dev = 0, cus = 0, per_cu = 0;
        (void)hipGetDevice(&dev); (void)hipDeviceGetAttribute(&cus, hipDeviceAttributeMultiprocessorCount, dev);
        (void)hipOccupancyMaxActiveBlocksPerMultiprocessor(&per_cu, (const void*)fwd_kernel, NTHREADS, LDS_BYTES);
        if (cus != GRID || per_cu < 1) fprintf(stderr, "kernel_launch: note: %d CUs, %d blocks/CU reported; launching %d workgroups\n", cus, per_cu, GRID);
        (void)hipGetLastError();
        ok = 1;
    }
    if (ok < 0) return;
    (void)hipMemsetAsync((char*)d_ws + WS_CTL, 0, CTL_ZERO_BYTES, stream);
    Args a{};
    for (int i = 0; i < 26; ++i) a.in[i] = (const float*)d_in[i];
    a.out = (float*)d_out; a.ws = (unsigned char*)d_ws;
#if MK_ONE_LAUNCH
    a.ph_lo = 0; a.ph_hi = NPHASE;
    hipLaunchKernelGGL(fwd_kernel, dim3(GRID), dim3(NTHREADS), LDS_BYTES, stream, a);
#else
    for (int p = 0; p < NPHASE; ++p) { a.ph_lo = p; a.ph_hi = p + 1; hipLaunchKernelGGL(fwd_kernel, dim3(GRID), dim3(NTHREADS), LDS_BYTES, stream, a); }
#endif
}
```

```cpp
#include <hip/hip_runtime.h>
#include <cstdio>
#include <cstdint>

#define LAS __attribute__((address_space(3)))
#define GAS __attribute__((address_space(1)))
typedef unsigned short bf16_t;
typedef short bf16x8 __attribute__((ext_vector_type(8)));
typedef float f32x4 __attribute__((ext_vector_type(4)));
typedef float f32x2 __attribute__((ext_vector_type(2)));
typedef float f32x16 __attribute__((ext_vector_type(16)));
typedef unsigned u32x4 __attribute__((ext_vector_type(4)));
typedef unsigned u32x2 __attribute__((ext_vector_type(2)));

#ifndef MK_ONE_LAUNCH
#define MK_ONE_LAUNCH 1
#endif

constexpr int D = 2048, T_P = 2048, NB_P = 4, NB_S = 128, T_S = 8;
constexpr int M_P = NB_P * T_P, M_S = NB_S * T_S, M = M_P + M_S;
constexpr int NH = 8, HD = 128;
constexpr int P_IN = 8224, NPROJ = 8192, NGATE = 32, DFF = 8192, CCONV = 3072;
constexpr int NGB = NB_P + NB_S;
constexpr int MODW = 6 * D, MODFW = 2 * D;
constexpr float EPS = 1e-6f;
constexpr int NWAVES = 8, NTHREADS = 512, GRID = 256;

constexpr size_t O_Y = 0;
constexpr size_t O_PC = (size_t)M * D;
constexpr size_t O_PN = O_PC + (size_t)NB_P * NH * HD * HD;
constexpr size_t O_PM = O_PN + (size_t)NB_P * NH * HD;
constexpr size_t O_PS = O_PM + (size_t)NB_P * NH;
constexpr size_t O_PCONV = O_PS + (size_t)NB_P * NH * HD * HD;
constexpr size_t O_SC = O_PCONV + (size_t)NB_P * 3 * CCONV;
constexpr size_t O_SN = O_SC + (size_t)NB_S * NH * HD * HD;
constexpr size_t O_SM = O_SN + (size_t)NB_S * NH * HD;
constexpr size_t O_SS = O_SM + (size_t)NB_S * NH;
constexpr size_t O_SCONV = O_SS + (size_t)NB_S * NH * HD * HD;
constexpr size_t O_END = O_SCONV + (size_t)NB_S * 3 * CCONV;
static_assert(O_END == 54830112, "d_out size");

constexpr size_t MiB = 1u << 20;
constexpr size_t WS_CTL = 0, CTL_ZERO_BYTES = 64 * 1024;
constexpr size_t WS_SCB = 1 * MiB;
constexpr size_t WS_MOD = 2 * MiB;
constexpr size_t WS_MODF = 9 * MiB;
constexpr size_t WS_GATES = 12 * MiB;
constexpr size_t WS_WIN = 16 * MiB;
constexpr size_t WS_WOUT = 49 * MiB;
constexpr size_t WS_WUP = 57 * MiB;
constexpr size_t WS_WDOWN = 89 * MiB;
constexpr size_t WS_HB = 121 * MiB;
constexpr size_t WS_MIX = 157 * MiB;
constexpr size_t WS_X1 = 193 * MiB;
constexpr size_t WS_PROJ = 265 * MiB;
constexpr size_t WS_IMGM = 409 * MiB;
constexpr size_t WS_IMGG = 467 * MiB;
constexpr size_t WS_END = 540 * MiB;
constexpr int MREC = 59392, MR_QI = 0, MR_SP = 16384, MR_KW = 24576, MR_VT = 40960, MR_SC = 57344, MR_DN = 58368;
static_assert(WS_WIN + (size_t)P_IN * D * 2 <= WS_WOUT && WS_PROJ + (size_t)M * NPROJ * 2 <= WS_IMGM && WS_IMGM + (size_t)1024 * MREC <= WS_IMGG && WS_IMGG + (size_t)1024 * 74752 <= WS_END, "ws map");
constexpr int GREC = 74752, GR_QG = 0, GR_WI = 16384, GR_KT = 32768, GR_QK = 49152, GR_SC = 57344, GR_UP = 58368, GDMA_BYTES = 58368;

constexpr int CW_BAR = 1024;

__device__ __forceinline__ unsigned f2bf(float f) { unsigned u = __builtin_bit_cast(unsigned, f); return (u + 0x7fffu + ((u >> 16) & 1u)) >> 16; }
typedef __bf16 bf16x2_t __attribute__((ext_vector_type(2)));
__device__ __forceinline__ unsigned pk2(float lo, float hi) { const f32x2 v = {lo, hi}; return __builtin_bit_cast(unsigned, __builtin_convertvector(v, bf16x2_t)); }
__device__ __forceinline__ float bf2f(bf16_t b) { return __builtin_bit_cast(float, (unsigned)b << 16); }
__device__ __forceinline__ float bflo(unsigned w) { return __builtin_bit_cast(float, w << 16); }
__device__ __forceinline__ float bfhi(unsigned w) { return __builtin_bit_cast(float, w & 0xffff0000u); }
__device__ __forceinline__ float wave_sum(float v) {
#pragma unroll
    for (int o = 1; o < 64; o <<= 1) v += __shfl_xor(v, o);
    return v;
}
__device__ __forceinline__ float sigmoidf_(float x) { return 1.0f / (1.0f + __expf(-x)); }
__device__ __forceinline__ float siluf_(float x) { return x / (1.0f + __expf(-x)); }
__device__ __forceinline__ float softplusf_(float x) { return fmaxf(x, 0.f) + log1pf(__expf(-fabsf(x))); }
__device__ __forceinline__ float logsigmoidf_(float x) { return fminf(x, 0.f) - log1pf(__expf(-fabsf(x))); }
__device__ __forceinline__ int row_gb(int r) { return r < M_P ? (r >> 11) : NB_P + ((r - M_P) >> 3); }
namespace pg8 {
#define PG8_LAS __attribute__((address_space(3)))
constexpr int BM = 256, BK = 64, HALF = 128, HTB = HALF * BK * 2  , STAGE_BYTES = 8 * HTB, NXCD = 8, WGM = 8;

__host__ __device__ __forceinline__ int lds_byte(int r, int c) { const int st = (r >> 4) * 2 + (c >> 5), rr = r & 15, cc = c & 31, ob = rr * 64 + cc * 2; return st * 1024 + (ob ^ (((ob >> 9) & 1) << 5)); }
__host__ __device__ __forceinline__ void stage_rc(int b, int& R, int& C) { const int st = b / 1024, sb = b % 1024, swz = sb ^ (((sb >> 9) & 1) << 5); R = (st >> 1) * 16 + swz / 64; C = (st & 1) * 32 + (swz % 64) / 2; }
__host__ __device__ __forceinline__ int perm32(int rho) { const int n = rho >> 4, i = rho & 15; return 8 * (i >> 2) + 4 * n + (i & 3); }

struct Unit { int pm, pn, k0, nt, part, ks, xt; };
struct Gemm { const bf16_t* A; const bf16_t* Bt; int M, N, K; };

struct StaticOrder {
    int nM, nN, nwg, G, c, ntk;
    __host__ __device__ void init(int M, int N, int K, int G_, int c_) { nM = M / BM; nN = N / BM; nwg = nM * nN; G = G_; c = c_; ntk = K / BK; }
    __host__ __device__ bool next(int i, Unit& u) const {
        const long L = (long)i * G + c; if (L >= nwg) return false;
        int wgid = (int)L; { const int q = nwg / NXCD, r = nwg % NXCD, xcd = wgid % NXCD, off = wgid / NXCD; wgid = (xcd < r ? xcd * (q + 1) : r * (q + 1) + (xcd - r) * q) + off; }
        const int nig = WGM * nN, gid = wgid / nig, fm = gid * WGM, gsz = (nM - fm) < WGM ? (nM - fm) : WGM;
        u.pm = fm + ((wgid % nig) % gsz); u.pn = (wgid % nig) / gsz; u.k0 = 0; u.nt = ntk; u.part = 0; u.ks = 0; u.xt = 0; return true;
    }
    __device__ __forceinline__ void a_ready(const Unit&) const {}
    __device__ __forceinline__ void done(const Unit&) const {}
};
struct SplitOrder {
    int c, ntk;
    __host__ __device__ void init(int K, int c_) { c = c_; ntk = K / BK; }
    __host__ __device__ bool next(int i, Unit& u) const {
        if (i == 0) { const int wgid = (c % NXCD) * 32 + c / NXCD; u.pm = (wgid >> 6) * 8 + (wgid & 7); u.pn = (wgid & 63) >> 3; u.k0 = 0; u.nt = ntk; u.part = 0; u.ks = 0; u.xt = 0; return true; }
        if (i == 1) { const int xt = c >> 3, ks = c & 7; u.pm = 32 + (xt >> 3); u.pn = xt & 7; u.nt = ntk / 8; u.k0 = ks * (ntk / 8) * BK; u.part = 1; u.ks = ks; u.xt = xt; return true; }
        return false;
    }
    __device__ __forceinline__ void a_ready(const Unit&) const {}
    __device__ __forceinline__ void done(const Unit&) const {}
};


__device__ __forceinline__ unsigned cvt_pk_bf16(float lo, float hi) { unsigned r; asm volatile("v_cvt_pk_bf16_f32 %0, %1, %2" : "=v"(r) : "v"(lo), "v"(hi)); return r; }
template <int ACT  > struct EpiBf16 {
    static constexpr bool PERM = true, AFTER_DRAIN = false;
    bf16_t* O; int ldc;
    __device__ __forceinline__ void operator()(const f32x4 (&acc)[2][2][4][2], const Unit& u, int wr, int wc, int fr, int fq) const {
        const int row0 = u.pm * BM + wr * 64 + fr, col0 = u.pn * BM + wc * 32 + 8 * fq;
#pragma unroll
        for (int ai = 0; ai < 2; ++ai)
#pragma unroll
            for (int m = 0; m < 4; ++m) { bf16_t* rowp = O + (size_t)(row0 + ai * HALF + m * 16) * ldc + col0;
#pragma unroll
                for (int bj = 0; bj < 2; ++bj) { f32x4 v0 = acc[ai][bj][m][0], v1 = acc[ai][bj][m][1];
                    if (ACT == 1) {
#pragma unroll
                        for (int q = 0; q < 4; ++q) { const float a = fmaxf(v0[q], 0.f), b = fmaxf(v1[q], 0.f); v0[q] = a * a; v1[q] = b * b; } }
                    u32x4 w; w.x = cvt_pk_bf16(v0[0], v0[1]); w.y = cvt_pk_bf16(v0[2], v0[3]); w.z = cvt_pk_bf16(v1[0], v1[1]); w.w = cvt_pk_bf16(v1[2], v1[3]);
                    *(u32x4*)(rowp + bj * HALF) = w; } }
    }
};
struct EpiRes {
    static constexpr bool PERM = false, AFTER_DRAIN = false;
    const float* base0; const float* base1; int split; const float* gate; int ldg; float* out; int ldc; float* part;
    __device__ __forceinline__ void operator()(const f32x4 (&acc)[2][2][4][2], const Unit& u, int wr, int wc, int fr, int fq) const {
        if (u.part) {
            float* pb = part + ((size_t)(u.ks * 32 + u.xt) * 256 + wr * 64 + fr) * 256 + wc * 32 + 4 * fq;
#pragma unroll
            for (int ai = 0; ai < 2; ++ai)
#pragma unroll
                for (int m = 0; m < 4; ++m)
#pragma unroll
                    for (int bj = 0; bj < 2; ++bj)
#pragma unroll
                        for (int n = 0; n < 2; ++n) *(f32x4*)(pb + (size_t)(ai * HALF + m * 16) * 256 + bj * HALF + n * 16) = acc[ai][bj][m][n];
            return;
        }
        const int row0 = u.pm * BM + wr * 64 + fr, col0 = u.pn * BM + wc * 32 + 4 * fq;
#pragma unroll
        for (int ai = 0; ai < 2; ++ai)
#pragma unroll
            for (int m = 0; m < 4; ++m) { const int r = row0 + ai * HALF + m * 16;
                const float* bp = (r < split ? base0 + (size_t)r * ldc : base1 + (size_t)(r - split) * ldc) + col0;
                const float* gp = gate + (size_t)row_gb(r) * ldg + col0; float* op = out + (size_t)r * ldc + col0;
#pragma unroll
                for (int bj = 0; bj < 2; ++bj)
#pragma unroll
                    for (int n = 0; n < 2; ++n) { const f32x4 bs = *(const f32x4*)(bp + bj * HALF + n * 16), g = *(const f32x4*)(gp + bj * HALF + n * 16);
                        *(f32x4*)(op + bj * HALF + n * 16) = bs + g * acc[ai][bj][m][n]; }
                if (m & 1) asm volatile("" ::: "memory"); }
    }
};
template <class Epi, class Sched, bool ALIGN_EPI = false, bool SP2 = false>
__device__ __forceinline__ void gemm_phase(PG8_LAS unsigned char* lds, const Gemm g, const Sched& S, const Epi& E) {
    const int tid = threadIdx.x, wid = __builtin_amdgcn_readfirstlane(tid >> 6), lane = tid & 63, wr = wid >> 2, wc = wid & 3, fr = lane & 15, fq = lane >> 4;
    const int K = g.K;
    unsigned voffA[2], voffB[2];
#pragma unroll
    for (int i = 0; i < 2; ++i) { int R, C; stage_rc(tid * 16 + i * 8192, R, C); const int Rb = Epi::PERM ? ((R & ~31) + perm32(R & 31)) : R;
        voffA[i] = (unsigned)(R * K + C) * 2u; voffB[i] = (unsigned)(Rb * K + C) * 2u; }
    const size_t kstep = (size_t)(BK * 2);
    const size_t hstep = (size_t)HALF * K * 2;
    const size_t tstep = 2 * hstep;
    const unsigned ldsw = (unsigned)wid * 1024u;
    const int aoff = lds_byte(wr * 64 + fr, fq * 8), boff = lds_byte(wc * 32 + fr, fq * 8);
#define PG8_SA(b, h) (((b) * 2 + (h)) * HTB)
#define PG8_SB(b, h) ((4 + (b) * 2 + (h)) * HTB)
#define PG8_STAGE(bufoff, gbase, voff) do { _Pragma("unroll") for (int _i = 0; _i < 2; ++_i) \
        __builtin_amdgcn_global_load_lds((const unsigned*)((const char*)(gbase) + (voff)[_i]), (PG8_LAS unsigned*)(lds + (bufoff) + ldsw + _i * 8192), 16, 0, 0); } while (0)
#define PG8_LDA(dst, b, h) do { _Pragma("unroll") for (int m = 0; m < 4; ++m) _Pragma("unroll") for (int k = 0; k < 2; ++k) dst[m][k] = *(const PG8_LAS bf16x8*)(lds + PG8_SA(b, h) + aoff + m * 2048 + k * 1024); } while (0)
#define PG8_LDB(dst, b, h) do { _Pragma("unroll") for (int n = 0; n < 2; ++n) _Pragma("unroll") for (int k = 0; k < 2; ++k) dst[n][k] = *(const PG8_LAS bf16x8*)(lds + PG8_SB(b, h) + boff + n * 2048 + k * 1024); } while (0)
#define PG8_MMA(ai, bj, At, Bt) do { __builtin_amdgcn_s_setprio(1); _Pragma("unroll") for (int m = 0; m < 4; ++m) _Pragma("unroll") for (int n = 0; n < 2; ++n) _Pragma("unroll") for (int k = 0; k < 2; ++k) \
        acc[ai][bj][m][n] = __builtin_amdgcn_mfma_f32_16x16x32_bf16(Bt[n][k], At[m][k], acc[ai][bj][m][n], 0, 0, 0); __builtin_amdgcn_s_setprio(0); } while (0)
#define PG8_WAIT_V(n) asm volatile("s_waitcnt vmcnt(" #n ")" ::: "memory")
#define PG8_WAIT_L(n) asm volatile("s_waitcnt lgkmcnt(" #n ")" ::: "memory")
#define PG8_BAR __builtin_amdgcn_s_barrier()
#define PG8_SCHED __builtin_amdgcn_sched_barrier(0)
    Unit cur, nxt; int ui = 0;
    if (!S.next(0, cur)) return;
    f32x4 acc[2][2][4][2];
#pragma unroll
    for (int a = 0; a < 2; ++a)
#pragma unroll
        for (int b = 0; b < 2; ++b)
#pragma unroll
            for (int m = 0; m < 4; ++m)
#pragma unroll
                for (int n = 0; n < 2; ++n) acc[a][b][m][n] = (f32x4){0.f, 0.f, 0.f, 0.f};
    bf16x8 At[4][2], B0[2][2], B1[2][2];
    const char* cA = (const char*)g.A + (size_t)cur.pm * tstep + (size_t)cur.k0 * 2; const char* cB = (const char*)g.Bt + (size_t)cur.pn * tstep + (size_t)cur.k0 * 2;
    S.a_ready(cur);
    if constexpr (SP2) {
        PG8_STAGE(PG8_SB(0, 0), cB, voffB); PG8_STAGE(PG8_SB(0, 1), cB + hstep, voffB); PG8_STAGE(PG8_SA(0, 0), cA, voffA); PG8_STAGE(PG8_SA(0, 1), cA + hstep, voffA);
        if (wr == 1) PG8_BAR;
        PG8_WAIT_V(2); PG8_BAR;
        PG8_STAGE(PG8_SB(1, 0), cB + kstep, voffB); PG8_STAGE(PG8_SA(1, 0), cA + kstep, voffA); PG8_STAGE(PG8_SB(1, 1), cB + hstep + kstep, voffB);
        PG8_WAIT_V(6); PG8_BAR;
    } else {
        PG8_STAGE(PG8_SB(0, 0), cB, voffB); PG8_STAGE(PG8_SA(0, 0), cA, voffA); PG8_STAGE(PG8_SB(0, 1), cB + hstep, voffB); PG8_STAGE(PG8_SA(0, 1), cA + hstep, voffA);
        if (wr == 1) PG8_BAR;
        PG8_WAIT_V(4); PG8_BAR;
        PG8_STAGE(PG8_SB(1, 0), cB + kstep, voffB); PG8_STAGE(PG8_SA(1, 0), cA + kstep, voffA); PG8_STAGE(PG8_SB(1, 1), cB + hstep + kstep, voffB);
        PG8_WAIT_V(6); PG8_BAR;
    }
    for (;;) {
        const bool has_next = S.next(ui + 1, nxt);
        const char* nA = has_next ? (const char*)g.A + (size_t)nxt.pm * tstep + (size_t)nxt.k0 * 2 : cA; const char* nB = has_next ? (const char*)g.Bt + (size_t)nxt.pn * tstep + (size_t)nxt.k0 * 2 : cB;
        const int nt = cur.nt;
        for (int t = 0; t < nt; t += 2) {
            const bool last = (t == nt - 2);
            const char* a1 = cA + (size_t)(t + 1) * kstep;
            const char* a2 = last ? nA : cA + (size_t)(t + 2) * kstep; const char* b2 = last ? nB : cB + (size_t)(t + 2) * kstep;
            const char* a3 = a2 + kstep; const char* b3 = b2 + kstep;
            if (last && has_next) S.a_ready(nxt);
            if constexpr (SP2) {
            PG8_LDB(B0, 0, 0); PG8_LDB(B1, 0, 1); PG8_SCHED; PG8_LDA(At, 0, 0); PG8_STAGE(PG8_SA(1, 1), a1 + hstep, voffA);
            PG8_WAIT_V(8); PG8_WAIT_L(0); PG8_BAR; PG8_MMA(0, 0, At, B0); PG8_MMA(0, 1, At, B1); PG8_BAR; PG8_SCHED;
            PG8_LDA(At, 0, 1); PG8_STAGE(PG8_SB(0, 0), b2, voffB); PG8_STAGE(PG8_SB(0, 1), b2 + hstep, voffB); PG8_STAGE(PG8_SA(0, 0), a2, voffA);
            PG8_WAIT_V(8); PG8_WAIT_L(0); PG8_BAR; PG8_MMA(1, 0, At, B0); PG8_MMA(1, 1, At, B1); PG8_BAR; PG8_SCHED;
            PG8_LDB(B0, 1, 0); PG8_LDB(B1, 1, 1); PG8_SCHED; PG8_LDA(At, 1, 0); PG8_STAGE(PG8_SA(0, 1), a2 + hstep, voffA);
            PG8_WAIT_V(8); PG8_WAIT_L(0); PG8_BAR; PG8_MMA(0, 0, At, B0); PG8_MMA(0, 1, At, B1); PG8_BAR; PG8_SCHED;
            PG8_LDA(At, 1, 1); PG8_STAGE(PG8_SB(1, 0), b3, voffB); PG8_STAGE(PG8_SB(1, 1), b3 + hstep, voffB); PG8_STAGE(PG8_SA(1, 0), a3, voffA);
            PG8_WAIT_V(8); PG8_WAIT_L(0); PG8_BAR; PG8_MMA(1, 0, At, B0); PG8_MMA(1, 1, At, B1); PG8_BAR; PG8_SCHED;
            } else {
            PG8_LDB(B0, 0, 0); PG8_SCHED; PG8_LDA(At, 0, 0); PG8_STAGE(PG8_SA(1, 1), a1 + hstep, voffA);
            PG8_WAIT_L(8); PG8_BAR; PG8_WAIT_L(0); PG8_MMA(0, 0, At, B0); PG8_BAR; PG8_SCHED;
            PG8_LDB(B1, 0, 1); PG8_STAGE(PG8_SB(0, 0), b2, voffB);
            PG8_BAR; PG8_WAIT_L(0); PG8_MMA(0, 1, At, B1); PG8_BAR;
            PG8_LDA(At, 0, 1); PG8_STAGE(PG8_SA(0, 0), a2, voffA);
            PG8_BAR; PG8_WAIT_L(0); PG8_MMA(1, 0, At, B0); PG8_BAR; PG8_SCHED;
            PG8_STAGE(PG8_SB(0, 1), b2 + hstep, voffB);
            PG8_WAIT_V(6); PG8_BAR; PG8_MMA(1, 1, At, B1); PG8_BAR;
            PG8_LDB(B0, 1, 0); PG8_SCHED; PG8_LDA(At, 1, 0); PG8_STAGE(PG8_SA(0, 1), a2 + hstep, voffA);
            PG8_WAIT_L(8); PG8_BAR; PG8_WAIT_L(0); PG8_MMA(0, 0, At, B0); PG8_BAR; PG8_SCHED;
            PG8_LDB(B1, 1, 1); PG8_STAGE(PG8_SB(1, 0), b3, voffB);
            PG8_BAR; PG8_WAIT_L(0); PG8_MMA(0, 1, At, B1); PG8_BAR;
            PG8_LDA(At, 1, 1); PG8_STAGE(PG8_SA(1, 0), a3, voffA);
            PG8_BAR; PG8_WAIT_L(0); PG8_MMA(1, 0, At, B0); PG8_BAR; PG8_SCHED;
            PG8_STAGE(PG8_SB(1, 1), b3 + hstep, voffB);
            PG8_WAIT_V(6); PG8_BAR; PG8_MMA(1, 1, At, B1); PG8_BAR;
            }
        }
        if constexpr (ALIGN_EPI) { if (wr == 0) PG8_BAR; }
        if constexpr (!Epi::AFTER_DRAIN) { E(acc, cur, wr, wc, fr, fq); S.done(cur); }
        if (!has_next) break;
#pragma unroll
        for (int a = 0; a < 2; ++a)
#pragma unroll
            for (int b = 0; b < 2; ++b)
#pragma unroll
                for (int m = 0; m < 4; ++m)
#pragma unroll
                    for (int n = 0; n < 2; ++n) acc[a][b][m][n] = (f32x4){0.f, 0.f, 0.f, 0.f};
        cur = nxt; cA = nA; cB = nB; ++ui;
        if constexpr (ALIGN_EPI) { if (wr == 1) PG8_BAR; }
    }
    PG8_WAIT_V(0);
    if constexpr (!ALIGN_EPI) { if (wr == 0) PG8_BAR; }
    PG8_BAR;
    if constexpr (Epi::AFTER_DRAIN) { E.fused(acc, cur, wr, wc, fr, fq, lds, wid, lane); S.done(cur); }
#undef PG8_SA
#undef PG8_SB
#undef PG8_STAGE
#undef PG8_LDA
#undef PG8_LDB
#undef PG8_MMA
#undef PG8_WAIT_V
#undef PG8_WAIT_L
#undef PG8_BAR
#undef PG8_SCHED
}
}

constexpr int RING_OFF = 0, RING_BYTES = 131072;
constexpr int LDS_BYTES = 163840;
constexpr int LDSCTL_OFF = LDS_BYTES - 512, MISC_OFF = LDSCTL_OFF + 320;
static_assert(8 * 19456 <= LDSCTL_OFF, "S1 per-wave scratch");

typedef GAS unsigned gu32;
#define RLX_AGENT __ATOMIC_RELAXED, __HIP_MEMORY_SCOPE_AGENT
#define LDS_WAIT() asm volatile("s_waitcnt lgkmcnt(0)" ::: "memory")
#define VM_WAIT() asm volatile("s_waitcnt vmcnt(0)" ::: "memory")

#define XB_TMO      128
#define XB_XCNT(j)  (256  + 64 * (j))
#define XB_XSUB(j)  (1280 + 64 * (j))
#define XB_XGEN(j)  (2304 + 64 * (j))
#define XB_TOP      3328
#define XB_TOPGEN   3392
#define XCD_BAR_WORDS 3456
#define XB_SPIN_CAP (1u << 18)
__device__ __forceinline__ unsigned xb_ld(unsigned* p)              { return __hip_atomic_load(p, __ATOMIC_RELAXED, __HIP_MEMORY_SCOPE_AGENT); }
__device__ __forceinline__ unsigned xb_add(unsigned* p, unsigned v) { return __hip_atomic_fetch_add(p, v, __ATOMIC_RELAXED, __HIP_MEMORY_SCOPE_AGENT); }
__device__ __forceinline__ unsigned xb_xcc_id() { return (unsigned)__builtin_amdgcn_s_getreg((3 << 11) | 20) & 0xFu; }
#define XB_SPIN(cond, bar) do { unsigned _sp = 0; while (cond) { __builtin_amdgcn_s_sleep(1); \
    if ((++_sp & 255u) == 0u) { if (xb_ld(&(bar)[XB_TMO])) break; if (_sp > XB_SPIN_CAP) { atomicAdd(&(bar)[XB_TMO], 1u); break; } } } } while (0)
struct XcdBarrier { unsigned* bar; unsigned x; volatile LAS unsigned* st; };
__device__ __forceinline__ XcdBarrier xcd_barrier_post(unsigned* bar, volatile LAS unsigned* st) {
    XcdBarrier b; b.bar = bar; b.x = xb_xcc_id(); b.st = st;
    if (threadIdx.x == 0) (void)xb_add(&bar[XB_XCNT(b.x)], 1u);
    return b;
}
__device__ __forceinline__ void xcd_barrier_complete(unsigned* bar, unsigned x, unsigned& nloc, unsigned& nx) {
    const unsigned G = gridDim.x * gridDim.y * gridDim.z;
    unsigned sum, cnt, mine, sp = 0u;
    for (;;) {
        sum = 0u; cnt = 0u; mine = 0u;
#pragma unroll
        for (unsigned j = 0; j < 16; ++j) { const unsigned c = xb_ld(&bar[XB_XCNT(j)]); sum += c; cnt += (c > 0u) ? 1u : 0u; mine = (j == x) ? c : mine; }
        if (sum == G) break;
        __builtin_amdgcn_s_sleep(1);
        if ((++sp & 255u) == 0u) { if (xb_ld(&bar[XB_TMO])) break; if (sp > XB_SPIN_CAP) { atomicAdd(&bar[XB_TMO], 1u); break; } }
    }
    nloc = mine > 0u ? mine : 1u; nx = cnt > 0u ? cnt : 1u;
}
__device__ __forceinline__ void xcd_barrier(const XcdBarrier& b) {
    asm volatile("s_waitcnt vmcnt(0)" ::: "memory");
    __syncthreads();
    if (threadIdx.x == 0) {
        unsigned* bar = b.bar;
        __builtin_amdgcn_s_waitcnt(0);
        unsigned nloc = b.st[0], nx = b.st[1];
        if (nloc == 0u) { xcd_barrier_complete(bar, b.x, nloc, nx); b.st[0] = nloc; b.st[1] = nx; }
        const unsigned old = xb_add(&bar[XB_XSUB(b.x)], 1u);
        const unsigned gen = old / nloc;
        if (old + 1u == (gen + 1u) * nloc) {
            __builtin_amdgcn_fence(__ATOMIC_RELEASE, "agent");
            asm volatile("s_waitcnt vmcnt(0)" ::: "memory");
            const unsigned og = xb_add(&bar[XB_TOP], 1u);
            const unsigned tg = og / nx;
            if (og + 1u == (tg + 1u) * nx) xb_add(&bar[XB_TOPGEN], 1u);
            else XB_SPIN(xb_ld(&bar[XB_TOPGEN]) == tg, bar);
            __builtin_amdgcn_fence(__ATOMIC_ACQUIRE, "agent");
            xb_add(&bar[XB_XGEN(b.x)], 1u);
            asm volatile("s_waitcnt vmcnt(0)" ::: "memory");
        } else {
            XB_SPIN(xb_ld(&bar[XB_XGEN(b.x)]) == gen, bar);
            __builtin_amdgcn_fence(__ATOMIC_ACQUIRE, "agent");
            asm volatile("s_waitcnt vmcnt(0)" ::: "memory");
        }
    }
    __syncthreads();
}

struct Frame {
    LAS unsigned char* lds;
    int tid, lane, wave, gw, ngw;
    const float *xp, *xs, *stC, *stN, *stM, *stS, *stConv, *cp, *cs, *ada_w, *ada_b, *norm1, *w_in, *gate_b, *mlstm_g, *conv_w, *A_log, *dt_bias, *gdn_g,
                *w_out, *norm2, *w_up, *w_down, *adaf_w, *adaf_b, *normf;
    float* out;
    bf16_t *SCB, *WIN, *WOUT, *WUP, *WDOWN, *HB, *MIX, *PROJ;
    float *MOD, *MODF, *GATES, *X1;
    unsigned char* IMGM; unsigned char* IMGG;
};
__device__ __forceinline__ const float* xrow(const Frame& F, int r) { return r < M_P ? F.xp + (size_t)r * D : F.xs + (size_t)(r - M_P) * D; }

__device__ __forceinline__ void p0_silu(Frame& F) {
    const int gt = blockIdx.x * NTHREADS + F.tid, GT = gridDim.x * NTHREADS;
    for (int g = gt; g < 160 * 256; g += GT) {
        const int row = g >> 8, c8 = (g & 255) * 8; u32x4 o = (u32x4){0u, 0u, 0u, 0u};
        if (row < NGB) { const float* src = (row < NB_P ? F.cp + (size_t)row * D : F.cs + (size_t)(row - NB_P) * D) + c8;
            const f32x4 a = *(const f32x4*)src, b = *(const f32x4*)(src + 4);
            o.x = pk2(siluf_(a.x), siluf_(a.y)); o.y = pk2(siluf_(a.z), siluf_(a.w)); o.z = pk2(siluf_(b.x), siluf_(b.y)); o.w = pk2(siluf_(b.z), siluf_(b.w)); }
        *(u32x4*)(F.SCB + (size_t)row * D + c8) = o;
    }
}

__device__ __forceinline__ void p1_modgemv(Frame& F) {
    LAS float* red = (LAS float*)(F.lds + RING_OFF);
    const int lane = F.lane, r = lane & 31, hh = lane >> 5, cbi = F.wave >> 2, ks = F.wave & 3;
    for (int pair = blockIdx.x; pair < 256; pair += gridDim.x) {
        const int cb = 2 * pair + cbi;
        const float* W; const float* bias; float* outp; int ldw, n0;
        if (cb < 384) { W = F.ada_w; ldw = MODW; n0 = cb * 32; bias = F.ada_b; outp = F.MOD; }
        else { W = F.adaf_w; ldw = MODFW; n0 = (cb - 384) * 32; bias = F.adaf_b; outp = F.MODF; }
        f32x16 acc[5];
#pragma unroll
        for (int g = 0; g < 5; ++g)
#pragma unroll
            for (int i = 0; i < 16; ++i) acc[g][i] = 0.f;
        const float* wp = W + (size_t)(ks * 512 + 8 * hh) * ldw + n0 + r;
        const bf16_t* ap = F.SCB + (size_t)r * D + ks * 512 + 8 * hh;
        for (int s = 0; s < 32; s += 4) {
            float wv[4][8];
#pragma unroll
            for (int u = 0; u < 4; ++u)
#pragma unroll
                for (int j = 0; j < 8; ++j) wv[u][j] = wp[(size_t)((s + u) * 16 + j) * ldw];
#pragma unroll
            for (int u = 0; u < 4; ++u) {
                u32x4 bw; bw.x = pk2(wv[u][0], wv[u][1]); bw.y = pk2(wv[u][2], wv[u][3]); bw.z = pk2(wv[u][4], wv[u][5]); bw.w = pk2(wv[u][6], wv[u][7]);
                const bf16x8 b = __builtin_bit_cast(bf16x8, bw);
#pragma unroll
                for (int g = 0; g < 5; ++g) { const bf16x8 a = *(const bf16x8*)(ap + (size_t)g * 32 * D + (s + u) * 16);
                    acc[g] = __builtin_amdgcn_mfma_f32_32x32x16_bf16(a, b, acc[g], 0, 0, 0); }
            }
        }
        if (ks > 0) {
#pragma unroll
            for (int g = 0; g < 5; ++g)
#pragma unroll
                for (int i = 0; i < 16; ++i) red[(((ks - 1) * 2 + cbi) * 80 + g * 16 + i) * 64 + lane] = acc[g][i];
        }
        __syncthreads();
        if (ks == 0) {
            const float bv = bias[n0 + r];
#pragma unroll
            for (int g = 0; g < 5; ++g)
#pragma unroll
                for (int i = 0; i < 16; ++i) {
                    float v = acc[g][i];
#pragma unroll
                    for (int k2 = 0; k2 < 3; ++k2) v += red[((k2 * 2 + cbi) * 80 + g * 16 + i) * 64 + lane];
                    const int gb = 32 * g + (i & 3) + 8 * (i >> 2) + 4 * hh;
                    if (gb < NGB) outp[(size_t)gb * ldw + n0 + r] = v + bv;
                }
        }
        __syncthreads();
    }
}

__device__ __forceinline__ int win_dst_row(int n) {
    if (n < 3072) return n;
    if (n < 3088) return 8192 + (n - 3072);
    if (n < 7184) return n - 16;
    if (n < 7200) return 8208 + (n - 7184);
    return n - 32;
}
struct TrItem { const float* W; bf16_t* WT; int K, N, k0, n0, mapwin; };
__device__ __forceinline__ TrItem tr_decode(const Frame& F, int it) {
    constexpr int I_IN = (D / 64) * (P_IN / 32), I_OUT = (D / 64) * (D / 32), I_UP = (D / 64) * (DFF / 32);
    TrItem t; int r = it;
    if (r < I_IN) { t.W = F.w_in; t.WT = F.WIN; t.K = D; t.N = P_IN; t.mapwin = 1; }
    else if ((r -= I_IN) < I_OUT) { t.W = F.w_out; t.WT = F.WOUT; t.K = D; t.N = D; t.mapwin = 0; }
    else if ((r -= I_OUT) < I_UP) { t.W = F.w_up; t.WT = F.WUP; t.K = D; t.N = DFF; t.mapwin = 0; }
    else { r -= I_UP; t.W = F.w_down; t.WT = F.WDOWN; t.K = DFF; t.N = D; t.mapwin = 0; }
    const int nblk = t.N / 32; t.k0 = 64 * (r / nblk); t.n0 = 32 * (r % nblk);
    return t;
}
__device__ __forceinline__ void p1_transposes(Frame& F) {
    LAS float* scr = (LAS float*)(F.lds + RING_OFF + F.wave * 16384);
    constexpr int NITEMS = (D / 64) * (P_IN / 32) + (D / 64) * (D / 32) + (D / 64) * (DFF / 32) + (DFF / 64) * (D / 32);
    const int lane = F.lane;
    int it = F.gw;
    if (it >= NITEMS) return;
    TrItem cur = tr_decode(F, it);
    float v[32];
#pragma unroll
    for (int i = 0; i < 32; ++i) v[i] = cur.W[(size_t)(cur.k0 + 2 * i + (lane >> 5)) * cur.N + cur.n0 + (lane & 31)];
    for (;;) {
#pragma unroll
        for (int i = 0; i < 32; ++i) scr[(2 * i + (lane >> 5)) * 33 + (lane & 31)] = v[i];
        const int nit = it + F.ngw; const bool more = nit < NITEMS;
        TrItem nx = cur;
        if (more) { nx = tr_decode(F, nit);
#pragma unroll
            for (int i = 0; i < 32; ++i) v[i] = nx.W[(size_t)(nx.k0 + 2 * i + (lane >> 5)) * nx.N + nx.n0 + (lane & 31)]; }
        LDS_WAIT(); asm volatile("" ::: "memory");
        const int c = lane & 7;
#pragma unroll
        for (int j = 0; j < 4; ++j) { const int n = (lane >> 3) + 8 * j; const LAS float* s = scr + (8 * c) * 33 + n;
            u32x4 o; o.x = pk2(s[0 * 33], s[1 * 33]); o.y = pk2(s[2 * 33], s[3 * 33]); o.z = pk2(s[4 * 33], s[5 * 33]); o.w = pk2(s[6 * 33], s[7 * 33]);
            const int dr = cur.mapwin ? win_dst_row(cur.n0 + n) : (cur.n0 + n);
            *(u32x4*)(cur.WT + (size_t)dr * cur.K + cur.k0 + 8 * c) = o; }
        LDS_WAIT(); asm volatile("" ::: "memory");
        if (!more) break;
        cur = nx; it = nit;
    }
}

__device__ __forceinline__ void norm_mod_row_bf16(const float* xr_, const float* g, const float* shift, const float* scale, bf16_t* orow, int lane) {
    const f32x4* xr = (const f32x4*)xr_ + lane;
    f32x4 v[8]; float s = 0.f;
#pragma unroll
    for (int j = 0; j < 8; ++j) { v[j] = xr[64 * j]; s += (v[j].x * v[j].x + v[j].y * v[j].y) + (v[j].z * v[j].z + v[j].w * v[j].w); }
    const float rstd = 1.0f / sqrtf(wave_sum(s) * (1.0f / D) + EPS);
    u32x2* o8 = (u32x2*)orow + lane;
#pragma unroll
    for (int j = 0; j < 8; ++j) { const f32x4 gg = ((const f32x4*)g)[lane + 64 * j], sh = ((const f32x4*)shift)[lane + 64 * j], sc = ((const f32x4*)scale)[lane + 64 * j];
        const f32x4 y = (v[j] * rstd * gg) * (sc + 1.0f) + sh; u32x2 w; w.x = pk2(y.x, y.y); w.y = pk2(y.z, y.w); o8[64 * j] = w; }
}
__device__ __forceinline__ void norm_mod_row_f32(const float* xr_, const float* g, const float* shift, const float* scale, float* orow, int lane) {
    const f32x4* xr = (const f32x4*)xr_ + lane;
    f32x4 v[8]; float s = 0.f;
#pragma unroll
    for (int j = 0; j < 8; ++j) { v[j] = xr[64 * j]; s += (v[j].x * v[j].x + v[j].y * v[j].y) + (v[j].z * v[j].z + v[j].w * v[j].w); }
    const float rstd = 1.0f / sqrtf(wave_sum(s) * (1.0f / D) + EPS);
    f32x4* o = (f32x4*)orow + lane;
#pragma unroll
    for (int j = 0; j < 8; ++j) { const f32x4 gg = ((const f32x4*)g)[lane + 64 * j], sh = ((const f32x4*)shift)[lane + 64 * j], sc = ((const f32x4*)scale)[lane + 64 * j];
        o[64 * j] = (v[j] * rstd * gg) * (sc + 1.0f) + sh; }
}

__device__ __forceinline__ void p3_gates(Frame& F) {
    const int lane = F.lane, fr = lane & 15, fq = lane >> 4;
    for (int task = F.gw; task < M / 16; task += F.ngw) {
        const int r0 = task * 16;
        const bf16_t* ap = F.HB + (size_t)(r0 + fr) * D + 8 * fq;
        const bf16_t* bp = F.WIN + (size_t)(NPROJ + fr) * D + 8 * fq;
        f32x4 c0 = (f32x4){0.f, 0.f, 0.f, 0.f}, c1 = c0;
#pragma unroll 8
        for (int k0 = 0; k0 < D; k0 += 32) {
            const bf16x8 a = *(const bf16x8*)(ap + k0), b0 = *(const bf16x8*)(bp + k0), b1 = *(const bf16x8*)(bp + (size_t)16 * D + k0);
            c0 = __builtin_amdgcn_mfma_f32_16x16x32_bf16(a, b0, c0, 0, 0, 0);
            c1 = __builtin_amdgcn_mfma_f32_16x16x32_bf16(a, b1, c1, 0, 0, 0);
        }
#pragma unroll
        for (int i = 0; i < 4; ++i) { float* o = F.GATES + (size_t)(r0 + 4 * fq + i) * NGATE + fr; o[0] = c0[i]; o[16] = c1[i]; }
    }
}

__device__ __forceinline__ void scan_mlstm_simple(Frame& F, bool prompt, int b, int hd) {
    LAS float* sq = (LAS float*)(F.lds + RING_OFF); LAS float* sk = sq + 128; LAS float* sv = sk + 128; LAS float* spart = sv + 128; LAS float* sred = spart + 512; LAS float* sred2 = sred + 8;
    const int tid = F.tid, e = tid & 127, q4 = tid >> 7, lane = F.lane, wave = F.wave;
    const int T = prompt ? T_P : T_S, row0 = prompt ? b * T_P : M_P + b * T_S, bh = b * NH + hd;
    float C[32]; float nst = 0.f, m = 0.f;
    if (prompt) {
#pragma unroll
        for (int dd = 0; dd < 32; ++dd) C[dd] = 0.f;
    } else {
#pragma unroll
        for (int dd = 0; dd < 32; ++dd) C[dd] = F.stC[((size_t)bh * HD + 32 * q4 + dd) * HD + e];
        if (tid < 128) nst = F.stN[(size_t)bh * HD + tid];
        m = F.stM[bh];
    }
    const float bi = F.gate_b[hd], bfg = F.gate_b[NH + hd], gn = F.mlstm_g[hd * HD + e];
    for (int t = 0; t < T; ++t) {
        const int row = row0 + t; const bf16_t* pr = F.PROJ + (size_t)row * NPROJ + hd * HD;
        float oa = 0.f;
        if (tid < 128) { sq[tid] = bf2f(pr[tid]); sk[tid] = bf2f(pr[1024 + tid]) * 0.08838834764831845f; sv[tid] = bf2f(pr[2048 + tid]); oa = bf2f(pr[3072 + tid]); }
        const float ia = F.GATES[(size_t)row * NGATE + hd], fa = F.GATES[(size_t)row * NGATE + 8 + hd];
        __syncthreads();
        const float li = ia + bi, lf = logsigmoidf_(fa + bfg);
        const float mn = fmaxf(lf + m, li), fdec = expf(lf + m - mn), iin = expf(li - mn); m = mn;
        const float ve = sv[e]; float part = 0.f;
#pragma unroll
        for (int dd = 0; dd < 32; ++dd) { const int d = 32 * q4 + dd; C[dd] = fdec * C[dd] + (iin * sk[d]) * ve; part += sq[d] * C[dd]; }
        spart[q4 * 128 + e] = part;
        if (tid < 128) { nst = fdec * nst + iin * sk[tid]; const float pn = wave_sum(sq[tid] * nst); if (lane == 0) sred[wave] = pn; }
        __syncthreads();
        const float numer = (spart[e] + spart[128 + e]) + (spart[256 + e] + spart[384 + e]);
        const float ddn = sred[0] + sred[1];
        const float hval = numer / fmaxf(fabsf(ddn), expf(-m));
        const float ss = wave_sum(hval * hval);
        if (lane == 0) sred2[wave] = ss;
        __syncthreads();
        const float tot = sred2[wave] + sred2[wave ^ 1];
        if (tid < 128) { const float y = hval * (1.0f / sqrtf(tot * (1.0f / HD) + EPS)) * gn * sigmoidf_(oa); F.MIX[(size_t)row * D + hd * HD + e] = (bf16_t)f2bf(y); }
    }
    float* oC = F.out + (prompt ? O_PC : O_SC) + (size_t)bh * HD * HD;
#pragma unroll
    for (int dd = 0; dd < 32; ++dd) oC[(size_t)(32 * q4 + dd) * HD + e] = C[dd];
    if (tid < 128) F.out[(prompt ? O_PN : O_SN) + (size_t)bh * HD + tid] = nst;
    if (tid == 0) F.out[(prompt ? O_PM : O_SM) + bh] = m;
    __syncthreads();
}
__device__ __forceinline__ void scan_gdn_simple(Frame& F, bool prompt, int b, int hd) {
    LAS float* sq = (LAS float*)(F.lds + RING_OFF); LAS float* sk = sq + 128; LAS float* sv = sk + 128; LAS float* spart = sv + 128; LAS float* spart2 = spart + 512; LAS float* sred = spart2 + 512; LAS float* sred2 = sred + 8;
    const int tid = F.tid, e = tid & 127, q4 = tid >> 7, lane = F.lane, wave = F.wave;
    const int T = prompt ? T_P : T_S, row0 = prompt ? b * T_P : M_P + b * T_S, bh = b * NH + hd;
    float S[32];
    if (prompt) {
#pragma unroll
        for (int dd = 0; dd < 32; ++dd) S[dd] = 0.f;
    } else {
#pragma unroll
        for (int dd = 0; dd < 32; ++dd) S[dd] = F.stS[((size_t)bh * HD + 32 * q4 + dd) * HD + e];
    }
    const int cch = (q4 < 3 ? q4 : 0) * 1024 + hd * HD + e;
    float h0 = 0.f, h1 = 0.f, h2 = 0.f;
    if (!prompt && q4 < 3) { const float* cv = F.stConv + (size_t)b * 3 * CCONV + cch; h0 = cv[0]; h1 = cv[CCONV]; h2 = cv[2 * CCONV]; }
    const float w0 = F.conv_w[cch], w1 = F.conv_w[CCONV + cch], w2 = F.conv_w[2 * CCONV + cch], w3 = F.conv_w[3 * CCONV + cch];
    const float negA = -expf(F.A_log[hd]), dtb = F.dt_bias[hd], gn = F.gdn_g[hd * HD + e];
    for (int t = 0; t < T; ++t) {
        const int row = row0 + t; const bf16_t* pr = F.PROJ + (size_t)row * NPROJ + 4096;
        float a = 0.f, zb = 0.f;
        if (q4 < 3) { const float u = bf2f(pr[cch]); const float cvv = w0 * h0 + w1 * h1 + w2 * h2 + w3 * u; h0 = h1; h1 = h2; h2 = u; a = siluf_(cvv); }
        if (q4 == 0) zb = bf2f(pr[3072 + hd * HD + e]);
        if (q4 < 2) { const float ss = wave_sum(a * a); if (lane == 0) sred[wave] = ss; }
        if (q4 == 2) sv[e] = a;
        const float ab = F.GATES[(size_t)row * NGATE + 16 + hd], bb = F.GATES[(size_t)row * NGATE + 24 + hd];
        __syncthreads();
        if (q4 == 0) sq[e] = a * (1.0f / sqrtf(sred[0] + sred[1] + EPS)) * 0.08838834764831845f;
        if (q4 == 1) sk[e] = a * (1.0f / sqrtf(sred[2] + sred[3] + EPS));
        __syncthreads();
        const float g = expf(negA * softplusf_(ab + dtb)), beta = sigmoidf_(bb);
        float part = 0.f;
#pragma unroll
        for (int dd = 0; dd < 32; ++dd) part += sk[32 * q4 + dd] * S[dd];
        spart[q4 * 128 + e] = part;
        __syncthreads();
        const float kS = (spart[e] + spart[128 + e]) + (spart[256 + e] + spart[384 + e]);
        const float ue = beta * (sv[e] - g * kS);
        float opart = 0.f;
#pragma unroll
        for (int dd = 0; dd < 32; ++dd) { const int d = 32 * q4 + dd; S[dd] = g * S[dd] + sk[d] * ue; opart += sq[d] * S[dd]; }
        spart2[q4 * 128 + e] = opart;
        __syncthreads();
        const float o = (spart2[e] + spart2[128 + e]) + (spart2[256 + e] + spart2[384 + e]);
        const float ss2 = wave_sum(o * o);
        if (lane == 0) sred2[wave] = ss2;
        __syncthreads();
        const float tot = sred2[wave] + sred2[wave ^ 1];
        if (q4 == 0) { const float y = o * (1.0f / sqrtf(tot * (1.0f / HD) + EPS)) * gn * siluf_(zb); F.MIX[(size_t)row * D + 1024 + hd * HD + e] = (bf16_t)f2bf(y); }
    }
    float* oS = F.out + (prompt ? O_PS : O_SS) + (size_t)bh * HD * HD;
#pragma unroll
    for (int dd = 0; dd < 32; ++dd) oS[(size_t)(32 * q4 + dd) * HD + e] = S[dd];
    if (q4 < 3) { float* oc = F.out + (prompt ? O_PCONV : O_SCONV) + (size_t)b * 3 * CCONV + cch; oc[0] = h0; oc[CCONV] = h1; oc[2 * CCONV] = h2; }
    __syncthreads();
}

__device__ __forceinline__ float wave_scan_add(float v, int lane) {
#pragma unroll
    for (int o = 1; o < 64; o <<= 1) { const float t = __shfl_up(v, o); if (lane >= o) v += t; }
    return v;
}
__device__ __forceinline__ float wave_scan_max(float v, int lane) {
#pragma unroll
    for (int o = 1; o < 64; o <<= 1) { const float t = __shfl_up(v, o); if (lane >= o) v = fmaxf(v, t); }
    return v;
}
__device__ __forceinline__ float wave_max(float v) {
#pragma unroll
    for (int o = 1; o < 64; o <<= 1) v = fmaxf(v, __shfl_xor(v, o));
    return v;
}
#define QK_SCALE 0.08838834764831845f
__device__ __forceinline__ void s1_mlstm_unit(Frame& F, int unit, LAS float* scr) {
    const int lane = F.lane, r = lane & 31, h = lane >> 5;
    const int c = unit & 31, bh = unit >> 5, hd = bh & 7, b = bh >> 3;
    const int rowb = b * T_P, row0 = rowb + 64 * c;
    unsigned char* rec = F.IMGM + (size_t)unit * MREC;
    const float bi = F.gate_b[hd], bfg = F.gate_b[NH + hd];
    LAS float* const scs = scr + 4096;
    float m_prev = 0.f;
    {
        float pb = 0.f, pa = 0.f;
        for (int c4 = 0; c4 < c; c4 += 4) {
            float lfv[4], liv[4];
#pragma unroll
            for (int x = 0; x < 4; ++x) { const int cc = (c4 + x < c) ? c4 + x : c4; const float* gp = F.GATES + (size_t)(rowb + 64 * cc + lane) * NGATE; lfv[x] = gp[8 + hd]; liv[x] = gp[hd]; }
#pragma unroll
            for (int x = 0; x < 4; ++x) { const float lf = logsigmoidf_(lfv[x] + bfg), li = liv[x] + bi;
                const float bb = wave_scan_add(lf, lane); const float amax = wave_max(li - bb); const float b63 = __shfl(bb, 63);
                if (lane == c4 + x) { pb = b63; pa = amax; } }
        }
        for (int cc = 0; cc < c; ++cc) m_prev = __shfl(pb, cc) + fmaxf(m_prev, __shfl(pa, cc));
    }
    float* sc = (float*)(rec + MR_SC);
    {
        const float* gp = F.GATES + (size_t)(row0 + lane) * NGATE;
        const float lfv = logsigmoidf_(gp[8 + hd] + bfg), liv = gp[hd] + bi;
        const float bb = wave_scan_add(lfv, lane); const float a = liv - bb; const float cm = wave_scan_max(a, lane);
        const float Mi = fmaxf(m_prev, cm), mi = bb + Mi; const float M63 = __shfl(Mi, 63), m_new = __shfl(mi, 63);
        scs[lane] = a; scs[64 + lane] = Mi; scs[128 + lane] = expf(a - M63) * QK_SCALE;
        sc[lane] = expf(m_prev - Mi); sc[64 + lane] = expf(-mi);
        if (lane == 0) { sc[192] = expf(m_prev - M63); sc[193] = m_new; if (c == 31) F.out[O_PM + bh] = m_new; }
    }
    asm volatile("s_waitcnt lgkmcnt(0)" ::: "memory");
    bf16x8 Qf[2][8], Kf[2][8];
    const bf16_t* pq = F.PROJ + (size_t)(row0 + r) * NPROJ + hd * HD + 8 * h;
#pragma unroll
    for (int rb = 0; rb < 2; ++rb)
#pragma unroll
        for (int s = 0; s < 8; ++s) { Qf[rb][s] = *(const bf16x8*)(pq + (size_t)(32 * rb) * NPROJ + 16 * s); Kf[rb][s] = *(const bf16x8*)(pq + (size_t)(32 * rb) * NPROJ + 1024 + 16 * s); }
#pragma unroll
    for (int rb = 0; rb < 2; ++rb)
#pragma unroll
        for (int s = 0; s < 8; ++s) { const int i = 32 * rb + r; const u32x4 wv = __builtin_bit_cast(u32x4, Qf[rb][s]);
            unsigned char* o0 = rec + MR_QI + ((((i >> 4) * 4 + (s >> 1)) * 64 + (2 * h) * 16 + (i & 15)) * 16) + 8 * (s & 1);
            *(u32x2*)o0 = (u32x2){wv.x, wv.y}; *(u32x2*)(o0 + 256) = (u32x2){wv.z, wv.w}; }
    float rs[2] = {0.f, 0.f};
#pragma unroll
    for (int blk = 0; blk < 3; ++blk) {
        const int jb = blk >> 1, ib = (blk + 1) >> 1;
        f32x16 Dm;
#pragma unroll
        for (int x = 0; x < 16; ++x) Dm[x] = 0.f;
#pragma unroll
        for (int s = 0; s < 8; ++s) Dm = __builtin_amdgcn_mfma_f32_32x32x16_bf16(Kf[jb][s], Qf[ib][s], Dm, 0, 0, 0);
        const int i = 32 * ib + r; const float Mi_i = scs[64 + i];
#pragma unroll
        for (int g = 0; g < 4; ++g) {
            const f32x4 aj = *(const LAS f32x4*)(scs + 32 * jb + 8 * g + 4 * h);
            float v[4];
#pragma unroll
            for (int ip = 0; ip < 4; ++ip) { const int j = 32 * jb + 8 * g + 4 * h + ip; const float x = Dm[4 * g + ip] * QK_SCALE * __expf(aj[ip] - Mi_i); v[ip] = (j <= i) ? x : 0.f; }
            rs[ib] += (v[0] + v[1]) + (v[2] + v[3]);
            *(u32x2*)(rec + MR_SP + ((((i >> 4) * 2 + jb) * 64 + g * 16 + (i & 15)) * 16) + 8 * h) = (u32x2){pk2(v[0], v[1]), pk2(v[2], v[3])};
        }
    }
    rs[0] += __shfl_xor(rs[0], 32); rs[1] += __shfl_xor(rs[1], 32);
    if (h == 0) { sc[128 + r] = rs[0]; sc[160 + r] = rs[1]; }
    LAS unsigned short* const stg = (LAS unsigned short*)scr;
#pragma unroll 1
    for (int mt = 0; mt < 2; ++mt) {
        const bf16_t* psrc = F.PROJ + (size_t)row0 * NPROJ + (mt + 1) * 1024 + hd * HD;
        u32x4 tv[16];
#pragma unroll
        for (int x = 0; x < 16; ++x) { const int idx = x * 64 + lane; tv[x] = *(const u32x4*)(psrc + (size_t)(idx >> 4) * NPROJ + (idx & 15) * 8); }
        asm volatile("s_waitcnt lgkmcnt(0)" ::: "memory");
#pragma unroll
        for (int x = 0; x < 16; ++x) { const int idx = x * 64 + lane; *(LAS u32x4*)(stg + (idx >> 4) * 128 + (idx & 15) * 8) = tv[x]; }
        asm volatile("s_waitcnt lgkmcnt(0)" ::: "memory");
#pragma unroll 1
        for (int blk = 0; blk < 4; ++blk) {
            const int d = 32 * blk + r; float dn = 0.f;
#pragma unroll
            for (int s = 0; s < 4; ++s) {
                unsigned xv[8];
#pragma unroll
                for (int j = 0; j < 8; ++j) xv[j] = stg[(16 * s + 8 * h + j) * 128 + d];
                const size_t off = ((((d >> 4) * 2 + (s >> 1)) * 64 + (2 * (s & 1) + h) * 16 + (d & 15)) * 16);
                if (mt == 0) {
                    const f32x4 w0 = *(const LAS f32x4*)(scs + 128 + 16 * s + 8 * h), w1 = *(const LAS f32x4*)(scs + 128 + 16 * s + 8 * h + 4);
                    float x[8];
#pragma unroll
                    for (int j = 0; j < 4; ++j) { x[j] = bflo(xv[j]) * w0[j]; x[4 + j] = bflo(xv[4 + j]) * w1[j]; }
                    dn += ((x[0] + x[1]) + (x[2] + x[3])) + ((x[4] + x[5]) + (x[6] + x[7]));
                    *(u32x4*)(rec + MR_KW + off) = (u32x4){pk2(x[0], x[1]), pk2(x[2], x[3]), pk2(x[4], x[5]), pk2(x[6], x[7])};
                } else {
                    *(u32x4*)(rec + MR_VT + off) = (u32x4){xv[0] | (xv[1] << 16), xv[2] | (xv[3] << 16), xv[4] | (xv[5] << 16), xv[6] | (xv[7] << 16)};
                }
            }
            if (mt == 0) { dn += __shfl_xor(dn, 32); if (h == 0) ((float*)(rec + MR_DN))[d] = dn; }
        }
    }
}
__device__ __forceinline__ void s2_mlstm_chain(Frame& F, int bh) {
    const int lane = F.lane, w = F.wave, cl = lane & 15, q = lane >> 4, hd = bh & 7, b = bh >> 3;
    LAS unsigned char* const buf0 = F.lds; LAS unsigned char* const buf1 = F.lds + MREC;
    LAS float* const s_qn = (LAS float*)(F.lds + 2 * MREC); LAS float* const s_n = s_qn + 64; LAS float* const s_part = s_n + 128;
    const unsigned char* recs = F.IMGM + (size_t)bh * 32 * MREC;
    f32x4 C[8];
#pragma unroll
    for (int db = 0; db < 8; ++db) C[db] = (f32x4){0.f, 0.f, 0.f, 0.f};
    if (F.tid < 128) s_n[F.tid] = 0.f;
    for (int piece = w; piece < MREC / 1024; piece += 8)
        __builtin_amdgcn_global_load_lds((const unsigned*)(recs + piece * 1024 + lane * 16), (LAS unsigned*)(buf0 + piece * 1024), 16, 0, 0);
    asm volatile("s_waitcnt vmcnt(0)" ::: "memory"); __syncthreads();
    const float gn = F.mlstm_g[hd * HD + 16 * w + cl];
    for (int c = 0; c < 32; ++c) {
        LAS unsigned char* const cur = (c & 1) ? buf1 : buf0; LAS unsigned char* const nxt = (c & 1) ? buf0 : buf1;
        if (c + 1 < 32) { const unsigned char* src = recs + (size_t)(c + 1) * MREC;
            for (int piece = w; piece < MREC / 1024; piece += 8)
                __builtin_amdgcn_global_load_lds((const unsigned*)(src + piece * 1024 + lane * 16), (LAS unsigned*)(nxt + piece * 1024), 16, 0, 0); }
        const int row0 = b * T_P + 64 * c;
        unsigned oa[16];
#pragma unroll
        for (int x = 0; x < 16; ++x) oa[x] = F.PROJ[(size_t)(row0 + 16 * (x >> 2) + 4 * q + (x & 3)) * NPROJ + 3072 + hd * HD + 16 * w + cl];
        const LAS float* sc = (const LAS float*)(cur + MR_SC);
        {
            const int t = 8 * w + (lane >> 3), p = lane & 7, s = p >> 1; float acc = 0.f;
#pragma unroll
            for (int qq = 0; qq < 4; ++qq) {
                const u32x2 qv = *(const LAS u32x2*)(cur + MR_QI + ((((t >> 4) * 4 + s) * 64 + qq * 16 + (t & 15)) * 16) + 8 * (p & 1));
                const f32x4 nv = *(const LAS f32x4*)(s_n + 32 * s + 16 * (p & 1) + 4 * qq);
                acc += (bflo(qv.x) * nv.x + bfhi(qv.x) * nv.y) + (bflo(qv.y) * nv.z + bfhi(qv.y) * nv.w);
            }
            acc += __shfl_xor(acc, 1); acc += __shfl_xor(acc, 2); acc += __shfl_xor(acc, 4);
            if (p == 0) s_qn[t] = acc;
        }
        bf16x8 Cb[4];
#pragma unroll
        for (int s = 0; s < 4; ++s) Cb[s] = __builtin_bit_cast(bf16x8, (u32x4){pk2(C[2 * s][0], C[2 * s][1]), pk2(C[2 * s][2], C[2 * s][3]), pk2(C[2 * s + 1][0], C[2 * s + 1][1]), pk2(C[2 * s + 1][2], C[2 * s + 1][3])});
#define FRAG(off, f) (*(const LAS bf16x8*)(cur + (off) + (f) * 1024 + lane * 16))
        const bf16x8 VB0 = FRAG(MR_VT, w * 2 + 0), VB1 = FRAG(MR_VT, w * 2 + 1);
        f32x4 num[4];
#pragma unroll
        for (int tp = 0; tp < 2; ++tp) {
            bf16x8 fq[8], fs[4];
#pragma unroll
            for (int x = 0; x < 8; ++x) fq[x] = FRAG(MR_QI, tp * 8 + x);
#pragma unroll
            for (int x = 0; x < 4; ++x) fs[x] = FRAG(MR_SP, tp * 4 + x);
            const f32x4 dv0 = *(const LAS f32x4*)(sc + 16 * (2 * tp) + 4 * q), dv1 = *(const LAS f32x4*)(sc + 16 * (2 * tp + 1) + 4 * q);
            f32x4 a0 = (f32x4){0.f, 0.f, 0.f, 0.f}, a1 = a0;
#pragma unroll
            for (int s = 0; s < 4; ++s) { a0 = __builtin_amdgcn_mfma_f32_16x16x32_bf16(fq[s], Cb[s], a0, 0, 0, 0); a1 = __builtin_amdgcn_mfma_f32_16x16x32_bf16(fq[4 + s], Cb[s], a1, 0, 0, 0); }
            a0 = a0 * dv0; a1 = a1 * dv1;
            a0 = __builtin_amdgcn_mfma_f32_16x16x32_bf16(fs[0], VB0, a0, 0, 0, 0); a1 = __builtin_amdgcn_mfma_f32_16x16x32_bf16(fs[2], VB0, a1, 0, 0, 0);
            if (tp == 1) { a0 = __builtin_amdgcn_mfma_f32_16x16x32_bf16(fs[1], VB1, a0, 0, 0, 0); a1 = __builtin_amdgcn_mfma_f32_16x16x32_bf16(fs[3], VB1, a1, 0, 0, 0); }
            num[2 * tp] = a0; num[2 * tp + 1] = a1;
        }
        const float dC = sc[192];
#pragma unroll
        for (int dp = 0; dp < 2; ++dp) {
            bf16x8 fk[8];
#pragma unroll
            for (int x = 0; x < 8; ++x) fk[x] = FRAG(MR_KW, dp * 8 + x);
#pragma unroll
            for (int x = 0; x < 4; ++x) { const int db = dp * 4 + x; f32x4 acc = C[db] * dC;
                acc = __builtin_amdgcn_mfma_f32_16x16x32_bf16(fk[2 * x], VB0, acc, 0, 0, 0);
                acc = __builtin_amdgcn_mfma_f32_16x16x32_bf16(fk[2 * x + 1], VB1, acc, 0, 0, 0);
                C[db] = acc; }
        }
#undef FRAG
        __syncthreads();
        if (F.tid < 128) s_n[F.tid] = dC * s_n[F.tid] + ((const LAS float*)(cur + MR_DN))[F.tid];
        float hv[16];
#pragma unroll
        for (int tb = 0; tb < 4; ++tb) {
            const f32x4 dv = *(const LAS f32x4*)(sc + 16 * tb + 4 * q), ev = *(const LAS f32x4*)(sc + 64 + 16 * tb + 4 * q), rv = *(const LAS f32x4*)(sc + 128 + 16 * tb + 4 * q), qn = *(const LAS f32x4*)(s_qn + 16 * tb + 4 * q);
            f32x4 ss;
#pragma unroll
            for (int i = 0; i < 4; ++i) { const float dd = dv[i] * qn[i] + rv[i]; const float hh = __fdividef(num[tb][i], fmaxf(fabsf(dd), ev[i])); hv[tb * 4 + i] = hh; ss[i] = hh * hh; }
#pragma unroll
            for (int o = 1; o < 16; o <<= 1) { ss.x += __shfl_xor(ss.x, o); ss.y += __shfl_xor(ss.y, o); ss.z += __shfl_xor(ss.z, o); ss.w += __shfl_xor(ss.w, o); }
            if (cl == 0) *(LAS f32x4*)(s_part + w * 64 + 16 * tb + 4 * q) = ss;
        }
        __syncthreads();
        unsigned yv[16];
#pragma unroll
        for (int tb = 0; tb < 4; ++tb) {
            f32x4 tot = (f32x4){0.f, 0.f, 0.f, 0.f};
#pragma unroll
            for (int ww = 0; ww < 8; ++ww) tot += *(const LAS f32x4*)(s_part + ww * 64 + 16 * tb + 4 * q);
#pragma unroll
            for (int i = 0; i < 4; ++i) yv[tb * 4 + i] = f2bf(hv[tb * 4 + i] * __frsqrt_rn(tot[i] * (1.0f / HD) + EPS) * gn * sigmoidf_(bflo(oa[tb * 4 + i])));
        }
        asm volatile("s_waitcnt vmcnt(0)" ::: "memory"); __syncthreads();
#pragma unroll
        for (int x = 0; x < 16; ++x) F.MIX[(size_t)(row0 + 16 * (x >> 2) + 4 * q + (x & 3)) * D + hd * HD + 16 * w + cl] = (bf16_t)yv[x];
    }
    float* oC = F.out + O_PC + (size_t)bh * HD * HD;
#pragma unroll
    for (int db = 0; db < 8; ++db)
#pragma unroll
        for (int i = 0; i < 4; ++i) oC[(size_t)(16 * db + 4 * q + i) * HD + 16 * w + cl] = C[db][i];
    if (F.tid < 128) F.out[O_PN + (size_t)bh * HD + F.tid] = s_n[F.tid];
    __syncthreads();
}


__device__ __forceinline__ float silu_fast(float x) { return __fdividef(x, 1.0f + __expf(-x)); }
__device__ __forceinline__ void s1_gdn_unit(Frame& F, int unit, LAS float* scr) {
    const int lane = F.lane, r = lane & 31, h = lane >> 5;
    const int c = unit & 31, bh = unit >> 5, hd = bh & 7, b = bh >> 3;
    const int rowb = b * T_P, row0 = rowb + 64 * c;
    unsigned char* rec = F.IMGG + (size_t)unit * GREC;
    LAS float* scrA = scr; LAS float* sG = scr + 4352; LAS float* sBe = sG + 64; LAS float* sRk = sBe + 64; LAS float* sRq = sRk + 64; LAS float* sF1 = sRq + 64; LAS float* sF2 = sF1 + 64;
    const float* gp = F.GATES + (size_t)(row0 + lane) * NGATE;
    const float lgv = -expf(F.A_log[hd]) * softplusf_(gp[16 + hd] + F.dt_bias[hd]);
    const float G = wave_scan_add(lgv, lane); const float be = sigmoidf_(gp[24 + hd]); const float G63 = __shfl(G, 63);
    sG[lane] = G; sBe[lane] = be;
    f32x16 Dk[3], Dq[3];
#pragma unroll
    for (int x = 0; x < 3; ++x)
#pragma unroll
        for (int y = 0; y < 16; ++y) { Dk[x][y] = 0.f; Dq[x][y] = 0.f; }
    float ssq[2][2] = {{0.f, 0.f}, {0.f, 0.f}};
    LAS unsigned short* const stg = (LAS unsigned short*)scrA;
    const float* cw = F.conv_w + hd * HD + 8 * h;
#pragma unroll 1
    for (int hf = 0; hf < 2; ++hf) {
        asm volatile("s_waitcnt lgkmcnt(0)" ::: "memory");
#pragma unroll 1
        for (int x0 = 0; x0 < 18; x0 += 6) {
            u32x4 tv[6];
#pragma unroll
            for (int x = 0; x < 6; ++x) { int idx = (x0 + x) * 64 + lane; idx = idx < 1072 ? idx : 1071; const int mtx = idx >= 536 ? 1 : 0, rem = idx - 536 * mtx, row = rem >> 3, piece = rem & 7;
                const bool dead = (c == 0) && (row < 3); const int grow = dead ? row0 : row0 - 3 + row;
                u32x4 v = *(const u32x4*)(F.PROJ + (size_t)grow * NPROJ + 4096 + mtx * 1024 + hd * HD + 64 * hf + piece * 8);
                if (dead) v = (u32x4){0u, 0u, 0u, 0u};
                tv[x] = v; }
#pragma unroll
            for (int x = 0; x < 6; ++x) { const int idx = (x0 + x) * 64 + lane; const int mtx = idx >= 536 ? 1 : 0, rem = idx - 536 * mtx, row = rem >> 3, piece = rem & 7;
                if (idx < 1072) *(LAS u32x4*)(stg + mtx * (67 * 64) + row * 64 + ((piece ^ ((row >> 1) & 7)) * 8)) = tv[x]; }
        }
        asm volatile("s_waitcnt lgkmcnt(0)" ::: "memory");
#pragma unroll 1
        for (int sl = 0; sl < 4; ++sl) {
            const int s = 4 * hf + sl;
            bf16x8 fr[2][2];
#pragma unroll
            for (int mt = 0; mt < 2; ++mt) {
                asm volatile("" ::: "memory");
                f32x4 wa[4], wb[4];
#pragma unroll
                for (int tap = 0; tap < 4; ++tap) { wa[tap] = *(const f32x4*)(cw + tap * CCONV + mt * 1024 + 16 * s); wb[tap] = *(const f32x4*)(cw + tap * CCONV + mt * 1024 + 16 * s + 4); }
#pragma unroll
                for (int rb = 0; rb < 2; ++rb) {
                    const int i = 32 * rb + r; f32x4 a0 = (f32x4){0.f, 0.f, 0.f, 0.f}, a1 = a0;
#pragma unroll
                    for (int tap = 0; tap < 4; ++tap) { const int row = i + tap, piece = 2 * sl + h;
                        const u32x4 uv = *(const LAS u32x4*)(stg + mt * (67 * 64) + row * 64 + ((piece ^ ((row >> 1) & 7)) * 8));
                        a0 += (f32x4){bflo(uv.x), bfhi(uv.x), bflo(uv.y), bfhi(uv.y)} * wa[tap]; a1 += (f32x4){bflo(uv.z), bfhi(uv.z), bflo(uv.w), bfhi(uv.w)} * wb[tap]; }
                    float y[8];
#pragma unroll
                    for (int j = 0; j < 4; ++j) { y[j] = silu_fast(a0[j]); y[4 + j] = silu_fast(a1[j]); }
                    ssq[rb][mt] += ((y[0] * y[0] + y[1] * y[1]) + (y[2] * y[2] + y[3] * y[3])) + ((y[4] * y[4] + y[5] * y[5]) + (y[6] * y[6] + y[7] * y[7]));
                    const u32x4 wv = (u32x4){pk2(y[0], y[1]), pk2(y[2], y[3]), pk2(y[4], y[5]), pk2(y[6], y[7])};
                    fr[mt][rb] = __builtin_bit_cast(bf16x8, wv);
                    if (mt == 0) { unsigned char* o0 = rec + GR_QG + ((((i >> 4) * 4 + (s >> 1)) * 64 + (2 * h) * 16 + (i & 15)) * 16) + 8 * (s & 1);
                        *(u32x2*)o0 = (u32x2){wv.x, wv.y}; *(u32x2*)(o0 + 256) = (u32x2){wv.z, wv.w}; }
                }
            }
#pragma unroll
            for (int blk = 0; blk < 3; ++blk) { const int jb = blk >> 1, ib = (blk + 1) >> 1;
                Dk[blk] = __builtin_amdgcn_mfma_f32_32x32x16_bf16(fr[1][jb], fr[1][ib], Dk[blk], 0, 0, 0);
                Dq[blk] = __builtin_amdgcn_mfma_f32_32x32x16_bf16(fr[1][jb], fr[0][ib], Dq[blk], 0, 0, 0); }
        }
    }
#pragma unroll
    for (int rb = 0; rb < 2; ++rb) {
        const float sq = ssq[rb][0] + __shfl_xor(ssq[rb][0], 32), sk = ssq[rb][1] + __shfl_xor(ssq[rb][1], 32);
        if (h == 0) { sRq[32 * rb + r] = 1.0f / sqrtf(sq + EPS); sRk[32 * rb + r] = 1.0f / sqrtf(sk + EPS); }
    }
    asm volatile("s_waitcnt lgkmcnt(0)" ::: "memory");
#pragma unroll
    for (int blk = 0; blk < 3; ++blk) {
        const int jb = blk >> 1, ib = (blk + 1) >> 1;
        const int i = 32 * ib + r; const float Gi = sG[i], bei = sBe[i], rki = sRk[i], rqi = sRq[i] * QK_SCALE;
#pragma unroll
        for (int g = 0; g < 4; ++g) {
            const int j0 = 32 * jb + 8 * g + 4 * h; const f32x4 Gj = *(const LAS f32x4*)(sG + j0), rkj = *(const LAS f32x4*)(sRk + j0);
            f32x4 av; float qv[4];
#pragma unroll
            for (int ip = 0; ip < 4; ++ip) { const float e = __expf(Gi - Gj[ip]); av[ip] = bei * e * rki * rkj[ip] * Dk[blk][4 * g + ip];
                qv[ip] = (j0 + ip <= i) ? -(rqi * rkj[ip] * e * Dq[blk][4 * g + ip]) : 0.f; }
            *(LAS f32x4*)(scrA + i * 68 + j0) = av;
            *(u32x2*)(rec + GR_QK + ((((i >> 4) * 2 + jb) * 64 + (2 * (g & 1) + h) * 16 + (i & 15)) * 16) + 8 * (g >> 1)) = (u32x2){pk2(qv[0], qv[1]), pk2(qv[2], qv[3])};
        }
    }
    asm volatile("s_waitcnt lgkmcnt(0)" ::: "memory");
    {
        float tc[64];
#pragma unroll
        for (int i = 0; i < 64; ++i) {
            float acc0 = (lane == i) ? 1.f : 0.f, acc1 = 0.f;
#pragma unroll
            for (int j4 = 0; j4 < i; j4 += 4) { const f32x4 av = *(const LAS f32x4*)(scrA + i * 68 + j4);
                acc0 -= av.x * tc[j4]; if (j4 + 1 < i) acc1 -= av.y * tc[j4 + 1]; if (j4 + 2 < i) acc0 -= av.z * tc[j4 + 2]; if (j4 + 3 < i) acc1 -= av.w * tc[j4 + 3]; }
            tc[i] = acc0 + acc1;
            scrA[i * 68 + lane] = tc[i];
            asm volatile("" ::: "memory");
        }
    }
    const float gam = expf(G), rkl = sRk[lane], rql = sRq[lane];
    sF1[lane] = be * gam * rkl; sF2[lane] = be;
    { float* sc = (float*)(rec + GR_SC); sc[lane] = gam * rql * QK_SCALE; sc[64 + lane] = expf(G63 - G) * rkl; if (lane == 0) sc[128] = expf(G63); }
    asm volatile("s_waitcnt lgkmcnt(0)" ::: "memory");
    bf16x8 Tp[6], Tpp[6];
#pragma unroll
    for (int x = 0; x < 6; ++x) { const int ib = x < 2 ? 0 : 1, s = x < 2 ? x : x - 2;
        const LAS float* tp = scrA + (32 * ib + r) * 68 + 16 * s + 8 * h; const f32x4 t0 = *(const LAS f32x4*)tp, t1 = *(const LAS f32x4*)(tp + 4);
        const f32x4 f1a = *(const LAS f32x4*)(sF1 + 16 * s + 8 * h), f1b = *(const LAS f32x4*)(sF1 + 16 * s + 8 * h + 4), f2a = *(const LAS f32x4*)(sF2 + 16 * s + 8 * h), f2b = *(const LAS f32x4*)(sF2 + 16 * s + 8 * h + 4);
        const f32x4 p0 = t0 * f1a, p1 = t1 * f1b, q0 = t0 * f2a, q1 = t1 * f2b;
        Tp[x] = __builtin_bit_cast(bf16x8, (u32x4){pk2(p0.x, p0.y), pk2(p0.z, p0.w), pk2(p1.x, p1.y), pk2(p1.z, p1.w)});
        Tpp[x] = __builtin_bit_cast(bf16x8, (u32x4){pk2(q0.x, q0.y), pk2(q0.z, q0.w), pk2(q1.x, q1.y), pk2(q1.z, q1.w)}); }
#pragma unroll 1
    for (int mt = 0; mt < 2; ++mt) {
        {
            u32x4 tv[17];
#pragma unroll
            for (int x = 0; x < 17; ++x) { int idx = x * 64 + lane; idx = idx < 1072 ? idx : 1071; const int row = idx >> 4, piece = idx & 15;
                const bool dead = (c == 0) && (row < 3); const int grow = dead ? row0 : row0 - 3 + row;
                u32x4 v = *(const u32x4*)(F.PROJ + (size_t)grow * NPROJ + 4096 + (mt + 1) * 1024 + hd * HD + piece * 8);
                if (dead) v = (u32x4){0u, 0u, 0u, 0u};
                tv[x] = v; }
            asm volatile("s_waitcnt lgkmcnt(0)" ::: "memory");
#pragma unroll
            for (int x = 0; x < 17; ++x) { const int idx = x * 64 + lane; if (idx < 1072) *(LAS u32x4*)(stg + (idx >> 4) * 128 + (idx & 15) * 8) = tv[x]; }
            asm volatile("s_waitcnt lgkmcnt(0)" ::: "memory");
        }
#pragma unroll 1
        for (int blk = 0; blk < 4; ++blk) {
            const int d = 32 * blk + r; const float* cwc = F.conv_w + (mt + 1) * 1024 + hd * HD + d;
            const float w0 = cwc[0], w1 = cwc[CCONV], w2 = cwc[2 * CCONV], w3 = cwc[3 * CCONV];
            bf16x8 Xc[4];
#pragma unroll
            for (int s = 0; s < 4; ++s) {
                float u[11];
#pragma unroll
                for (int x = 0; x < 11; ++x) u[x] = bf2f(stg[(16 * s + 8 * h + x) * 128 + d]);
                float y[8];
#pragma unroll
                for (int j = 0; j < 8; ++j) y[j] = silu_fast(((w0 * u[j] + w1 * u[j + 1]) + w2 * u[j + 2]) + w3 * u[j + 3]);
                const u32x4 xw = (u32x4){pk2(y[0], y[1]), pk2(y[2], y[3]), pk2(y[4], y[5]), pk2(y[6], y[7])};
                Xc[s] = __builtin_bit_cast(bf16x8, xw);
                if (mt == 0) { unsigned char* o0 = rec + GR_KT + ((((d >> 4) * 2 + (s >> 1)) * 64 + (2 * h) * 16 + (d & 15)) * 16) + 8 * (s & 1);
                    *(u32x2*)o0 = (u32x2){xw.x ^ 0x80008000u, xw.y ^ 0x80008000u}; *(u32x2*)(o0 + 256) = (u32x2){xw.z ^ 0x80008000u, xw.w ^ 0x80008000u}; }
            }
#pragma unroll
            for (int ib = 0; ib < 2; ++ib) {
                f32x16 Dm;
#pragma unroll
                for (int x = 0; x < 16; ++x) Dm[x] = 0.f;
                if (mt == 0) {
                    if (ib == 0) { Dm = __builtin_amdgcn_mfma_f32_32x32x16_bf16(Xc[0], Tp[0], Dm, 0, 0, 0); Dm = __builtin_amdgcn_mfma_f32_32x32x16_bf16(Xc[1], Tp[1], Dm, 0, 0, 0); }
                    else {
#pragma unroll
                        for (int s = 0; s < 4; ++s) Dm = __builtin_amdgcn_mfma_f32_32x32x16_bf16(Xc[s], Tp[2 + s], Dm, 0, 0, 0); }
                    const int i = 32 * ib + r;
#pragma unroll
                    for (int g = 0; g < 4; ++g)
                        *(u32x2*)(rec + GR_WI + ((((i >> 4) * 4 + blk) * 64 + (2 * (g & 1) + h) * 16 + (i & 15)) * 16) + 8 * (g >> 1)) = (u32x2){pk2(Dm[4 * g], Dm[4 * g + 1]), pk2(Dm[4 * g + 2], Dm[4 * g + 3])};
                } else {
                    if (ib == 0) { Dm = __builtin_amdgcn_mfma_f32_32x32x16_bf16(Tpp[0], Xc[0], Dm, 0, 0, 0); Dm = __builtin_amdgcn_mfma_f32_32x32x16_bf16(Tpp[1], Xc[1], Dm, 0, 0, 0); }
                    else {
#pragma unroll
                        for (int s = 0; s < 4; ++s) Dm = __builtin_amdgcn_mfma_f32_32x32x16_bf16(Tpp[2 + s], Xc[s], Dm, 0, 0, 0); }
#pragma unroll
                    for (int g = 0; g < 4; ++g)
                        *(u32x2*)(rec + GR_UP + ((((d >> 4) * 4 + (2 * ib + (g >> 1))) * 64 + (2 * (g & 1) + h) * 16 + (d & 15)) * 8)) = (u32x2){pk2(Dm[4 * g], Dm[4 * g + 1]), pk2(Dm[4 * g + 2], Dm[4 * g + 3])};
                }
            }
        }
    }
    if (c == 31) {
        for (int x = lane; x < 3 * 384; x += 64) { const int jr = x / 384, cc = x % 384, ch = (cc >> 7) * 1024 + hd * HD + (cc & 127);
            F.out[O_PCONV + (size_t)(b * 3 + jr) * CCONV + ch] = bf2f(F.PROJ[(size_t)(rowb + T_P - 3 + jr) * NPROJ + 4096 + ch]); }
    }
}
__device__ __forceinline__ void s2_gdn_chain(Frame& F, int bh) {
    const int lane = F.lane, w = F.wave, cl = lane & 15, q = lane >> 4, hd = bh & 7, b = bh >> 3;
    LAS unsigned char* const buf0 = F.lds; LAS unsigned char* const buf1 = F.lds + GDMA_BYTES;
    LAS float* const s_part = (LAS float*)(F.lds + 2 * GDMA_BYTES);
    const unsigned char* recs = F.IMGG + (size_t)bh * 32 * GREC;
    f32x4 S[8];
#pragma unroll
    for (int db = 0; db < 8; ++db) S[db] = (f32x4){0.f, 0.f, 0.f, 0.f};
    u32x2 upn[4];
#pragma unroll
    for (int tb = 0; tb < 4; ++tb) upn[tb] = *(const u32x2*)(recs + GR_UP + ((w * 4 + tb) * 64 + lane) * 8);
    for (int piece = w; piece < GDMA_BYTES / 1024; piece += 8)
        __builtin_amdgcn_global_load_lds((const unsigned*)(recs + piece * 1024 + lane * 16), (LAS unsigned*)(buf0 + piece * 1024), 16, 0, 0);
    asm volatile("s_waitcnt vmcnt(0)" ::: "memory"); __syncthreads();
    const float gn = F.gdn_g[hd * HD + 16 * w + cl];
    for (int c = 0; c < 32; ++c) {
        LAS unsigned char* const cur = (c & 1) ? buf1 : buf0; LAS unsigned char* const nxt = (c & 1) ? buf0 : buf1;
        u32x2 up[4];
#pragma unroll
        for (int tb = 0; tb < 4; ++tb) up[tb] = upn[tb];
        const int row0 = b * T_P + 64 * c;
        unsigned zb[16];
#pragma unroll
        for (int x = 0; x < 16; ++x) zb[x] = F.PROJ[(size_t)(row0 + 16 * (x >> 2) + 4 * q + (x & 3)) * NPROJ + 7168 + hd * HD + 16 * w + cl];
        if (c + 1 < 32) { const unsigned char* src = recs + (size_t)(c + 1) * GREC;
#pragma unroll
            for (int tb = 0; tb < 4; ++tb) upn[tb] = *(const u32x2*)(src + GR_UP + ((w * 4 + tb) * 64 + lane) * 8);
            for (int piece = w; piece < GDMA_BYTES / 1024; piece += 8)
                __builtin_amdgcn_global_load_lds((const unsigned*)(src + piece * 1024 + lane * 16), (LAS unsigned*)(nxt + piece * 1024), 16, 0, 0); }
        const LAS float* sc = (const LAS float*)(cur + GR_SC);
        bf16x8 Sb[4];
#pragma unroll
        for (int s = 0; s < 4; ++s) Sb[s] = __builtin_bit_cast(bf16x8, (u32x4){pk2(S[2 * s][0], S[2 * s][1]), pk2(S[2 * s][2], S[2 * s][3]), pk2(S[2 * s + 1][0], S[2 * s + 1][1]), pk2(S[2 * s + 1][2], S[2 * s + 1][3])});
#define FRAG(off, f) (*(const LAS bf16x8*)(cur + (off) + (f) * 1024 + lane * 16))
        f32x4 P[4];
#pragma unroll
        for (int tp = 0; tp < 2; ++tp) {
            bf16x8 fw[8];
#pragma unroll
            for (int x = 0; x < 8; ++x) fw[x] = FRAG(GR_WI, tp * 8 + x);
            f32x4 a0 = (f32x4){-bflo(up[2 * tp].x), -bfhi(up[2 * tp].x), -bflo(up[2 * tp].y), -bfhi(up[2 * tp].y)};
            f32x4 a1 = (f32x4){-bflo(up[2 * tp + 1].x), -bfhi(up[2 * tp + 1].x), -bflo(up[2 * tp + 1].y), -bfhi(up[2 * tp + 1].y)};
#pragma unroll
            for (int s = 0; s < 4; ++s) { a0 = __builtin_amdgcn_mfma_f32_16x16x32_bf16(fw[s], Sb[s], a0, 0, 0, 0); a1 = __builtin_amdgcn_mfma_f32_16x16x32_bf16(fw[4 + s], Sb[s], a1, 0, 0, 0); }
            P[2 * tp] = a0; P[2 * tp + 1] = a1;
        }
        f32x4 o[4];
#pragma unroll
        for (int tp = 0; tp < 2; ++tp) {
            bf16x8 fq[8];
#pragma unroll
            for (int x = 0; x < 8; ++x) fq[x] = FRAG(GR_QG, tp * 8 + x);
            f32x4 a0 = (f32x4){0.f, 0.f, 0.f, 0.f}, a1 = a0;
#pragma unroll
            for (int s = 0; s < 4; ++s) { a0 = __builtin_amdgcn_mfma_f32_16x16x32_bf16(fq[s], Sb[s], a0, 0, 0, 0); a1 = __builtin_amdgcn_mfma_f32_16x16x32_bf16(fq[4 + s], Sb[s], a1, 0, 0, 0); }
            o[2 * tp] = a0 * *(const LAS f32x4*)(sc + 16 * (2 * tp) + 4 * q); o[2 * tp + 1] = a1 * *(const LAS f32x4*)(sc + 16 * (2 * tp + 1) + 4 * q);
        }
        bf16x8 Pb[2], Pbs[2];
#pragma unroll
        for (int sp = 0; sp < 2; ++sp) {
            const f32x4 k0 = *(const LAS f32x4*)(sc + 64 + 16 * (2 * sp) + 4 * q), k1 = *(const LAS f32x4*)(sc + 64 + 16 * (2 * sp + 1) + 4 * q);
            const f32x4 a = P[2 * sp], bq = P[2 * sp + 1], as = a * k0, bs = bq * k1;
            Pb[sp] = __builtin_bit_cast(bf16x8, (u32x4){pk2(a[0], a[1]), pk2(a[2], a[3]), pk2(bq[0], bq[1]), pk2(bq[2], bq[3])});
            Pbs[sp] = __builtin_bit_cast(bf16x8, (u32x4){pk2(as[0], as[1]), pk2(as[2], as[3]), pk2(bs[0], bs[1]), pk2(bs[2], bs[3])});
        }
        {
            bf16x8 fk[6];
            fk[0] = FRAG(GR_QK, 0); fk[1] = FRAG(GR_QK, 2); fk[2] = FRAG(GR_QK, 4); fk[3] = FRAG(GR_QK, 5); fk[4] = FRAG(GR_QK, 6); fk[5] = FRAG(GR_QK, 7);
            o[0] = __builtin_amdgcn_mfma_f32_16x16x32_bf16(fk[0], Pb[0], o[0], 0, 0, 0); o[1] = __builtin_amdgcn_mfma_f32_16x16x32_bf16(fk[1], Pb[0], o[1], 0, 0, 0);
            o[2] = __builtin_amdgcn_mfma_f32_16x16x32_bf16(fk[2], Pb[0], o[2], 0, 0, 0); o[3] = __builtin_amdgcn_mfma_f32_16x16x32_bf16(fk[4], Pb[0], o[3], 0, 0, 0);
            o[2] = __builtin_amdgcn_mfma_f32_16x16x32_bf16(fk[3], Pb[1], o[2], 0, 0, 0); o[3] = __builtin_amdgcn_mfma_f32_16x16x32_bf16(fk[5], Pb[1], o[3], 0, 0, 0);
        }
        const float gL = sc[128];
#pragma unroll
        for (int dp = 0; dp < 2; ++dp) {
            bf16x8 fk[8];
#pragma unroll
            for (int x = 0; x < 8; ++x) fk[x] = FRAG(GR_KT, dp * 8 + x);
#pragma unroll
            for (int x = 0; x < 4; ++x) { const int db = dp * 4 + x; f32x4 acc = S[db] * gL;
                acc = __builtin_amdgcn_mfma_f32_16x16x32_bf16(fk[2 * x], Pbs[0], acc, 0, 0, 0);
                acc = __builtin_amdgcn_mfma_f32_16x16x32_bf16(fk[2 * x + 1], Pbs[1], acc, 0, 0, 0);
                S[db] = acc; }
        }
#undef FRAG
#pragma unroll
        for (int tb = 0; tb < 4; ++tb) {
            f32x4 ss = o[tb] * o[tb];
#pragma unroll
            for (int x = 1; x < 16; x <<= 1) { ss.x += __shfl_xor(ss.x, x); ss.y += __shfl_xor(ss.y, x); ss.z += __shfl_xor(ss.z, x); ss.w += __shfl_xor(ss.w, x); }
            if (cl == 0) *(LAS f32x4*)(s_part + w * 64 + 16 * tb + 4 * q) = ss;
        }
        __syncthreads();
        unsigned yv[16];
#pragma unroll
        for (int tb = 0; tb < 4; ++tb) {
            f32x4 tot = (f32x4){0.f, 0.f, 0.f, 0.f};
#pragma unroll
            for (int ww = 0; ww < 8; ++ww) tot += *(const LAS f32x4*)(s_part + ww * 64 + 16 * tb + 4 * q);
#pragma unroll
            for (int i = 0; i < 4; ++i) yv[tb * 4 + i] = f2bf(o[tb][i] * __frsqrt_rn(tot[i] * (1.0f / HD) + EPS) * gn * siluf_(bflo(zb[tb * 4 + i])));
        }
        asm volatile("s_waitcnt vmcnt(0)" ::: "memory"); __syncthreads();
#pragma unroll
        for (int x = 0; x < 16; ++x) F.MIX[(size_t)(row0 + 16 * (x >> 2) + 4 * q + (x & 3)) * D + 1024 + hd * HD + 16 * w + cl] = (bf16_t)yv[x];
    }
    float* oS = F.out + O_PS + (size_t)bh * HD * HD;
#pragma unroll
    for (int db = 0; db < 8; ++db)
#pragma unroll
        for (int i = 0; i < 4; ++i) oS[(size_t)(16 * db + 4 * q + i) * HD + 16 * w + cl] = S[db][i];
    __syncthreads();
}


__device__ __forceinline__ void sample_mlstm(Frame& F, int b, int hd) {
    LAS float* sQ = (LAS float*)(F.lds); LAS float* sK = sQ + 1024; LAS float* sV = sK + 1024; LAS float* sOA = sV + 1024; LAS float* sKW = sOA + 1024;
    LAS float* sPart = sKW + 1024;
    LAS float* sN0 = sPart + 4096;
    LAS float* sQK = sN0 + 128;
    LAS float* sQN = sQK + 64;
    LAS float* sW = sQN + 8;
    LAS float* sSc = sW + 64;
    LAS float* sNorm = sSc + 32;
    const int tid = F.tid, e = tid & 127, q4 = tid >> 7, lane = F.lane, w = F.wave;
    const int row0 = M_P + b * T_S, bh = b * NH + hd;
    float C[32];
#pragma unroll
    for (int dd = 0; dd < 32; ++dd) C[dd] = F.stC[((size_t)bh * HD + 32 * q4 + dd) * HD + e];
    {
        const int t = tid >> 6, arr = (tid >> 4) & 3, c8 = (tid & 15) * 8;
        const u32x4 uv = *(const u32x4*)(F.PROJ + (size_t)(row0 + t) * NPROJ + arr * 1024 + hd * HD + c8);
        const float sc = (arr == 1) ? QK_SCALE : 1.0f;
        LAS float* dst = sQ + arr * 1024 + t * 128 + c8;
        *(LAS f32x4*)dst = (f32x4){bflo(uv.x) * sc, bfhi(uv.x) * sc, bflo(uv.y) * sc, bfhi(uv.y) * sc};
        *(LAS f32x4*)(dst + 4) = (f32x4){bflo(uv.z) * sc, bfhi(uv.z) * sc, bflo(uv.w) * sc, bfhi(uv.w) * sc};
    }
    float n0 = 0.f;
    if (tid < 128) { n0 = F.stN[(size_t)bh * HD + tid]; sN0[tid] = n0; }
    if (w == 0) {
        const int t = lane & 7; const float* gp = F.GATES + (size_t)(row0 + t) * NGATE;
        const float m0 = F.stM[bh];
        const float lfv = logsigmoidf_(gp[8 + hd] + F.gate_b[NH + hd]), liv = gp[hd] + F.gate_b[hd];
        float bb = lfv;
#pragma unroll
        for (int o = 1; o < 8; o <<= 1) { const float x = __shfl_up(bb, o); if (t >= o) bb += x; }
        const float a = liv - bb; float cm = a;
#pragma unroll
        for (int o = 1; o < 8; o <<= 1) { const float x = __shfl_up(cm, o); if (t >= o) cm = fmaxf(cm, x); }
        const float Mi = fmaxf(m0, cm), mi = bb + Mi; const float M7 = __shfl(Mi, 7), m7 = __shfl(mi, 7);
        if (lane < 8) { sSc[t] = expf(m0 - Mi); sSc[8 + t] = expf(-mi); sSc[16 + t] = expf(a - M7); if (t == 0) { sSc[24] = expf(m0 - M7); sSc[25] = m7; } }
#pragma unroll
        for (int s = 0; s < 8; ++s) { const float as = __shfl(a, s); if (lane < 8) sW[t * 8 + s] = (s <= t) ? expf(as - Mi) : 0.f; }
    }
    __syncthreads();
    {
        const float q0 = sQ[w * 128 + lane], q1 = sQ[w * 128 + 64 + lane];
#pragma unroll
        for (int s = 0; s < 8; ++s) { if (s <= w) { const float d = wave_sum(q0 * sK[s * 128 + lane] + q1 * sK[s * 128 + 64 + lane]); if (lane == 0) sQK[w * 8 + s] = d * sW[w * 8 + s]; } else if (lane == 0) sQK[w * 8 + s] = 0.f; }
        const float dn = wave_sum(q0 * sN0[lane] + q1 * sN0[64 + lane]); if (lane == 0) sQN[w] = dn;
    }
    {
#pragma unroll
        for (int x = 0; x < 2; ++x) { const int idx = tid + 512 * x; sKW[idx] = sK[idx] * sSc[16 + (idx >> 7)]; }
    }
    {
        float part[8];
#pragma unroll
        for (int t = 0; t < 8; ++t) part[t] = 0.f;
#pragma unroll
        for (int d4 = 0; d4 < 8; ++d4)
#pragma unroll
            for (int t = 0; t < 8; ++t) { const f32x4 qv = *(const LAS f32x4*)(sQ + t * 128 + 32 * q4 + 4 * d4);
                part[t] += (qv.x * C[4 * d4] + qv.y * C[4 * d4 + 1]) + (qv.z * C[4 * d4 + 2] + qv.w * C[4 * d4 + 3]); }
#pragma unroll
        for (int t = 0; t < 8; ++t) sPart[(q4 * 8 + t) * 128 + e] = part[t];
    }
    __syncthreads();
    float hv[2];
#pragma unroll
    for (int tt = 0; tt < 2; ++tt) {
        const int t = 2 * q4 + tt;
        float numer = ((sPart[(0 * 8 + t) * 128 + e] + sPart[(1 * 8 + t) * 128 + e]) + (sPart[(2 * 8 + t) * 128 + e] + sPart[(3 * 8 + t) * 128 + e])) * sSc[t];
        float dd = sSc[t] * sQN[t];
#pragma unroll
        for (int s = 0; s < 8; ++s) { const float wq = sQK[t * 8 + s]; numer += wq * sV[s * 128 + e]; dd += wq; }
        hv[tt] = numer / fmaxf(fabsf(dd), sSc[8 + t]);
        const float ss = wave_sum(hv[tt] * hv[tt]);
        if (lane == 0) sNorm[w * 2 + tt] = ss;
    }
    {
        const float dC = sSc[24];
        float vv[8];
#pragma unroll
        for (int s = 0; s < 8; ++s) vv[s] = sV[s * 128 + e];
#pragma unroll
        for (int d4 = 0; d4 < 8; ++d4) {
            f32x4 acc = (f32x4){C[4 * d4], C[4 * d4 + 1], C[4 * d4 + 2], C[4 * d4 + 3]} * dC;
#pragma unroll
            for (int s = 0; s < 8; ++s) acc += *(const LAS f32x4*)(sKW + s * 128 + 32 * q4 + 4 * d4) * vv[s];
            C[4 * d4] = acc.x; C[4 * d4 + 1] = acc.y; C[4 * d4 + 2] = acc.z; C[4 * d4 + 3] = acc.w;
        }
        float* oC = F.out + O_SC + (size_t)bh * HD * HD;
#pragma unroll
        for (int dd = 0; dd < 32; ++dd) oC[(size_t)(32 * q4 + dd) * HD + e] = C[dd];
        if (tid < 128) { float nn = dC * n0;
#pragma unroll
            for (int s = 0; s < 8; ++s) nn += sKW[s * 128 + tid];
            F.out[O_SN + (size_t)bh * HD + tid] = nn; }
        if (tid == 0) F.out[O_SM + bh] = sSc[25];
    }
    __syncthreads();
    const float gn = F.mlstm_g[hd * HD + e];
#pragma unroll
    for (int tt = 0; tt < 2; ++tt) {
        const int t = 2 * q4 + tt; const float tot = sNorm[(w & ~1) * 2 + tt] + sNorm[(w | 1) * 2 + tt];
        const float y = hv[tt] * (1.0f / sqrtf(tot * (1.0f / HD) + EPS)) * gn * sigmoidf_(sOA[t * 128 + e]);
        F.MIX[(size_t)(row0 + t) * D + hd * HD + e] = (bf16_t)f2bf(y);
    }
    __syncthreads();
}
__device__ __forceinline__ void sample_gdn(Frame& F, int b, int hd) {
    LAS float* sQ = (LAS float*)(F.lds); LAS float* sK = sQ + 1024; LAS float* sV = sK + 1024; LAS float* sZ = sV + 1024; LAS float* sKs = sZ + 1024; LAS float* sU = sKs + 1024;
    LAS float* sPartK = sU + 1024;
    LAS float* sPartQ = sPartK + 4096;
    LAS float* sKK = sPartQ + 4096;
    LAS float* sQKr = sKK + 64;
    LAS float* sA = sQKr + 64;
    LAS float* sQKd = sA + 64;
    LAS float* sSc = sQKd + 64;
    LAS float* sNorm = sSc + 64;
    const int tid = F.tid, e = tid & 127, q4 = tid >> 7, lane = F.lane, w = F.wave;
    const int row0 = M_P + b * T_S, bh = b * NH + hd;
    float S[32];
#pragma unroll
    for (int dd = 0; dd < 32; ++dd) S[dd] = F.stS[((size_t)bh * HD + 32 * q4 + dd) * HD + e];
    if (tid < 384) {
        const int arr = tid >> 7, ch = arr * 1024 + hd * HD + e;
        const float* cv = F.stConv + (size_t)b * 3 * CCONV + ch; float h0 = cv[0], h1 = cv[CCONV], h2 = cv[2 * CCONV];
        const float w0 = F.conv_w[ch], w1 = F.conv_w[CCONV + ch], w2 = F.conv_w[2 * CCONV + ch], w3 = F.conv_w[3 * CCONV + ch];
        float u[8];
#pragma unroll
        for (int t = 0; t < 8; ++t) u[t] = bf2f(F.PROJ[(size_t)(row0 + t) * NPROJ + 4096 + ch]);
        LAS float* dst = sQ + arr * 1024 + e;
#pragma unroll
        for (int t = 0; t < 8; ++t) { const float cvv = ((w0 * h0 + w1 * h1) + w2 * h2) + w3 * u[t]; h0 = h1; h1 = h2; h2 = u[t]; dst[t * 128] = siluf_(cvv); }
        float* oc = F.out + O_SCONV + (size_t)b * 3 * CCONV + ch; oc[0] = h0; oc[CCONV] = h1; oc[2 * CCONV] = h2;
    } else {
#pragma unroll
        for (int t = 0; t < 8; ++t) sZ[t * 128 + e] = bf2f(F.PROJ[(size_t)(row0 + t) * NPROJ + 7168 + hd * HD + e]);
    }
    if (w == 0) {
        const int t = lane & 7; const float* gp = F.GATES + (size_t)(row0 + t) * NGATE;
        float G = -expf(F.A_log[hd]) * softplusf_(gp[16 + hd] + F.dt_bias[hd]);
#pragma unroll
        for (int o = 1; o < 8; o <<= 1) { const float x = __shfl_up(G, o); if (t >= o) G += x; }
        if (lane < 8) { sSc[t] = G; sSc[8 + t] = sigmoidf_(gp[24 + hd]); sSc[16 + t] = expf(G); }
    }
    __syncthreads();
    {
        const float q0 = sQ[w * 128 + lane], q1 = sQ[w * 128 + 64 + lane], k0 = sK[w * 128 + lane], k1 = sK[w * 128 + 64 + lane];
        const float sq = wave_sum(q0 * q0 + q1 * q1), sk = wave_sum(k0 * k0 + k1 * k1);
        if (lane == 0) { sSc[24 + w] = 1.0f / sqrtf(sq + EPS); sSc[32 + w] = 1.0f / sqrtf(sk + EPS); }
#pragma unroll
        for (int s = 0; s < 8; ++s) { if (s <= w) { const float ks0 = sK[s * 128 + lane], ks1 = sK[s * 128 + 64 + lane];
                const float dk = wave_sum(k0 * ks0 + k1 * ks1), dq = wave_sum(q0 * ks0 + q1 * ks1); if (lane == 0) { sKK[w * 8 + s] = dk; sQKr[w * 8 + s] = dq; } } }
    }
    {
        float pk[8], pq[8];
#pragma unroll
        for (int t = 0; t < 8; ++t) { pk[t] = 0.f; pq[t] = 0.f; }
#pragma unroll
        for (int d4 = 0; d4 < 8; ++d4)
#pragma unroll
            for (int t = 0; t < 8; ++t) { const f32x4 kv = *(const LAS f32x4*)(sK + t * 128 + 32 * q4 + 4 * d4), qv = *(const LAS f32x4*)(sQ + t * 128 + 32 * q4 + 4 * d4);
                pk[t] += (kv.x * S[4 * d4] + kv.y * S[4 * d4 + 1]) + (kv.z * S[4 * d4 + 2] + kv.w * S[4 * d4 + 3]);
                pq[t] += (qv.x * S[4 * d4] + qv.y * S[4 * d4 + 1]) + (qv.z * S[4 * d4 + 2] + qv.w * S[4 * d4 + 3]); }
#pragma unroll
        for (int t = 0; t < 8; ++t) { sPartK[(q4 * 8 + t) * 128 + e] = pk[t]; sPartQ[(q4 * 8 + t) * 128 + e] = pq[t]; }
    }
    __syncthreads();
    if (w == 0) {
        const int t = lane >> 3, s = lane & 7; const float dec = expf(sSc[t] - sSc[s]);
        sA[lane] = (s < t) ? sSc[8 + t] * dec * sSc[32 + t] * sSc[32 + s] * sKK[lane] : 0.f;
        sQKd[lane] = (s <= t) ? sSc[24 + t] * QK_SCALE * sSc[32 + s] * dec * sQKr[lane] : 0.f;
    }
    {
        const float G7 = sSc[7];
#pragma unroll
        for (int x = 0; x < 2; ++x) { const int idx = tid + 512 * x, s = idx >> 7; sKs[idx] = sK[idx] * (expf(G7 - sSc[s]) * sSc[32 + s]); }
    }
    __syncthreads();
    float ov[8];
    if (tid < 128) {
        float u[8];
#pragma unroll
        for (int t = 0; t < 8; ++t) {
            const float kS = ((sPartK[(0 * 8 + t) * 128 + e] + sPartK[(1 * 8 + t) * 128 + e]) + (sPartK[(2 * 8 + t) * 128 + e] + sPartK[(3 * 8 + t) * 128 + e])) * sSc[32 + t];
            float ut = sSc[8 + t] * (sV[t * 128 + e] - sSc[16 + t] * kS);
#pragma unroll
            for (int s = 0; s < 8; ++s) if (s < t) ut -= sA[t * 8 + s] * u[s];
            u[t] = ut; sU[t * 128 + e] = ut;
            float o = ((sPartQ[(0 * 8 + t) * 128 + e] + sPartQ[(1 * 8 + t) * 128 + e]) + (sPartQ[(2 * 8 + t) * 128 + e] + sPartQ[(3 * 8 + t) * 128 + e])) * (sSc[16 + t] * sSc[24 + t] * QK_SCALE);
#pragma unroll
            for (int s = 0; s < 8; ++s) if (s <= t) o += sQKd[t * 8 + s] * u[s];
            ov[t] = o;
            const float ss = wave_sum(o * o);
            if (lane == 0) sNorm[w * 8 + t] = ss;
        }
    }
    __syncthreads();
    {
        const float gL = sSc[23];
        float uu[8];
#pragma unroll
        for (int s = 0; s < 8; ++s) uu[s] = sU[s * 128 + e];
#pragma unroll
        for (int d4 = 0; d4 < 8; ++d4) {
            f32x4 acc = (f32x4){S[4 * d4], S[4 * d4 + 1], S[4 * d4 + 2], S[4 * d4 + 3]} * gL;
#pragma unroll
            for (int s = 0; s < 8; ++s) acc += *(const LAS f32x4*)(sKs + s * 128 + 32 * q4 + 4 * d4) * uu[s];
            S[4 * d4] = acc.x; S[4 * d4 + 1] = acc.y; S[4 * d4 + 2] = acc.z; S[4 * d4 + 3] = acc.w;
        }
        float* oS = F.out + O_SS + (size_t)bh * HD * HD;
#pragma unroll
        for (int dd = 0; dd < 32; ++dd) oS[(size_t)(32 * q4 + dd) * HD + e] = S[dd];
    }
    if (tid < 128) {
        const float gn = F.gdn_g[hd * HD + e];
#pragma unroll
        for (int t = 0; t < 8; ++t) { const float tot = sNorm[t] + sNorm[8 + t];
            const float y = ov[t] * (1.0f / sqrtf(tot * (1.0f / HD) + EPS)) * gn * siluf_(sZ[t * 128 + e]);
            F.MIX[(size_t)(row0 + t) * D + 1024 + hd * HD + e] = (bf16_t)f2bf(y); }
    }
    __syncthreads();
}

__device__ __forceinline__ void p4_scan_s1(Frame& F) {
    LAS float* scr = (LAS float*)(F.lds + F.wave * 19456);
    if (F.wave >= 4) { const int u = 4 * (int)blockIdx.x + (F.wave - 4); if (u < 1024) s1_mlstm_unit(F, u, scr); }
    else { const int u = 4 * (int)blockIdx.x + F.wave; if (u < 1024) s1_gdn_unit(F, u, scr); }
}
__device__ __forceinline__ void p4_scan_s2(Frame& F) {
    const int w = blockIdx.x;
    if (w < 32) s2_mlstm_chain(F, w);
    else if (w < 64) s2_gdn_chain(F, w - 32);
    else { for (int idx = w - 64; idx < 2048; idx += (int)gridDim.x - 64) { const int mixer = idx >> 10, b = (idx & 1023) >> 3, hd = idx & 7;
            if (mixer == 0) sample_mlstm(F, b, hd); else sample_gdn(F, b, hd); } }
}

#ifndef PROBE_REPEAT
#define PROBE_REPEAT -1
#endif
__device__ __forceinline__ void ph1(Frame& F) { p1_modgemv(F); p1_transposes(F); }
__device__ __forceinline__ void ph2(Frame& F) {
    for (int r = F.gw; r < M; r += F.ngw) { const float* md = F.MOD + (size_t)row_gb(r) * MODW; norm_mod_row_bf16(xrow(F, r), F.norm1, md, md + D, F.HB + (size_t)r * D, F.lane); }
}
__device__ __forceinline__ void ph3(Frame& F) {
    p3_gates(F);
    asm volatile("s_waitcnt vmcnt(0) lgkmcnt(0)" ::: "memory"); __syncthreads();
    pg8::Gemm g{F.HB, F.WIN, M, NPROJ, D}; pg8::StaticOrder S; S.init(M, NPROJ, D, gridDim.x, (int)blockIdx.x);
    pg8::EpiBf16<0> E{F.PROJ, NPROJ};
    pg8::gemm_phase<pg8::EpiBf16<0>, pg8::StaticOrder, true, true>(F.lds + RING_OFF, g, S, E);
}
__device__ __forceinline__ void ph6(Frame& F) {
    pg8::Gemm g{F.MIX, F.WOUT, M, D, D}; pg8::SplitOrder S; S.init(D, (int)blockIdx.x);
    pg8::EpiRes E{F.xp, F.xs, M_P, F.MOD + 2 * D, MODW, F.X1, D, (float*)F.IMGM};
    pg8::gemm_phase<pg8::EpiRes, pg8::SplitOrder, true, true>(F.lds + RING_OFF, g, S, E);
}
__device__ __forceinline__ void combine_slab_row(const Frame& F, int r, const float* base, const float* gate, float* dst) {
    const float* part = (const float*)F.IMGM; const int rp = r - M_P, pmx = rp >> 8, rr = rp & 255;
#pragma unroll
    for (int j = 0; j < 8; ++j) {
        f32x4 s = (f32x4){0.f, 0.f, 0.f, 0.f};
#pragma unroll
        for (int ks = 0; ks < 8; ++ks) s += *(const f32x4*)(part + ((size_t)(ks * 32 + pmx * 8 + j) * 256 + rr) * 256 + 4 * F.lane);
        const f32x4 bs = ((const f32x4*)base)[F.lane + 64 * j], g = ((const f32x4*)gate)[F.lane + 64 * j];
        ((f32x4*)dst)[F.lane + 64 * j] = bs + g * s;
    }
    asm volatile("s_waitcnt vmcnt(0)" ::: "memory");
}
__device__ __forceinline__ void ph7(Frame& F) {
    for (int r = F.gw; r < M; r += F.ngw) {
        if (r >= M_P) combine_slab_row(F, r, xrow(F, r), F.MOD + (size_t)row_gb(r) * MODW + 2 * D, F.X1 + (size_t)r * D); const float* md = F.MOD + (size_t)row_gb(r) * MODW; norm_mod_row_bf16(F.X1 + (size_t)r * D, F.norm2, md + 3 * D, md + 4 * D, F.HB + (size_t)r * D, F.lane); }
}
__device__ __forceinline__ void ph8(Frame& F) {
    pg8::Gemm g{F.HB, F.WUP, M, DFF, D}; pg8::StaticOrder S; S.init(M, DFF, D, gridDim.x, (int)blockIdx.x);
    pg8::EpiBf16<1> E{F.PROJ, DFF};
    pg8::gemm_phase<pg8::EpiBf16<1>, pg8::StaticOrder, true, true>(F.lds + RING_OFF, g, S, E);
}
__device__ __forceinline__ void ph9(Frame& F) {
    pg8::Gemm g{F.PROJ, F.WDOWN, M, D, DFF}; pg8::SplitOrder S; S.init(DFF, (int)blockIdx.x);
    pg8::EpiRes E{F.X1, F.X1, M, F.MOD + 5 * D, MODW, F.out + O_Y, D, (float*)F.IMGM};
    pg8::gemm_phase<pg8::EpiRes, pg8::SplitOrder, true, true>(F.lds + RING_OFF, g, S, E);
}
__device__ __forceinline__ void ph10(Frame& F) {
    for (int r = F.gw; r < M; r += F.ngw) { const float* md = F.MODF + (size_t)row_gb(r) * MODFW; float* yr = F.out + O_Y + (size_t)r * D;
        if (r >= M_P) combine_slab_row(F, r, F.X1 + (size_t)r * D, F.MOD + (size_t)row_gb(r) * MODW + 5 * D, yr);
        norm_mod_row_f32(yr, F.normf, md, md + D, yr, F.lane); }
}

struct Args { const float* in[26]; float* out; unsigned char* ws; int ph_lo, ph_hi; };
constexpr int NPHASE = 11;
__global__ void __launch_bounds__(NTHREADS, 2) fwd_kernel(Args args) {
    extern __shared__ __attribute__((aligned(16))) unsigned char lds[];
    Frame F;
    F.lds = (LAS unsigned char*)lds;
    F.tid = threadIdx.x; F.lane = F.tid & 63; F.wave = __builtin_amdgcn_readfirstlane(F.tid >> 6);
    F.gw = blockIdx.x * NWAVES + F.wave; F.ngw = gridDim.x * NWAVES;
    F.xp = args.in[0]; F.xs = args.in[1]; F.stC = args.in[2]; F.stN = args.in[3]; F.stM = args.in[4]; F.stS = args.in[5]; F.stConv = args.in[6]; F.cp = args.in[7]; F.cs = args.in[8];
    F.ada_w = args.in[9]; F.ada_b = args.in[10]; F.norm1 = args.in[11]; F.w_in = args.in[12]; F.gate_b = args.in[13]; F.mlstm_g = args.in[14]; F.conv_w = args.in[15]; F.A_log = args.in[16];
    F.dt_bias = args.in[17]; F.gdn_g = args.in[18]; F.w_out = args.in[19]; F.norm2 = args.in[20]; F.w_up = args.in[21]; F.w_down = args.in[22]; F.adaf_w = args.in[23]; F.adaf_b = args.in[24]; F.normf = args.in[25];
    F.out = args.out;
    unsigned char* ws = args.ws;
    F.SCB = (bf16_t*)(ws + WS_SCB); F.WIN = (bf16_t*)(ws + WS_WIN); F.WOUT = (bf16_t*)(ws + WS_WOUT); F.WUP = (bf16_t*)(ws + WS_WUP); F.WDOWN = (bf16_t*)(ws + WS_WDOWN);
    F.HB = (bf16_t*)(ws + WS_HB); F.MIX = (bf16_t*)(ws + WS_MIX); F.PROJ = (bf16_t*)(ws + WS_PROJ);
    F.IMGM = ws + WS_IMGM; F.IMGG = ws + WS_IMGG; F.MOD = (float*)(ws + WS_MOD); F.MODF = (float*)(ws + WS_MODF); F.GATES = (float*)(ws + WS_GATES); F.X1 = (float*)(ws + WS_X1);

    for (int u = F.tid; u < (LDS_BYTES - LDSCTL_OFF) / 4; u += NTHREADS) ((LAS unsigned*)(F.lds + LDSCTL_OFF))[u] = 0u;
    __syncthreads();
    XcdBarrier bar; bar.bar = (unsigned*)(ws + WS_CTL) + CW_BAR; bar.x = 0; bar.st = nullptr;
#if MK_ONE_LAUNCH
    bar = xcd_barrier_post((unsigned*)(ws + WS_CTL) + CW_BAR, (volatile LAS unsigned*)(F.lds + MISC_OFF) + 8);
#define GRID_BAR() xcd_barrier(bar)
#else
#define GRID_BAR() do { } while (0)
#endif
    const int lo = args.ph_lo, hi = args.ph_hi;
#define IN(k) (lo <= (k) && (k) < hi)
#define BOTH(k) (IN(k) && IN((k) + 1))

#define RUN(k, body) if (IN(k)) { body; if (PROBE_REPEAT == (k)) { GRID_BAR(); body; } if (BOTH(k)) GRID_BAR(); }
    RUN(0, p0_silu(F))
    RUN(1, ph1(F))
    RUN(2, ph2(F))
    RUN(3, ph3(F))
    RUN(4, p4_scan_s1(F))
    RUN(5, p4_scan_s2(F))
    RUN(6, ph6(F))
    RUN(7, ph7(F))
    RUN(8, ph8(F))
    RUN(9, ph9(F))
    RUN(10, ph10(F))
#undef RUN
#undef IN
#undef BOTH
}

extern "C" void kernel_launch(void* const* d_in, const int* in_sizes, int n_in, void* d_out, int out_size, void* d_ws, size_t ws_size, hipStream_t stream) {
    static int ok = 0;
    if (ok == 0) {
        if (n_in != 26 || (size_t)out_size != O_END || ws_size < WS_END) { fprintf(stderr, "kernel_launch: unexpected shapes: n_in %d out %d ws %zu\n", n_in, out_size, ws_size); ok = -1; return; }
        if (hipFuncSetAttribute((const void*)fwd_kernel, hipFuncAttributeMaxDynamicSharedMemorySize, LDS_BYTES) != hipSuccess) { fprintf(stderr, "kernel_launch: hipFuncSetAttribute failed\n"); ok = -1; return; }
        int dev = 0, cus = 0, per_cu = 0;
        (void)hipGetDevice(&dev); (void)hipDeviceGetAttribute(&cus, hipDeviceAttributeMultiprocessorCount, dev);
        (void)hipOccupancyMaxActiveBlocksPerMultiprocessor(&per_cu, (const void*)fwd_kernel, NTHREADS, LDS_BYTES);
        if (cus != GRID || per_cu < 1) fprintf(stderr, "kernel_launch: note: %d CUs, %d blocks/CU reported; launching %d workgroups\n", cus, per_cu, GRID);
        (void)hipGetLastError();
        ok = 1;
    }
    if (ok < 0) return;
    (void)hipMemsetAsync((char*)d_ws + WS_CTL, 0, CTL_ZERO_BYTES, stream);
    Args a{};
    for (int i = 0; i < 26; ++i) a.in[i] = (const float*)d_in[i];
    a.out = (float*)d_out; a.ws = (unsigned char*)d_ws;
#if MK_ONE_LAUNCH
    a.ph_lo = 0; a.ph_hi = NPHASE;
    hipLaunchKernelGGL(fwd_kernel, dim3(GRID), dim3(NTHREADS), LDS_BYTES, stream, a);
#else
    for (int p = 0; p < NPHASE; ++p) { a.ph_lo = p; a.ph_hi = p + 1; hipLaunchKernelGGL(fwd_kernel, dim3(GRID), dim3(NTHREADS), LDS_BYTES, stream, a); }
#endif
}
```

```cpp
#include <hip/hip_runtime.h>
#include <cstdio>
#include <cstdint>

#define LAS __attribute__((address_space(3)))
#define GAS __attribute__((address_space(1)))
typedef unsigned short bf16_t;
typedef short bf16x8 __attribute__((ext_vector_type(8)));
typedef float f32x4 __attribute__((ext_vector_type(4)));
typedef float f32x2 __attribute__((ext_vector_type(2)));
typedef float f32x16 __attribute__((ext_vector_type(16)));
typedef unsigned u32x4 __attribute__((ext_vector_type(4)));
typedef unsigned u32x2 __attribute__((ext_vector_type(2)));

#ifndef MK_ONE_LAUNCH
#define MK_ONE_LAUNCH 1
#endif

constexpr int D = 2048, T_P = 2048, NB_P = 4, NB_S = 128, T_S = 8;
constexpr int M_P = NB_P * T_P, M_S = NB_S * T_S, M = M_P + M_S;
constexpr int NH = 8, HD = 128;
constexpr int P_IN = 8224, NPROJ = 8192, NGATE = 32, DFF = 8192, CCONV = 3072;
constexpr int NGB = NB_P + NB_S;
constexpr int MODW = 6 * D, MODFW = 2 * D;
constexpr float EPS = 1e-6f;
constexpr int NWAVES = 8, NTHREADS = 512, GRID = 256;

constexpr size_t O_Y = 0;
constexpr size_t O_PC = (size_t)M * D;
constexpr size_t O_PN = O_PC + (size_t)NB_P * NH * HD * HD;
constexpr size_t O_PM = O_PN + (size_t)NB_P * NH * HD;
constexpr size_t O_PS = O_PM + (size_t)NB_P * NH;
constexpr size_t O_PCONV = O_PS + (size_t)NB_P * NH * HD * HD;
constexpr size_t O_SC = O_PCONV + (size_t)NB_P * 3 * CCONV;
constexpr size_t O_SN = O_SC + (size_t)NB_S * NH * HD * HD;
constexpr size_t O_SM = O_SN + (size_t)NB_S * NH * HD;
constexpr size_t O_SS = O_SM + (size_t)NB_S * NH;
constexpr size_t O_SCONV = O_SS + (size_t)NB_S * NH * HD * HD;
constexpr size_t O_END = O_SCONV + (size_t)NB_S * 3 * CCONV;
static_assert(O_END == 54830112, "d_out size");

constexpr size_t MiB = 1u << 20;
constexpr size_t WS_CTL = 0, CTL_ZERO_BYTES = 64 * 1024;
constexpr size_t WS_SCB = 1 * MiB;
constexpr size_t WS_MOD = 2 * MiB;
constexpr size_t WS_MODF = 9 * MiB;
constexpr size_t WS_GATES = 12 * MiB;
constexpr size_t WS_WIN = 16 * MiB;
constexpr size_t WS_WOUT = 49 * MiB;
constexpr size_t WS_WUP = 57 * MiB;
constexpr size_t WS_WDOWN = 89 * MiB;
constexpr size_t WS_HB = 121 * MiB;
constexpr size_t WS_MIX = 157 * MiB;
constexpr size_t WS_X1 = 193 * MiB;
constexpr size_t WS_PROJ = 265 * MiB;
constexpr size_t WS_IMGM = 409 * MiB;
constexpr size_t WS_IMGG = 467 * MiB;
constexpr size_t WS_END = 540 * MiB;
constexpr int MREC = 59392, MR_QI = 0, MR_SP = 16384, MR_KW = 24576, MR_VT = 40960, MR_SC = 57344, MR_DN = 58368;
static_assert(WS_WIN + (size_t)P_IN * D * 2 <= WS_WOUT && WS_PROJ + (size_t)M * NPROJ * 2 <= WS_IMGM && WS_IMGM + (size_t)1024 * MREC <= WS_IMGG && WS_IMGG + (size_t)1024 * 74752 <= WS_END, "ws map");
constexpr int SNAPM = 33280;
static_assert((size_t)1024 * SNAPM <= (size_t)M * D * 2, "snapshots fit in HB");
constexpr int SNAPG = 49152;
static_assert((size_t)1024 * SNAPG <= (size_t)M * D * 4, "GDN snapshots fit in X1");
constexpr int GREC = 74752, GR_QG = 0, GR_WI = 16384, GR_KT = 32768, GR_QK = 49152, GR_SC = 57344, GR_UP = 58368, GDMA_BYTES = 58368;

constexpr int CW_BAR = 1024;

__device__ __forceinline__ unsigned f2bf(float f) { unsigned u = __builtin_bit_cast(unsigned, f); return (u + 0x7fffu + ((u >> 16) & 1u)) >> 16; }
typedef __bf16 bf16x2_t __attribute__((ext_vector_type(2)));
__device__ __forceinline__ unsigned pk2(float lo, float hi) { const f32x2 v = {lo, hi}; return __builtin_bit_cast(unsigned, __builtin_convertvector(v, bf16x2_t)); }
__device__ __forceinline__ float bf2f(bf16_t b) { return __builtin_bit_cast(float, (unsigned)b << 16); }
__device__ __forceinline__ float bflo(unsigned w) { return __builtin_bit_cast(float, w << 16); }
__device__ __forceinline__ float bfhi(unsigned w) { return __builtin_bit_cast(float, w & 0xffff0000u); }
__device__ __forceinline__ float wave_sum(float v) {
#pragma unroll
    for (int o = 1; o < 64; o <<= 1) v += __shfl_xor(v, o);
    return v;
}
template <int CTRL> __device__ __forceinline__ float dpp_mov(float x) { return __builtin_bit_cast(float, __builtin_amdgcn_update_dpp(0, __builtin_bit_cast(int, x), CTRL, 0xf, 0xf, false)); }
__device__ __forceinline__ float quad_sum(float x) { x += dpp_mov<0xB1>(x); x += dpp_mov<0x4E>(x); return x; }
__device__ __forceinline__ float row8_sum(float x) { x = quad_sum(x); x += dpp_mov<0x141>(x); return x; }
__device__ __forceinline__ float row16_sum(float x) { x = row8_sum(x); x += dpp_mov<0x140>(x); return x; }
__device__ __forceinline__ float wave_sum_fast(float x) { x = row16_sum(x); x += __shfl_xor(x, 16); x += __shfl_xor(x, 32); return x; }
__device__ __forceinline__ float sigmoidf_(float x) { return 1.0f / (1.0f + __expf(-x)); }
__device__ __forceinline__ float siluf_(float x) { return x / (1.0f + __expf(-x)); }
__device__ __forceinline__ float softplusf_(float x) { return fmaxf(x, 0.f) + log1pf(__expf(-fabsf(x))); }
__device__ __forceinline__ float logsigmoidf_(float x) { return fminf(x, 0.f) - log1pf(__expf(-fabsf(x))); }
__device__ __forceinline__ int row_gb(int r) { return r < M_P ? (r >> 11) : NB_P + ((r - M_P) >> 3); }
namespace pg8 {
#define PG8_LAS __attribute__((address_space(3)))
constexpr int BM = 256, BK = 64, HALF = 128, HTB = HALF * BK * 2  , STAGE_BYTES = 8 * HTB, NXCD = 8, WGM = 8;

__host__ __device__ __forceinline__ int lds_byte(int r, int c) { const int st = (r >> 4) * 2 + (c >> 5), rr = r & 15, cc = c & 31, ob = rr * 64 + cc * 2; return st * 1024 + (ob ^ (((ob >> 9) & 1) << 5)); }
__host__ __device__ __forceinline__ void stage_rc(int b, int& R, int& C) { const int st = b / 1024, sb = b % 1024, swz = sb ^ (((sb >> 9) & 1) << 5); R = (st >> 1) * 16 + swz / 64; C = (st & 1) * 32 + (swz % 64) / 2; }
__host__ __device__ __forceinline__ int perm32(int rho) { const int n = rho >> 4, i = rho & 15; return 8 * (i >> 2) + 4 * n + (i & 3); }

struct Unit { int pm, pn, k0, nt, part, ks, xt; };
struct Gemm { const bf16_t* A; const bf16_t* Bt; int M, N, K; };

struct StaticOrder {
    int nM, nN, nwg, G, c, ntk;
    __host__ __device__ void init(int M, int N, int K, int G_, int c_) { nM = M / BM; nN = N / BM; nwg = nM * nN; G = G_; c = c_; ntk = K / BK; }
    __host__ __device__ bool next(int i, Unit& u) const {
        const long L = (long)i * G + c; if (L >= nwg) return false;
        int wgid = (int)L; { const int q = nwg / NXCD, r = nwg % NXCD, xcd = wgid % NXCD, off = wgid / NXCD; wgid = (xcd < r ? xcd * (q + 1) : r * (q + 1) + (xcd - r) * q) + off; }
        const int nig = WGM * nN, gid = wgid / nig, fm = gid * WGM, gsz = (nM - fm) < WGM ? (nM - fm) : WGM;
        u.pm = fm + ((wgid % nig) % gsz); u.pn = (wgid % nig) / gsz; u.k0 = 0; u.nt = ntk; u.part = 0; u.ks = 0; u.xt = 0; return true;
    }
    __device__ __forceinline__ void a_ready(const Unit&) const {}
    __device__ __forceinline__ void done(const Unit&) const {}
};
struct SplitOrder {
    int c, ntk;
    __host__ __device__ void init(int K, int c_) { c = c_; ntk = K / BK; }
    __host__ __device__ bool next(int i, Unit& u) const {
        if (i == 0) { const int wgid = (c % NXCD) * 32 + c / NXCD; u.pm = (wgid >> 6) * 8 + (wgid & 7); u.pn = (wgid & 63) >> 3; u.k0 = 0; u.nt = ntk; u.part = 0; u.ks = 0; u.xt = 0; return true; }
        if (i == 1) { const int xt = c >> 3, ks = c & 7; u.pm = 32 + (xt >> 3); u.pn = xt & 7; u.nt = ntk / 8; u.k0 = ks * (ntk / 8) * BK; u.part = 1; u.ks = ks; u.xt = xt; return true; }
        return false;
    }
    __device__ __forceinline__ void a_ready(const Unit&) const {}
    __device__ __forceinline__ void done(const Unit&) const {}
};


__device__ __forceinline__ unsigned cvt_pk_bf16(float lo, float hi) { unsigned r; asm volatile("v_cvt_pk_bf16_f32 %0, %1, %2" : "=v"(r) : "v"(lo), "v"(hi)); return r; }
template <int ACT  > struct EpiBf16 {
    static constexpr bool PERM = true, AFTER_DRAIN = false;
    bf16_t* O; int ldc;
    __device__ __forceinline__ void operator()(const f32x4 (&acc)[2][2][4][2], const Unit& u, int wr, int wc, int fr, int fq) const {
        const int row0 = u.pm * BM + wr * 64 + fr, col0 = u.pn * BM + wc * 32 + 8 * fq;
#pragma unroll
        for (int ai = 0; ai < 2; ++ai)
#pragma unroll
            for (int m = 0; m < 4; ++m) { bf16_t* rowp = O + (size_t)(row0 + ai * HALF + m * 16) * ldc + col0;
#pragma unroll
                for (int bj = 0; bj < 2; ++bj) { f32x4 v0 = acc[ai][bj][m][0], v1 = acc[ai][bj][m][1];
                    if (ACT == 1) {
#pragma unroll
                        for (int q = 0; q < 4; ++q) { const float a = fmaxf(v0[q], 0.f), b = fmaxf(v1[q], 0.f); v0[q] = a * a; v1[q] = b * b; } }
                    u32x4 w; w.x = cvt_pk_bf16(v0[0], v0[1]); w.y = cvt_pk_bf16(v0[2], v0[3]); w.z = cvt_pk_bf16(v1[0], v1[1]); w.w = cvt_pk_bf16(v1[2], v1[3]);
                    *(u32x4*)(rowp + bj * HALF) = w; } }
    }
};
struct EpiRes {
    static constexpr bool PERM = false, AFTER_DRAIN = false;
    const float* base0; const float* base1; int split; const float* gate; int ldg; float* out; int ldc; float* part;
    __device__ __forceinline__ void operator()(const f32x4 (&acc)[2][2][4][2], const Unit& u, int wr, int wc, int fr, int fq) const {
        if (u.part) {
            float* pb = part + ((size_t)(u.ks * 32 + u.xt) * 256 + wr * 64 + fr) * 256 + wc * 32 + 4 * fq;
#pragma unroll
            for (int ai = 0; ai < 2; ++ai)
#pragma unroll
                for (int m = 0; m < 4; ++m)
#pragma unroll
                    for (int bj = 0; bj < 2; ++bj)
#pragma unroll
                        for (int n = 0; n < 2; ++n) *(f32x4*)(pb + (size_t)(ai * HALF + m * 16) * 256 + bj * HALF + n * 16) = acc[ai][bj][m][n];
            return;
        }
        const int row0 = u.pm * BM + wr * 64 + fr, col0 = u.pn * BM + wc * 32 + 4 * fq;
#pragma unroll
        for (int ai = 0; ai < 2; ++ai)
#pragma unroll
            for (int m = 0; m < 4; ++m) { const int r = row0 + ai * HALF + m * 16;
                const float* bp = (r < split ? base0 + (size_t)r * ldc : base1 + (size_t)(r - split) * ldc) + col0;
                const float* gp = gate + (size_t)row_gb(r) * ldg + col0; float* op = out + (size_t)r * ldc + col0;
#pragma unroll
                for (int bj = 0; bj < 2; ++bj)
#pragma unroll
                    for (int n = 0; n < 2; ++n) { const f32x4 bs = *(const f32x4*)(bp + bj * HALF + n * 16), g = *(const f32x4*)(gp + bj * HALF + n * 16);
                        *(f32x4*)(op + bj * HALF + n * 16) = bs + g * acc[ai][bj][m][n]; }
                if (m & 1) asm volatile("" ::: "memory"); }
    }
};
template <class Epi, class Sched, bool ALIGN_EPI = false, bool SP2 = false>
__device__ __forceinline__ void gemm_phase(PG8_LAS unsigned char* lds, const Gemm g, const Sched& S, const Epi& E) {
    const int tid = threadIdx.x, wid = __builtin_amdgcn_readfirstlane(tid >> 6), lane = tid & 63, wr = wid >> 2, wc = wid & 3, fr = lane & 15, fq = lane >> 4;
    const int K = g.K;
    unsigned voffA[2], voffB[2];
#pragma unroll
    for (int i = 0; i < 2; ++i) { int R, C; stage_rc(tid * 16 + i * 8192, R, C); const int Rb = Epi::PERM ? ((R & ~31) + perm32(R & 31)) : R;
        voffA[i] = (unsigned)(R * K + C) * 2u; voffB[i] = (unsigned)(Rb * K + C) * 2u; }
    const size_t kstep = (size_t)(BK * 2);
    const size_t hstep = (size_t)HALF * K * 2;
    const size_t tstep = 2 * hstep;
    const unsigned ldsw = (unsigned)wid * 1024u;
    const int aoff = lds_byte(wr * 64 + fr, fq * 8), boff = lds_byte(wc * 32 + fr, fq * 8);
#define PG8_SA(b, h) (((b) * 2 + (h)) * HTB)
#define PG8_SB(b, h) ((4 + (b) * 2 + (h)) * HTB)
#define PG8_STAGE(bufoff, gbase, voff) do { _Pragma("unroll") for (int _i = 0; _i < 2; ++_i) \
        __builtin_amdgcn_global_load_lds((const unsigned*)((const char*)(gbase) + (voff)[_i]), (PG8_LAS unsigned*)(lds + (bufoff) + ldsw + _i * 8192), 16, 0, 0); } while (0)
#define PG8_LDA(dst, b, h) do { _Pragma("unroll") for (int m = 0; m < 4; ++m) _Pragma("unroll") for (int k = 0; k < 2; ++k) dst[m][k] = *(const PG8_LAS bf16x8*)(lds + PG8_SA(b, h) + aoff + m * 2048 + k * 1024); } while (0)
#define PG8_LDB(dst, b, h) do { _Pragma("unroll") for (int n = 0; n < 2; ++n) _Pragma("unroll") for (int k = 0; k < 2; ++k) dst[n][k] = *(const PG8_LAS bf16x8*)(lds + PG8_SB(b, h) + boff + n * 2048 + k * 1024); } while (0)
#define PG8_MMA(ai, bj, At, Bt) do { __builtin_amdgcn_s_setprio(1); _Pragma("unroll") for (int m = 0; m < 4; ++m) _Pragma("unroll") for (int n = 0; n < 2; ++n) _Pragma("unroll") for (int k = 0; k < 2; ++k) \
        acc[ai][bj][m][n] = __builtin_amdgcn_mfma_f32_16x16x32_bf16(Bt[n][k], At[m][k], acc[ai][bj][m][n], 0, 0, 0); __builtin_amdgcn_s_setprio(0); } while (0)
#define PG8_WAIT_V(n) asm volatile("s_waitcnt vmcnt(" #n ")" ::: "memory")
#define PG8_WAIT_L(n) asm volatile("s_waitcnt lgkmcnt(" #n ")" ::: "memory")
#define PG8_BAR __builtin_amdgcn_s_barrier()
#define PG8_SCHED __builtin_amdgcn_sched_barrier(0)
    Unit cur, nxt; int ui = 0;
    if (!S.next(0, cur)) return;
    f32x4 acc[2][2][4][2];
#pragma unroll
    for (int a = 0; a < 2; ++a)
#pragma unroll
        for (int b = 0; b < 2; ++b)
#pragma unroll
            for (int m = 0; m < 4; ++m)
#pragma unroll
                for (int n = 0; n < 2; ++n) acc[a][b][m][n] = (f32x4){0.f, 0.f, 0.f, 0.f};
    bf16x8 At[4][2], B0[2][2], B1[2][2];
    const char* cA = (const char*)g.A + (size_t)cur.pm * tstep + (size_t)cur.k0 * 2; const char* cB = (const char*)g.Bt + (size_t)cur.pn * tstep + (size_t)cur.k0 * 2;
    S.a_ready(cur);
    if constexpr (SP2) {
        PG8_STAGE(PG8_SB(0, 0), cB, voffB); PG8_STAGE(PG8_SB(0, 1), cB + hstep, voffB); PG8_STAGE(PG8_SA(0, 0), cA, voffA); PG8_STAGE(PG8_SA(0, 1), cA + hstep, voffA);
        if (wr == 1) PG8_BAR;
        PG8_WAIT_V(2); PG8_BAR;
        PG8_STAGE(PG8_SB(1, 0), cB + kstep, voffB); PG8_STAGE(PG8_SA(1, 0), cA + kstep, voffA); PG8_STAGE(PG8_SB(1, 1), cB + hstep + kstep, voffB);
        PG8_WAIT_V(6); PG8_BAR;
    } else {
        PG8_STAGE(PG8_SB(0, 0), cB, voffB); PG8_STAGE(PG8_SA(0, 0), cA, voffA); PG8_STAGE(PG8_SB(0, 1), cB + hstep, voffB); PG8_STAGE(PG8_SA(0, 1), cA + hstep, voffA);
        if (wr == 1) PG8_BAR;
        PG8_WAIT_V(4); PG8_BAR;
        PG8_STAGE(PG8_SB(1, 0), cB + kstep, voffB); PG8_STAGE(PG8_SA(1, 0), cA + kstep, voffA); PG8_STAGE(PG8_SB(1, 1), cB + hstep + kstep, voffB);
        PG8_WAIT_V(6); PG8_BAR;
    }
    for (;;) {
        const bool has_next = S.next(ui + 1, nxt);
        const char* nA = has_next ? (const char*)g.A + (size_t)nxt.pm * tstep + (size_t)nxt.k0 * 2 : cA; const char* nB = has_next ? (const char*)g.Bt + (size_t)nxt.pn * tstep + (size_t)nxt.k0 * 2 : cB;
        const int nt = cur.nt;
        for (int t = 0; t < nt; t += 2) {
            const bool last = (t == nt - 2);
            const char* a1 = cA + (size_t)(t + 1) * kstep;
            const char* a2 = last ? nA : cA + (size_t)(t + 2) * kstep; const char* b2 = last ? nB : cB + (size_t)(t + 2) * kstep;
            const char* a3 = a2 + kstep; const char* b3 = b2 + kstep;
            if (last && has_next) S.a_ready(nxt);
            if constexpr (SP2) {
            PG8_LDB(B0, 0, 0); PG8_LDB(B1, 0, 1); PG8_SCHED; PG8_LDA(At, 0, 0); PG8_STAGE(PG8_SA(1, 1), a1 + hstep, voffA);
            PG8_WAIT_V(8); PG8_WAIT_L(0); PG8_BAR; PG8_MMA(0, 0, At, B0); PG8_MMA(0, 1, At, B1); PG8_BAR; PG8_SCHED;
            PG8_LDA(At, 0, 1); PG8_STAGE(PG8_SB(0, 0), b2, voffB); PG8_STAGE(PG8_SB(0, 1), b2 + hstep, voffB); PG8_STAGE(PG8_SA(0, 0), a2, voffA);
            PG8_WAIT_V(8); PG8_WAIT_L(0); PG8_BAR; PG8_MMA(1, 0, At, B0); PG8_MMA(1, 1, At, B1); PG8_BAR; PG8_SCHED;
            PG8_LDB(B0, 1, 0); PG8_LDB(B1, 1, 1); PG8_SCHED; PG8_LDA(At, 1, 0); PG8_STAGE(PG8_SA(0, 1), a2 + hstep, voffA);
            PG8_WAIT_V(8); PG8_WAIT_L(0); PG8_BAR; PG8_MMA(0, 0, At, B0); PG8_MMA(0, 1, At, B1); PG8_BAR; PG8_SCHED;
            PG8_LDA(At, 1, 1); PG8_STAGE(PG8_SB(1, 0), b3, voffB); PG8_STAGE(PG8_SB(1, 1), b3 + hstep, voffB); PG8_STAGE(PG8_SA(1, 0), a3, voffA);
            PG8_WAIT_V(8); PG8_WAIT_L(0); PG8_BAR; PG8_MMA(1, 0, At, B0); PG8_MMA(1, 1, At, B1); PG8_BAR; PG8_SCHED;
            } else {
            PG8_LDB(B0, 0, 0); PG8_SCHED; PG8_LDA(At, 0, 0); PG8_STAGE(PG8_SA(1, 1), a1 + hstep, voffA);
            PG8_WAIT_L(8); PG8_BAR; PG8_WAIT_L(0); PG8_MMA(0, 0, At, B0); PG8_BAR; PG8_SCHED;
            PG8_LDB(B1, 0, 1); PG8_STAGE(PG8_SB(0, 0), b2, voffB);
            PG8_BAR; PG8_WAIT_L(0); PG8_MMA(0, 1, At, B1); PG8_BAR;
            PG8_LDA(At, 0, 1); PG8_STAGE(PG8_SA(0, 0), a2, voffA);
            PG8_BAR; PG8_WAIT_L(0); PG8_MMA(1, 0, At, B0); PG8_BAR; PG8_SCHED;
            PG8_STAGE(PG8_SB(0, 1), b2 + hstep, voffB);
            PG8_WAIT_V(6); PG8_BAR; PG8_MMA(1, 1, At, B1); PG8_BAR;
            PG8_LDB(B0, 1, 0); PG8_SCHED; PG8_LDA(At, 1, 0); PG8_STAGE(PG8_SA(0, 1), a2 + hstep, voffA);
            PG8_WAIT_L(8); PG8_BAR; PG8_WAIT_L(0); PG8_MMA(0, 0, At, B0); PG8_BAR; PG8_SCHED;
            PG8_LDB(B1, 1, 1); PG8_STAGE(PG8_SB(1, 0), b3, voffB);
            PG8_BAR; PG8_WAIT_L(0); PG8_MMA(0, 1, At, B1); PG8_BAR;
            PG8_LDA(At, 1, 1); PG8_STAGE(PG8_SA(1, 0), a3, voffA);
            PG8_BAR; PG8_WAIT_L(0); PG8_MMA(1, 0, At, B0); PG8_BAR; PG8_SCHED;
            PG8_STAGE(PG8_SB(1, 1), b3 + hstep, voffB);
            PG8_WAIT_V(6); PG8_BAR; PG8_MMA(1, 1, At, B1); PG8_BAR;
            }
        }
        if constexpr (ALIGN_EPI) { if (wr == 0) PG8_BAR; }
        if constexpr (!Epi::AFTER_DRAIN) { E(acc, cur, wr, wc, fr, fq); S.done(cur); }
        if (!has_next) break;
#pragma unroll
        for (int a = 0; a < 2; ++a)
#pragma unroll
            for (int b = 0; b < 2; ++b)
#pragma unroll
                for (int m = 0; m < 4; ++m)
#pragma unroll
                    for (int n = 0; n < 2; ++n) acc[a][b][m][n] = (f32x4){0.f, 0.f, 0.f, 0.f};
        cur = nxt; cA = nA; cB = nB; ++ui;
        if constexpr (ALIGN_EPI) { if (wr == 1) PG8_BAR; }
    }
    PG8_WAIT_V(0);
    if constexpr (!ALIGN_EPI) { if (wr == 0) PG8_BAR; }
    PG8_BAR;
    if constexpr (Epi::AFTER_DRAIN) { E.fused(acc, cur, wr, wc, fr, fq, lds, wid, lane); S.done(cur); }
#undef PG8_SA
#undef PG8_SB
#undef PG8_STAGE
#undef PG8_LDA
#undef PG8_LDB
#undef PG8_MMA
#undef PG8_WAIT_V
#undef PG8_WAIT_L
#undef PG8_BAR
#undef PG8_SCHED
}
}

constexpr int RING_OFF = 0, RING_BYTES = 131072;
constexpr int LDS_BYTES = 163840;
constexpr int LDSCTL_OFF = LDS_BYTES - 512, MISC_OFF = LDSCTL_OFF + 320;
static_assert(8 * 19456 <= LDSCTL_OFF, "S1 per-wave scratch");

typedef GAS unsigned gu32;
#define RLX_AGENT __ATOMIC_RELAXED, __HIP_MEMORY_SCOPE_AGENT
#define LDS_WAIT() asm volatile("s_waitcnt lgkmcnt(0)" ::: "memory")
#define VM_WAIT() asm volatile("s_waitcnt vmcnt(0)" ::: "memory")

#define XB_TMO      128
#define XB_XCNT(j)  (256  + 64 * (j))
#define XB_XSUB(j)  (1280 + 64 * (j))
#define XB_XGEN(j)  (2304 + 64 * (j))
#define XB_TOP      3328
#define XB_TOPGEN   3392
#define XCD_BAR_WORDS 3456
#define XB_SPIN_CAP (1u << 18)
__device__ __forceinline__ unsigned xb_ld(unsigned* p)              { return __hip_atomic_load(p, __ATOMIC_RELAXED, __HIP_MEMORY_SCOPE_AGENT); }
__device__ __forceinline__ unsigned xb_add(unsigned* p, unsigned v) { return __hip_atomic_fetch_add(p, v, __ATOMIC_RELAXED, __HIP_MEMORY_SCOPE_AGENT); }
__device__ __forceinline__ unsigned xb_xcc_id() { return (unsigned)__builtin_amdgcn_s_getreg((3 << 11) | 20) & 0xFu; }
#define XB_SPIN(cond, bar) do { unsigned _sp = 0; while (cond) { __builtin_amdgcn_s_sleep(1); \
    if ((++_sp & 255u) == 0u) { if (xb_ld(&(bar)[XB_TMO])) break; if (_sp > XB_SPIN_CAP) { atomicAdd(&(bar)[XB_TMO], 1u); break; } } } } while (0)
struct XcdBarrier { unsigned* bar; unsigned x; volatile LAS unsigned* st; };
__device__ __forceinline__ XcdBarrier xcd_barrier_post(unsigned* bar, volatile LAS unsigned* st) {
    XcdBarrier b; b.bar = bar; b.x = xb_xcc_id(); b.st = st;
    if (threadIdx.x == 0) (void)xb_add(&bar[XB_XCNT(b.x)], 1u);
    return b;
}
__device__ __forceinline__ void xcd_barrier_complete(unsigned* bar, unsigned x, unsigned& nloc, unsigned& nx) {
    const unsigned G = gridDim.x * gridDim.y * gridDim.z;
    unsigned sum, cnt, mine, sp = 0u;
    for (;;) {
        sum = 0u; cnt = 0u; mine = 0u;
#pragma unroll
        for (unsigned j = 0; j < 16; ++j) { const unsigned c = xb_ld(&bar[XB_XCNT(j)]); sum += c; cnt += (c > 0u) ? 1u : 0u; mine = (j == x) ? c : mine; }
        if (sum == G) break;
        __builtin_amdgcn_s_sleep(1);
        if ((++sp & 255u) == 0u) { if (xb_ld(&bar[XB_TMO])) break; if (sp > XB_SPIN_CAP) { atomicAdd(&bar[XB_TMO], 1u); break; } }
    }
    nloc = mine > 0u ? mine : 1u; nx = cnt > 0u ? cnt : 1u;
}
__device__ __forceinline__ void xcd_barrier(const XcdBarrier& b) {
    asm volatile("s_waitcnt vmcnt(0)" ::: "memory");
    __syncthreads();
    if (threadIdx.x == 0) {
        unsigned* bar = b.bar;
        __builtin_amdgcn_s_waitcnt(0);
        unsigned nloc = b.st[0], nx = b.st[1];
        if (nloc == 0u) { xcd_barrier_complete(bar, b.x, nloc, nx); b.st[0] = nloc; b.st[1] = nx; }
        const unsigned old = xb_add(&bar[XB_XSUB(b.x)], 1u);
        const unsigned gen = old / nloc;
        if (old + 1u == (gen + 1u) * nloc) {
            __builtin_amdgcn_fence(__ATOMIC_RELEASE, "agent");
            asm volatile("s_waitcnt vmcnt(0)" ::: "memory");
            const unsigned og = xb_add(&bar[XB_TOP], 1u);
            const unsigned tg = og / nx;
            if (og + 1u == (tg + 1u) * nx) xb_add(&bar[XB_TOPGEN], 1u);
            else XB_SPIN(xb_ld(&bar[XB_TOPGEN]) == tg, bar);
            __builtin_amdgcn_fence(__ATOMIC_ACQUIRE, "agent");
            xb_add(&bar[XB_XGEN(b.x)], 1u);
            asm volatile("s_waitcnt vmcnt(0)" ::: "memory");
        } else {
            XB_SPIN(xb_ld(&bar[XB_XGEN(b.x)]) == gen, bar);
            __builtin_amdgcn_fence(__ATOMIC_ACQUIRE, "agent");
            asm volatile("s_waitcnt vmcnt(0)" ::: "memory");
        }
    }
    __syncthreads();
}

struct Frame {
    LAS unsigned char* lds;
    int tid, lane, wave, gw, ngw;
    const float *xp, *xs, *stC, *stN, *stM, *stS, *stConv, *cp, *cs, *ada_w, *ada_b, *norm1, *w_in, *gate_b, *mlstm_g, *conv_w, *A_log, *dt_bias, *gdn_g,
                *w_out, *norm2, *w_up, *w_down, *adaf_w, *adaf_b, *normf;
    float* out;
    bf16_t *SCB, *WIN, *WOUT, *WUP, *WDOWN, *HB, *MIX, *PROJ;
    float *MOD, *MODF, *GATES, *X1;
    unsigned char* IMGM; unsigned char* IMGG;
};
__device__ __forceinline__ const float* xrow(const Frame& F, int r) { return r < M_P ? F.xp + (size_t)r * D : F.xs + (size_t)(r - M_P) * D; }

__device__ __forceinline__ void p0_silu(Frame& F) {
    const int gt = blockIdx.x * NTHREADS + F.tid, GT = gridDim.x * NTHREADS;
    for (int g = gt; g < 160 * 256; g += GT) {
        const int row = g >> 8, c8 = (g & 255) * 8; u32x4 o = (u32x4){0u, 0u, 0u, 0u};
        if (row < NGB) { const float* src = (row < NB_P ? F.cp + (size_t)row * D : F.cs + (size_t)(row - NB_P) * D) + c8;
            const f32x4 a = *(const f32x4*)src, b = *(const f32x4*)(src + 4);
            o.x = pk2(siluf_(a.x), siluf_(a.y)); o.y = pk2(siluf_(a.z), siluf_(a.w)); o.z = pk2(siluf_(b.x), siluf_(b.y)); o.w = pk2(siluf_(b.z), siluf_(b.w)); }
        *(u32x4*)(F.SCB + (size_t)row * D + c8) = o;
    }
}

__device__ __forceinline__ void p1_modgemv(Frame& F) {
    LAS float* red = (LAS float*)(F.lds + RING_OFF);
    const int lane = F.lane, r = lane & 31, hh = lane >> 5, cbi = F.wave >> 2, ks = F.wave & 3;
    for (int pair = blockIdx.x; pair < 256; pair += gridDim.x) {
        const int cb = 2 * pair + cbi;
        const float* W; const float* bias; float* outp; int ldw, n0;
        if (cb < 384) { W = F.ada_w; ldw = MODW; n0 = cb * 32; bias = F.ada_b; outp = F.MOD; }
        else { W = F.adaf_w; ldw = MODFW; n0 = (cb - 384) * 32; bias = F.adaf_b; outp = F.MODF; }
        f32x16 acc[5];
#pragma unroll
        for (int g = 0; g < 5; ++g)
#pragma unroll
            for (int i = 0; i < 16; ++i) acc[g][i] = 0.f;
        const float* wp = W + (size_t)(ks * 512 + 8 * hh) * ldw + n0 + r;
        const bf16_t* ap = F.SCB + (size_t)r * D + ks * 512 + 8 * hh;
        for (int s = 0; s < 32; s += 4) {
            float wv[4][8];
#pragma unroll
            for (int u = 0; u < 4; ++u)
#pragma unroll
                for (int j = 0; j < 8; ++j) wv[u][j] = wp[(size_t)((s + u) * 16 + j) * ldw];
#pragma unroll
            for (int u = 0; u < 4; ++u) {
                u32x4 bw; bw.x = pk2(wv[u][0], wv[u][1]); bw.y = pk2(wv[u][2], wv[u][3]); bw.z = pk2(wv[u][4], wv[u][5]); bw.w = pk2(wv[u][6], wv[u][7]);
                const bf16x8 b = __builtin_bit_cast(bf16x8, bw);
#pragma unroll
                for (int g = 0; g < 5; ++g) { const bf16x8 a = *(const bf16x8*)(ap + (size_t)g * 32 * D + (s + u) * 16);
                    acc[g] = __builtin_amdgcn_mfma_f32_32x32x16_bf16(a, b, acc[g], 0, 0, 0); }
            }
        }
        if (ks > 0) {
#pragma unroll
            for (int g = 0; g < 5; ++g)
#pragma unroll
                for (int i = 0; i < 16; ++i) red[(((ks - 1) * 2 + cbi) * 80 + g * 16 + i) * 64 + lane] = acc[g][i];
        }
        __syncthreads();
        if (ks == 0) {
            const float bv = bias[n0 + r];
#pragma unroll
            for (int g = 0; g < 5; ++g)
#pragma unroll
                for (int i = 0; i < 16; ++i) {
                    float v = acc[g][i];
#pragma unroll
                    for (int k2 = 0; k2 < 3; ++k2) v += red[((k2 * 2 + cbi) * 80 + g * 16 + i) * 64 + lane];
                    const int gb = 32 * g + (i & 3) + 8 * (i >> 2) + 4 * hh;
                    if (gb < NGB) outp[(size_t)gb * ldw + n0 + r] = v + bv;
                }
        }
        __syncthreads();
    }
}

__device__ __forceinline__ int win_dst_row(int n) {
    if (n < 3072) return n;
    if (n < 3088) return 8192 + (n - 3072);
    if (n < 7184) return n - 16;
    if (n < 7200) return 8208 + (n - 7184);
    return n - 32;
}
struct TrItem { const float* W; bf16_t* WT; int K, N, k0, n0, mapwin; };
__device__ __forceinline__ TrItem tr_decode(const Frame& F, int it) {
    constexpr int I_IN = (D / 64) * (P_IN / 32), I_OUT = (D / 64) * (D / 32), I_UP = (D / 64) * (DFF / 32);
    TrItem t; int r = it;
    if (r < I_IN) { t.W = F.w_in; t.WT = F.WIN; t.K = D; t.N = P_IN; t.mapwin = 1; }
    else if ((r -= I_IN) < I_OUT) { t.W = F.w_out; t.WT = F.WOUT; t.K = D; t.N = D; t.mapwin = 0; }
    else if ((r -= I_OUT) < I_UP) { t.W = F.w_up; t.WT = F.WUP; t.K = D; t.N = DFF; t.mapwin = 0; }
    else { r -= I_UP; t.W = F.w_down; t.WT = F.WDOWN; t.K = DFF; t.N = D; t.mapwin = 0; }
    const int nblk = t.N / 32; t.k0 = 64 * (r / nblk); t.n0 = 32 * (r % nblk);
    return t;
}
__device__ __forceinline__ void p1_transposes(Frame& F) {
    LAS float* scr = (LAS float*)(F.lds + RING_OFF + F.wave * 16384);
    constexpr int NITEMS = (D / 64) * (P_IN / 32) + (D / 64) * (D / 32) + (D / 64) * (DFF / 32) + (DFF / 64) * (D / 32);
    const int lane = F.lane;
    int it = F.gw;
    if (it >= NITEMS) return;
    TrItem cur = tr_decode(F, it);
    float v[32];
#pragma unroll
    for (int i = 0; i < 32; ++i) v[i] = cur.W[(size_t)(cur.k0 + 2 * i + (lane >> 5)) * cur.N + cur.n0 + (lane & 31)];
    for (;;) {
#pragma unroll
        for (int i = 0; i < 32; ++i) scr[(2 * i + (lane >> 5)) * 33 + (lane & 31)] = v[i];
        const int nit = it + F.ngw; const bool more = nit < NITEMS;
        TrItem nx = cur;
        if (more) { nx = tr_decode(F, nit);
#pragma unroll
            for (int i = 0; i < 32; ++i) v[i] = nx.W[(size_t)(nx.k0 + 2 * i + (lane >> 5)) * nx.N + nx.n0 + (lane & 31)]; }
        LDS_WAIT(); asm volatile("" ::: "memory");
        const int c = lane & 7;
#pragma unroll
        for (int j = 0; j < 4; ++j) { const int n = (lane >> 3) + 8 * j; const LAS float* s = scr + (8 * c) * 33 + n;
            u32x4 o; o.x = pk2(s[0 * 33], s[1 * 33]); o.y = pk2(s[2 * 33], s[3 * 33]); o.z = pk2(s[4 * 33], s[5 * 33]); o.w = pk2(s[6 * 33], s[7 * 33]);
            const int dr = cur.mapwin ? win_dst_row(cur.n0 + n) : (cur.n0 + n);
            *(u32x4*)(cur.WT + (size_t)dr * cur.K + cur.k0 + 8 * c) = o; }
        LDS_WAIT(); asm volatile("" ::: "memory");
        if (!more) break;
        cur = nx; it = nit;
    }
}

__device__ __forceinline__ void norm_mod_row_bf16(const float* xr_, const float* g, const float* shift, const float* scale, bf16_t* orow, int lane) {
    const f32x4* xr = (const f32x4*)xr_ + lane;
    f32x4 v[8]; float s = 0.f;
#pragma unroll
    for (int j = 0; j < 8; ++j) { v[j] = xr[64 * j]; s += (v[j].x * v[j].x + v[j].y * v[j].y) + (v[j].z * v[j].z + v[j].w * v[j].w); }
    const float rstd = 1.0f / sqrtf(wave_sum(s) * (1.0f / D) + EPS);
    u32x2* o8 = (u32x2*)orow + lane;
#pragma unroll
    for (int j = 0; j < 8; ++j) { const f32x4 gg = ((const f32x4*)g)[lane + 64 * j], sh = ((const f32x4*)shift)[lane + 64 * j], sc = ((const f32x4*)scale)[lane + 64 * j];
        const f32x4 y = (v[j] * rstd * gg) * (sc + 1.0f) + sh; u32x2 w; w.x = pk2(y.x, y.y); w.y = pk2(y.z, y.w); o8[64 * j] = w; }
}
__device__ __forceinline__ void norm_mod_row_f32(const float* xr_, const float* g, const float* shift, const float* scale, float* orow, int lane) {
    const f32x4* xr = (const f32x4*)xr_ + lane;
    f32x4 v[8]; float s = 0.f;
#pragma unroll
    for (int j = 0; j < 8; ++j) { v[j] = xr[64 * j]; s += (v[j].x * v[j].x + v[j].y * v[j].y) + (v[j].z * v[j].z + v[j].w * v[j].w); }
    const float rstd = 1.0f / sqrtf(wave_sum(s) * (1.0f / D) + EPS);
    f32x4* o = (f32x4*)orow + lane;
#pragma unroll
    for (int j = 0; j < 8; ++j) { const f32x4 gg = ((const f32x4*)g)[lane + 64 * j], sh = ((const f32x4*)shift)[lane + 64 * j], sc = ((const f32x4*)scale)[lane + 64 * j];
        o[64 * j] = (v[j] * rstd * gg) * (sc + 1.0f) + sh; }
}

__device__ __forceinline__ void p3_gates(Frame& F) {
    const int lane = F.lane, fr = lane & 15, fq = lane >> 4, w = F.wave;
    LAS f32x4* red = (LAS f32x4*)(F.lds + RING_OFF);
    for (int chunk = blockIdx.x; chunk < M / 16; chunk += gridDim.x) {
        const int r0 = chunk * 16;
        const bf16_t* ap = F.HB + (size_t)(r0 + fr) * D + 256 * w + 8 * fq;
        const bf16_t* bp = F.WIN + (size_t)(NPROJ + fr) * D + 256 * w + 8 * fq;
        bf16x8 a[8], b0[8], b1[8];
#pragma unroll
        for (int k = 0; k < 8; ++k) { a[k] = *(const bf16x8*)(ap + 32 * k); b0[k] = *(const bf16x8*)(bp + 32 * k); b1[k] = *(const bf16x8*)(bp + (size_t)16 * D + 32 * k); }
        f32x4 c0 = (f32x4){0.f, 0.f, 0.f, 0.f}, c1 = c0;
#pragma unroll
        for (int k = 0; k < 8; ++k) { c0 = __builtin_amdgcn_mfma_f32_16x16x32_bf16(a[k], b0[k], c0, 0, 0, 0); c1 = __builtin_amdgcn_mfma_f32_16x16x32_bf16(a[k], b1[k], c1, 0, 0, 0); }
        red[(w * 2 + 0) * 64 + lane] = c0; red[(w * 2 + 1) * 64 + lane] = c1;
        __syncthreads();
        if (w < 2) {
            f32x4 s = (f32x4){0.f, 0.f, 0.f, 0.f};
#pragma unroll
            for (int ww = 0; ww < 8; ++ww) s += red[(ww * 2 + w) * 64 + lane];
#pragma unroll
            for (int i = 0; i < 4; ++i) F.GATES[(size_t)(r0 + 4 * fq + i) * NGATE + 16 * w + fr] = s[i];
        }
        __syncthreads();
    }
}

__device__ __forceinline__ void scan_mlstm_simple(Frame& F, bool prompt, int b, int hd) {
    LAS float* sq = (LAS float*)(F.lds + RING_OFF); LAS float* sk = sq + 128; LAS float* sv = sk + 128; LAS float* spart = sv + 128; LAS float* sred = spart + 512; LAS float* sred2 = sred + 8;
    const int tid = F.tid, e = tid & 127, q4 = tid >> 7, lane = F.lane, wave = F.wave;
    const int T = prompt ? T_P : T_S, row0 = prompt ? b * T_P : M_P + b * T_S, bh = b * NH + hd;
    float C[32]; float nst = 0.f, m = 0.f;
    if (prompt) {
#pragma unroll
        for (int dd = 0; dd < 32; ++dd) C[dd] = 0.f;
    } else {
#pragma unroll
        for (int dd = 0; dd < 32; ++dd) C[dd] = F.stC[((size_t)bh * HD + 32 * q4 + dd) * HD + e];
        if (tid < 128) nst = F.stN[(size_t)bh * HD + tid];
        m = F.stM[bh];
    }
    const float bi = F.gate_b[hd], bfg = F.gate_b[NH + hd], gn = F.mlstm_g[hd * HD + e];
    for (int t = 0; t < T; ++t) {
        const int row = row0 + t; const bf16_t* pr = F.PROJ + (size_t)row * NPROJ + hd * HD;
        float oa = 0.f;
        if (tid < 128) { sq[tid] = bf2f(pr[tid]); sk[tid] = bf2f(pr[1024 + tid]) * 0.08838834764831845f; sv[tid] = bf2f(pr[2048 + tid]); oa = bf2f(pr[3072 + tid]); }
        const float ia = F.GATES[(size_t)row * NGATE + hd], fa = F.GATES[(size_t)row * NGATE + 8 + hd];
        __syncthreads();
        const float li = ia + bi, lf = logsigmoidf_(fa + bfg);
        const float mn = fmaxf(lf + m, li), fdec = expf(lf + m - mn), iin = expf(li - mn); m = mn;
        const float ve = sv[e]; float part = 0.f;
#pragma unroll
        for (int dd = 0; dd < 32; ++dd) { const int d = 32 * q4 + dd; C[dd] = fdec * C[dd] + (iin * sk[d]) * ve; part += sq[d] * C[dd]; }
        spart[q4 * 128 + e] = part;
        if (tid < 128) { nst = fdec * nst + iin * sk[tid]; const float pn = wave_sum(sq[tid] * nst); if (lane == 0) sred[wave] = pn; }
        __syncthreads();
        const float numer = (spart[e] + spart[128 + e]) + (spart[256 + e] + spart[384 + e]);
        const float ddn = sred[0] + sred[1];
        const float hval = numer / fmaxf(fabsf(ddn), expf(-m));
        const float ss = wave_sum(hval * hval);
        if (lane == 0) sred2[wave] = ss;
        __syncthreads();
        const float tot = sred2[wave] + sred2[wave ^ 1];
        if (tid < 128) { const float y = hval * (1.0f / sqrtf(tot * (1.0f / HD) + EPS)) * gn * sigmoidf_(oa); F.MIX[(size_t)row * D + hd * HD + e] = (bf16_t)f2bf(y); }
    }
    float* oC = F.out + (prompt ? O_PC : O_SC) + (size_t)bh * HD * HD;
#pragma unroll
    for (int dd = 0; dd < 32; ++dd) oC[(size_t)(32 * q4 + dd) * HD + e] = C[dd];
    if (tid < 128) F.out[(prompt ? O_PN : O_SN) + (size_t)bh * HD + tid] = nst;
    if (tid == 0) F.out[(prompt ? O_PM : O_SM) + bh] = m;
    __syncthreads();
}
__device__ __forceinline__ void scan_gdn_simple(Frame& F, bool prompt, int b, int hd) {
    LAS float* sq = (LAS float*)(F.lds + RING_OFF); LAS float* sk = sq + 128; LAS float* sv = sk + 128; LAS float* spart = sv + 128; LAS float* spart2 = spart + 512; LAS float* sred = spart2 + 512; LAS float* sred2 = sred + 8;
    const int tid = F.tid, e = tid & 127, q4 = tid >> 7, lane = F.lane, wave = F.wave;
    const int T = prompt ? T_P : T_S, row0 = prompt ? b * T_P : M_P + b * T_S, bh = b * NH + hd;
    float S[32];
    if (prompt) {
#pragma unroll
        for (int dd = 0; dd < 32; ++dd) S[dd] = 0.f;
    } else {
#pragma unroll
        for (int dd = 0; dd < 32; ++dd) S[dd] = F.stS[((size_t)bh * HD + 32 * q4 + dd) * HD + e];
    }
    const int cch = (q4 < 3 ? q4 : 0) * 1024 + hd * HD + e;
    float h0 = 0.f, h1 = 0.f, h2 = 0.f;
    if (!prompt && q4 < 3) { const float* cv = F.stConv + (size_t)b * 3 * CCONV + cch; h0 = cv[0]; h1 = cv[CCONV]; h2 = cv[2 * CCONV]; }
    const float w0 = F.conv_w[cch], w1 = F.conv_w[CCONV + cch], w2 = F.conv_w[2 * CCONV + cch], w3 = F.conv_w[3 * CCONV + cch];
    const float negA = -expf(F.A_log[hd]), dtb = F.dt_bias[hd], gn = F.gdn_g[hd * HD + e];
    for (int t = 0; t < T; ++t) {
        const int row = row0 + t; const bf16_t* pr = F.PROJ + (size_t)row * NPROJ + 4096;
        float a = 0.f, zb = 0.f;
        if (q4 < 3) { const float u = bf2f(pr[cch]); const float cvv = w0 * h0 + w1 * h1 + w2 * h2 + w3 * u; h0 = h1; h1 = h2; h2 = u; a = siluf_(cvv); }
        if (q4 == 0) zb = bf2f(pr[3072 + hd * HD + e]);
        if (q4 < 2) { const float ss = wave_sum(a * a); if (lane == 0) sred[wave] = ss; }
        if (q4 == 2) sv[e] = a;
        const float ab = F.GATES[(size_t)row * NGATE + 16 + hd], bb = F.GATES[(size_t)row * NGATE + 24 + hd];
        __syncthreads();
        if (q4 == 0) sq[e] = a * (1.0f / sqrtf(sred[0] + sred[1] + EPS)) * 0.08838834764831845f;
        if (q4 == 1) sk[e] = a * (1.0f / sqrtf(sred[2] + sred[3] + EPS));
        __syncthreads();
        const float g = expf(negA * softplusf_(ab + dtb)), beta = sigmoidf_(bb);
        float part = 0.f;
#pragma unroll
        for (int dd = 0; dd < 32; ++dd) part += sk[32 * q4 + dd] * S[dd];
        spart[q4 * 128 + e] = part;
        __syncthreads();
        const float kS = (spart[e] + spart[128 + e]) + (spart[256 + e] + spart[384 + e]);
        const float ue = beta * (sv[e] - g * kS);
        float opart = 0.f;
#pragma unroll
        for (int dd = 0; dd < 32; ++dd) { const int d = 32 * q4 + dd; S[dd] = g * S[dd] + sk[d] * ue; opart += sq[d] * S[dd]; }
        spart2[q4 * 128 + e] = opart;
        __syncthreads();
        const float o = (spart2[e] + spart2[128 + e]) + (spart2[256 + e] + spart2[384 + e]);
        const float ss2 = wave_sum(o * o);
        if (lane == 0) sred2[wave] = ss2;
        __syncthreads();
        const float tot = sred2[wave] + sred2[wave ^ 1];
        if (q4 == 0) { const float y = o * (1.0f / sqrtf(tot * (1.0f / HD) + EPS)) * gn * siluf_(zb); F.MIX[(size_t)row * D + 1024 + hd * HD + e] = (bf16_t)f2bf(y); }
    }
    float* oS = F.out + (prompt ? O_PS : O_SS) + (size_t)bh * HD * HD;
#pragma unroll
    for (int dd = 0; dd < 32; ++dd) oS[(size_t)(32 * q4 + dd) * HD + e] = S[dd];
    if (q4 < 3) { float* oc = F.out + (prompt ? O_PCONV : O_SCONV) + (size_t)b * 3 * CCONV + cch; oc[0] = h0; oc[CCONV] = h1; oc[2 * CCONV] = h2; }
    __syncthreads();
}

__device__ __forceinline__ float wave_scan_add(float v, int lane) {
#pragma unroll
    for (int o = 1; o < 64; o <<= 1) { const float t = __shfl_up(v, o); if (lane >= o) v += t; }
    return v;
}
__device__ __forceinline__ float wave_scan_max(float v, int lane) {
#pragma unroll
    for (int o = 1; o < 64; o <<= 1) { const float t = __shfl_up(v, o); if (lane >= o) v = fmaxf(v, t); }
    return v;
}
__device__ __forceinline__ float wave_max(float v) {
#pragma unroll
    for (int o = 1; o < 64; o <<= 1) v = fmaxf(v, __shfl_xor(v, o));
    return v;
}
#define QK_SCALE 0.08838834764831845f
__device__ __forceinline__ void s1_mlstm_unit(Frame& F, int unit, LAS float* scr) {
    const int lane = F.lane, r = lane & 31, h = lane >> 5;
    const int c = unit & 31, bh = unit >> 5, hd = bh & 7, b = bh >> 3;
    const int rowb = b * T_P, row0 = rowb + 64 * c;
    unsigned char* rec = F.IMGM + (size_t)unit * MREC;
    const float bi = F.gate_b[hd], bfg = F.gate_b[NH + hd];
    LAS float* const scs = scr + 4096;
    float m_prev = 0.f;
    {
        float pb = 0.f, pa = 0.f;
        for (int c4 = 0; c4 < c; c4 += 4) {
            float lfv[4], liv[4];
#pragma unroll
            for (int x = 0; x < 4; ++x) { const int cc = (c4 + x < c) ? c4 + x : c4; const float* gp = F.GATES + (size_t)(rowb + 64 * cc + lane) * NGATE; lfv[x] = gp[8 + hd]; liv[x] = gp[hd]; }
#pragma unroll
            for (int x = 0; x < 4; ++x) { const float lf = logsigmoidf_(lfv[x] + bfg), li = liv[x] + bi;
                const float bb = wave_scan_add(lf, lane); const float amax = wave_max(li - bb); const float b63 = __shfl(bb, 63);
                if (lane == c4 + x) { pb = b63; pa = amax; } }
        }
        for (int cc = 0; cc < c; ++cc) m_prev = __shfl(pb, cc) + fmaxf(m_prev, __shfl(pa, cc));
    }
    float* sc = (float*)(rec + MR_SC);
    {
        const float* gp = F.GATES + (size_t)(row0 + lane) * NGATE;
        const float lfv = logsigmoidf_(gp[8 + hd] + bfg), liv = gp[hd] + bi;
        const float bb = wave_scan_add(lfv, lane); const float a = liv - bb; const float cm = wave_scan_max(a, lane);
        const float Mi = fmaxf(m_prev, cm), mi = bb + Mi; const float M63 = __shfl(Mi, 63), m_new = __shfl(mi, 63);
        scs[lane] = a; scs[64 + lane] = Mi; scs[128 + lane] = expf(a - M63) * QK_SCALE;
        sc[lane] = expf(m_prev - Mi); sc[64 + lane] = expf(-mi);
        if (lane == 0) { sc[192] = expf(m_prev - M63); sc[193] = m_new; if (c == 31) F.out[O_PM + bh] = m_new; }
    }
    asm volatile("s_waitcnt lgkmcnt(0)" ::: "memory");
    bf16x8 Qf[2][8], Kf[2][8];
    const bf16_t* pq = F.PROJ + (size_t)(row0 + r) * NPROJ + hd * HD + 8 * h;
#pragma unroll
    for (int rb = 0; rb < 2; ++rb)
#pragma unroll
        for (int s = 0; s < 8; ++s) { Qf[rb][s] = *(const bf16x8*)(pq + (size_t)(32 * rb) * NPROJ + 16 * s); Kf[rb][s] = *(const bf16x8*)(pq + (size_t)(32 * rb) * NPROJ + 1024 + 16 * s); }
#pragma unroll
    for (int rb = 0; rb < 2; ++rb)
#pragma unroll
        for (int s = 0; s < 8; ++s) { const int i = 32 * rb + r; const u32x4 wv = __builtin_bit_cast(u32x4, Qf[rb][s]);
            unsigned char* o0 = rec + MR_QI + ((((i >> 4) * 4 + (s >> 1)) * 64 + (2 * h) * 16 + (i & 15)) * 16) + 8 * (s & 1);
            *(u32x2*)o0 = (u32x2){wv.x, wv.y}; *(u32x2*)(o0 + 256) = (u32x2){wv.z, wv.w}; }
    float rs[2] = {0.f, 0.f};
#pragma unroll
    for (int blk = 0; blk < 3; ++blk) {
        const int jb = blk >> 1, ib = (blk + 1) >> 1;
        f32x16 Dm;
#pragma unroll
        for (int x = 0; x < 16; ++x) Dm[x] = 0.f;
#pragma unroll
        for (int s = 0; s < 8; ++s) Dm = __builtin_amdgcn_mfma_f32_32x32x16_bf16(Kf[jb][s], Qf[ib][s], Dm, 0, 0, 0);
        const int i = 32 * ib + r; const float Mi_i = scs[64 + i];
#pragma unroll
        for (int g = 0; g < 4; ++g) {
            const f32x4 aj = *(const LAS f32x4*)(scs + 32 * jb + 8 * g + 4 * h);
            float v[4];
#pragma unroll
            for (int ip = 0; ip < 4; ++ip) { const int j = 32 * jb + 8 * g + 4 * h + ip; const float x = Dm[4 * g + ip] * QK_SCALE * __expf(aj[ip] - Mi_i); v[ip] = (j <= i) ? x : 0.f; }
            rs[ib] += (v[0] + v[1]) + (v[2] + v[3]);
            *(u32x2*)(rec + MR_SP + ((((i >> 4) * 2 + jb) * 64 + g * 16 + (i & 15)) * 16) + 8 * h) = (u32x2){pk2(v[0], v[1]), pk2(v[2], v[3])};
        }
    }
    rs[0] += __shfl_xor(rs[0], 32); rs[1] += __shfl_xor(rs[1], 32);
    if (h == 0) { sc[128 + r] = rs[0]; sc[160 + r] = rs[1]; }
    LAS unsigned short* const stg = (LAS unsigned short*)scr;
#pragma unroll 1
    for (int mt = 0; mt < 2; ++mt) {
        const bf16_t* psrc = F.PROJ + (size_t)row0 * NPROJ + (mt + 1) * 1024 + hd * HD;
        u32x4 tv[16];
#pragma unroll
        for (int x = 0; x < 16; ++x) { const int idx = x * 64 + lane; tv[x] = *(const u32x4*)(psrc + (size_t)(idx >> 4) * NPROJ + (idx & 15) * 8); }
        asm volatile("s_waitcnt lgkmcnt(0)" ::: "memory");
#pragma unroll
        for (int x = 0; x < 16; ++x) { const int idx = x * 64 + lane; *(LAS u32x4*)(stg + (idx >> 4) * 128 + (idx & 15) * 8) = tv[x]; }
        asm volatile("s_waitcnt lgkmcnt(0)" ::: "memory");
#pragma unroll 1
        for (int blk = 0; blk < 4; ++blk) {
            const int d = 32 * blk + r; float dn = 0.f;
#pragma unroll
            for (int s = 0; s < 4; ++s) {
                unsigned xv[8];
#pragma unroll
                for (int j = 0; j < 8; ++j) xv[j] = stg[(16 * s + 8 * h + j) * 128 + d];
                const size_t off = ((((d >> 4) * 2 + (s >> 1)) * 64 + (2 * (s & 1) + h) * 16 + (d & 15)) * 16);
                if (mt == 0) {
                    const f32x4 w0 = *(const LAS f32x4*)(scs + 128 + 16 * s + 8 * h), w1 = *(const LAS f32x4*)(scs + 128 + 16 * s + 8 * h + 4);
                    float x[8];
#pragma unroll
                    for (int j = 0; j < 4; ++j) { x[j] = bflo(xv[j]) * w0[j]; x[4 + j] = bflo(xv[4 + j]) * w1[j]; }
                    dn += ((x[0] + x[1]) + (x[2] + x[3])) + ((x[4] + x[5]) + (x[6] + x[7]));
                    *(u32x4*)(rec + MR_KW + off) = (u32x4){pk2(x[0], x[1]), pk2(x[2], x[3]), pk2(x[4], x[5]), pk2(x[6], x[7])};
                } else {
                    *(u32x4*)(rec + MR_VT + off) = (u32x4){xv[0] | (xv[1] << 16), xv[2] | (xv[3] << 16), xv[4] | (xv[5] << 16), xv[6] | (xv[7] << 16)};
                }
            }
            if (mt == 0) { dn += __shfl_xor(dn, 32); if (h == 0) ((float*)(rec + MR_DN))[d] = dn; }
        }
    }
}
constexpr int MDMA_OFF = MR_KW, MDMA_BYTES = MREC - MR_KW;
__device__ __forceinline__ void s2_mlstm_chain(Frame& F, int bh) {
    const int lane = F.lane, w = F.wave, cl = lane & 15, q = lane >> 4;
    LAS unsigned char* const buf0 = F.lds; LAS unsigned char* const buf1 = F.lds + MDMA_BYTES;
    LAS float* const s_n = (LAS float*)(F.lds + 2 * MDMA_BYTES);
    const unsigned char* recs = F.IMGM + (size_t)bh * 32 * MREC + MDMA_OFF;
    unsigned char* snaps = (unsigned char*)F.HB + (size_t)bh * 32 * SNAPM;
    f32x4 C[8];
#pragma unroll
    for (int db = 0; db < 8; ++db) C[db] = (f32x4){0.f, 0.f, 0.f, 0.f};
    if (F.tid < 128) s_n[F.tid] = 0.f;
    for (int piece = w; piece < MDMA_BYTES / 1024; piece += 8)
        __builtin_amdgcn_global_load_lds((const unsigned*)(recs + piece * 1024 + lane * 16), (LAS unsigned*)(buf0 + piece * 1024), 16, 0, 0);
    asm volatile("s_waitcnt vmcnt(0)" ::: "memory"); __syncthreads();
    for (int c = 0; c < 32; ++c) {
        LAS unsigned char* const cur = (c & 1) ? buf1 : buf0; LAS unsigned char* const nxt = (c & 1) ? buf0 : buf1;
        if (c + 1 < 32) { const unsigned char* src = recs + (size_t)(c + 1) * MREC;
            for (int piece = w; piece < MDMA_BYTES / 1024; piece += 8)
                __builtin_amdgcn_global_load_lds((const unsigned*)(src + piece * 1024 + lane * 16), (LAS unsigned*)(nxt + piece * 1024), 16, 0, 0); }
        unsigned char* sn = snaps + (size_t)c * SNAPM;
#pragma unroll
        for (int s = 0; s < 4; ++s)
            *(u32x4*)(sn + ((w * 4 + s) * 64 + lane) * 16) = (u32x4){pk2(C[2 * s][0], C[2 * s][1]), pk2(C[2 * s][2], C[2 * s][3]), pk2(C[2 * s + 1][0], C[2 * s + 1][1]), pk2(C[2 * s + 1][2], C[2 * s + 1][3])};
        const LAS float* sc = (const LAS float*)(cur + (MR_SC - MDMA_OFF));
        const float dC = sc[192];
        if (F.tid < 128) { const float nv = s_n[F.tid]; ((float*)(sn + 32768))[F.tid] = nv; s_n[F.tid] = dC * nv + ((const LAS float*)(cur + (MR_DN - MDMA_OFF)))[F.tid]; }
#define FRAG(off, f) (*(const LAS bf16x8*)(cur + ((off) - MDMA_OFF) + (f) * 1024 + lane * 16))
        const bf16x8 VB0 = FRAG(MR_VT, w * 2 + 0), VB1 = FRAG(MR_VT, w * 2 + 1);
#pragma unroll
        for (int dp = 0; dp < 2; ++dp) {
            bf16x8 fk[8];
#pragma unroll
            for (int x = 0; x < 8; ++x) fk[x] = FRAG(MR_KW, dp * 8 + x);
#pragma unroll
            for (int x = 0; x < 4; ++x) { const int db = dp * 4 + x; f32x4 acc = C[db] * dC;
                acc = __builtin_amdgcn_mfma_f32_16x16x32_bf16(fk[2 * x], VB0, acc, 0, 0, 0);
                acc = __builtin_amdgcn_mfma_f32_16x16x32_bf16(fk[2 * x + 1], VB1, acc, 0, 0, 0);
                C[db] = acc; }
        }
#undef FRAG
        asm volatile("s_waitcnt vmcnt(0)" ::: "memory"); __syncthreads();
    }
    float* oC = F.out + O_PC + (size_t)bh * HD * HD;
#pragma unroll
    for (int db = 0; db < 8; ++db)
#pragma unroll
        for (int i = 0; i < 4; ++i) oC[(size_t)(16 * db + 4 * q + i) * HD + 16 * w + cl] = C[db][i];
    if (F.tid < 128) F.out[O_PN + (size_t)bh * HD + F.tid] = s_n[F.tid];
    __syncthreads();
}
__device__ __forceinline__ void s3_mlstm_task(Frame& F, int unit, int tb) {
    const int lane = F.lane, cl = lane & 15, q = lane >> 4;
    const int c = unit & 31, bh = unit >> 5, hd = bh & 7, b = bh >> 3, row0 = b * T_P + 64 * c + 16 * tb;
    const unsigned char* rec = F.IMGM + (size_t)unit * MREC; const unsigned char* sn = (const unsigned char*)F.HB + (size_t)unit * SNAPM;
    const float* sc = (const float*)(rec + MR_SC) + 16 * tb;
    bf16x8 fq[4], fs[2];
#pragma unroll
    for (int x = 0; x < 4; ++x) fq[x] = *(const bf16x8*)(rec + MR_QI + (tb * 4 + x) * 1024 + lane * 16);
#pragma unroll
    for (int x = 0; x < 2; ++x) fs[x] = *(const bf16x8*)(rec + MR_SP + (tb * 2 + x) * 1024 + lane * 16);
    float den2e;
    {
        const int tt = lane >> 2, part = lane & 3;
        const u32x4* qp = (const u32x4*)(F.PROJ + (size_t)(row0 + tt) * NPROJ + hd * HD + 32 * part);
        const f32x4* np = (const f32x4*)(sn + 32768) + 8 * part;
        float acc = 0.f;
#pragma unroll
        for (int x = 0; x < 4; ++x) { const u32x4 qv = qp[x]; const f32x4 n0 = np[2 * x], n1 = np[2 * x + 1];
            acc += ((bflo(qv.x) * n0.x + bfhi(qv.x) * n0.y) + (bflo(qv.y) * n0.z + bfhi(qv.y) * n0.w)) + ((bflo(qv.z) * n1.x + bfhi(qv.z) * n1.y) + (bflo(qv.w) * n1.z + bfhi(qv.w) * n1.w)); }
        acc = quad_sum(acc);
        const float dd = sc[tt] * acc + sc[128 + tt], den = fmaxf(fabsf(dd), sc[64 + tt]);
        den2e = EPS * den * den;
    }
    f32x4 num[8];
    const f32x4 dv = *(const f32x4*)(sc + 4 * q);
    if (tb < 2) fs[1] = (bf16x8){0, 0, 0, 0, 0, 0, 0, 0};
#pragma unroll
    for (int wh = 0; wh < 2; ++wh) {
        bf16x8 Cb[4][4], VB[4][2];
#pragma unroll
        for (int x = 0; x < 4; ++x) { const int w = 4 * wh + x;
#pragma unroll
            for (int s = 0; s < 4; ++s) Cb[x][s] = *(const bf16x8*)(sn + ((w * 4 + s) * 64 + lane) * 16);
#pragma unroll
            for (int s = 0; s < 2; ++s) VB[x][s] = *(const bf16x8*)(rec + MR_VT + ((w * 2 + s) * 64 + lane) * 16); }
        asm volatile("" ::: "memory");
#pragma unroll
        for (int x = 0; x < 4; ++x) {
            f32x4 a0 = (f32x4){0.f, 0.f, 0.f, 0.f};
#pragma unroll
            for (int s = 0; s < 4; ++s) a0 = __builtin_amdgcn_mfma_f32_16x16x32_bf16(fq[s], Cb[x][s], a0, 0, 0, 0);
            a0 = a0 * dv;
            a0 = __builtin_amdgcn_mfma_f32_16x16x32_bf16(fs[0], VB[x][0], a0, 0, 0, 0);
            a0 = __builtin_amdgcn_mfma_f32_16x16x32_bf16(fs[1], VB[x][1], a0, 0, 0, 0);
            num[4 * wh + x] = a0;
        }
    }
    f32x4 ss = (f32x4){0.f, 0.f, 0.f, 0.f};
#pragma unroll
    for (int w = 0; w < 8; ++w) ss += num[w] * num[w];
    float scl[4];
#pragma unroll
    for (int i = 0; i < 4; ++i) { const float tot = row16_sum(ss[i]); const float d2 = __shfl(den2e, 4 * (4 * q + i)); scl[i] = __frsqrt_rn(tot * (1.0f / HD) + d2); }
#pragma unroll
    for (int w = 0; w < 8; ++w) { const float gn = F.mlstm_g[hd * HD + 16 * w + cl];
#pragma unroll
        for (int i = 0; i < 4; ++i) { const size_t row = (size_t)(row0 + 4 * q + i);
            const float oa = bf2f(F.PROJ[row * NPROJ + 3072 + hd * HD + 16 * w + cl]);
            F.MIX[row * D + hd * HD + 16 * w + cl] = (bf16_t)f2bf(num[w][i] * scl[i] * gn * sigmoidf_(oa)); } }
}
__device__ __forceinline__ float silu_fast(float x) { return __fdividef(x, 1.0f + __expf(-x)); }
__device__ __forceinline__ void s1_gdn_unit(Frame& F, int unit, LAS float* scr) {
    const int lane = F.lane, r = lane & 31, h = lane >> 5;
    const int c = unit & 31, bh = unit >> 5, hd = bh & 7, b = bh >> 3;
    const int rowb = b * T_P, row0 = rowb + 64 * c;
    unsigned char* rec = F.IMGG + (size_t)unit * GREC;
    LAS float* scrA = scr; LAS float* sG = scr + 4352; LAS float* sBe = sG + 64; LAS float* sRk = sBe + 64; LAS float* sRq = sRk + 64; LAS float* sF1 = sRq + 64; LAS float* sF2 = sF1 + 64;
    const float* gp = F.GATES + (size_t)(row0 + lane) * NGATE;
    const float lgv = -expf(F.A_log[hd]) * softplusf_(gp[16 + hd] + F.dt_bias[hd]);
    const float G = wave_scan_add(lgv, lane); const float be = sigmoidf_(gp[24 + hd]); const float G63 = __shfl(G, 63);
    sG[lane] = G; sBe[lane] = be;
    f32x16 Dk[3], Dq[3];
#pragma unroll
    for (int x = 0; x < 3; ++x)
#pragma unroll
        for (int y = 0; y < 16; ++y) { Dk[x][y] = 0.f; Dq[x][y] = 0.f; }
    float ssq[2][2] = {{0.f, 0.f}, {0.f, 0.f}};
    LAS unsigned short* const stg = (LAS unsigned short*)scrA;
    const float* cw = F.conv_w + hd * HD + 8 * h;
#pragma unroll 1
    for (int hf = 0; hf < 2; ++hf) {
        asm volatile("s_waitcnt lgkmcnt(0)" ::: "memory");
#pragma unroll 1
        for (int x0 = 0; x0 < 18; x0 += 6) {
            u32x4 tv[6];
#pragma unroll
            for (int x = 0; x < 6; ++x) { int idx = (x0 + x) * 64 + lane; idx = idx < 1072 ? idx : 1071; const int mtx = idx >= 536 ? 1 : 0, rem = idx - 536 * mtx, row = rem >> 3, piece = rem & 7;
                const bool dead = (c == 0) && (row < 3); const int grow = dead ? row0 : row0 - 3 + row;
                u32x4 v = *(const u32x4*)(F.PROJ + (size_t)grow * NPROJ + 4096 + mtx * 1024 + hd * HD + 64 * hf + piece * 8);
                if (dead) v = (u32x4){0u, 0u, 0u, 0u};
                tv[x] = v; }
#pragma unroll
            for (int x = 0; x < 6; ++x) { const int idx = (x0 + x) * 64 + lane; const int mtx = idx >= 536 ? 1 : 0, rem = idx - 536 * mtx, row = rem >> 3, piece = rem & 7;
                if (idx < 1072) *(LAS u32x4*)(stg + mtx * (67 * 64) + row * 64 + ((piece ^ ((row >> 1) & 7)) * 8)) = tv[x]; }
        }
        asm volatile("s_waitcnt lgkmcnt(0)" ::: "memory");
#pragma unroll 1
        for (int sl = 0; sl < 4; ++sl) {
            const int s = 4 * hf + sl;
            bf16x8 fr[2][2];
#pragma unroll
            for (int mt = 0; mt < 2; ++mt) {
                asm volatile("" ::: "memory");
                f32x4 wa[4], wb[4];
#pragma unroll
                for (int tap = 0; tap < 4; ++tap) { wa[tap] = *(const f32x4*)(cw + tap * CCONV + mt * 1024 + 16 * s); wb[tap] = *(const f32x4*)(cw + tap * CCONV + mt * 1024 + 16 * s + 4); }
#pragma unroll
                for (int rb = 0; rb < 2; ++rb) {
                    const int i = 32 * rb + r; f32x4 a0 = (f32x4){0.f, 0.f, 0.f, 0.f}, a1 = a0;
#pragma unroll
                    for (int tap = 0; tap < 4; ++tap) { const int row = i + tap, piece = 2 * sl + h;
                        const u32x4 uv = *(const LAS u32x4*)(stg + mt * (67 * 64) + row * 64 + ((piece ^ ((row >> 1) & 7)) * 8));
                        a0 += (f32x4){bflo(uv.x), bfhi(uv.x), bflo(uv.y), bfhi(uv.y)} * wa[tap]; a1 += (f32x4){bflo(uv.z), bfhi(uv.z), bflo(uv.w), bfhi(uv.w)} * wb[tap]; }
                    float y[8];
#pragma unroll
                    for (int j = 0; j < 4; ++j) { y[j] = silu_fast(a0[j]); y[4 + j] = silu_fast(a1[j]); }
                    ssq[rb][mt] += ((y[0] * y[0] + y[1] * y[1]) + (y[2] * y[2] + y[3] * y[3])) + ((y[4] * y[4] + y[5] * y[5]) + (y[6] * y[6] + y[7] * y[7]));
                    const u32x4 wv = (u32x4){pk2(y[0], y[1]), pk2(y[2], y[3]), pk2(y[4], y[5]), pk2(y[6], y[7])};
                    fr[mt][rb] = __builtin_bit_cast(bf16x8, wv);
                    if (mt == 0) { unsigned char* o0 = rec + GR_QG + ((((i >> 4) * 4 + (s >> 1)) * 64 + (2 * h) * 16 + (i & 15)) * 16) + 8 * (s & 1);
                        *(u32x2*)o0 = (u32x2){wv.x, wv.y}; *(u32x2*)(o0 + 256) = (u32x2){wv.z, wv.w}; }
                }
            }
#pragma unroll
            for (int blk = 0; blk < 3; ++blk) { const int jb = blk >> 1, ib = (blk + 1) >> 1;
                Dk[blk] = __builtin_amdgcn_mfma_f32_32x32x16_bf16(fr[1][jb], fr[1][ib], Dk[blk], 0, 0, 0);
                Dq[blk] = __builtin_amdgcn_mfma_f32_32x32x16_bf16(fr[1][jb], fr[0][ib], Dq[blk], 0, 0, 0); }
        }
    }
#pragma unroll
    for (int rb = 0; rb < 2; ++rb) {
        const float sq = ssq[rb][0] + __shfl_xor(ssq[rb][0], 32), sk = ssq[rb][1] + __shfl_xor(ssq[rb][1], 32);
        if (h == 0) { sRq[32 * rb + r] = 1.0f / sqrtf(sq + EPS); sRk[32 * rb + r] = 1.0f / sqrtf(sk + EPS); }
    }
    asm volatile("s_waitcnt lgkmcnt(0)" ::: "memory");
#pragma unroll
    for (int blk = 0; blk < 3; ++blk) {
        const int jb = blk >> 1, ib = (blk + 1) >> 1;
        const int i = 32 * ib + r; const float Gi = sG[i], bei = sBe[i], rki = sRk[i], rqi = sRq[i] * QK_SCALE;
#pragma unroll
        for (int g = 0; g < 4; ++g) {
            const int j0 = 32 * jb + 8 * g + 4 * h; const f32x4 Gj = *(const LAS f32x4*)(sG + j0), rkj = *(const LAS f32x4*)(sRk + j0);
            f32x4 av; float qv[4];
#pragma unroll
            for (int ip = 0; ip < 4; ++ip) { const float e = __expf(Gi - Gj[ip]); av[ip] = bei * e * rki * rkj[ip] * Dk[blk][4 * g + ip];
                qv[ip] = (j0 + ip <= i) ? -(rqi * rkj[ip] * e * Dq[blk][4 * g + ip]) : 0.f; }
            *(LAS f32x4*)(scrA + i * 68 + j0) = av;
            *(u32x2*)(rec + GR_QK + ((((i >> 4) * 2 + jb) * 64 + (2 * (g & 1) + h) * 16 + (i & 15)) * 16) + 8 * (g >> 1)) = (u32x2){pk2(qv[0], qv[1]), pk2(qv[2], qv[3])};
        }
    }
    asm volatile("s_waitcnt lgkmcnt(0)" ::: "memory");
    {
        float tc[64];
#pragma unroll
        for (int i = 0; i < 64; ++i) {
            float acc0 = (lane == i) ? 1.f : 0.f, acc1 = 0.f;
#pragma unroll
            for (int j4 = 0; j4 < i; j4 += 4) { const f32x4 av = *(const LAS f32x4*)(scrA + i * 68 + j4);
                acc0 -= av.x * tc[j4]; if (j4 + 1 < i) acc1 -= av.y * tc[j4 + 1]; if (j4 + 2 < i) acc0 -= av.z * tc[j4 + 2]; if (j4 + 3 < i) acc1 -= av.w * tc[j4 + 3]; }
            tc[i] = acc0 + acc1;
            scrA[i * 68 + lane] = tc[i];
            asm volatile("" ::: "memory");
        }
    }
    const float gam = expf(G), rkl = sRk[lane], rql = sRq[lane];
    sF1[lane] = be * gam * rkl; sF2[lane] = be;
    { float* sc = (float*)(rec + GR_SC); sc[lane] = gam * rql * QK_SCALE; sc[64 + lane] = expf(G63 - G) * rkl; if (lane == 0) sc[128] = expf(G63); }
    asm volatile("s_waitcnt lgkmcnt(0)" ::: "memory");
    bf16x8 Tp[6], Tpp[6];
#pragma unroll
    for (int x = 0; x < 6; ++x) { const int ib = x < 2 ? 0 : 1, s = x < 2 ? x : x - 2;
        const LAS float* tp = scrA + (32 * ib + r) * 68 + 16 * s + 8 * h; const f32x4 t0 = *(const LAS f32x4*)tp, t1 = *(const LAS f32x4*)(tp + 4);
        const f32x4 f1a = *(const LAS f32x4*)(sF1 + 16 * s + 8 * h), f1b = *(const LAS f32x4*)(sF1 + 16 * s + 8 * h + 4), f2a = *(const LAS f32x4*)(sF2 + 16 * s + 8 * h), f2b = *(const LAS f32x4*)(sF2 + 16 * s + 8 * h + 4);
        const f32x4 p0 = t0 * f1a, p1 = t1 * f1b, q0 = t0 * f2a, q1 = t1 * f2b;
        Tp[x] = __builtin_bit_cast(bf16x8, (u32x4){pk2(p0.x, p0.y), pk2(p0.z, p0.w), pk2(p1.x, p1.y), pk2(p1.z, p1.w)});
        Tpp[x] = __builtin_bit_cast(bf16x8, (u32x4){pk2(q0.x, q0.y), pk2(q0.z, q0.w), pk2(q1.x, q1.y), pk2(q1.z, q1.w)}); }
#pragma unroll 1
    for (int mt = 0; mt < 2; ++mt) {
        {
            u32x4 tv[17];
#pragma unroll
            for (int x = 0; x < 17; ++x) { int idx = x * 64 + lane; idx = idx < 1072 ? idx : 1071; const int row = idx >> 4, piece = idx & 15;
                const bool dead = (c == 0) && (row < 3); const int grow = dead ? row0 : row0 - 3 + row;
                u32x4 v = *(const u32x4*)(F.PROJ + (size_t)grow * NPROJ + 4096 + (mt + 1) * 1024 + hd * HD + piece * 8);
                if (dead) v = (u32x4){0u, 0u, 0u, 0u};
                tv[x] = v; }
            asm volatile("s_waitcnt lgkmcnt(0)" ::: "memory");
#pragma unroll
            for (int x = 0; x < 17; ++x) { const int idx = x * 64 + lane; if (idx < 1072) *(LAS u32x4*)(stg + (idx >> 4) * 128 + (idx & 15) * 8) = tv[x]; }
            asm volatile("s_waitcnt lgkmcnt(0)" ::: "memory");
        }
#pragma unroll 1
        for (int blk = 0; blk < 4; ++blk) {
            const int d = 32 * blk + r; const float* cwc = F.conv_w + (mt + 1) * 1024 + hd * HD + d;
            const float w0 = cwc[0], w1 = cwc[CCONV], w2 = cwc[2 * CCONV], w3 = cwc[3 * CCONV];
            bf16x8 Xc[4];
#pragma unroll
            for (int s = 0; s < 4; ++s) {
                float u[11];
#pragma unroll
                for (int x = 0; x < 11; ++x) u[x] = bf2f(stg[(16 * s + 8 * h + x) * 128 + d]);
                float y[8];
#pragma unroll
                for (int j = 0; j < 8; ++j) y[j] = silu_fast(((w0 * u[j] + w1 * u[j + 1]) + w2 * u[j + 2]) + w3 * u[j + 3]);
                const u32x4 xw = (u32x4){pk2(y[0], y[1]), pk2(y[2], y[3]), pk2(y[4], y[5]), pk2(y[6], y[7])};
                Xc[s] = __builtin_bit_cast(bf16x8, xw);
                if (mt == 0) { unsigned char* o0 = rec + GR_KT + ((((d >> 4) * 2 + (s >> 1)) * 64 + (2 * h) * 16 + (d & 15)) * 16) + 8 * (s & 1);
                    *(u32x2*)o0 = (u32x2){xw.x ^ 0x80008000u, xw.y ^ 0x80008000u}; *(u32x2*)(o0 + 256) = (u32x2){xw.z ^ 0x80008000u, xw.w ^ 0x80008000u}; }
            }
#pragma unroll
            for (int ib = 0; ib < 2; ++ib) {
                f32x16 Dm;
#pragma unroll
                for (int x = 0; x < 16; ++x) Dm[x] = 0.f;
                if (mt == 0) {
                    if (ib == 0) { Dm = __builtin_amdgcn_mfma_f32_32x32x16_bf16(Xc[0], Tp[0], Dm, 0, 0, 0); Dm = __builtin_amdgcn_mfma_f32_32x32x16_bf16(Xc[1], Tp[1], Dm, 0, 0, 0); }
                    else {
#pragma unroll
                        for (int s = 0; s < 4; ++s) Dm = __builtin_amdgcn_mfma_f32_32x32x16_bf16(Xc[s], Tp[2 + s], Dm, 0, 0, 0); }
                    const int i = 32 * ib + r;
#pragma unroll
                    for (int g = 0; g < 4; ++g)
                        *(u32x2*)(rec + GR_WI + ((((i >> 4) * 4 + blk) * 64 + (2 * (g & 1) + h) * 16 + (i & 15)) * 16) + 8 * (g >> 1)) = (u32x2){pk2(Dm[4 * g], Dm[4 * g + 1]), pk2(Dm[4 * g + 2], Dm[4 * g + 3])};
                } else {
                    if (ib == 0) { Dm = __builtin_amdgcn_mfma_f32_32x32x16_bf16(Tpp[0], Xc[0], Dm, 0, 0, 0); Dm = __builtin_amdgcn_mfma_f32_32x32x16_bf16(Tpp[1], Xc[1], Dm, 0, 0, 0); }
                    else {
#pragma unroll
                        for (int s = 0; s < 4; ++s) Dm = __builtin_amdgcn_mfma_f32_32x32x16_bf16(Tpp[2 + s], Xc[s], Dm, 0, 0, 0); }
#pragma unroll
                    for (int g = 0; g < 4; ++g)
                        *(u32x2*)(rec + GR_UP + ((((d >> 4) * 4 + (2 * ib + (g >> 1))) * 64 + (2 * (g & 1) + h) * 16 + (d & 15)) * 8)) = (u32x2){pk2(Dm[4 * g], Dm[4 * g + 1]), pk2(Dm[4 * g + 2], Dm[4 * g + 3])};
                }
            }
        }
    }
    if (c == 31) {
        for (int x = lane; x < 3 * 384; x += 64) { const int jr = x / 384, cc = x % 384, ch = (cc >> 7) * 1024 + hd * HD + (cc & 127);
            F.out[O_PCONV + (size_t)(b * 3 + jr) * CCONV + ch] = bf2f(F.PROJ[(size_t)(rowb + T_P - 3 + jr) * NPROJ + 4096 + ch]); }
    }
}
constexpr int GBUF = 33792;
__device__ __forceinline__ void gdn_dma(const unsigned char* rec, LAS unsigned char* dst, int w, int lane) {
    for (int piece = w; piece < 33; piece += 8) { const unsigned char* s = rec + (piece < 32 ? GR_WI + piece * 1024 : GR_SC);
        __builtin_amdgcn_global_load_lds((const unsigned*)(s + lane * 16), (LAS unsigned*)(dst + piece * 1024), 16, 0, 0); }
}
__device__ __forceinline__ void s2_gdn_chain(Frame& F, int bh) {
    const int lane = F.lane, w = F.wave, cl = lane & 15, q = lane >> 4;
    LAS unsigned char* const buf0 = F.lds; LAS unsigned char* const buf1 = F.lds + GBUF;
    const unsigned char* recs = F.IMGG + (size_t)bh * 32 * GREC;
    unsigned char* snaps = (unsigned char*)F.X1 + (size_t)bh * 32 * SNAPG;
    f32x4 S[8];
#pragma unroll
    for (int db = 0; db < 8; ++db) S[db] = (f32x4){0.f, 0.f, 0.f, 0.f};
    u32x2 upn[4];
#pragma unroll
    for (int tb = 0; tb < 4; ++tb) upn[tb] = *(const u32x2*)(recs + GR_UP + ((w * 4 + tb) * 64 + lane) * 8);
    gdn_dma(recs, buf0, w, lane);
    asm volatile("s_waitcnt vmcnt(0)" ::: "memory"); __syncthreads();
    for (int c = 0; c < 32; ++c) {
        LAS unsigned char* const cur = (c & 1) ? buf1 : buf0; LAS unsigned char* const nxt = (c & 1) ? buf0 : buf1;
        u32x2 up[4];
#pragma unroll
        for (int tb = 0; tb < 4; ++tb) up[tb] = upn[tb];
        if (c + 1 < 32) { const unsigned char* src = recs + (size_t)(c + 1) * GREC;
#pragma unroll
            for (int tb = 0; tb < 4; ++tb) upn[tb] = *(const u32x2*)(src + GR_UP + ((w * 4 + tb) * 64 + lane) * 8);
            gdn_dma(src, nxt, w, lane); }
        unsigned char* sn = snaps + (size_t)c * SNAPG;
        const LAS float* sc = (const LAS float*)(cur + 32768);
        bf16x8 Sb[4];
#pragma unroll
        for (int s = 0; s < 4; ++s) { const u32x4 pv = (u32x4){pk2(S[2 * s][0], S[2 * s][1]), pk2(S[2 * s][2], S[2 * s][3]), pk2(S[2 * s + 1][0], S[2 * s + 1][1]), pk2(S[2 * s + 1][2], S[2 * s + 1][3])};
            Sb[s] = __builtin_bit_cast(bf16x8, pv); *(u32x4*)(sn + ((w * 4 + s) * 64 + lane) * 16) = pv; }
#define FRAG(off, f) (*(const LAS bf16x8*)(cur + (off) + (f) * 1024 + lane * 16))
        f32x4 P[4];
#pragma unroll
        for (int tp = 0; tp < 2; ++tp) {
            bf16x8 fw[8];
#pragma unroll
            for (int x = 0; x < 8; ++x) fw[x] = FRAG(0, tp * 8 + x);
            f32x4 a0 = (f32x4){-bflo(up[2 * tp].x), -bfhi(up[2 * tp].x), -bflo(up[2 * tp].y), -bfhi(up[2 * tp].y)};
            f32x4 a1 = (f32x4){-bflo(up[2 * tp + 1].x), -bfhi(up[2 * tp + 1].x), -bflo(up[2 * tp + 1].y), -bfhi(up[2 * tp + 1].y)};
#pragma unroll
            for (int s = 0; s < 4; ++s) { a0 = __builtin_amdgcn_mfma_f32_16x16x32_bf16(fw[s], Sb[s], a0, 0, 0, 0); a1 = __builtin_amdgcn_mfma_f32_16x16x32_bf16(fw[4 + s], Sb[s], a1, 0, 0, 0); }
            P[2 * tp] = a0; P[2 * tp + 1] = a1;
        }
        bf16x8 Pbs[2];
#pragma unroll
        for (int sp = 0; sp < 2; ++sp) {
            const f32x4 k0 = *(const LAS f32x4*)(sc + 64 + 16 * (2 * sp) + 4 * q), k1 = *(const LAS f32x4*)(sc + 64 + 16 * (2 * sp + 1) + 4 * q);
            const f32x4 a = P[2 * sp], bq = P[2 * sp + 1], as = a * k0, bs = bq * k1;
            *(u32x4*)(sn + 32768 + ((w * 2 + sp) * 64 + lane) * 16) = (u32x4){pk2(a[0], a[1]), pk2(a[2], a[3]), pk2(bq[0], bq[1]), pk2(bq[2], bq[3])};
            Pbs[sp] = __builtin_bit_cast(bf16x8, (u32x4){pk2(as[0], as[1]), pk2(as[2], as[3]), pk2(bs[0], bs[1]), pk2(bs[2], bs[3])});
        }
        const float gL = sc[128];
#pragma unroll
        for (int dp = 0; dp < 2; ++dp) {
            bf16x8 fk[8];
#pragma unroll
            for (int x = 0; x < 8; ++x) fk[x] = FRAG(16384, dp * 8 + x);
#pragma unroll
            for (int x = 0; x < 4; ++x) { const int db = dp * 4 + x; f32x4 acc = S[db] * gL;
                acc = __builtin_amdgcn_mfma_f32_16x16x32_bf16(fk[2 * x], Pbs[0], acc, 0, 0, 0);
                acc = __builtin_amdgcn_mfma_f32_16x16x32_bf16(fk[2 * x + 1], Pbs[1], acc, 0, 0, 0);
                S[db] = acc; }
        }
#undef FRAG
        asm volatile("s_waitcnt vmcnt(0)" ::: "memory"); __syncthreads();
    }
    float* oS = F.out + O_PS + (size_t)bh * HD * HD;
#pragma unroll
    for (int db = 0; db < 8; ++db)
#pragma unroll
        for (int i = 0; i < 4; ++i) oS[(size_t)(16 * db + 4 * q + i) * HD + 16 * w + cl] = S[db][i];
    __syncthreads();
}
__device__ __forceinline__ void s3_gdn_task(Frame& F, int unit, int tb) {
    const int lane = F.lane, cl = lane & 15, q = lane >> 4;
    const int c = unit & 31, bh = unit >> 5, hd = bh & 7, b = bh >> 3, row0 = b * T_P + 64 * c + 16 * tb;
    const unsigned char* rec = F.IMGG + (size_t)unit * GREC; const unsigned char* sn = (const unsigned char*)F.X1 + (size_t)unit * SNAPG;
    const float* sc = (const float*)(rec + GR_SC);
    bf16x8 fq[4], fk[2];
#pragma unroll
    for (int x = 0; x < 4; ++x) fq[x] = *(const bf16x8*)(rec + GR_QG + (tb * 4 + x) * 1024 + lane * 16);
    fk[0] = *(const bf16x8*)(rec + GR_QK + (tb * 2) * 1024 + lane * 16);
    fk[1] = *(const bf16x8*)(rec + GR_QK + (tb * 2 + 1) * 1024 + lane * 16);
    const f32x4 rs = *(const f32x4*)(sc + 16 * tb + 4 * q);
    f32x4 ov[8];
    if (tb < 2) fk[1] = (bf16x8){0, 0, 0, 0, 0, 0, 0, 0};
#pragma unroll
    for (int wh = 0; wh < 2; ++wh) {
        bf16x8 Sb[4][4], Pb[4][2];
#pragma unroll
        for (int x = 0; x < 4; ++x) { const int w = 4 * wh + x;
#pragma unroll
            for (int s = 0; s < 4; ++s) Sb[x][s] = *(const bf16x8*)(sn + ((w * 4 + s) * 64 + lane) * 16);
#pragma unroll
            for (int s = 0; s < 2; ++s) Pb[x][s] = *(const bf16x8*)(sn + 32768 + ((w * 2 + s) * 64 + lane) * 16); }
        asm volatile("" ::: "memory");
#pragma unroll
        for (int x = 0; x < 4; ++x) {
            f32x4 a0 = (f32x4){0.f, 0.f, 0.f, 0.f};
#pragma unroll
            for (int s = 0; s < 4; ++s) a0 = __builtin_amdgcn_mfma_f32_16x16x32_bf16(fq[s], Sb[x][s], a0, 0, 0, 0);
            a0 = a0 * rs;
            a0 = __builtin_amdgcn_mfma_f32_16x16x32_bf16(fk[0], Pb[x][0], a0, 0, 0, 0);
            a0 = __builtin_amdgcn_mfma_f32_16x16x32_bf16(fk[1], Pb[x][1], a0, 0, 0, 0);
            ov[4 * wh + x] = a0;
        }
    }
    f32x4 ss = (f32x4){0.f, 0.f, 0.f, 0.f};
#pragma unroll
    for (int w = 0; w < 8; ++w) ss += ov[w] * ov[w];
    float scl[4];
#pragma unroll
    for (int i = 0; i < 4; ++i) scl[i] = __frsqrt_rn(row16_sum(ss[i]) * (1.0f / HD) + EPS);
#pragma unroll
    for (int w = 0; w < 8; ++w) { const float gn = F.gdn_g[hd * HD + 16 * w + cl];
#pragma unroll
        for (int i = 0; i < 4; ++i) { const size_t row = (size_t)(row0 + 4 * q + i);
            const float zb = bf2f(F.PROJ[row * NPROJ + 7168 + hd * HD + 16 * w + cl]);
            F.MIX[row * D + 1024 + hd * HD + 16 * w + cl] = (bf16_t)f2bf(ov[w][i] * scl[i] * gn * siluf_(zb)); } }
}
constexpr int SMP_ST = 61440, SMP_RAW = 126976;
__device__ __forceinline__ void sample_dma(const Frame& F, const float* st, int b, int hd, int colbase, int w, int lane) {
    const unsigned char* ssrc = (const unsigned char*)(st + (size_t)(b * NH + hd) * HD * HD);
    for (int piece = w; piece < 64; piece += 8)
        __builtin_amdgcn_global_load_lds((const unsigned*)(ssrc + piece * 1024 + lane * 16), (LAS unsigned*)(F.lds + SMP_ST + piece * 1024), 16, 0, 0);
    {
        const bf16_t* tsrc = F.PROJ + (size_t)(M_P + b * T_S + 4 * (w & 1) + (lane >> 4)) * NPROJ + colbase + (w >> 1) * 1024 + hd * HD + (lane & 15) * 8;
        __builtin_amdgcn_global_load_lds((const unsigned*)tsrc, (LAS unsigned*)(F.lds + SMP_RAW + w * 1024), 16, 0, 0);
    }
}
struct SmpPre { float g0, g1, m0, n0; };
__device__ __forceinline__ void sample_mlstm(Frame& F, int b, int hd, SmpPre& pre, bool has_next, int nb, int nhd) {
    LAS float* sQ = (LAS float*)(F.lds); LAS float* sK = sQ + 1024; LAS float* sV = sK + 1024; LAS float* sOA = sV + 1024; LAS float* sKW = sOA + 1024;
    LAS float* sPart = sKW + 1024;
    LAS float* sN0 = sPart + 4096;
    LAS float* sQK = sN0 + 128;
    LAS float* sQN = sQK + 64;
    LAS float* sW = sQN + 8;
    LAS float* sSc = sW + 64;
    LAS float* sNorm = sSc + 32;
    const int tid = F.tid, e = tid & 127, q4 = tid >> 7, lane = F.lane, w = F.wave;
    const int row0 = M_P + b * T_S, bh = b * NH + hd;
    asm volatile("s_waitcnt vmcnt(0)" ::: "memory"); __syncthreads();
    float C[32];
#pragma unroll
    for (int dd = 0; dd < 32; ++dd) C[dd] = ((const LAS float*)(F.lds + SMP_ST))[(32 * q4 + dd) * HD + e];
    {
        const int t = tid >> 6, arr = (tid >> 4) & 3, c8 = (tid & 15) * 8;
        const u32x4 uv = *(const LAS u32x4*)(F.lds + SMP_RAW + arr * 2048 + t * 256 + c8 * 2);
        const float sc = (arr == 1) ? QK_SCALE : 1.0f;
        LAS float* dst = sQ + arr * 1024 + t * 128 + c8;
        *(LAS f32x4*)dst = (f32x4){bflo(uv.x) * sc, bfhi(uv.x) * sc, bflo(uv.y) * sc, bfhi(uv.y) * sc};
        *(LAS f32x4*)(dst + 4) = (f32x4){bflo(uv.z) * sc, bfhi(uv.z) * sc, bflo(uv.w) * sc, bfhi(uv.w) * sc};
    }
    const float n0 = pre.n0;
    if (tid < 128) sN0[tid] = n0;
    if (w == 0) {
        const int t = lane & 7;
        const float m0 = pre.m0;
        const float lfv = logsigmoidf_(pre.g1 + F.gate_b[NH + hd]), liv = pre.g0 + F.gate_b[hd];
        float bb = lfv;
#pragma unroll
        for (int o = 1; o < 8; o <<= 1) { const float x = __shfl_up(bb, o); if (t >= o) bb += x; }
        const float a = liv - bb; float cm = a;
#pragma unroll
        for (int o = 1; o < 8; o <<= 1) { const float x = __shfl_up(cm, o); if (t >= o) cm = fmaxf(cm, x); }
        const float Mi = fmaxf(m0, cm), mi = bb + Mi; const float M7 = __shfl(Mi, 7), m7 = __shfl(mi, 7);
        if (lane < 8) { sSc[t] = expf(m0 - Mi); sSc[8 + t] = expf(-mi); sSc[16 + t] = expf(a - M7); if (t == 0) { sSc[24] = expf(m0 - M7); sSc[25] = m7; } }
#pragma unroll
        for (int s = 0; s < 8; ++s) { const float as = __shfl(a, s); if (lane < 8) sW[t * 8 + s] = (s <= t) ? expf(as - Mi) : 0.f; }
    }
    __syncthreads();
    if (has_next) {
        sample_dma(F, F.stC, nb, nhd, 0, w, lane);
        const int nbh = nb * NH + nhd;
        if (w == 0) { const float* gp = F.GATES + (size_t)(M_P + nb * T_S + (lane & 7)) * NGATE; pre.g0 = gp[nhd]; pre.g1 = gp[8 + nhd]; pre.m0 = F.stM[nbh]; }
        if (tid < 128) pre.n0 = F.stN[(size_t)nbh * HD + tid];
    }
    if (w == 0) {
        const int rr = lane & 7, kq = lane >> 4, cl16 = lane & 15;
        f32x4 acc = (f32x4){0.f, 0.f, 0.f, 0.f};
#pragma unroll
        for (int s = 0; s < 4; ++s) {
            const f32x4 a0 = *(const LAS f32x4*)(sQ + rr * 128 + 32 * s + 8 * kq), a1 = *(const LAS f32x4*)(sQ + rr * 128 + 32 * s + 8 * kq + 4);
            const f32x4 b0 = *(const LAS f32x4*)(sK + rr * 128 + 32 * s + 8 * kq), b1 = *(const LAS f32x4*)(sK + rr * 128 + 32 * s + 8 * kq + 4);
            const bf16x8 af = __builtin_bit_cast(bf16x8, (u32x4){pk2(a0.x, a0.y), pk2(a0.z, a0.w), pk2(a1.x, a1.y), pk2(a1.z, a1.w)});
            const bf16x8 bfr = __builtin_bit_cast(bf16x8, (u32x4){pk2(b0.x, b0.y), pk2(b0.z, b0.w), pk2(b1.x, b1.y), pk2(b1.z, b1.w)});
            acc = __builtin_amdgcn_mfma_f32_16x16x32_bf16(af, bfr, acc, 0, 0, 0);
        }
        if (cl16 < 8 && kq < 2) {
#pragma unroll
            for (int i = 0; i < 4; ++i) { const int t = 4 * kq + i; sQK[t * 8 + cl16] = acc[i] * sW[t * 8 + cl16]; } }
    }
    {
        const float dn = wave_sum_fast(sQ[w * 128 + lane] * sN0[lane] + sQ[w * 128 + 64 + lane] * sN0[64 + lane]); if (lane == 0) sQN[w] = dn;
    }
    {
#pragma unroll
        for (int x = 0; x < 2; ++x) { const int idx = tid + 512 * x; sKW[idx] = sK[idx] * sSc[16 + (idx >> 7)]; }
    }
    {
        float part[8];
#pragma unroll
        for (int t = 0; t < 8; ++t) part[t] = 0.f;
#pragma unroll
        for (int d4 = 0; d4 < 8; ++d4)
#pragma unroll
            for (int t = 0; t < 8; ++t) { const f32x4 qv = *(const LAS f32x4*)(sQ + t * 128 + 32 * q4 + 4 * d4);
                part[t] += (qv.x * C[4 * d4] + qv.y * C[4 * d4 + 1]) + (qv.z * C[4 * d4 + 2] + qv.w * C[4 * d4 + 3]); }
#pragma unroll
        for (int t = 0; t < 8; ++t) sPart[(q4 * 8 + t) * 128 + e] = part[t];
    }
    __syncthreads();
    float hv[2];
#pragma unroll
    for (int tt = 0; tt < 2; ++tt) {
        const int t = 2 * q4 + tt;
        float numer = ((sPart[(0 * 8 + t) * 128 + e] + sPart[(1 * 8 + t) * 128 + e]) + (sPart[(2 * 8 + t) * 128 + e] + sPart[(3 * 8 + t) * 128 + e])) * sSc[t];
        float dd = sSc[t] * sQN[t];
#pragma unroll
        for (int s = 0; s < 8; ++s) { const float wq = sQK[t * 8 + s]; numer += wq * sV[s * 128 + e]; dd += wq; }
        hv[tt] = numer / fmaxf(fabsf(dd), sSc[8 + t]);
        const float ss = wave_sum(hv[tt] * hv[tt]);
        if (lane == 0) sNorm[w * 2 + tt] = ss;
    }
    {
        const float dC = sSc[24];
        float vv[8];
#pragma unroll
        for (int s = 0; s < 8; ++s) vv[s] = sV[s * 128 + e];
#pragma unroll
        for (int d4 = 0; d4 < 8; ++d4) {
            f32x4 acc = (f32x4){C[4 * d4], C[4 * d4 + 1], C[4 * d4 + 2], C[4 * d4 + 3]} * dC;
#pragma unroll
            for (int s = 0; s < 8; ++s) acc += *(const LAS f32x4*)(sKW + s * 128 + 32 * q4 + 4 * d4) * vv[s];
            C[4 * d4] = acc.x; C[4 * d4 + 1] = acc.y; C[4 * d4 + 2] = acc.z; C[4 * d4 + 3] = acc.w;
        }
        float* oC = F.out + O_SC + (size_t)bh * HD * HD;
#pragma unroll
        for (int dd = 0; dd < 32; ++dd) oC[(size_t)(32 * q4 + dd) * HD + e] = C[dd];
        if (tid < 128) { float nn = dC * n0;
#pragma unroll
            for (int s = 0; s < 8; ++s) nn += sKW[s * 128 + tid];
            F.out[O_SN + (size_t)bh * HD + tid] = nn; }
        if (tid == 0) F.out[O_SM + bh] = sSc[25];
    }
    __syncthreads();
    const float gn = F.mlstm_g[hd * HD + e];
#pragma unroll
    for (int tt = 0; tt < 2; ++tt) {
        const int t = 2 * q4 + tt; const float tot = sNorm[(w & ~1) * 2 + tt] + sNorm[(w | 1) * 2 + tt];
        const float y = hv[tt] * (1.0f / sqrtf(tot * (1.0f / HD) + EPS)) * gn * sigmoidf_(sOA[t * 128 + e]);
        F.MIX[(size_t)(row0 + t) * D + hd * HD + e] = (bf16_t)f2bf(y);
    }
    __syncthreads();
}
struct SmpPreG { float g0, g1, h0, h1, h2; };
__device__ __forceinline__ void sample_gdn(Frame& F, int b, int hd, SmpPreG& pre, bool has_next, int nb, int nhd) {
    LAS float* sQ = (LAS float*)(F.lds); LAS float* sK = sQ + 1024; LAS float* sV = sK + 1024; LAS float* sZ = sV + 1024; LAS float* sKs = sZ + 1024; LAS float* sU = sKs + 1024;
    LAS float* sPartK = sU + 1024;
    LAS float* sPartQ = sPartK + 4096;
    LAS float* sKK = sPartQ + 4096;
    LAS float* sQKr = sKK + 64;
    LAS float* sA = sQKr + 64;
    LAS float* sQKd = sA + 64;
    LAS float* sSc = sQKd + 64;
    LAS float* sNorm = sSc + 64;
    const int tid = F.tid, e = tid & 127, q4 = tid >> 7, lane = F.lane, w = F.wave;
    const int row0 = M_P + b * T_S, bh = b * NH + hd;
    asm volatile("s_waitcnt vmcnt(0)" ::: "memory"); __syncthreads();
    float S[32];
#pragma unroll
    for (int dd = 0; dd < 32; ++dd) S[dd] = ((const LAS float*)(F.lds + SMP_ST))[(32 * q4 + dd) * HD + e];
    if (tid < 384) {
        const int arr = tid >> 7, ch = arr * 1024 + hd * HD + e;
        float h0 = pre.h0, h1 = pre.h1, h2 = pre.h2;
        const float w0 = F.conv_w[ch], w1 = F.conv_w[CCONV + ch], w2 = F.conv_w[2 * CCONV + ch], w3 = F.conv_w[3 * CCONV + ch];
        float u[8];
#pragma unroll
        for (int t = 0; t < 8; ++t) u[t] = bf2f(((const LAS bf16_t*)(F.lds + SMP_RAW))[arr * 1024 + t * 128 + e]);
        LAS float* dst = sQ + arr * 1024 + e;
#pragma unroll
        for (int t = 0; t < 8; ++t) { const float cvv = ((w0 * h0 + w1 * h1) + w2 * h2) + w3 * u[t]; h0 = h1; h1 = h2; h2 = u[t]; dst[t * 128] = siluf_(cvv); }
        float* oc = F.out + O_SCONV + (size_t)b * 3 * CCONV + ch; oc[0] = h0; oc[CCONV] = h1; oc[2 * CCONV] = h2;
    } else {
#pragma unroll
        for (int t = 0; t < 8; ++t) sZ[t * 128 + e] = bf2f(((const LAS bf16_t*)(F.lds + SMP_RAW))[3 * 1024 + t * 128 + e]);
    }
    if (w == 0) {
        const int t = lane & 7;
        float G = -expf(F.A_log[hd]) * softplusf_(pre.g0 + F.dt_bias[hd]);
#pragma unroll
        for (int o = 1; o < 8; o <<= 1) { const float x = __shfl_up(G, o); if (t >= o) G += x; }
        if (lane < 8) { sSc[t] = G; sSc[8 + t] = sigmoidf_(pre.g1); sSc[16 + t] = expf(G); }
    }
    __syncthreads();
    if (has_next) {
        sample_dma(F, F.stS, nb, nhd, 4096, w, lane);
        if (w == 0) { const float* gp = F.GATES + (size_t)(M_P + nb * T_S + (lane & 7)) * NGATE; pre.g0 = gp[16 + nhd]; pre.g1 = gp[24 + nhd]; }
        if (tid < 384) { const float* cv = F.stConv + (size_t)nb * 3 * CCONV + (tid >> 7) * 1024 + nhd * HD + e; pre.h0 = cv[0]; pre.h1 = cv[CCONV]; pre.h2 = cv[2 * CCONV]; }
    }
    if (w == 0) {
        const int r16 = lane & 15, kq = lane >> 4;
        const LAS float* arow = (r16 < 8 ? sQ : sK) + (r16 & 7) * 128; const LAS float* brow = (r16 < 8 ? sK : sQ) + (r16 & 7) * 128;
        f32x4 acc = (f32x4){0.f, 0.f, 0.f, 0.f};
#pragma unroll
        for (int s = 0; s < 4; ++s) {
            const f32x4 a0 = *(const LAS f32x4*)(arow + 32 * s + 8 * kq), a1 = *(const LAS f32x4*)(arow + 32 * s + 8 * kq + 4);
            const f32x4 b0 = *(const LAS f32x4*)(brow + 32 * s + 8 * kq), b1 = *(const LAS f32x4*)(brow + 32 * s + 8 * kq + 4);
            const bf16x8 af = __builtin_bit_cast(bf16x8, (u32x4){pk2(a0.x, a0.y), pk2(a0.z, a0.w), pk2(a1.x, a1.y), pk2(a1.z, a1.w)});
            const bf16x8 bfr = __builtin_bit_cast(bf16x8, (u32x4){pk2(b0.x, b0.y), pk2(b0.z, b0.w), pk2(b1.x, b1.y), pk2(b1.z, b1.w)});
            acc = __builtin_amdgcn_mfma_f32_16x16x32_bf16(af, bfr, acc, 0, 0, 0);
        }
#pragma unroll
        for (int i = 0; i < 4; ++i) { const int R = 4 * kq + i, c = r16;
            if (R < 8 && c < 8) sQKr[R * 8 + c] = acc[i];
            if (R >= 8 && c < 8) { sKK[(R - 8) * 8 + c] = acc[i]; if (R - 8 == c) sSc[32 + c] = 1.0f / sqrtf(acc[i] + EPS); }
            if (R < 8 && c >= 8 && R == c - 8) sSc[24 + R] = 1.0f / sqrtf(acc[i] + EPS); }
    }
    {
        float pk[8], pq[8];
#pragma unroll
        for (int t = 0; t < 8; ++t) { pk[t] = 0.f; pq[t] = 0.f; }
#pragma unroll
        for (int d4 = 0; d4 < 8; ++d4)
#pragma unroll
            for (int t = 0; t < 8; ++t) { const f32x4 kv = *(const LAS f32x4*)(sK + t * 128 + 32 * q4 + 4 * d4), qv = *(const LAS f32x4*)(sQ + t * 128 + 32 * q4 + 4 * d4);
                pk[t] += (kv.x * S[4 * d4] + kv.y * S[4 * d4 + 1]) + (kv.z * S[4 * d4 + 2] + kv.w * S[4 * d4 + 3]);
                pq[t] += (qv.x * S[4 * d4] + qv.y * S[4 * d4 + 1]) + (qv.z * S[4 * d4 + 2] + qv.w * S[4 * d4 + 3]); }
#pragma unroll
        for (int t = 0; t < 8; ++t) { sPartK[(q4 * 8 + t) * 128 + e] = pk[t]; sPartQ[(q4 * 8 + t) * 128 + e] = pq[t]; }
    }
    __syncthreads();
    if (w == 0) {
        const int t = lane >> 3, s = lane & 7; const float dec = expf(sSc[t] - sSc[s]);
        sA[lane] = (s < t) ? sSc[8 + t] * dec * sSc[32 + t] * sSc[32 + s] * sKK[lane] : 0.f;
        sQKd[lane] = (s <= t) ? sSc[24 + t] * QK_SCALE * sSc[32 + s] * dec * sQKr[lane] : 0.f;
    }
    {
        const float G7 = sSc[7];
#pragma unroll
        for (int x = 0; x < 2; ++x) { const int idx = tid + 512 * x, s = idx >> 7; sKs[idx] = sK[idx] * (expf(G7 - sSc[s]) * sSc[32 + s]); }
    }
    __syncthreads();
    float ov[8];
    if (tid < 128) {
        float u[8];
#pragma unroll
        for (int t = 0; t < 8; ++t) {
            const float kS = ((sPartK[(0 * 8 + t) * 128 + e] + sPartK[(1 * 8 + t) * 128 + e]) + (sPartK[(2 * 8 + t) * 128 + e] + sPartK[(3 * 8 + t) * 128 + e])) * sSc[32 + t];
            float ut = sSc[8 + t] * (sV[t * 128 + e] - sSc[16 + t] * kS);
#pragma unroll
            for (int s = 0; s < 8; ++s) if (s < t) ut -= sA[t * 8 + s] * u[s];
            u[t] = ut; sU[t * 128 + e] = ut;
            float o = ((sPartQ[(0 * 8 + t) * 128 + e] + sPartQ[(1 * 8 + t) * 128 + e]) + (sPartQ[(2 * 8 + t) * 128 + e] + sPartQ[(3 * 8 + t) * 128 + e])) * (sSc[16 + t] * sSc[24 + t] * QK_SCALE);
#pragma unroll
            for (int s = 0; s < 8; ++s) if (s <= t) o += sQKd[t * 8 + s] * u[s];
            ov[t] = o;
            const float ss = wave_sum(o * o);
            if (lane == 0) sNorm[w * 8 + t] = ss;
        }
    }
    __syncthreads();
    {
        const float gL = sSc[23];
        float uu[8];
#pragma unroll
        for (int s = 0; s < 8; ++s) uu[s] = sU[s * 128 + e];
#pragma unroll
        for (int d4 = 0; d4 < 8; ++d4) {
            f32x4 acc = (f32x4){S[4 * d4], S[4 * d4 + 1], S[4 * d4 + 2], S[4 * d4 + 3]} * gL;
#pragma unroll
            for (int s = 0; s < 8; ++s) acc += *(const LAS f32x4*)(sKs + s * 128 + 32 * q4 + 4 * d4) * uu[s];
            S[4 * d4] = acc.x; S[4 * d4 + 1] = acc.y; S[4 * d4 + 2] = acc.z; S[4 * d4 + 3] = acc.w;
        }
        float* oS = F.out + O_SS + (size_t)bh * HD * HD;
#pragma unroll
        for (int dd = 0; dd < 32; ++dd) oS[(size_t)(32 * q4 + dd) * HD + e] = S[dd];
    }
    if (tid < 128) {
        const float gn = F.gdn_g[hd * HD + e];
#pragma unroll
        for (int t = 0; t < 8; ++t) { const float tot = sNorm[t] + sNorm[8 + t];
            const float y = ov[t] * (1.0f / sqrtf(tot * (1.0f / HD) + EPS)) * gn * siluf_(sZ[t * 128 + e]);
            F.MIX[(size_t)(row0 + t) * D + 1024 + hd * HD + e] = (bf16_t)f2bf(y); }
    }
    __syncthreads();
}

__device__ __forceinline__ void p4_scan_s1(Frame& F) {
    LAS float* scr = (LAS float*)(F.lds + F.wave * 19456);
    if (F.wave >= 4) { const int u = 4 * (int)blockIdx.x + (F.wave - 4); if (u < 1024) s1_mlstm_unit(F, u, scr); }
    else { const int u = 4 * (int)blockIdx.x + F.wave; if (u < 1024) s1_gdn_unit(F, u, scr); }
}
__device__ __forceinline__ void p4_scan_s2(Frame& F) {
    const int w = blockIdx.x;
    if (w < 32) s2_mlstm_chain(F, w);
    else if (w < 64) s2_gdn_chain(F, w - 32);
    else {
        const int stride = (int)gridDim.x - 64, first = w - 64, wv = F.wave, lane = F.lane, tid = F.tid, e = tid & 127;
        {
            int idx = first;
            if (idx < 1024) {
                SmpPre pre; pre.g0 = pre.g1 = pre.m0 = pre.n0 = 0.f;
                { const int b = idx >> 3, hd = idx & 7, bh = idx; sample_dma(F, F.stC, b, hd, 0, wv, lane);
                  if (wv == 0) { const float* gp = F.GATES + (size_t)(M_P + b * T_S + (lane & 7)) * NGATE; pre.g0 = gp[hd]; pre.g1 = gp[8 + hd]; pre.m0 = F.stM[bh]; }
                  if (tid < 128) pre.n0 = F.stN[(size_t)bh * HD + tid]; }
                for (; idx < 1024; idx += stride) { const int nidx = idx + stride; sample_mlstm(F, idx >> 3, idx & 7, pre, nidx < 1024, nidx >> 3, nidx & 7); }
            }
        }
        {
            int idx = first; while (idx < 1024) idx += stride; idx -= 1024;
            if (idx < 1024) {
                SmpPreG pre; pre.g0 = pre.g1 = pre.h0 = pre.h1 = pre.h2 = 0.f;
                { const int b = idx >> 3, hd = idx & 7; sample_dma(F, F.stS, b, hd, 4096, wv, lane);
                  if (wv == 0) { const float* gp = F.GATES + (size_t)(M_P + b * T_S + (lane & 7)) * NGATE; pre.g0 = gp[16 + hd]; pre.g1 = gp[24 + hd]; }
                  if (tid < 384) { const float* cv = F.stConv + (size_t)b * 3 * CCONV + (tid >> 7) * 1024 + hd * HD + e; pre.h0 = cv[0]; pre.h1 = cv[CCONV]; pre.h2 = cv[2 * CCONV]; } }
                for (; idx < 1024; idx += stride) { const int nidx = idx + stride; sample_gdn(F, idx >> 3, idx & 7, pre, nidx < 1024, nidx >> 3, nidx & 7); }
            }
        }
    }
}

template <int MIXER  >
__device__ __forceinline__ void s3_dma(const Frame& F, int unit, LAS unsigned char* dst, int w, int lane) {
    const unsigned char* sn = MIXER == 0 ? (const unsigned char*)F.HB + (size_t)unit * SNAPM : (const unsigned char*)F.X1 + (size_t)unit * SNAPG;
    const unsigned char* rec = MIXER == 0 ? F.IMGM + (size_t)unit * MREC : F.IMGG + (size_t)unit * GREC;
    for (int piece = w; piece < 50; piece += 8) {
        const unsigned char* s = piece < 32 ? sn + piece * 1024 : piece < 48 ? (MIXER == 0 ? rec + MR_VT + (piece - 32) * 1024 : sn + piece * 1024)
                                 : piece == 48 ? (MIXER == 0 ? sn + 32768 : rec + GR_SC) : rec + (MIXER == 0 ? MR_SC : GR_SC);
        __builtin_amdgcn_global_load_lds((const unsigned*)(s + lane * 16), (LAS unsigned*)(dst + piece * 1024), 16, 0, 0); }
}
template <int MIXER>
__device__ __forceinline__ void s3_prefetch(const Frame& F, int unit, int tb, int wh, int lane, bf16x8 (&fq)[4], bf16x8 (&fs)[2], unsigned (&gt)[16]) {
    const unsigned char* rec = MIXER == 0 ? F.IMGM + (size_t)unit * MREC : F.IMGG + (size_t)unit * GREC;
#pragma unroll
    for (int x = 0; x < 4; ++x) fq[x] = *(const bf16x8*)(rec + (MIXER == 0 ? MR_QI : GR_QG) + (tb * 4 + x) * 1024 + lane * 16);
#pragma unroll
    for (int x = 0; x < 2; ++x) fs[x] = *(const bf16x8*)(rec + (MIXER == 0 ? MR_SP : GR_QK) + (tb * 2 + x) * 1024 + lane * 16);
    const int c = unit & 31, bh = unit >> 5, hd = bh & 7, b = bh >> 3, row0 = b * T_P + 64 * c + 16 * tb, cl = lane & 15, q = lane >> 4;
#pragma unroll
    for (int x = 0; x < 4; ++x)
#pragma unroll
        for (int i = 0; i < 4; ++i) gt[x * 4 + i] = F.PROJ[(size_t)(row0 + 4 * q + i) * NPROJ + (MIXER == 0 ? 3072 : 7168) + hd * HD + 16 * (4 * wh + x) + cl];
}
template <int MIXER>
__device__ __forceinline__ void s3_wg(Frame& F, int u0) {
    const int lane = F.lane, wv = F.wave, cl = lane & 15, q = lane >> 4, tb = wv & 3, wh = wv >> 2;
    constexpr int IMG = 51200;
    LAS unsigned char* const buf0 = F.lds; LAS unsigned char* const buf1 = F.lds + IMG;
    LAS float* const s_part = (LAS float*)(F.lds + 2 * IMG);
    bf16x8 fq[4], fs[2], fqn[4], fsn[2]; unsigned gt[16], gtn[16];
    u32x2 yv[4]; size_t yoff = 0; bool ypend = false;
    s3_dma<MIXER>(F, u0, buf0, wv, lane);
    s3_prefetch<MIXER>(F, u0, tb, wh, lane, fq, fs, gt);
    asm volatile("s_waitcnt vmcnt(0)" ::: "memory"); __syncthreads();
#pragma unroll 1
    for (int k = 0; k < 8; ++k) {
        const int unit = u0 + k;
        LAS unsigned char* const cur = (k & 1) ? buf1 : buf0; LAS unsigned char* const nxt = (k & 1) ? buf0 : buf1;
        const int c = unit & 31, bh = unit >> 5, hd = bh & 7, b = bh >> 3, row0 = b * T_P + 64 * c + 16 * tb;
        if (ypend) {
#pragma unroll
            for (int x = 0; x < 4; ++x) { bf16_t* o = F.MIX + yoff + 16 * x;
                o[0] = (bf16_t)(yv[x].x & 0xffffu); o[D] = (bf16_t)(yv[x].x >> 16); o[2 * D] = (bf16_t)(yv[x].y & 0xffffu); o[3 * D] = (bf16_t)(yv[x].y >> 16); } }
        if (k + 1 < 8) { s3_dma<MIXER>(F, unit + 1, nxt, wv, lane); s3_prefetch<MIXER>(F, unit + 1, tb, wh, lane, fqn, fsn, gtn); }
        const LAS float* sc = (const LAS float*)(cur + (MIXER == 0 ? 50176 : 49152)) + 16 * tb;
        float den2e = EPS;
        if (MIXER == 0) {
            const LAS float* np = (const LAS float*)(cur + 49152);
            float acc = 0.f;
#pragma unroll
            for (int s = 0; s < 4; ++s) { const f32x4 n0 = *(const LAS f32x4*)(np + 32 * s + 4 * q), n1 = *(const LAS f32x4*)(np + 32 * s + 16 + 4 * q); const u32x4 qv = __builtin_bit_cast(u32x4, fq[s]);
                acc += ((bflo(qv.x) * n0.x + bfhi(qv.x) * n0.y) + (bflo(qv.y) * n0.z + bfhi(qv.y) * n0.w)) + ((bflo(qv.z) * n1.x + bfhi(qv.z) * n1.y) + (bflo(qv.w) * n1.z + bfhi(qv.w) * n1.w)); }
            acc += __shfl_xor(acc, 16); acc += __shfl_xor(acc, 32);
            const float dd = sc[cl] * acc + sc[128 + cl], den = fmaxf(fabsf(dd), sc[64 + cl]);
            den2e = EPS * den * den;
        }
        const f32x4 rsc = *(const LAS f32x4*)(sc + 4 * q);
        const bf16x8 fs1 = (tb >= 2) ? fs[1] : (bf16x8){0, 0, 0, 0, 0, 0, 0, 0};
        f32x4 num[4];
#pragma unroll
        for (int x = 0; x < 4; ++x) { const int w = 4 * wh + x;
            bf16x8 Bf[4], Vf[2];
#pragma unroll
            for (int s = 0; s < 4; ++s) Bf[s] = *(const LAS bf16x8*)(cur + ((w * 4 + s) * 64 + lane) * 16);
#pragma unroll
            for (int s = 0; s < 2; ++s) Vf[s] = *(const LAS bf16x8*)(cur + 32768 + ((w * 2 + s) * 64 + lane) * 16);
            f32x4 a0 = (f32x4){0.f, 0.f, 0.f, 0.f};
#pragma unroll
            for (int s = 0; s < 4; ++s) a0 = __builtin_amdgcn_mfma_f32_16x16x32_bf16(fq[s], Bf[s], a0, 0, 0, 0);
            a0 = a0 * rsc;
            a0 = __builtin_amdgcn_mfma_f32_16x16x32_bf16(fs[0], Vf[0], a0, 0, 0, 0);
            a0 = __builtin_amdgcn_mfma_f32_16x16x32_bf16(fs1, Vf[1], a0, 0, 0, 0);
            num[x] = a0; }
        f32x4 ss = (num[0] * num[0] + num[1] * num[1]) + (num[2] * num[2] + num[3] * num[3]);
        ss.x = row16_sum(ss.x); ss.y = row16_sum(ss.y); ss.z = row16_sum(ss.z); ss.w = row16_sum(ss.w);
        if (cl == 0) *(LAS f32x4*)(s_part + wv * 16 + 4 * q) = ss;
        __syncthreads();
        const f32x4 tot = ss + *(const LAS f32x4*)(s_part + (wv ^ 4) * 16 + 4 * q);
        float scl[4];
#pragma unroll
        for (int i = 0; i < 4; ++i) { const float d2 = MIXER == 0 ? __shfl(den2e, 4 * q + i) : EPS; scl[i] = __frsqrt_rn(tot[i] * (1.0f / HD) + d2); }
#pragma unroll
        for (int x = 0; x < 4; ++x) { const int w = 4 * wh + x; const float gn = (MIXER == 0 ? F.mlstm_g : F.gdn_g)[hd * HD + 16 * w + cl];
            float y[4];
#pragma unroll
            for (int i = 0; i < 4; ++i) { const float g = bflo(gt[x * 4 + i]); y[i] = num[x][i] * scl[i] * gn * (MIXER == 0 ? sigmoidf_(g) : siluf_(g)); }
            yv[x] = (u32x2){pk2(y[0], y[1]), pk2(y[2], y[3])}; }
        yoff = (size_t)(row0 + 4 * q) * D + MIXER * 1024 + hd * HD + 64 * wh + cl; ypend = true;
        asm volatile("s_waitcnt vmcnt(0)" ::: "memory"); __syncthreads();
#pragma unroll
        for (int x = 0; x < 4; ++x) fq[x] = fqn[x];
        fs[0] = fsn[0]; fs[1] = fsn[1];
#pragma unroll
        for (int x = 0; x < 16; ++x) gt[x] = gtn[x];
    }
#pragma unroll
    for (int x = 0; x < 4; ++x) { bf16_t* o = F.MIX + yoff + 16 * x;
        o[0] = (bf16_t)(yv[x].x & 0xffffu); o[D] = (bf16_t)(yv[x].x >> 16); o[2 * D] = (bf16_t)(yv[x].y & 0xffffu); o[3 * D] = (bf16_t)(yv[x].y >> 16); }
}
__device__ __forceinline__ void p4_scan_s3(Frame& F) {
    const int g = blockIdx.x;
    if (g < 128) s3_wg<0>(F, g * 8); else s3_wg<1>(F, (g - 128) * 8);
}

#ifndef PROBE_REPEAT
#define PROBE_REPEAT -1
#endif
__device__ __forceinline__ void ph1(Frame& F) { p1_modgemv(F); p1_transposes(F); }

template <int MODE>
__device__ __forceinline__ void norm_finish(const f32x4 (&v)[8], const f32x4 (&gg)[8], const f32x4 (&sh)[8], const f32x4 (&sc)[8], bf16_t* ob, float* of, int lane) {
    float s = 0.f;
#pragma unroll
    for (int j = 0; j < 8; ++j) s += (v[j].x * v[j].x + v[j].y * v[j].y) + (v[j].z * v[j].z + v[j].w * v[j].w);
    const float rstd = 1.0f / sqrtf(wave_sum(s) * (1.0f / D) + EPS);
#pragma unroll
    for (int j = 0; j < 8; ++j) { const f32x4 y = (v[j] * rstd * gg[j]) * (sc[j] + 1.0f) + sh[j];
        if (MODE == 10) ((f32x4*)of)[lane + 64 * j] = y; else { u32x2 w; w.x = pk2(y.x, y.y); w.y = pk2(y.z, y.w); ((u32x2*)ob)[lane + 64 * j] = w; } }
}
template <int MODE>
__device__ __forceinline__ void norm_phase(Frame& F) {
    const int lane = F.lane;
    const float* gsrc = MODE == 2 ? F.norm1 : (MODE == 7 ? F.norm2 : F.normf);
    f32x4 gg[8], sh[8], sc[8], v[8], vn[8];
#pragma unroll
    for (int j = 0; j < 8; ++j) gg[j] = ((const f32x4*)gsrc)[lane + 64 * j];
    {
        const int r0 = 4 * F.gw, gb = r0 >> 11;
        const float* md = MODE == 10 ? F.MODF + (size_t)gb * MODFW : F.MOD + (size_t)gb * MODW + (MODE == 7 ? 3 * D : 0);
        const float* src = MODE == 2 ? F.xp : (MODE == 7 ? F.X1 : F.out + O_Y);
#pragma unroll
        for (int j = 0; j < 8; ++j) { sh[j] = ((const f32x4*)md)[lane + 64 * j]; sc[j] = ((const f32x4*)(md + D))[lane + 64 * j]; }
#pragma unroll
        for (int j = 0; j < 8; ++j) v[j] = ((const f32x4*)(src + (size_t)r0 * D))[lane + 64 * j];
#pragma unroll
        for (int k = 0; k < 4; ++k) {
            if (k < 3) {
#pragma unroll
                for (int j = 0; j < 8; ++j) vn[j] = ((const f32x4*)(src + (size_t)(r0 + k + 1) * D))[lane + 64 * j]; }
            norm_finish<MODE>(v, gg, sh, sc, F.HB + (size_t)(r0 + k) * D, F.out + O_Y + (size_t)(r0 + k) * D, lane);
#pragma unroll
            for (int j = 0; j < 8; ++j) v[j] = vn[j];
        }
    }
    if (F.gw < M_S) {
        const int r = M_P + F.gw, gb = row_gb(r);
        const float* md = MODE == 10 ? F.MODF + (size_t)gb * MODFW : F.MOD + (size_t)gb * MODW + (MODE == 7 ? 3 * D : 0);
#pragma unroll
        for (int j = 0; j < 8; ++j) { sh[j] = ((const f32x4*)md)[lane + 64 * j]; sc[j] = ((const f32x4*)(md + D))[lane + 64 * j]; }
        if (MODE == 2) {
#pragma unroll
            for (int j = 0; j < 8; ++j) v[j] = ((const f32x4*)(F.xs + (size_t)F.gw * D))[lane + 64 * j];
        } else {
            const float* part = (const float*)F.IMGM; const int pmx = F.gw >> 8, rr = F.gw & 255;
            const float* base = MODE == 7 ? F.xs + (size_t)F.gw * D : F.X1 + (size_t)r * D;
            const float* gate = F.MOD + (size_t)gb * MODW + (MODE == 7 ? 2 * D : 5 * D);
#pragma unroll
            for (int jh = 0; jh < 4; ++jh) {
                f32x4 t[2][8];
#pragma unroll
                for (int j = 0; j < 2; ++j)
#pragma unroll
                    for (int ks = 0; ks < 8; ++ks) t[j][ks] = *(const f32x4*)(part + ((size_t)(ks * 32 + pmx * 8 + 2 * jh + j) * 256 + rr) * 256 + 4 * lane);
#pragma unroll
                for (int j = 0; j < 2; ++j) { const f32x4 s = ((t[j][0] + t[j][1]) + (t[j][2] + t[j][3])) + ((t[j][4] + t[j][5]) + (t[j][6] + t[j][7]));
                    const f32x4 bs = ((const f32x4*)base)[lane + 64 * (2 * jh + j)], g = ((const f32x4*)gate)[lane + 64 * (2 * jh + j)];
                    v[2 * jh + j] = bs + g * s; }
            }
            if (MODE == 7) {
#pragma unroll
                for (int j = 0; j < 8; ++j) ((f32x4*)(F.X1 + (size_t)r * D))[lane + 64 * j] = v[j]; }
        }
        norm_finish<MODE>(v, gg, sh, sc, F.HB + (size_t)r * D, F.out + O_Y + (size_t)r * D, lane);
    }
}
__device__ __forceinline__ void ph2(Frame& F) { norm_phase<2>(F); }
__device__ __forceinline__ void ph7(Frame& F) { norm_phase<7>(F); }
__device__ __forceinline__ void ph10(Frame& F) { norm_phase<10>(F); }
__device__ __forceinline__ void ph3(Frame& F) {
    p3_gates(F);
    asm volatile("s_waitcnt vmcnt(0) lgkmcnt(0)" ::: "memory"); __syncthreads();
    pg8::Gemm g{F.HB, F.WIN, M, NPROJ, D}; pg8::StaticOrder S; S.init(M, NPROJ, D, gridDim.x, (int)blockIdx.x);
    pg8::EpiBf16<0> E{F.PROJ, NPROJ};
    pg8::gemm_phase<pg8::EpiBf16<0>, pg8::StaticOrder, true, true>(F.lds + RING_OFF, g, S, E);
}
__device__ __forceinline__ void ph6(Frame& F) {
    pg8::Gemm g{F.MIX, F.WOUT, M, D, D}; pg8::SplitOrder S; S.init(D, (int)blockIdx.x);
    pg8::EpiRes E{F.xp, F.xs, M_P, F.MOD + 2 * D, MODW, F.X1, D, (float*)F.IMGM};
    pg8::gemm_phase<pg8::EpiRes, pg8::SplitOrder, true, true>(F.lds + RING_OFF, g, S, E);
}
__device__ __forceinline__ void ph8(Frame& F) {
    pg8::Gemm g{F.HB, F.WUP, M, DFF, D}; pg8::StaticOrder S; S.init(M, DFF, D, gridDim.x, (int)blockIdx.x);
    pg8::EpiBf16<1> E{F.PROJ, DFF};
    pg8::gemm_phase<pg8::EpiBf16<1>, pg8::StaticOrder, true, true>(F.lds + RING_OFF, g, S, E);
}
__device__ __forceinline__ void ph9(Frame& F) {
    pg8::Gemm g{F.PROJ, F.WDOWN, M, D, DFF}; pg8::SplitOrder S; S.init(DFF, (int)blockIdx.x);
    pg8::EpiRes E{F.X1, F.X1, M, F.MOD + 5 * D, MODW, F.out + O_Y, D, (float*)F.IMGM};
    pg8::gemm_phase<pg8::EpiRes, pg8::SplitOrder, true, true>(F.lds + RING_OFF, g, S, E);
}

struct Args { const float* in[26]; float* out; unsigned char* ws; int ph_lo, ph_hi; };
constexpr int NPHASE = 12;
__global__ void __launch_bounds__(NTHREADS, 2) fwd_kernel(Args args) {
    extern __shared__ __attribute__((aligned(16))) unsigned char lds[];
    Frame F;
    F.lds = (LAS unsigned char*)lds;
    F.tid = threadIdx.x; F.lane = F.tid & 63; F.wave = __builtin_amdgcn_readfirstlane(F.tid >> 6);
    F.gw = blockIdx.x * NWAVES + F.wave; F.ngw = gridDim.x * NWAVES;
    F.xp = args.in[0]; F.xs = args.in[1]; F.stC = args.in[2]; F.stN = args.in[3]; F.stM = args.in[4]; F.stS = args.in[5]; F.stConv = args.in[6]; F.cp = args.in[7]; F.cs = args.in[8];
    F.ada_w = args.in[9]; F.ada_b = args.in[10]; F.norm1 = args.in[11]; F.w_in = args.in[12]; F.gate_b = args.in[13]; F.mlstm_g = args.in[14]; F.conv_w = args.in[15]; F.A_log = args.in[16];
    F.dt_bias = args.in[17]; F.gdn_g = args.in[18]; F.w_out = args.in[19]; F.norm2 = args.in[20]; F.w_up = args.in[21]; F.w_down = args.in[22]; F.adaf_w = args.in[23]; F.adaf_b = args.in[24]; F.normf = args.in[25];
    F.out = args.out;
    unsigned char* ws = args.ws;
    F.SCB = (bf16_t*)(ws + WS_SCB); F.WIN = (bf16_t*)(ws + WS_WIN); F.WOUT = (bf16_t*)(ws + WS_WOUT); F.WUP = (bf16_t*)(ws + WS_WUP); F.WDOWN = (bf16_t*)(ws + WS_WDOWN);
    F.HB = (bf16_t*)(ws + WS_HB); F.MIX = (bf16_t*)(ws + WS_MIX); F.PROJ = (bf16_t*)(ws + WS_PROJ);
    F.IMGM = ws + WS_IMGM; F.IMGG = ws + WS_IMGG; F.MOD = (float*)(ws + WS_MOD); F.MODF = (float*)(ws + WS_MODF); F.GATES = (float*)(ws + WS_GATES); F.X1 = (float*)(ws + WS_X1);

    for (int u = F.tid; u < (LDS_BYTES - LDSCTL_OFF) / 4; u += NTHREADS) ((LAS unsigned*)(F.lds + LDSCTL_OFF))[u] = 0u;
    __syncthreads();
    XcdBarrier bar; bar.bar = (unsigned*)(ws + WS_CTL) + CW_BAR; bar.x = 0; bar.st = nullptr;
#if MK_ONE_LAUNCH
    bar = xcd_barrier_post((unsigned*)(ws + WS_CTL) + CW_BAR, (volatile LAS unsigned*)(F.lds + MISC_OFF) + 8);
#define GRID_BAR() xcd_barrier(bar)
#else
#define GRID_BAR() do { } while (0)
#endif
    const int lo = args.ph_lo, hi = args.ph_hi;
#define IN(k) (lo <= (k) && (k) < hi)
#define BOTH(k) (IN(k) && IN((k) + 1))

#define RUN(k, body) if (IN(k)) { body; if (PROBE_REPEAT == (k)) { GRID_BAR(); body; } if (BOTH(k)) GRID_BAR(); }
    RUN(0, p0_silu(F))
    RUN(1, ph1(F))
    RUN(2, ph2(F))
    RUN(3, ph3(F))
    RUN(4, p4_scan_s1(F))
    RUN(5, p4_scan_s2(F))
    RUN(6, p4_scan_s3(F))
    RUN(7, ph6(F))
    RUN(8, ph7(F))
    RUN(9, ph8(F))
    RUN(10, ph9(F))
    RUN(11, ph10(F))
#undef RUN
#undef IN
#undef BOTH
}

extern "C" void kernel_launch(void* const* d_in, const int* in_sizes, int n_in, void* d_out, int out_size, void* d_ws, size_t ws_size, hipStream_t stream) {
    static int ok = 0;
    if (ok == 0) {
        if (n_in != 26 || (size_t)out_size != O_END || ws_size < WS_END) { fprintf(stderr, "kernel_launch: unexpected shapes: n_in %d out %d ws %zu\n", n_in, out_size, ws_size); ok = -1; return; }
        if (hipFuncSetAttribute((const void*)fwd_kernel, hipFuncAttributeMaxDynamicSharedMemorySize, LDS_BYTES) != hipSuccess) { fprintf(stderr, "kernel_launch: hipFuncSetAttribute failed\n"); ok = -1; return; }
        int dev = 0, cus = 0, per_cu = 0;
        (void)hipGetDevice(&dev); (void)hipDeviceGetAttribute(&cus, hipDeviceAttributeMultiprocessorCount, dev);
        (void)hipOccupancyMaxActiveBlocksPerMultiprocessor(&per_cu, (const void*)fwd_kernel, NTHREADS, LDS_BYTES);
        if (cus != GRID || per_cu < 1) fprintf(stderr, "kernel_launch: note: %d CUs, %d blocks/CU reported; launching %d workgroups\n", cus, per_cu, GRID);
        (void)hipGetLastError();
        ok = 1;
    }
    if (ok < 0) return;
    (void)hipMemsetAsync((char*)d_ws + WS_CTL, 0, CTL_ZERO_BYTES, stream);
    Args a{};
    for (int i = 0; i < 26; ++i) a.in[i] = (const float*)d_in[i];
    a.out = (float*)d_out; a.ws = (unsigned char*)d_ws;
#if MK_ONE_LAUNCH
    a.ph_lo = 0; a.ph_hi = NPHASE;
    hipLaunchKernelGGL(fwd_kernel, dim3(GRID), dim3(NTHREADS), LDS_BYTES, stream, a);
#else
    for (int p = 0; p < NPHASE; ++p) { a.ph_lo = p; a.ph_hi = p + 1; hipLaunchKernelGGL(fwd_kernel, dim3(GRID), dim3(NTHREADS), LDS_BYTES, stream, a); }
#endif
}
```

```cpp
#include <hip/hip_runtime.h>
#include <cstdio>
#include <cstdint>

#define LAS __attribute__((address_space(3)))
#define GAS __attribute__((address_space(1)))
typedef unsigned short bf16_t;
typedef short bf16x8 __attribute__((ext_vector_type(8)));
typedef float f32x4 __attribute__((ext_vector_type(4)));
typedef float f32x2 __attribute__((ext_vector_type(2)));
typedef float f32x16 __attribute__((ext_vector_type(16)));
typedef unsigned u32x4 __attribute__((ext_vector_type(4)));
typedef unsigned u32x2 __attribute__((ext_vector_type(2)));

#ifndef MK_ONE_LAUNCH
#define MK_ONE_LAUNCH 1
#endif

constexpr int D = 2048, T_P = 2048, NB_P = 4, NB_S = 128, T_S = 8;
constexpr int M_P = NB_P * T_P, M_S = NB_S * T_S, M = M_P + M_S;
constexpr int NH = 8, HD = 128;
constexpr int P_IN = 8224, NPROJ = 8192, NGATE = 32, DFF = 8192, CCONV = 3072;
constexpr int NGB = NB_P + NB_S;
constexpr int MODW = 6 * D, MODFW = 2 * D;
constexpr float EPS = 1e-6f;
constexpr int NWAVES = 8, NTHREADS = 512, GRID = 256;

constexpr size_t O_Y = 0;
constexpr size_t O_PC = (size_t)M * D;
constexpr size_t O_PN = O_PC + (size_t)NB_P * NH * HD * HD;
constexpr size_t O_PM = O_PN + (size_t)NB_P * NH * HD;
constexpr size_t O_PS = O_PM + (size_t)NB_P * NH;
constexpr size_t O_PCONV = O_PS + (size_t)NB_P * NH * HD * HD;
constexpr size_t O_SC = O_PCONV + (size_t)NB_P * 3 * CCONV;
constexpr size_t O_SN = O_SC + (size_t)NB_S * NH * HD * HD;
constexpr size_t O_SM = O_SN + (size_t)NB_S * NH * HD;
constexpr size_t O_SS = O_SM + (size_t)NB_S * NH;
constexpr size_t O_SCONV = O_SS + (size_t)NB_S * NH * HD * HD;
constexpr size_t O_END = O_SCONV + (size_t)NB_S * 3 * CCONV;
static_assert(O_END == 54830112, "d_out size");

constexpr size_t MiB = 1u << 20;
constexpr size_t WS_CTL = 0, CTL_ZERO_BYTES = 64 * 1024;
constexpr size_t WS_SCB = 1 * MiB;
constexpr size_t WS_MOD = 2 * MiB;
constexpr size_t WS_MODF = 9 * MiB;
constexpr size_t WS_GATES = 12 * MiB;
constexpr size_t WS_WIN = 16 * MiB;
constexpr size_t WS_WOUT = 49 * MiB;
constexpr size_t WS_WUP = 57 * MiB;
constexpr size_t WS_WDOWN = 89 * MiB;
constexpr size_t WS_HB = 121 * MiB;
constexpr size_t WS_MIX = 157 * MiB;
constexpr size_t WS_X1 = 193 * MiB;
constexpr size_t WS_PROJ = 265 * MiB;
constexpr size_t WS_IMGM = 409 * MiB;
constexpr size_t WS_IMGG = 467 * MiB;
constexpr size_t WS_END = 540 * MiB;
constexpr int MREC = 59392, MR_QI = 0, MR_SP = 16384, MR_KW = 24576, MR_VT = 40960, MR_SC = 57344, MR_DN = 58368;
static_assert(WS_WIN + (size_t)P_IN * D * 2 <= WS_WOUT && WS_PROJ + (size_t)M * NPROJ * 2 <= WS_IMGM && WS_IMGM + (size_t)1024 * MREC <= WS_IMGG && WS_IMGG + (size_t)1024 * 74752 <= WS_END, "ws map");
constexpr int SNAPM = 33280;
static_assert((size_t)1024 * SNAPM <= (size_t)M * D * 2, "snapshots fit in HB");
constexpr int SNAPG = 49152;
static_assert((size_t)1024 * SNAPG <= (size_t)M * D * 4, "GDN snapshots fit in X1");
constexpr int GREC = 74752, GR_QG = 0, GR_WI = 16384, GR_KT = 32768, GR_QK = 49152, GR_SC = 57344, GR_UP = 58368, GDMA_BYTES = 58368;

constexpr int CW_BAR = 1024;

__device__ __forceinline__ unsigned f2bf(float f) { unsigned u = __builtin_bit_cast(unsigned, f); return (u + 0x7fffu + ((u >> 16) & 1u)) >> 16; }
typedef __bf16 bf16x2_t __attribute__((ext_vector_type(2)));
__device__ __forceinline__ unsigned pk2(float lo, float hi) { const f32x2 v = {lo, hi}; return __builtin_bit_cast(unsigned, __builtin_convertvector(v, bf16x2_t)); }
__device__ __forceinline__ float bf2f(bf16_t b) { return __builtin_bit_cast(float, (unsigned)b << 16); }
__device__ __forceinline__ float bflo(unsigned w) { return __builtin_bit_cast(float, w << 16); }
__device__ __forceinline__ float bfhi(unsigned w) { return __builtin_bit_cast(float, w & 0xffff0000u); }
__device__ __forceinline__ float wave_sum(float v) {
#pragma unroll
    for (int o = 1; o < 64; o <<= 1) v += __shfl_xor(v, o);
    return v;
}
template <int CTRL> __device__ __forceinline__ float dpp_mov(float x) { return __builtin_bit_cast(float, __builtin_amdgcn_update_dpp(0, __builtin_bit_cast(int, x), CTRL, 0xf, 0xf, false)); }
__device__ __forceinline__ float quad_sum(float x) { x += dpp_mov<0xB1>(x); x += dpp_mov<0x4E>(x); return x; }
__device__ __forceinline__ float row8_sum(float x) { x = quad_sum(x); x += dpp_mov<0x141>(x); return x; }
__device__ __forceinline__ float row16_sum(float x) { x = row8_sum(x); x += dpp_mov<0x140>(x); return x; }
__device__ __forceinline__ float wave_sum_fast(float x) { x = row16_sum(x); x += __shfl_xor(x, 16); x += __shfl_xor(x, 32); return x; }
__device__ __forceinline__ float sigmoidf_(float x) { return 1.0f / (1.0f + __expf(-x)); }
__device__ __forceinline__ float siluf_(float x) { return x / (1.0f + __expf(-x)); }
__device__ __forceinline__ float softplusf_(float x) { return fmaxf(x, 0.f) + log1pf(__expf(-fabsf(x))); }
__device__ __forceinline__ float logsigmoidf_(float x) { return fminf(x, 0.f) - log1pf(__expf(-fabsf(x))); }
__device__ __forceinline__ int row_gb(int r) { return r < M_P ? (r >> 11) : NB_P + ((r - M_P) >> 3); }
namespace pg8 {
#define PG8_LAS __attribute__((address_space(3)))
constexpr int BM = 256, BK = 64, HALF = 128, HTB = HALF * BK * 2  , STAGE_BYTES = 8 * HTB, NXCD = 8, WGM = 8;

__host__ __device__ __forceinline__ int lds_byte(int r, int c) { const int st = (r >> 4) * 2 + (c >> 5), rr = r & 15, cc = c & 31, ob = rr * 64 + cc * 2; return st * 1024 + (ob ^ (((ob >> 9) & 1) << 5)); }
__host__ __device__ __forceinline__ void stage_rc(int b, int& R, int& C) { const int st = b / 1024, sb = b % 1024, swz = sb ^ (((sb >> 9) & 1) << 5); R = (st >> 1) * 16 + swz / 64; C = (st & 1) * 32 + (swz % 64) / 2; }
__host__ __device__ __forceinline__ int perm32(int rho) { const int n = rho >> 4, i = rho & 15; return 8 * (i >> 2) + 4 * n + (i & 3); }

struct Unit { int pm, pn, k0, nt, part, ks, xt, mh; };
struct Gemm { const bf16_t* A; const bf16_t* Bt; int M, N, K; };

struct StaticOrder {
    int nM, nN, nwg, G, c, ntk;
    __host__ __device__ void init(int M, int N, int K, int G_, int c_) { nM = M / BM; nN = N / BM; nwg = nM * nN; G = G_; c = c_; ntk = K / BK; }
    __host__ __device__ bool next(int i, Unit& u) const {
        long L = (long)i * G + c; int mh = 0;
        if ((long)i * G + G > nwg && (long)i * G < nwg && nwg - i * G == G / 2 && (G & 15) == 0) {
            L = (long)i * G + (((c >> 4) << 3) | (c & 7)); mh = 1 + ((c >> 3) & 1); }
        if (L >= nwg) return false;
        int wgid = (int)L; { const int q = nwg / NXCD, r = nwg % NXCD, xcd = wgid % NXCD, off = wgid / NXCD; wgid = (xcd < r ? xcd * (q + 1) : r * (q + 1) + (xcd - r) * q) + off; }
        const int nig = WGM * nN, gid = wgid / nig, fm = gid * WGM, gsz = (nM - fm) < WGM ? (nM - fm) : WGM;
        u.pm = fm + ((wgid % nig) % gsz); u.pn = (wgid % nig) / gsz; u.k0 = 0; u.nt = ntk; u.part = 0; u.ks = 0; u.xt = 0; u.mh = mh; return true;
    }
    __device__ __forceinline__ void a_ready(const Unit&) const {}
    __device__ __forceinline__ void done(const Unit&) const {}
};
struct SplitOrder {
    int c, ntk;
    __host__ __device__ void init(int K, int c_) { c = c_; ntk = K / BK; }
    __host__ __device__ bool next(int i, Unit& u) const {
        if (i == 0) { const int wgid = (c % NXCD) * 32 + c / NXCD; u.pm = (wgid >> 6) * 8 + (wgid & 7); u.pn = (wgid & 63) >> 3; u.k0 = 0; u.nt = ntk; u.part = 0; u.ks = 0; u.xt = 0; u.mh = 0; return true; }
        if (i == 1) { const int xt = c >> 3, ks = c & 7; u.pm = 32 + (xt >> 3); u.pn = xt & 7; u.nt = ntk / 8; u.k0 = ks * (ntk / 8) * BK; u.part = 1; u.ks = ks; u.xt = xt; u.mh = 0; return true; }
        return false;
    }
    __device__ __forceinline__ void a_ready(const Unit&) const {}
    __device__ __forceinline__ void done(const Unit&) const {}
};


__device__ __forceinline__ unsigned cvt_pk_bf16(float lo, float hi) { unsigned r; asm volatile("v_cvt_pk_bf16_f32 %0, %1, %2" : "=v"(r) : "v"(lo), "v"(hi)); return r; }
template <int ACT  > struct EpiBf16 {
    static constexpr bool PERM = true, AFTER_DRAIN = false;
    bf16_t* O; int ldc;
    __device__ __forceinline__ void operator()(const f32x4 (&acc)[2][2][4][2], const Unit& u, int wr, int wc, int fr, int fq) const {
        const int row0 = u.pm * BM + wr * 64 + fr, col0 = u.pn * BM + wc * 32 + 8 * fq;
#pragma unroll
        for (int ai = 0; ai < 2; ++ai) { if (u.mh == 2 - ai) continue;
#pragma unroll
            for (int m = 0; m < 4; ++m) { bf16_t* rowp = O + (size_t)(row0 + ai * HALF + m * 16) * ldc + col0;
#pragma unroll
                for (int bj = 0; bj < 2; ++bj) { f32x4 v0 = acc[ai][bj][m][0], v1 = acc[ai][bj][m][1];
                    if (ACT == 1) {
#pragma unroll
                        for (int q = 0; q < 4; ++q) { const float a = fmaxf(v0[q], 0.f), b = fmaxf(v1[q], 0.f); v0[q] = a * a; v1[q] = b * b; } }
                    u32x4 w; w.x = cvt_pk_bf16(v0[0], v0[1]); w.y = cvt_pk_bf16(v0[2], v0[3]); w.z = cvt_pk_bf16(v1[0], v1[1]); w.w = cvt_pk_bf16(v1[2], v1[3]);
                    *(u32x4*)(rowp + bj * HALF) = w; } } }
    }
};
struct EpiRes {
    static constexpr bool PERM = false, AFTER_DRAIN = false;
    const float* base0; const float* base1; int split; const float* gate; int ldg; float* out; int ldc; float* part;
    __device__ __forceinline__ void operator()(const f32x4 (&acc)[2][2][4][2], const Unit& u, int wr, int wc, int fr, int fq) const {
        if (u.part) {
            float* pb = part + ((size_t)(u.ks * 32 + u.xt) * 256 + wr * 64 + fr) * 256 + wc * 32 + 4 * fq;
#pragma unroll
            for (int ai = 0; ai < 2; ++ai)
#pragma unroll
                for (int m = 0; m < 4; ++m)
#pragma unroll
                    for (int bj = 0; bj < 2; ++bj)
#pragma unroll
                        for (int n = 0; n < 2; ++n) *(f32x4*)(pb + (size_t)(ai * HALF + m * 16) * 256 + bj * HALF + n * 16) = acc[ai][bj][m][n];
            return;
        }
        const int row0 = u.pm * BM + wr * 64 + fr, col0 = u.pn * BM + wc * 32 + 4 * fq;
#pragma unroll
        for (int ai = 0; ai < 2; ++ai)
#pragma unroll
            for (int m = 0; m < 4; ++m) { const int r = row0 + ai * HALF + m * 16;
                const float* bp = (r < split ? base0 + (size_t)r * ldc : base1 + (size_t)(r - split) * ldc) + col0;
                const float* gp = gate + (size_t)row_gb(r) * ldg + col0; float* op = out + (size_t)r * ldc + col0;
#pragma unroll
                for (int bj = 0; bj < 2; ++bj)
#pragma unroll
                    for (int n = 0; n < 2; ++n) { const f32x4 bs = *(const f32x4*)(bp + bj * HALF + n * 16), g = *(const f32x4*)(gp + bj * HALF + n * 16);
                        *(f32x4*)(op + bj * HALF + n * 16) = bs + g * acc[ai][bj][m][n]; }
                if (m & 1) asm volatile("" ::: "memory"); }
    }
};
template <class Epi, class Sched, bool ALIGN_EPI = false, bool SP2 = false>
__device__ __forceinline__ void gemm_phase(PG8_LAS unsigned char* lds, const Gemm g, const Sched& S, const Epi& E) {
    const int tid = threadIdx.x, wid = __builtin_amdgcn_readfirstlane(tid >> 6), lane = tid & 63, wr = wid >> 2, wc = wid & 3, fr = lane & 15, fq = lane >> 4;
    const int K = g.K;
    unsigned voffA[2], voffB[2];
#pragma unroll
    for (int i = 0; i < 2; ++i) { int R, C; stage_rc(tid * 16 + i * 8192, R, C); const int Rb = Epi::PERM ? ((R & ~31) + perm32(R & 31)) : R;
        voffA[i] = (unsigned)(R * K + C) * 2u; voffB[i] = (unsigned)(Rb * K + C) * 2u; }
    const size_t kstep = (size_t)(BK * 2);
    const size_t hstep = (size_t)HALF * K * 2;
    const size_t tstep = 2 * hstep;
    const unsigned ldsw = (unsigned)wid * 1024u;
    const int aoff = lds_byte(wr * 64 + fr, fq * 8), boff = lds_byte(wc * 32 + fr, fq * 8);
#define PG8_SA(b, h) (((b) * 2 + (h)) * HTB)
#define PG8_SB(b, h) ((4 + (b) * 2 + (h)) * HTB)
#define PG8_STAGE(bufoff, gbase, voff) do { _Pragma("unroll") for (int _i = 0; _i < 2; ++_i) \
        __builtin_amdgcn_global_load_lds((const unsigned*)((const char*)(gbase) + (voff)[_i]), (PG8_LAS unsigned*)(lds + (bufoff) + ldsw + _i * 8192), 16, 0, 0); } while (0)
#define PG8_LDA(dst, b, h) do { _Pragma("unroll") for (int m = 0; m < 4; ++m) _Pragma("unroll") for (int k = 0; k < 2; ++k) dst[m][k] = *(const PG8_LAS bf16x8*)(lds + PG8_SA(b, h) + aoff + m * 2048 + k * 1024); } while (0)
#define PG8_LDB(dst, b, h) do { _Pragma("unroll") for (int n = 0; n < 2; ++n) _Pragma("unroll") for (int k = 0; k < 2; ++k) dst[n][k] = *(const PG8_LAS bf16x8*)(lds + PG8_SB(b, h) + boff + n * 2048 + k * 1024); } while (0)
#define PG8_MMA(ai, bj, At, Bt) do { __builtin_amdgcn_s_setprio(1); _Pragma("unroll") for (int m = 0; m < 4; ++m) _Pragma("unroll") for (int n = 0; n < 2; ++n) _Pragma("unroll") for (int k = 0; k < 2; ++k) \
        acc[ai][bj][m][n] = __builtin_amdgcn_mfma_f32_16x16x32_bf16(Bt[n][k], At[m][k], acc[ai][bj][m][n], 0, 0, 0); __builtin_amdgcn_s_setprio(0); } while (0)
#define PG8_WAIT_V(n) asm volatile("s_waitcnt vmcnt(" #n ")" ::: "memory")
#define PG8_WAIT_L(n) asm volatile("s_waitcnt lgkmcnt(" #n ")" ::: "memory")
#define PG8_BAR __builtin_amdgcn_s_barrier()
#define PG8_SCHED __builtin_amdgcn_sched_barrier(0)
    Unit cur, nxt; int ui = 0;
    if (!S.next(0, cur)) return;
    f32x4 acc[2][2][4][2];
#pragma unroll
    for (int a = 0; a < 2; ++a)
#pragma unroll
        for (int b = 0; b < 2; ++b)
#pragma unroll
            for (int m = 0; m < 4; ++m)
#pragma unroll
                for (int n = 0; n < 2; ++n) acc[a][b][m][n] = (f32x4){0.f, 0.f, 0.f, 0.f};
    bf16x8 At[4][2], B0[2][2], B1[2][2];
    const char* cA = (const char*)g.A + (size_t)cur.pm * tstep + (size_t)cur.k0 * 2; const char* cB = (const char*)g.Bt + (size_t)cur.pn * tstep + (size_t)cur.k0 * 2;
    S.a_ready(cur);
    if constexpr (SP2) {
        PG8_STAGE(PG8_SB(0, 0), cB, voffB); PG8_STAGE(PG8_SB(0, 1), cB + hstep, voffB); PG8_STAGE(PG8_SA(0, 0), cA, voffA); PG8_STAGE(PG8_SA(0, 1), cA + hstep, voffA);
        if (wr == 1) PG8_BAR;
        PG8_WAIT_V(2); PG8_BAR;
        PG8_STAGE(PG8_SB(1, 0), cB + kstep, voffB); PG8_STAGE(PG8_SA(1, 0), cA + kstep, voffA); PG8_STAGE(PG8_SB(1, 1), cB + hstep + kstep, voffB);
        PG8_WAIT_V(6); PG8_BAR;
    } else {
        PG8_STAGE(PG8_SB(0, 0), cB, voffB); PG8_STAGE(PG8_SA(0, 0), cA, voffA); PG8_STAGE(PG8_SB(0, 1), cB + hstep, voffB); PG8_STAGE(PG8_SA(0, 1), cA + hstep, voffA);
        if (wr == 1) PG8_BAR;
        PG8_WAIT_V(4); PG8_BAR;
        PG8_STAGE(PG8_SB(1, 0), cB + kstep, voffB); PG8_STAGE(PG8_SA(1, 0), cA + kstep, voffA); PG8_STAGE(PG8_SB(1, 1), cB + hstep + kstep, voffB);
        PG8_WAIT_V(6); PG8_BAR;
    }
    for (;;) {
        const bool has_next = S.next(ui + 1, nxt);
        const char* nA = has_next ? (const char*)g.A + (size_t)nxt.pm * tstep + (size_t)nxt.k0 * 2 : cA; const char* nB = has_next ? (const char*)g.Bt + (size_t)nxt.pn * tstep + (size_t)nxt.k0 * 2 : cB;
        const int nt = cur.nt, mh = cur.mh;
        for (int t = 0; t < nt; t += 2) {
            const bool last = (t == nt - 2);
            const char* a1 = cA + (size_t)(t + 1) * kstep;
            const char* a2 = last ? nA : cA + (size_t)(t + 2) * kstep; const char* b2 = last ? nB : cB + (size_t)(t + 2) * kstep;
            const char* a3 = a2 + kstep; const char* b3 = b2 + kstep;
            if (last && has_next) S.a_ready(nxt);
            if constexpr (SP2) {
            PG8_LDB(B0, 0, 0); PG8_LDB(B1, 0, 1); PG8_SCHED; PG8_LDA(At, 0, 0); PG8_STAGE(PG8_SA(1, 1), a1 + hstep, voffA);
            PG8_WAIT_V(8); PG8_WAIT_L(0); PG8_BAR; if (mh != 2) { PG8_MMA(0, 0, At, B0); PG8_MMA(0, 1, At, B1); } PG8_BAR; PG8_SCHED;
            PG8_LDA(At, 0, 1); PG8_STAGE(PG8_SB(0, 0), b2, voffB); PG8_STAGE(PG8_SB(0, 1), b2 + hstep, voffB); PG8_STAGE(PG8_SA(0, 0), a2, voffA);
            PG8_WAIT_V(8); PG8_WAIT_L(0); PG8_BAR; if (mh != 1) { PG8_MMA(1, 0, At, B0); PG8_MMA(1, 1, At, B1); } PG8_BAR; PG8_SCHED;
            PG8_LDB(B0, 1, 0); PG8_LDB(B1, 1, 1); PG8_SCHED; PG8_LDA(At, 1, 0); PG8_STAGE(PG8_SA(0, 1), a2 + hstep, voffA);
            PG8_WAIT_V(8); PG8_WAIT_L(0); PG8_BAR; if (mh != 2) { PG8_MMA(0, 0, At, B0); PG8_MMA(0, 1, At, B1); } PG8_BAR; PG8_SCHED;
            PG8_LDA(At, 1, 1); PG8_STAGE(PG8_SB(1, 0), b3, voffB); PG8_STAGE(PG8_SB(1, 1), b3 + hstep, voffB); PG8_STAGE(PG8_SA(1, 0), a3, voffA);
            PG8_WAIT_V(8); PG8_WAIT_L(0); PG8_BAR; if (mh != 1) { PG8_MMA(1, 0, At, B0); PG8_MMA(1, 1, At, B1); } PG8_BAR; PG8_SCHED;
            } else {
            PG8_LDB(B0, 0, 0); PG8_SCHED; PG8_LDA(At, 0, 0); PG8_STAGE(PG8_SA(1, 1), a1 + hstep, voffA);
            PG8_WAIT_L(8); PG8_BAR; PG8_WAIT_L(0); PG8_MMA(0, 0, At, B0); PG8_BAR; PG8_SCHED;
            PG8_LDB(B1, 0, 1); PG8_STAGE(PG8_SB(0, 0), b2, voffB);
            PG8_BAR; PG8_WAIT_L(0); PG8_MMA(0, 1, At, B1); PG8_BAR;
            PG8_LDA(At, 0, 1); PG8_STAGE(PG8_SA(0, 0), a2, voffA);
            PG8_BAR; PG8_WAIT_L(0); PG8_MMA(1, 0, At, B0); PG8_BAR; PG8_SCHED;
            PG8_STAGE(PG8_SB(0, 1), b2 + hstep, voffB);
            PG8_WAIT_V(6); PG8_BAR; PG8_MMA(1, 1, At, B1); PG8_BAR;
            PG8_LDB(B0, 1, 0); PG8_SCHED; PG8_LDA(At, 1, 0); PG8_STAGE(PG8_SA(0, 1), a2 + hstep, voffA);
            PG8_WAIT_L(8); PG8_BAR; PG8_WAIT_L(0); PG8_MMA(0, 0, At, B0); PG8_BAR; PG8_SCHED;
            PG8_LDB(B1, 1, 1); PG8_STAGE(PG8_SB(1, 0), b3, voffB);
            PG8_BAR; PG8_WAIT_L(0); PG8_MMA(0, 1, At, B1); PG8_BAR;
            PG8_LDA(At, 1, 1); PG8_STAGE(PG8_SA(1, 0), a3, voffA);
            PG8_BAR; PG8_WAIT_L(0); PG8_MMA(1, 0, At, B0); PG8_BAR; PG8_SCHED;
            PG8_STAGE(PG8_SB(1, 1), b3 + hstep, voffB);
            PG8_WAIT_V(6); PG8_BAR; PG8_MMA(1, 1, At, B1); PG8_BAR;
            }
        }
        if constexpr (ALIGN_EPI) { if (wr == 0) PG8_BAR; }
        if constexpr (!Epi::AFTER_DRAIN) { E(acc, cur, wr, wc, fr, fq); S.done(cur); }
        if (!has_next) break;
#pragma unroll
        for (int a = 0; a < 2; ++a)
#pragma unroll
            for (int b = 0; b < 2; ++b)
#pragma unroll
                for (int m = 0; m < 4; ++m)
#pragma unroll
                    for (int n = 0; n < 2; ++n) acc[a][b][m][n] = (f32x4){0.f, 0.f, 0.f, 0.f};
        cur = nxt; cA = nA; cB = nB; ++ui;
        if constexpr (ALIGN_EPI) { if (wr == 1) PG8_BAR; }
    }
    PG8_WAIT_V(0);
    if constexpr (!ALIGN_EPI) { if (wr == 0) PG8_BAR; }
    PG8_BAR;
    if constexpr (Epi::AFTER_DRAIN) { E.fused(acc, cur, wr, wc, fr, fq, lds, wid, lane); S.done(cur); }
#undef PG8_SA
#undef PG8_SB
#undef PG8_STAGE
#undef PG8_LDA
#undef PG8_LDB
#undef PG8_MMA
#undef PG8_WAIT_V
#undef PG8_WAIT_L
#undef PG8_BAR
#undef PG8_SCHED
}
}

constexpr int RING_OFF = 0, RING_BYTES = 131072;
constexpr int LDS_BYTES = 163840;
constexpr int LDSCTL_OFF = LDS_BYTES - 512, MISC_OFF = LDSCTL_OFF + 320;
static_assert(8 * 19456 <= LDSCTL_OFF, "S1 per-wave scratch");

typedef GAS unsigned gu32;
#define RLX_AGENT __ATOMIC_RELAXED, __HIP_MEMORY_SCOPE_AGENT
#define LDS_WAIT() asm volatile("s_waitcnt lgkmcnt(0)" ::: "memory")
#define VM_WAIT() asm volatile("s_waitcnt vmcnt(0)" ::: "memory")

#define XB_TMO      128
#define XB_XCNT(j)  (256  + 64 * (j))
#define XB_XSUB(j)  (1280 + 64 * (j))
#define XB_XGEN(j)  (2304 + 64 * (j))
#define XB_TOP      3328
#define XB_TOPGEN   3392
#define XCD_BAR_WORDS 3456
#define XB_SPIN_CAP (1u << 18)
__device__ __forceinline__ unsigned xb_ld(unsigned* p)              { return __hip_atomic_load(p, __ATOMIC_RELAXED, __HIP_MEMORY_SCOPE_AGENT); }
__device__ __forceinline__ unsigned xb_add(unsigned* p, unsigned v) { return __hip_atomic_fetch_add(p, v, __ATOMIC_RELAXED, __HIP_MEMORY_SCOPE_AGENT); }
__device__ __forceinline__ unsigned xb_xcc_id() { return (unsigned)__builtin_amdgcn_s_getreg((3 << 11) | 20) & 0xFu; }
#define XB_SPIN(cond, bar) do { unsigned _sp = 0; while (cond) { __builtin_amdgcn_s_sleep(1); \
    if ((++_sp & 255u) == 0u) { if (xb_ld(&(bar)[XB_TMO])) break; if (_sp > XB_SPIN_CAP) { atomicAdd(&(bar)[XB_TMO], 1u); break; } } } } while (0)
struct XcdBarrier { unsigned* bar; unsigned x; volatile LAS unsigned* st; };
__device__ __forceinline__ XcdBarrier xcd_barrier_post(unsigned* bar, volatile LAS unsigned* st) {
    XcdBarrier b; b.bar = bar; b.x = xb_xcc_id(); b.st = st;
    if (threadIdx.x == 0) (void)xb_add(&bar[XB_XCNT(b.x)], 1u);
    return b;
}
__device__ __forceinline__ void xcd_barrier_complete(unsigned* bar, unsigned x, unsigned& nloc, unsigned& nx) {
    const unsigned G = gridDim.x * gridDim.y * gridDim.z;
    unsigned sum, cnt, mine, sp = 0u;
    for (;;) {
        sum = 0u; cnt = 0u; mine = 0u;
#pragma unroll
        for (unsigned j = 0; j < 16; ++j) { const unsigned c = xb_ld(&bar[XB_XCNT(j)]); sum += c; cnt += (c > 0u) ? 1u : 0u; mine = (j == x) ? c : mine; }
        if (sum == G) break;
        __builtin_amdgcn_s_sleep(1);
        if ((++sp & 255u) == 0u) { if (xb_ld(&bar[XB_TMO])) break; if (sp > XB_SPIN_CAP) { atomicAdd(&bar[XB_TMO], 1u); break; } }
    }
    nloc = mine > 0u ? mine : 1u; nx = cnt > 0u ? cnt : 1u;
}
__device__ __forceinline__ void xcd_barrier(const XcdBarrier& b) {
    asm volatile("s_waitcnt vmcnt(0)" ::: "memory");
    __syncthreads();
    if (threadIdx.x == 0) {
        unsigned* bar = b.bar;
        __builtin_amdgcn_s_waitcnt(0);
        unsigned nloc = b.st[0], nx = b.st[1];
        if (nloc == 0u) { xcd_barrier_complete(bar, b.x, nloc, nx); b.st[0] = nloc; b.st[1] = nx; }
        const unsigned old = xb_add(&bar[XB_XSUB(b.x)], 1u);
        const unsigned gen = old / nloc;
        if (old + 1u == (gen + 1u) * nloc) {
            __builtin_amdgcn_fence(__ATOMIC_RELEASE, "agent");
            asm volatile("s_waitcnt vmcnt(0)" ::: "memory");
            const unsigned og = xb_add(&bar[XB_TOP], 1u);
            const unsigned tg = og / nx;
            if (og + 1u == (tg + 1u) * nx) xb_add(&bar[XB_TOPGEN], 1u);
            else XB_SPIN(xb_ld(&bar[XB_TOPGEN]) == tg, bar);
            __builtin_amdgcn_fence(__ATOMIC_ACQUIRE, "agent");
            xb_add(&bar[XB_XGEN(b.x)], 1u);
            asm volatile("s_waitcnt vmcnt(0)" ::: "memory");
        } else {
            XB_SPIN(xb_ld(&bar[XB_XGEN(b.x)]) == gen, bar);
            __builtin_amdgcn_fence(__ATOMIC_ACQUIRE, "agent");
            asm volatile("s_waitcnt vmcnt(0)" ::: "memory");
        }
    }
    __syncthreads();
}

struct Frame {
    LAS unsigned char* lds;
    int tid, lane, wave, gw, ngw;
    const float *xp, *xs, *stC, *stN, *stM, *stS, *stConv, *cp, *cs, *ada_w, *ada_b, *norm1, *w_in, *gate_b, *mlstm_g, *conv_w, *A_log, *dt_bias, *gdn_g,
                *w_out, *norm2, *w_up, *w_down, *adaf_w, *adaf_b, *normf;
    float* out;
    bf16_t *SCB, *WIN, *WOUT, *WUP, *WDOWN, *HB, *MIX, *PROJ;
    float *MOD, *MODF, *GATES, *X1;
    unsigned char* IMGM; unsigned char* IMGG;
};
__device__ __forceinline__ const float* xrow(const Frame& F, int r) { return r < M_P ? F.xp + (size_t)r * D : F.xs + (size_t)(r - M_P) * D; }

__device__ __forceinline__ void p0_silu(Frame& F) {
    const int gt = blockIdx.x * NTHREADS + F.tid, GT = gridDim.x * NTHREADS;
    for (int g = gt; g < 160 * 256; g += GT) {
        const int row = g >> 8, c8 = (g & 255) * 8; u32x4 o = (u32x4){0u, 0u, 0u, 0u};
        if (row < NGB) { const float* src = (row < NB_P ? F.cp + (size_t)row * D : F.cs + (size_t)(row - NB_P) * D) + c8;
            const f32x4 a = *(const f32x4*)src, b = *(const f32x4*)(src + 4);
            o.x = pk2(siluf_(a.x), siluf_(a.y)); o.y = pk2(siluf_(a.z), siluf_(a.w)); o.z = pk2(siluf_(b.x), siluf_(b.y)); o.w = pk2(siluf_(b.z), siluf_(b.w)); }
        *(u32x4*)(F.SCB + (size_t)row * D + c8) = o;
    }
}

__device__ __forceinline__ void p1_modgemv(Frame& F) {
    LAS float* red = (LAS float*)(F.lds + RING_OFF);
    const int lane = F.lane, r = lane & 31, hh = lane >> 5, cbi = F.wave >> 2, ks = F.wave & 3;
    for (int pair = blockIdx.x; pair < 256; pair += gridDim.x) {
        const int cb = 2 * pair + cbi;
        const float* W; const float* bias; float* outp; int ldw, n0;
        if (cb < 384) { W = F.ada_w; ldw = MODW; n0 = cb * 32; bias = F.ada_b; outp = F.MOD; }
        else { W = F.adaf_w; ldw = MODFW; n0 = (cb - 384) * 32; bias = F.adaf_b; outp = F.MODF; }
        f32x16 acc[5];
#pragma unroll
        for (int g = 0; g < 5; ++g)
#pragma unroll
            for (int i = 0; i < 16; ++i) acc[g][i] = 0.f;
        const float* wp = W + (size_t)(ks * 512 + 8 * hh) * ldw + n0 + r;
        const bf16_t* ap = F.SCB + (size_t)r * D + ks * 512 + 8 * hh;
        for (int s = 0; s < 32; s += 4) {
            float wv[4][8];
#pragma unroll
            for (int u = 0; u < 4; ++u)
#pragma unroll
                for (int j = 0; j < 8; ++j) wv[u][j] = wp[(size_t)((s + u) * 16 + j) * ldw];
#pragma unroll
            for (int u = 0; u < 4; ++u) {
                u32x4 bw; bw.x = pk2(wv[u][0], wv[u][1]); bw.y = pk2(wv[u][2], wv[u][3]); bw.z = pk2(wv[u][4], wv[u][5]); bw.w = pk2(wv[u][6], wv[u][7]);
                const bf16x8 b = __builtin_bit_cast(bf16x8, bw);
#pragma unroll
                for (int g = 0; g < 5; ++g) { const bf16x8 a = *(const bf16x8*)(ap + (size_t)g * 32 * D + (s + u) * 16);
                    acc[g] = __builtin_amdgcn_mfma_f32_32x32x16_bf16(a, b, acc[g], 0, 0, 0); }
            }
        }
        if (ks > 0) {
#pragma unroll
            for (int g = 0; g < 5; ++g)
#pragma unroll
                for (int i = 0; i < 16; ++i) red[(((ks - 1) * 2 + cbi) * 80 + g * 16 + i) * 64 + lane] = acc[g][i];
        }
        __syncthreads();
        if (ks == 0) {
            const float bv = bias[n0 + r];
#pragma unroll
            for (int g = 0; g < 5; ++g)
#pragma unroll
                for (int i = 0; i < 16; ++i) {
                    float v = acc[g][i];
#pragma unroll
                    for (int k2 = 0; k2 < 3; ++k2) v += red[((k2 * 2 + cbi) * 80 + g * 16 + i) * 64 + lane];
                    const int gb = 32 * g + (i & 3) + 8 * (i >> 2) + 4 * hh;
                    if (gb < NGB) outp[(size_t)gb * ldw + n0 + r] = v + bv;
                }
        }
        __syncthreads();
    }
}

__device__ __forceinline__ int win_dst_row(int n) {
    if (n < 3072) return n;
    if (n < 3088) return 8192 + (n - 3072);
    if (n < 7184) return n - 16;
    if (n < 7200) return 8208 + (n - 7184);
    return n - 32;
}
struct TrItem { const float* W; bf16_t* WT; int K, N, k0, n0, mapwin; };
__device__ __forceinline__ TrItem tr_decode(const Frame& F, int it) {
    constexpr int I_IN = (D / 64) * (P_IN / 32), I_OUT = (D / 64) * (D / 32), I_UP = (D / 64) * (DFF / 32);
    TrItem t; int r = it;
    if (r < I_IN) { t.W = F.w_in; t.WT = F.WIN; t.K = D; t.N = P_IN; t.mapwin = 1; }
    else if ((r -= I_IN) < I_OUT) { t.W = F.w_out; t.WT = F.WOUT; t.K = D; t.N = D; t.mapwin = 0; }
    else if ((r -= I_OUT) < I_UP) { t.W = F.w_up; t.WT = F.WUP; t.K = D; t.N = DFF; t.mapwin = 0; }
    else { r -= I_UP; t.W = F.w_down; t.WT = F.WDOWN; t.K = DFF; t.N = D; t.mapwin = 0; }
    const int nblk = t.N / 32; t.k0 = 64 * (r / nblk); t.n0 = 32 * (r % nblk);
    return t;
}
__device__ __forceinline__ void p1_transposes(Frame& F) {
    LAS float* scr = (LAS float*)(F.lds + RING_OFF + F.wave * 16384);
    constexpr int NITEMS = (D / 64) * (P_IN / 32) + (D / 64) * (D / 32) + (D / 64) * (DFF / 32) + (DFF / 64) * (D / 32);
    const int lane = F.lane;
    int it = F.gw;
    if (it >= NITEMS) return;
    TrItem cur = tr_decode(F, it);
    float v[32];
#pragma unroll
    for (int i = 0; i < 32; ++i) v[i] = cur.W[(size_t)(cur.k0 + 2 * i + (lane >> 5)) * cur.N + cur.n0 + (lane & 31)];
    for (;;) {
#pragma unroll
        for (int i = 0; i < 32; ++i) scr[(2 * i + (lane >> 5)) * 33 + (lane & 31)] = v[i];
        const int nit = it + F.ngw; const bool more = nit < NITEMS;
        TrItem nx = cur;
        if (more) { nx = tr_decode(F, nit);
#pragma unroll
            for (int i = 0; i < 32; ++i) v[i] = nx.W[(size_t)(nx.k0 + 2 * i + (lane >> 5)) * nx.N + nx.n0 + (lane & 31)]; }
        LDS_WAIT(); asm volatile("" ::: "memory");
        const int c = lane & 7;
#pragma unroll
        for (int j = 0; j < 4; ++j) { const int n = (lane >> 3) + 8 * j; const LAS float* s = scr + (8 * c) * 33 + n;
            u32x4 o; o.x = pk2(s[0 * 33], s[1 * 33]); o.y = pk2(s[2 * 33], s[3 * 33]); o.z = pk2(s[4 * 33], s[5 * 33]); o.w = pk2(s[6 * 33], s[7 * 33]);
            const int dr = cur.mapwin ? win_dst_row(cur.n0 + n) : (cur.n0 + n);
            *(u32x4*)(cur.WT + (size_t)dr * cur.K + cur.k0 + 8 * c) = o; }
        LDS_WAIT(); asm volatile("" ::: "memory");
        if (!more) break;
        cur = nx; it = nit;
    }
}

__device__ __forceinline__ void norm_mod_row_bf16(const float* xr_, const float* g, const float* shift, const float* scale, bf16_t* orow, int lane) {
    const f32x4* xr = (const f32x4*)xr_ + lane;
    f32x4 v[8]; float s = 0.f;
#pragma unroll
    for (int j = 0; j < 8; ++j) { v[j] = xr[64 * j]; s += (v[j].x * v[j].x + v[j].y * v[j].y) + (v[j].z * v[j].z + v[j].w * v[j].w); }
    const float rstd = 1.0f / sqrtf(wave_sum(s) * (1.0f / D) + EPS);
    u32x2* o8 = (u32x2*)orow + lane;
#pragma unroll
    for (int j = 0; j < 8; ++j) { const f32x4 gg = ((const f32x4*)g)[lane + 64 * j], sh = ((const f32x4*)shift)[lane + 64 * j], sc = ((const f32x4*)scale)[lane + 64 * j];
        const f32x4 y = (v[j] * rstd * gg) * (sc + 1.0f) + sh; u32x2 w; w.x = pk2(y.x, y.y); w.y = pk2(y.z, y.w); o8[64 * j] = w; }
}
__device__ __forceinline__ void norm_mod_row_f32(const float* xr_, const float* g, const float* shift, const float* scale, float* orow, int lane) {
    const f32x4* xr = (const f32x4*)xr_ + lane;
    f32x4 v[8]; float s = 0.f;
#pragma unroll
    for (int j = 0; j < 8; ++j) { v[j] = xr[64 * j]; s += (v[j].x * v[j].x + v[j].y * v[j].y) + (v[j].z * v[j].z + v[j].w * v[j].w); }
    const float rstd = 1.0f / sqrtf(wave_sum(s) * (1.0f / D) + EPS);
    f32x4* o = (f32x4*)orow + lane;
#pragma unroll
    for (int j = 0; j < 8; ++j) { const f32x4 gg = ((const f32x4*)g)[lane + 64 * j], sh = ((const f32x4*)shift)[lane + 64 * j], sc = ((const f32x4*)scale)[lane + 64 * j];
        o[64 * j] = (v[j] * rstd * gg) * (sc + 1.0f) + sh; }
}

__device__ __forceinline__ void p3_gates(Frame& F) {
    const int lane = F.lane, fr = lane & 15, fq = lane >> 4, w = F.wave;
    LAS f32x4* red = (LAS f32x4*)(F.lds + RING_OFF);
    for (int chunk = blockIdx.x; chunk < M / 16; chunk += gridDim.x) {
        const int r0 = chunk * 16;
        const bf16_t* ap = F.HB + (size_t)(r0 + fr) * D + 256 * w + 8 * fq;
        const bf16_t* bp = F.WIN + (size_t)(NPROJ + fr) * D + 256 * w + 8 * fq;
        bf16x8 a[8], b0[8], b1[8];
#pragma unroll
        for (int k = 0; k < 8; ++k) { a[k] = *(const bf16x8*)(ap + 32 * k); b0[k] = *(const bf16x8*)(bp + 32 * k); b1[k] = *(const bf16x8*)(bp + (size_t)16 * D + 32 * k); }
        f32x4 c0 = (f32x4){0.f, 0.f, 0.f, 0.f}, c1 = c0;
#pragma unroll
        for (int k = 0; k < 8; ++k) { c0 = __builtin_amdgcn_mfma_f32_16x16x32_bf16(a[k], b0[k], c0, 0, 0, 0); c1 = __builtin_amdgcn_mfma_f32_16x16x32_bf16(a[k], b1[k], c1, 0, 0, 0); }
        red[(w * 2 + 0) * 64 + lane] = c0; red[(w * 2 + 1) * 64 + lane] = c1;
        __syncthreads();
        if (w < 2) {
            f32x4 s = (f32x4){0.f, 0.f, 0.f, 0.f};
#pragma unroll
            for (int ww = 0; ww < 8; ++ww) s += red[(ww * 2 + w) * 64 + lane];
#pragma unroll
            for (int i = 0; i < 4; ++i) F.GATES[(size_t)(r0 + 4 * fq + i) * NGATE + 16 * w + fr] = s[i];
        }
        __syncthreads();
    }
}

__device__ __forceinline__ void scan_mlstm_simple(Frame& F, bool prompt, int b, int hd) {
    LAS float* sq = (LAS float*)(F.lds + RING_OFF); LAS float* sk = sq + 128; LAS float* sv = sk + 128; LAS float* spart = sv + 128; LAS float* sred = spart + 512; LAS float* sred2 = sred + 8;
    const int tid = F.tid, e = tid & 127, q4 = tid >> 7, lane = F.lane, wave = F.wave;
    const int T = prompt ? T_P : T_S, row0 = prompt ? b * T_P : M_P + b * T_S, bh = b * NH + hd;
    float C[32]; float nst = 0.f, m = 0.f;
    if (prompt) {
#pragma unroll
        for (int dd = 0; dd < 32; ++dd) C[dd] = 0.f;
    } else {
#pragma unroll
        for (int dd = 0; dd < 32; ++dd) C[dd] = F.stC[((size_t)bh * HD + 32 * q4 + dd) * HD + e];
        if (tid < 128) nst = F.stN[(size_t)bh * HD + tid];
        m = F.stM[bh];
    }
    const float bi = F.gate_b[hd], bfg = F.gate_b[NH + hd], gn = F.mlstm_g[hd * HD + e];
    for (int t = 0; t < T; ++t) {
        const int row = row0 + t; const bf16_t* pr = F.PROJ + (size_t)row * NPROJ + hd * HD;
        float oa = 0.f;
        if (tid < 128) { sq[tid] = bf2f(pr[tid]); sk[tid] = bf2f(pr[1024 + tid]) * 0.08838834764831845f; sv[tid] = bf2f(pr[2048 + tid]); oa = bf2f(pr[3072 + tid]); }
        const float ia = F.GATES[(size_t)row * NGATE + hd], fa = F.GATES[(size_t)row * NGATE + 8 + hd];
        __syncthreads();
        const float li = ia + bi, lf = logsigmoidf_(fa + bfg);
        const float mn = fmaxf(lf + m, li), fdec = expf(lf + m - mn), iin = expf(li - mn); m = mn;
        const float ve = sv[e]; float part = 0.f;
#pragma unroll
        for (int dd = 0; dd < 32; ++dd) { const int d = 32 * q4 + dd; C[dd] = fdec * C[dd] + (iin * sk[d]) * ve; part += sq[d] * C[dd]; }
        spart[q4 * 128 + e] = part;
        if (tid < 128) { nst = fdec * nst + iin * sk[tid]; const float pn = wave_sum(sq[tid] * nst); if (lane == 0) sred[wave] = pn; }
        __syncthreads();
        const float numer = (spart[e] + spart[128 + e]) + (spart[256 + e] + spart[384 + e]);
        const float ddn = sred[0] + sred[1];
        const float hval = numer / fmaxf(fabsf(ddn), expf(-m));
        const float ss = wave_sum(hval * hval);
        if (lane == 0) sred2[wave] = ss;
        __syncthreads();
        const float tot = sred2[wave] + sred2[wave ^ 1];
        if (tid < 128) { const float y = hval * (1.0f / sqrtf(tot * (1.0f / HD) + EPS)) * gn * sigmoidf_(oa); F.MIX[(size_t)row * D + hd * HD + e] = (bf16_t)f2bf(y); }
    }
    float* oC = F.out + (prompt ? O_PC : O_SC) + (size_t)bh * HD * HD;
#pragma unroll
    for (int dd = 0; dd < 32; ++dd) oC[(size_t)(32 * q4 + dd) * HD + e] = C[dd];
    if (tid < 128) F.out[(prompt ? O_PN : O_SN) + (size_t)bh * HD + tid] = nst;
    if (tid == 0) F.out[(prompt ? O_PM : O_SM) + bh] = m;
    __syncthreads();
}
__device__ __forceinline__ void scan_gdn_simple(Frame& F, bool prompt, int b, int hd) {
    LAS float* sq = (LAS float*)(F.lds + RING_OFF); LAS float* sk = sq + 128; LAS float* sv = sk + 128; LAS float* spart = sv + 128; LAS float* spart2 = spart + 512; LAS float* sred = spart2 + 512; LAS float* sred2 = sred + 8;
    const int tid = F.tid, e = tid & 127, q4 = tid >> 7, lane = F.lane, wave = F.wave;
    const int T = prompt ? T_P : T_S, row0 = prompt ? b * T_P : M_P + b * T_S, bh = b * NH + hd;
    float S[32];
    if (prompt) {
#pragma unroll
        for (int dd = 0; dd < 32; ++dd) S[dd] = 0.f;
    } else {
#pragma unroll
        for (int dd = 0; dd < 32; ++dd) S[dd] = F.stS[((size_t)bh * HD + 32 * q4 + dd) * HD + e];
    }
    const int cch = (q4 < 3 ? q4 : 0) * 1024 + hd * HD + e;
    float h0 = 0.f, h1 = 0.f, h2 = 0.f;
    if (!prompt && q4 < 3) { const float* cv = F.stConv + (size_t)b * 3 * CCONV + cch; h0 = cv[0]; h1 = cv[CCONV]; h2 = cv[2 * CCONV]; }
    const float w0 = F.conv_w[cch], w1 = F.conv_w[CCONV + cch], w2 = F.conv_w[2 * CCONV + cch], w3 = F.conv_w[3 * CCONV + cch];
    const float negA = -expf(F.A_log[hd]), dtb = F.dt_bias[hd], gn = F.gdn_g[hd * HD + e];
    for (int t = 0; t < T; ++t) {
        const int row = row0 + t; const bf16_t* pr = F.PROJ + (size_t)row * NPROJ + 4096;
        float a = 0.f, zb = 0.f;
        if (q4 < 3) { const float u = bf2f(pr[cch]); const float cvv = w0 * h0 + w1 * h1 + w2 * h2 + w3 * u; h0 = h1; h1 = h2; h2 = u; a = siluf_(cvv); }
        if (q4 == 0) zb = bf2f(pr[3072 + hd * HD + e]);
        if (q4 < 2) { const float ss = wave_sum(a * a); if (lane == 0) sred[wave] = ss; }
        if (q4 == 2) sv[e] = a;
        const float ab = F.GATES[(size_t)row * NGATE + 16 + hd], bb = F.GATES[(size_t)row * NGATE + 24 + hd];
        __syncthreads();
        if (q4 == 0) sq[e] = a * (1.0f / sqrtf(sred[0] + sred[1] + EPS)) * 0.08838834764831845f;
        if (q4 == 1) sk[e] = a * (1.0f / sqrtf(sred[2] + sred[3] + EPS));
        __syncthreads();
        const float g = expf(negA * softplusf_(ab + dtb)), beta = sigmoidf_(bb);
        float part = 0.f;
#pragma unroll
        for (int dd = 0; dd < 32; ++dd) part += sk[32 * q4 + dd] * S[dd];
        spart[q4 * 128 + e] = part;
        __syncthreads();
        const float kS = (spart[e] + spart[128 + e]) + (spart[256 + e] + spart[384 + e]);
        const float ue = beta * (sv[e] - g * kS);
        float opart = 0.f;
#pragma unroll
        for (int dd = 0; dd < 32; ++dd) { const int d = 32 * q4 + dd; S[dd] = g * S[dd] + sk[d] * ue; opart += sq[d] * S[dd]; }
        spart2[q4 * 128 + e] = opart;
        __syncthreads();
        const float o = (spart2[e] + spart2[128 + e]) + (spart2[256 + e] + spart2[384 + e]);
        const float ss2 = wave_sum(o * o);
        if (lane == 0) sred2[wave] = ss2;
        __syncthreads();
        const float tot = sred2[wave] + sred2[wave ^ 1];
        if (q4 == 0) { const float y = o * (1.0f / sqrtf(tot * (1.0f / HD) + EPS)) * gn * siluf_(zb); F.MIX[(size_t)row * D + 1024 + hd * HD + e] = (bf16_t)f2bf(y); }
    }
    float* oS = F.out + (prompt ? O_PS : O_SS) + (size_t)bh * HD * HD;
#pragma unroll
    for (int dd = 0; dd < 32; ++dd) oS[(size_t)(32 * q4 + dd) * HD + e] = S[dd];
    if (q4 < 3) { float* oc = F.out + (prompt ? O_PCONV : O_SCONV) + (size_t)b * 3 * CCONV + cch; oc[0] = h0; oc[CCONV] = h1; oc[2 * CCONV] = h2; }
    __syncthreads();
}

__device__ __forceinline__ float wave_scan_add(float v, int lane) {
#pragma unroll
    for (int o = 1; o < 64; o <<= 1) { const float t = __shfl_up(v, o); if (lane >= o) v += t; }
    return v;
}
__device__ __forceinline__ float wave_scan_max(float v, int lane) {
#pragma unroll
    for (int o = 1; o < 64; o <<= 1) { const float t = __shfl_up(v, o); if (lane >= o) v = fmaxf(v, t); }
    return v;
}
__device__ __forceinline__ float wave_max(float v) {
#pragma unroll
    for (int o = 1; o < 64; o <<= 1) v = fmaxf(v, __shfl_xor(v, o));
    return v;
}
#define QK_SCALE 0.08838834764831845f
__device__ __forceinline__ void s1_mlstm_unit(Frame& F, int unit, LAS float* scr) {
    const int lane = F.lane, r = lane & 31, h = lane >> 5;
    const int c = unit & 31, bh = unit >> 5, hd = bh & 7, b = bh >> 3;
    const int rowb = b * T_P, row0 = rowb + 64 * c;
    unsigned char* rec = F.IMGM + (size_t)unit * MREC;
    const float bi = F.gate_b[hd], bfg = F.gate_b[NH + hd];
    LAS float* const scs = scr + 4096;
    float m_prev = 0.f;
    {
        float pb = 0.f, pa = 0.f;
        for (int c4 = 0; c4 < c; c4 += 4) {
            float lfv[4], liv[4];
#pragma unroll
            for (int x = 0; x < 4; ++x) { const int cc = (c4 + x < c) ? c4 + x : c4; const float* gp = F.GATES + (size_t)(rowb + 64 * cc + lane) * NGATE; lfv[x] = gp[8 + hd]; liv[x] = gp[hd]; }
#pragma unroll
            for (int x = 0; x < 4; ++x) { const float lf = logsigmoidf_(lfv[x] + bfg), li = liv[x] + bi;
                const float bb = wave_scan_add(lf, lane); const float amax = wave_max(li - bb); const float b63 = __shfl(bb, 63);
                if (lane == c4 + x) { pb = b63; pa = amax; } }
        }
        for (int cc = 0; cc < c; ++cc) m_prev = __shfl(pb, cc) + fmaxf(m_prev, __shfl(pa, cc));
    }
    float* sc = (float*)(rec + MR_SC);
    {
        const float* gp = F.GATES + (size_t)(row0 + lane) * NGATE;
        const float lfv = logsigmoidf_(gp[8 + hd] + bfg), liv = gp[hd] + bi;
        const float bb = wave_scan_add(lfv, lane); const float a = liv - bb; const float cm = wave_scan_max(a, lane);
        const float Mi = fmaxf(m_prev, cm), mi = bb + Mi; const float M63 = __shfl(Mi, 63), m_new = __shfl(mi, 63);
        scs[lane] = a; scs[64 + lane] = Mi; scs[128 + lane] = expf(a - M63) * QK_SCALE;
        sc[lane] = expf(m_prev - Mi); sc[64 + lane] = expf(-mi);
        if (lane == 0) { sc[192] = expf(m_prev - M63); sc[193] = m_new; if (c == 31) F.out[O_PM + bh] = m_new; }
    }
    asm volatile("s_waitcnt lgkmcnt(0)" ::: "memory");
    bf16x8 Qf[2][8], Kf[2][8];
    const bf16_t* pq = F.PROJ + (size_t)(row0 + r) * NPROJ + hd * HD + 8 * h;
#pragma unroll
    for (int rb = 0; rb < 2; ++rb)
#pragma unroll
        for (int s = 0; s < 8; ++s) { Qf[rb][s] = *(const bf16x8*)(pq + (size_t)(32 * rb) * NPROJ + 16 * s); Kf[rb][s] = *(const bf16x8*)(pq + (size_t)(32 * rb) * NPROJ + 1024 + 16 * s); }
#pragma unroll
    for (int rb = 0; rb < 2; ++rb)
#pragma unroll
        for (int s = 0; s < 8; ++s) { const int i = 32 * rb + r; const u32x4 wv = __builtin_bit_cast(u32x4, Qf[rb][s]);
            unsigned char* o0 = rec + MR_QI + ((((i >> 4) * 4 + (s >> 1)) * 64 + (2 * h) * 16 + (i & 15)) * 16) + 8 * (s & 1);
            *(u32x2*)o0 = (u32x2){wv.x, wv.y}; *(u32x2*)(o0 + 256) = (u32x2){wv.z, wv.w}; }
    float rs[2] = {0.f, 0.f};
#pragma unroll
    for (int blk = 0; blk < 3; ++blk) {
        const int jb = blk >> 1, ib = (blk + 1) >> 1;
        f32x16 Dm;
#pragma unroll
        for (int x = 0; x < 16; ++x) Dm[x] = 0.f;
#pragma unroll
        for (int s = 0; s < 8; ++s) Dm = __builtin_amdgcn_mfma_f32_32x32x16_bf16(Kf[jb][s], Qf[ib][s], Dm, 0, 0, 0);
        const int i = 32 * ib + r; const float Mi_i = scs[64 + i];
#pragma unroll
        for (int g = 0; g < 4; ++g) {
            const f32x4 aj = *(const LAS f32x4*)(scs + 32 * jb + 8 * g + 4 * h);
            float v[4];
#pragma unroll
            for (int ip = 0; ip < 4; ++ip) { const int j = 32 * jb + 8 * g + 4 * h + ip; const float x = Dm[4 * g + ip] * QK_SCALE * __expf(aj[ip] - Mi_i); v[ip] = (j <= i) ? x : 0.f; }
            rs[ib] += (v[0] + v[1]) + (v[2] + v[3]);
            *(u32x2*)(rec + MR_SP + ((((i >> 4) * 2 + jb) * 64 + g * 16 + (i & 15)) * 16) + 8 * h) = (u32x2){pk2(v[0], v[1]), pk2(v[2], v[3])};
        }
    }
    rs[0] += __shfl_xor(rs[0], 32); rs[1] += __shfl_xor(rs[1], 32);
    if (h == 0) { sc[128 + r] = rs[0]; sc[160 + r] = rs[1]; }
    LAS unsigned short* const stg = (LAS unsigned short*)scr;
#pragma unroll 1
    for (int mt = 0; mt < 2; ++mt) {
        const bf16_t* psrc = F.PROJ + (size_t)row0 * NPROJ + (mt + 1) * 1024 + hd * HD;
        u32x4 tv[16];
#pragma unroll
        for (int x = 0; x < 16; ++x) { const int idx = x * 64 + lane; tv[x] = *(const u32x4*)(psrc + (size_t)(idx >> 4) * NPROJ + (idx & 15) * 8); }
        asm volatile("s_waitcnt lgkmcnt(0)" ::: "memory");
#pragma unroll
        for (int x = 0; x < 16; ++x) { const int idx = x * 64 + lane; *(LAS u32x4*)(stg + (idx >> 4) * 128 + (idx & 15) * 8) = tv[x]; }
        asm volatile("s_waitcnt lgkmcnt(0)" ::: "memory");
#pragma unroll 1
        for (int blk = 0; blk < 4; ++blk) {
            const int d = 32 * blk + r; float dn = 0.f;
#pragma unroll
            for (int s = 0; s < 4; ++s) {
                unsigned xv[8];
#pragma unroll
                for (int j = 0; j < 8; ++j) xv[j] = stg[(16 * s + 8 * h + j) * 128 + d];
                const size_t off = ((((d >> 4) * 2 + (s >> 1)) * 64 + (2 * (s & 1) + h) * 16 + (d & 15)) * 16);
                if (mt == 0) {
                    const f32x4 w0 = *(const LAS f32x4*)(scs + 128 + 16 * s + 8 * h), w1 = *(const LAS f32x4*)(scs + 128 + 16 * s + 8 * h + 4);
                    float x[8];
#pragma unroll
                    for (int j = 0; j < 4; ++j) { x[j] = bflo(xv[j]) * w0[j]; x[4 + j] = bflo(xv[4 + j]) * w1[j]; }
                    dn += ((x[0] + x[1]) + (x[2] + x[3])) + ((x[4] + x[5]) + (x[6] + x[7]));
                    *(u32x4*)(rec + MR_KW + off) = (u32x4){pk2(x[0], x[1]), pk2(x[2], x[3]), pk2(x[4], x[5]), pk2(x[6], x[7])};
                } else {
                    *(u32x4*)(rec + MR_VT + off) = (u32x4){xv[0] | (xv[1] << 16), xv[2] | (xv[3] << 16), xv[4] | (xv[5] << 16), xv[6] | (xv[7] << 16)};
                }
            }
            if (mt == 0) { dn += __shfl_xor(dn, 32); if (h == 0) ((float*)(rec + MR_DN))[d] = dn; }
        }
    }
}
constexpr int MDMA_OFF = MR_KW, MDMA_BYTES = MREC - MR_KW;
__device__ __forceinline__ void s2_mlstm_chain(Frame& F, int bh) {
    const int lane = F.lane, w = F.wave, cl = lane & 15, q = lane >> 4;
    LAS unsigned char* const buf0 = F.lds; LAS unsigned char* const buf1 = F.lds + MDMA_BYTES;
    LAS float* const s_n = (LAS float*)(F.lds + 2 * MDMA_BYTES);
    const unsigned char* recs = F.IMGM + (size_t)bh * 32 * MREC + MDMA_OFF;
    unsigned char* snaps = (unsigned char*)F.HB + (size_t)bh * 32 * SNAPM;
    f32x4 C[8];
#pragma unroll
    for (int db = 0; db < 8; ++db) C[db] = (f32x4){0.f, 0.f, 0.f, 0.f};
    if (F.tid < 128) s_n[F.tid] = 0.f;
    for (int piece = w; piece < MDMA_BYTES / 1024; piece += 8)
        __builtin_amdgcn_global_load_lds((const unsigned*)(recs + piece * 1024 + lane * 16), (LAS unsigned*)(buf0 + piece * 1024), 16, 0, 0);
    asm volatile("s_waitcnt vmcnt(0)" ::: "memory"); __syncthreads();
    for (int c = 0; c < 32; ++c) {
        LAS unsigned char* const cur = (c & 1) ? buf1 : buf0; LAS unsigned char* const nxt = (c & 1) ? buf0 : buf1;
        if (c + 1 < 32) { const unsigned char* src = recs + (size_t)(c + 1) * MREC;
            for (int piece = w; piece < MDMA_BYTES / 1024; piece += 8)
                __builtin_amdgcn_global_load_lds((const unsigned*)(src + piece * 1024 + lane * 16), (LAS unsigned*)(nxt + piece * 1024), 16, 0, 0); }
        unsigned char* sn = snaps + (size_t)c * SNAPM;
#pragma unroll
        for (int s = 0; s < 4; ++s)
            *(u32x4*)(sn + ((w * 4 + s) * 64 + lane) * 16) = (u32x4){pk2(C[2 * s][0], C[2 * s][1]), pk2(C[2 * s][2], C[2 * s][3]), pk2(C[2 * s + 1][0], C[2 * s + 1][1]), pk2(C[2 * s + 1][2], C[2 * s + 1][3])};
        const LAS float* sc = (const LAS float*)(cur + (MR_SC - MDMA_OFF));
        const float dC = sc[192];
        if (F.tid < 128) { const float nv = s_n[F.tid]; ((float*)(sn + 32768))[F.tid] = nv; s_n[F.tid] = dC * nv + ((const LAS float*)(cur + (MR_DN - MDMA_OFF)))[F.tid]; }
#define FRAG(off, f) (*(const LAS bf16x8*)(cur + ((off) - MDMA_OFF) + (f) * 1024 + lane * 16))
        const bf16x8 VB0 = FRAG(MR_VT, w * 2 + 0), VB1 = FRAG(MR_VT, w * 2 + 1);
#pragma unroll
        for (int dp = 0; dp < 2; ++dp) {
            bf16x8 fk[8];
#pragma unroll
            for (int x = 0; x < 8; ++x) fk[x] = FRAG(MR_KW, dp * 8 + x);
#pragma unroll
            for (int x = 0; x < 4; ++x) { const int db = dp * 4 + x; f32x4 acc = C[db] * dC;
                acc = __builtin_amdgcn_mfma_f32_16x16x32_bf16(fk[2 * x], VB0, acc, 0, 0, 0);
                acc = __builtin_amdgcn_mfma_f32_16x16x32_bf16(fk[2 * x + 1], VB1, acc, 0, 0, 0);
                C[db] = acc; }
        }
#undef FRAG
        asm volatile("s_waitcnt vmcnt(0)" ::: "memory"); __syncthreads();
    }
    float* oC = F.out + O_PC + (size_t)bh * HD * HD;
#pragma unroll
    for (int db = 0; db < 8; ++db)
#pragma unroll
        for (int i = 0; i < 4; ++i) oC[(size_t)(16 * db + 4 * q + i) * HD + 16 * w + cl] = C[db][i];
    if (F.tid < 128) F.out[O_PN + (size_t)bh * HD + F.tid] = s_n[F.tid];
    __syncthreads();
}
__device__ __forceinline__ void s3_mlstm_task(Frame& F, int unit, int tb) {
    const int lane = F.lane, cl = lane & 15, q = lane >> 4;
    const int c = unit & 31, bh = unit >> 5, hd = bh & 7, b = bh >> 3, row0 = b * T_P + 64 * c + 16 * tb;
    const unsigned char* rec = F.IMGM + (size_t)unit * MREC; const unsigned char* sn = (const unsigned char*)F.HB + (size_t)unit * SNAPM;
    const float* sc = (const float*)(rec + MR_SC) + 16 * tb;
    bf16x8 fq[4], fs[2];
#pragma unroll
    for (int x = 0; x < 4; ++x) fq[x] = *(const bf16x8*)(rec + MR_QI + (tb * 4 + x) * 1024 + lane * 16);
#pragma unroll
    for (int x = 0; x < 2; ++x) fs[x] = *(const bf16x8*)(rec + MR_SP + (tb * 2 + x) * 1024 + lane * 16);
    float den2e;
    {
        const int tt = lane >> 2, part = lane & 3;
        const u32x4* qp = (const u32x4*)(F.PROJ + (size_t)(row0 + tt) * NPROJ + hd * HD + 32 * part);
        const f32x4* np = (const f32x4*)(sn + 32768) + 8 * part;
        float acc = 0.f;
#pragma unroll
        for (int x = 0; x < 4; ++x) { const u32x4 qv = qp[x]; const f32x4 n0 = np[2 * x], n1 = np[2 * x + 1];
            acc += ((bflo(qv.x) * n0.x + bfhi(qv.x) * n0.y) + (bflo(qv.y) * n0.z + bfhi(qv.y) * n0.w)) + ((bflo(qv.z) * n1.x + bfhi(qv.z) * n1.y) + (bflo(qv.w) * n1.z + bfhi(qv.w) * n1.w)); }
        acc = quad_sum(acc);
        const float dd = sc[tt] * acc + sc[128 + tt], den = fmaxf(fabsf(dd), sc[64 + tt]);
        den2e = EPS * den * den;
    }
    f32x4 num[8];
    const f32x4 dv = *(const f32x4*)(sc + 4 * q);
    if (tb < 2) fs[1] = (bf16x8){0, 0, 0, 0, 0, 0, 0, 0};
#pragma unroll
    for (int wh = 0; wh < 2; ++wh) {
        bf16x8 Cb[4][4], VB[4][2];
#pragma unroll
        for (int x = 0; x < 4; ++x) { const int w = 4 * wh + x;
#pragma unroll
            for (int s = 0; s < 4; ++s) Cb[x][s] = *(const bf16x8*)(sn + ((w * 4 + s) * 64 + lane) * 16);
#pragma unroll
            for (int s = 0; s < 2; ++s) VB[x][s] = *(const bf16x8*)(rec + MR_VT + ((w * 2 + s) * 64 + lane) * 16); }
        asm volatile("" ::: "memory");
#pragma unroll
        for (int x = 0; x < 4; ++x) {
            f32x4 a0 = (f32x4){0.f, 0.f, 0.f, 0.f};
#pragma unroll
            for (int s = 0; s < 4; ++s) a0 = __builtin_amdgcn_mfma_f32_16x16x32_bf16(fq[s], Cb[x][s], a0, 0, 0, 0);
            a0 = a0 * dv;
            a0 = __builtin_amdgcn_mfma_f32_16x16x32_bf16(fs[0], VB[x][0], a0, 0, 0, 0);
            a0 = __builtin_amdgcn_mfma_f32_16x16x32_bf16(fs[1], VB[x][1], a0, 0, 0, 0);
            num[4 * wh + x] = a0;
        }
    }
    f32x4 ss = (f32x4){0.f, 0.f, 0.f, 0.f};
#pragma unroll
    for (int w = 0; w < 8; ++w) ss += num[w] * num[w];
    float scl[4];
#pragma unroll
    for (int i = 0; i < 4; ++i) { const float tot = row16_sum(ss[i]); const float d2 = __shfl(den2e, 4 * (4 * q + i)); scl[i] = __frsqrt_rn(tot * (1.0f / HD) + d2); }
#pragma unroll
    for (int w = 0; w < 8; ++w) { const float gn = F.mlstm_g[hd * HD + 16 * w + cl];
#pragma unroll
        for (int i = 0; i < 4; ++i) { const size_t row = (size_t)(row0 + 4 * q + i);
            const float oa = bf2f(F.PROJ[row * NPROJ + 3072 + hd * HD + 16 * w + cl]);
            F.MIX[row * D + hd * HD + 16 * w + cl] = (bf16_t)f2bf(num[w][i] * scl[i] * gn * sigmoidf_(oa)); } }
}
__device__ __forceinline__ float silu_fast(float x) { return __fdividef(x, 1.0f + __expf(-x)); }
__device__ __forceinline__ void s1_gdn_unit(Frame& F, int unit, LAS float* scr) {
    const int lane = F.lane, r = lane & 31, h = lane >> 5;
    const int c = unit & 31, bh = unit >> 5, hd = bh & 7, b = bh >> 3;
    const int rowb = b * T_P, row0 = rowb + 64 * c;
    unsigned char* rec = F.IMGG + (size_t)unit * GREC;
    LAS float* scrA = scr; LAS float* sG = scr + 4352; LAS float* sBe = sG + 64; LAS float* sRk = sBe + 64; LAS float* sRq = sRk + 64; LAS float* sF1 = sRq + 64; LAS float* sF2 = sF1 + 64;
    const float* gp = F.GATES + (size_t)(row0 + lane) * NGATE;
    const float lgv = -expf(F.A_log[hd]) * softplusf_(gp[16 + hd] + F.dt_bias[hd]);
    const float G = wave_scan_add(lgv, lane); const float be = sigmoidf_(gp[24 + hd]); const float G63 = __shfl(G, 63);
    sG[lane] = G; sBe[lane] = be;
    f32x16 Dk[3], Dq[3];
#pragma unroll
    for (int x = 0; x < 3; ++x)
#pragma unroll
        for (int y = 0; y < 16; ++y) { Dk[x][y] = 0.f; Dq[x][y] = 0.f; }
    float ssq[2][2] = {{0.f, 0.f}, {0.f, 0.f}};
    LAS unsigned short* const stg = (LAS unsigned short*)scrA;
    const LAS float* cwl = (const LAS float*)(F.lds + 8 * 19456);
#pragma unroll 1
    for (int hf = 0; hf < 2; ++hf) {
        asm volatile("s_waitcnt lgkmcnt(0)" ::: "memory");
#pragma unroll 1
        for (int x0 = 0; x0 < 18; x0 += 6) {
            u32x4 tv[6];
#pragma unroll
            for (int x = 0; x < 6; ++x) { int idx = (x0 + x) * 64 + lane; idx = idx < 1072 ? idx : 1071; const int mtx = idx >= 536 ? 1 : 0, rem = idx - 536 * mtx, row = rem >> 3, piece = rem & 7;
                const bool dead = (c == 0) && (row < 3); const int grow = dead ? row0 : row0 - 3 + row;
                u32x4 v = *(const u32x4*)(F.PROJ + (size_t)grow * NPROJ + 4096 + mtx * 1024 + hd * HD + 64 * hf + piece * 8);
                if (dead) v = (u32x4){0u, 0u, 0u, 0u};
                tv[x] = v; }
#pragma unroll
            for (int x = 0; x < 6; ++x) { const int idx = (x0 + x) * 64 + lane; const int mtx = idx >= 536 ? 1 : 0, rem = idx - 536 * mtx, row = rem >> 3, piece = rem & 7;
                if (idx < 1072) *(LAS u32x4*)(stg + mtx * (67 * 64) + row * 64 + ((piece ^ ((row >> 1) & 7)) * 8)) = tv[x]; }
        }
        asm volatile("s_waitcnt lgkmcnt(0)" ::: "memory");
#pragma unroll 1
        for (int sl = 0; sl < 4; ++sl) {
            const int s = 4 * hf + sl;
            bf16x8 fr[2][2];
#pragma unroll
            for (int mt = 0; mt < 2; ++mt) {
                asm volatile("" ::: "memory");
                f32x4 wa[4], wb[4];
#pragma unroll
                for (int tap = 0; tap < 4; ++tap) { wa[tap] = *(const LAS f32x4*)(cwl + (mt * 4 + tap) * 128 + 16 * s + 8 * h); wb[tap] = *(const LAS f32x4*)(cwl + (mt * 4 + tap) * 128 + 16 * s + 8 * h + 4); }
#pragma unroll
                for (int rb = 0; rb < 2; ++rb) {
                    const int i = 32 * rb + r; f32x4 a0 = (f32x4){0.f, 0.f, 0.f, 0.f}, a1 = a0;
#pragma unroll
                    for (int tap = 0; tap < 4; ++tap) { const int row = i + tap, piece = 2 * sl + h;
                        const u32x4 uv = *(const LAS u32x4*)(stg + mt * (67 * 64) + row * 64 + ((piece ^ ((row >> 1) & 7)) * 8));
                        a0 += (f32x4){bflo(uv.x), bfhi(uv.x), bflo(uv.y), bfhi(uv.y)} * wa[tap]; a1 += (f32x4){bflo(uv.z), bfhi(uv.z), bflo(uv.w), bfhi(uv.w)} * wb[tap]; }
                    float y[8];
#pragma unroll
                    for (int j = 0; j < 4; ++j) { y[j] = silu_fast(a0[j]); y[4 + j] = silu_fast(a1[j]); }
                    ssq[rb][mt] += ((y[0] * y[0] + y[1] * y[1]) + (y[2] * y[2] + y[3] * y[3])) + ((y[4] * y[4] + y[5] * y[5]) + (y[6] * y[6] + y[7] * y[7]));
                    const u32x4 wv = (u32x4){pk2(y[0], y[1]), pk2(y[2], y[3]), pk2(y[4], y[5]), pk2(y[6], y[7])};
                    fr[mt][rb] = __builtin_bit_cast(bf16x8, wv);
                    if (mt == 0) { unsigned char* o0 = rec + GR_QG + ((((i >> 4) * 4 + (s >> 1)) * 64 + (2 * h) * 16 + (i & 15)) * 16) + 8 * (s & 1);
                        *(u32x2*)o0 = (u32x2){wv.x, wv.y}; *(u32x2*)(o0 + 256) = (u32x2){wv.z, wv.w}; }
                }
            }
#pragma unroll
            for (int blk = 0; blk < 3; ++blk) { const int jb = blk >> 1, ib = (blk + 1) >> 1;
                Dk[blk] = __builtin_amdgcn_mfma_f32_32x32x16_bf16(fr[1][jb], fr[1][ib], Dk[blk], 0, 0, 0);
                Dq[blk] = __builtin_amdgcn_mfma_f32_32x32x16_bf16(fr[1][jb], fr[0][ib], Dq[blk], 0, 0, 0); }
        }
    }
#pragma unroll
    for (int rb = 0; rb < 2; ++rb) {
        const float sq = ssq[rb][0] + __shfl_xor(ssq[rb][0], 32), sk = ssq[rb][1] + __shfl_xor(ssq[rb][1], 32);
        if (h == 0) { sRq[32 * rb + r] = 1.0f / sqrtf(sq + EPS); sRk[32 * rb + r] = 1.0f / sqrtf(sk + EPS); }
    }
    asm volatile("s_waitcnt lgkmcnt(0)" ::: "memory");
#pragma unroll
    for (int blk = 0; blk < 3; ++blk) {
        const int jb = blk >> 1, ib = (blk + 1) >> 1;
        const int i = 32 * ib + r; const float Gi = sG[i], bei = sBe[i], rki = sRk[i], rqi = sRq[i] * QK_SCALE;
#pragma unroll
        for (int g = 0; g < 4; ++g) {
            const int j0 = 32 * jb + 8 * g + 4 * h; const f32x4 Gj = *(const LAS f32x4*)(sG + j0), rkj = *(const LAS f32x4*)(sRk + j0);
            f32x4 av; float qv[4];
#pragma unroll
            for (int ip = 0; ip < 4; ++ip) { const float e = __expf(Gi - Gj[ip]); av[ip] = bei * e * rki * rkj[ip] * Dk[blk][4 * g + ip];
                qv[ip] = (j0 + ip <= i) ? -(rqi * rkj[ip] * e * Dq[blk][4 * g + ip]) : 0.f; }
            *(LAS f32x4*)(scrA + i * 68 + j0) = av;
            *(u32x2*)(rec + GR_QK + ((((i >> 4) * 2 + jb) * 64 + (2 * (g & 1) + h) * 16 + (i & 15)) * 16) + 8 * (g >> 1)) = (u32x2){pk2(qv[0], qv[1]), pk2(qv[2], qv[3])};
        }
    }
    asm volatile("s_waitcnt lgkmcnt(0)" ::: "memory");
    {
        float tc[64];
#pragma unroll
        for (int i = 0; i < 64; ++i) {
            float acc0 = (lane == i) ? 1.f : 0.f, acc1 = 0.f;
#pragma unroll
            for (int j4 = 0; j4 < i; j4 += 4) { const f32x4 av = *(const LAS f32x4*)(scrA + i * 68 + j4);
                acc0 -= av.x * tc[j4]; if (j4 + 1 < i) acc1 -= av.y * tc[j4 + 1]; if (j4 + 2 < i) acc0 -= av.z * tc[j4 + 2]; if (j4 + 3 < i) acc1 -= av.w * tc[j4 + 3]; }
            tc[i] = acc0 + acc1;
            scrA[i * 68 + lane] = tc[i];
            asm volatile("" ::: "memory");
        }
    }
    const float gam = expf(G), rkl = sRk[lane], rql = sRq[lane];
    sF1[lane] = be * gam * rkl; sF2[lane] = be;
    { float* sc = (float*)(rec + GR_SC); sc[lane] = gam * rql * QK_SCALE; sc[64 + lane] = expf(G63 - G) * rkl; if (lane == 0) sc[128] = expf(G63); }
    asm volatile("s_waitcnt lgkmcnt(0)" ::: "memory");
    bf16x8 Tp[6], Tpp[6];
#pragma unroll
    for (int x = 0; x < 6; ++x) { const int ib = x < 2 ? 0 : 1, s = x < 2 ? x : x - 2;
        const LAS float* tp = scrA + (32 * ib + r) * 68 + 16 * s + 8 * h; const f32x4 t0 = *(const LAS f32x4*)tp, t1 = *(const LAS f32x4*)(tp + 4);
        const f32x4 f1a = *(const LAS f32x4*)(sF1 + 16 * s + 8 * h), f1b = *(const LAS f32x4*)(sF1 + 16 * s + 8 * h + 4), f2a = *(const LAS f32x4*)(sF2 + 16 * s + 8 * h), f2b = *(const LAS f32x4*)(sF2 + 16 * s + 8 * h + 4);
        const f32x4 p0 = t0 * f1a, p1 = t1 * f1b, q0 = t0 * f2a, q1 = t1 * f2b;
        Tp[x] = __builtin_bit_cast(bf16x8, (u32x4){pk2(p0.x, p0.y), pk2(p0.z, p0.w), pk2(p1.x, p1.y), pk2(p1.z, p1.w)});
        Tpp[x] = __builtin_bit_cast(bf16x8, (u32x4){pk2(q0.x, q0.y), pk2(q0.z, q0.w), pk2(q1.x, q1.y), pk2(q1.z, q1.w)}); }
#pragma unroll 1
    for (int mt = 0; mt < 2; ++mt) {
        {
            u32x4 tv[17];
#pragma unroll
            for (int x = 0; x < 17; ++x) { int idx = x * 64 + lane; idx = idx < 1072 ? idx : 1071; const int row = idx >> 4, piece = idx & 15;
                const bool dead = (c == 0) && (row < 3); const int grow = dead ? row0 : row0 - 3 + row;
                u32x4 v = *(const u32x4*)(F.PROJ + (size_t)grow * NPROJ + 4096 + (mt + 1) * 1024 + hd * HD + piece * 8);
                if (dead) v = (u32x4){0u, 0u, 0u, 0u};
                tv[x] = v; }
            asm volatile("s_waitcnt lgkmcnt(0)" ::: "memory");
#pragma unroll
            for (int x = 0; x < 17; ++x) { const int idx = x * 64 + lane; if (idx < 1072) *(LAS u32x4*)(stg + (idx >> 4) * 128 + (idx & 15) * 8) = tv[x]; }
            asm volatile("s_waitcnt lgkmcnt(0)" ::: "memory");
        }
#pragma unroll 1
        for (int blk = 0; blk < 4; ++blk) {
            const int d = 32 * blk + r; const LAS float* cwc = cwl + (mt + 1) * 512 + d;
            const float w0 = cwc[0], w1 = cwc[128], w2 = cwc[256], w3 = cwc[384];
            bf16x8 Xc[4];
#pragma unroll
            for (int s = 0; s < 4; ++s) {
                float u[11];
#pragma unroll
                for (int x = 0; x < 11; ++x) u[x] = bf2f(stg[(16 * s + 8 * h + x) * 128 + d]);
                float y[8];
#pragma unroll
                for (int j = 0; j < 8; ++j) y[j] = silu_fast(((w0 * u[j] + w1 * u[j + 1]) + w2 * u[j + 2]) + w3 * u[j + 3]);
                const u32x4 xw = (u32x4){pk2(y[0], y[1]), pk2(y[2], y[3]), pk2(y[4], y[5]), pk2(y[6], y[7])};
                Xc[s] = __builtin_bit_cast(bf16x8, xw);
                if (mt == 0) { unsigned char* o0 = rec + GR_KT + ((((d >> 4) * 2 + (s >> 1)) * 64 + (2 * h) * 16 + (d & 15)) * 16) + 8 * (s & 1);
                    *(u32x2*)o0 = (u32x2){xw.x ^ 0x80008000u, xw.y ^ 0x80008000u}; *(u32x2*)(o0 + 256) = (u32x2){xw.z ^ 0x80008000u, xw.w ^ 0x80008000u}; }
            }
#pragma unroll
            for (int ib = 0; ib < 2; ++ib) {
                f32x16 Dm;
#pragma unroll
                for (int x = 0; x < 16; ++x) Dm[x] = 0.f;
                if (mt == 0) {
                    if (ib == 0) { Dm = __builtin_amdgcn_mfma_f32_32x32x16_bf16(Xc[0], Tp[0], Dm, 0, 0, 0); Dm = __builtin_amdgcn_mfma_f32_32x32x16_bf16(Xc[1], Tp[1], Dm, 0, 0, 0); }
                    else {
#pragma unroll
                        for (int s = 0; s < 4; ++s) Dm = __builtin_amdgcn_mfma_f32_32x32x16_bf16(Xc[s], Tp[2 + s], Dm, 0, 0, 0); }
                    const int i = 32 * ib + r;
#pragma unroll
                    for (int g = 0; g < 4; ++g)
                        *(u32x2*)(rec + GR_WI + ((((i >> 4) * 4 + blk) * 64 + (2 * (g & 1) + h) * 16 + (i & 15)) * 16) + 8 * (g >> 1)) = (u32x2){pk2(Dm[4 * g], Dm[4 * g + 1]), pk2(Dm[4 * g + 2], Dm[4 * g + 3])};
                } else {
                    if (ib == 0) { Dm = __builtin_amdgcn_mfma_f32_32x32x16_bf16(Tpp[0], Xc[0], Dm, 0, 0, 0); Dm = __builtin_amdgcn_mfma_f32_32x32x16_bf16(Tpp[1], Xc[1], Dm, 0, 0, 0); }
                    else {
#pragma unroll
                        for (int s = 0; s < 4; ++s) Dm = __builtin_amdgcn_mfma_f32_32x32x16_bf16(Tpp[2 + s], Xc[s], Dm, 0, 0, 0); }
#pragma unroll
                    for (int g = 0; g < 4; ++g)
                        *(u32x2*)(rec + GR_UP + ((((d >> 4) * 4 + (2 * ib + (g >> 1))) * 64 + (2 * (g & 1) + h) * 16 + (d & 15)) * 8)) = (u32x2){pk2(Dm[4 * g], Dm[4 * g + 1]), pk2(Dm[4 * g + 2], Dm[4 * g + 3])};
                }
            }
        }
    }
    if (c == 31) {
        for (int x = lane; x < 3 * 384; x += 64) { const int jr = x / 384, cc = x % 384, ch = (cc >> 7) * 1024 + hd * HD + (cc & 127);
            F.out[O_PCONV + (size_t)(b * 3 + jr) * CCONV + ch] = bf2f(F.PROJ[(size_t)(rowb + T_P - 3 + jr) * NPROJ + 4096 + ch]); }
    }
}
constexpr int GBUF = 33792;
__device__ __forceinline__ void gdn_dma(const unsigned char* rec, LAS unsigned char* dst, int w, int lane) {
    for (int piece = w; piece < 33; piece += 8) { const unsigned char* s = rec + (piece < 32 ? GR_WI + piece * 1024 : GR_SC);
        __builtin_amdgcn_global_load_lds((const unsigned*)(s + lane * 16), (LAS unsigned*)(dst + piece * 1024), 16, 0, 0); }
}
__device__ __forceinline__ void s2_gdn_chain(Frame& F, int bh) {
    const int lane = F.lane, w = F.wave, cl = lane & 15, q = lane >> 4;
    LAS unsigned char* const buf0 = F.lds; LAS unsigned char* const buf1 = F.lds + GBUF;
    const unsigned char* recs = F.IMGG + (size_t)bh * 32 * GREC;
    unsigned char* snaps = (unsigned char*)F.X1 + (size_t)bh * 32 * SNAPG;
    f32x4 S[8];
#pragma unroll
    for (int db = 0; db < 8; ++db) S[db] = (f32x4){0.f, 0.f, 0.f, 0.f};
    u32x2 upn[4];
#pragma unroll
    for (int tb = 0; tb < 4; ++tb) upn[tb] = *(const u32x2*)(recs + GR_UP + ((w * 4 + tb) * 64 + lane) * 8);
    gdn_dma(recs, buf0, w, lane);
    asm volatile("s_waitcnt vmcnt(0)" ::: "memory"); __syncthreads();
    for (int c = 0; c < 32; ++c) {
        LAS unsigned char* const cur = (c & 1) ? buf1 : buf0; LAS unsigned char* const nxt = (c & 1) ? buf0 : buf1;
        u32x2 up[4];
#pragma unroll
        for (int tb = 0; tb < 4; ++tb) up[tb] = upn[tb];
        if (c + 1 < 32) { const unsigned char* src = recs + (size_t)(c + 1) * GREC;
#pragma unroll
            for (int tb = 0; tb < 4; ++tb) upn[tb] = *(const u32x2*)(src + GR_UP + ((w * 4 + tb) * 64 + lane) * 8);
            gdn_dma(src, nxt, w, lane); }
        unsigned char* sn = snaps + (size_t)c * SNAPG;
        const LAS float* sc = (const LAS float*)(cur + 32768);
        bf16x8 Sb[4];
#pragma unroll
        for (int s = 0; s < 4; ++s) { const u32x4 pv = (u32x4){pk2(S[2 * s][0], S[2 * s][1]), pk2(S[2 * s][2], S[2 * s][3]), pk2(S[2 * s + 1][0], S[2 * s + 1][1]), pk2(S[2 * s + 1][2], S[2 * s + 1][3])};
            Sb[s] = __builtin_bit_cast(bf16x8, pv); *(u32x4*)(sn + ((w * 4 + s) * 64 + lane) * 16) = pv; }
#define FRAG(off, f) (*(const LAS bf16x8*)(cur + (off) + (f) * 1024 + lane * 16))
        f32x4 P[4];
#pragma unroll
        for (int tp = 0; tp < 2; ++tp) {
            bf16x8 fw[8];
#pragma unroll
            for (int x = 0; x < 8; ++x) fw[x] = FRAG(0, tp * 8 + x);
            f32x4 a0 = (f32x4){-bflo(up[2 * tp].x), -bfhi(up[2 * tp].x), -bflo(up[2 * tp].y), -bfhi(up[2 * tp].y)};
            f32x4 a1 = (f32x4){-bflo(up[2 * tp + 1].x), -bfhi(up[2 * tp + 1].x), -bflo(up[2 * tp + 1].y), -bfhi(up[2 * tp + 1].y)};
#pragma unroll
            for (int s = 0; s < 4; ++s) { a0 = __builtin_amdgcn_mfma_f32_16x16x32_bf16(fw[s], Sb[s], a0, 0, 0, 0); a1 = __builtin_amdgcn_mfma_f32_16x16x32_bf16(fw[4 + s], Sb[s], a1, 0, 0, 0); }
            P[2 * tp] = a0; P[2 * tp + 1] = a1;
        }
        bf16x8 Pbs[2];
#pragma unroll
        for (int sp = 0; sp < 2; ++sp) {
            const f32x4 k0 = *(const LAS f32x4*)(sc + 64 + 16 * (2 * sp) + 4 * q), k1 = *(const LAS f32x4*)(sc + 64 + 16 * (2 * sp + 1) + 4 * q);
            const f32x4 a = P[2 * sp], bq = P[2 * sp + 1], as = a * k0, bs = bq * k1;
            *(u32x4*)(sn + 32768 + ((w * 2 + sp) * 64 + lane) * 16) = (u32x4){pk2(a[0], a[1]), pk2(a[2], a[3]), pk2(bq[0], bq[1]), pk2(bq[2], bq[3])};
            Pbs[sp] = __builtin_bit_cast(bf16x8, (u32x4){pk2(as[0], as[1]), pk2(as[2], as[3]), pk2(bs[0], bs[1]), pk2(bs[2], bs[3])});
        }
        const float gL = sc[128];
#pragma unroll
        for (int dp = 0; dp < 2; ++dp) {
            bf16x8 fk[8];
#pragma unroll
            for (int x = 0; x < 8; ++x) fk[x] = FRAG(16384, dp * 8 + x);
#pragma unroll
            for (int x = 0; x < 4; ++x) { const int db = dp * 4 + x; f32x4 acc = S[db] * gL;
                acc = __builtin_amdgcn_mfma_f32_16x16x32_bf16(fk[2 * x], Pbs[0], acc, 0, 0, 0);
                acc = __builtin_amdgcn_mfma_f32_16x16x32_bf16(fk[2 * x + 1], Pbs[1], acc, 0, 0, 0);
                S[db] = acc; }
        }
#undef FRAG
        asm volatile("s_waitcnt vmcnt(0)" ::: "memory"); __syncthreads();
    }
    float* oS = F.out + O_PS + (size_t)bh * HD * HD;
#pragma unroll
    for (int db = 0; db < 8; ++db)
#pragma unroll
        for (int i = 0; i < 4; ++i) oS[(size_t)(16 * db + 4 * q + i) * HD + 16 * w + cl] = S[db][i];
    __syncthreads();
}
__device__ __forceinline__ void s3_gdn_task(Frame& F, int unit, int tb) {
    const int lane = F.lane, cl = lane & 15, q = lane >> 4;
    const int c = unit & 31, bh = unit >> 5, hd = bh & 7, b = bh >> 3, row0 = b * T_P + 64 * c + 16 * tb;
    const unsigned char* rec = F.IMGG + (size_t)unit * GREC; const unsigned char* sn = (const unsigned char*)F.X1 + (size_t)unit * SNAPG;
    const float* sc = (const float*)(rec + GR_SC);
    bf16x8 fq[4], fk[2];
#pragma unroll
    for (int x = 0; x < 4; ++x) fq[x] = *(const bf16x8*)(rec + GR_QG + (tb * 4 + x) * 1024 + lane * 16);
    fk[0] = *(const bf16x8*)(rec + GR_QK + (tb * 2) * 1024 + lane * 16);
    fk[1] = *(const bf16x8*)(rec + GR_QK + (tb * 2 + 1) * 1024 + lane * 16);
    const f32x4 rs = *(const f32x4*)(sc + 16 * tb + 4 * q);
    f32x4 ov[8];
    if (tb < 2) fk[1] = (bf16x8){0, 0, 0, 0, 0, 0, 0, 0};
#pragma unroll
    for (int wh = 0; wh < 2; ++wh) {
        bf16x8 Sb[4][4], Pb[4][2];
#pragma unroll
        for (int x = 0; x < 4; ++x) { const int w = 4 * wh + x;
#pragma unroll
            for (int s = 0; s < 4; ++s) Sb[x][s] = *(const bf16x8*)(sn + ((w * 4 + s) * 64 + lane) * 16);
#pragma unroll
            for (int s = 0; s < 2; ++s) Pb[x][s] = *(const bf16x8*)(sn + 32768 + ((w * 2 + s) * 64 + lane) * 16); }
        asm volatile("" ::: "memory");
#pragma unroll
        for (int x = 0; x < 4; ++x) {
            f32x4 a0 = (f32x4){0.f, 0.f, 0.f, 0.f};
#pragma unroll
            for (int s = 0; s < 4; ++s) a0 = __builtin_amdgcn_mfma_f32_16x16x32_bf16(fq[s], Sb[x][s], a0, 0, 0, 0);
            a0 = a0 * rs;
            a0 = __builtin_amdgcn_mfma_f32_16x16x32_bf16(fk[0], Pb[x][0], a0, 0, 0, 0);
            a0 = __builtin_amdgcn_mfma_f32_16x16x32_bf16(fk[1], Pb[x][1], a0, 0, 0, 0);
            ov[4 * wh + x] = a0;
        }
    }
    f32x4 ss = (f32x4){0.f, 0.f, 0.f, 0.f};
#pragma unroll
    for (int w = 0; w < 8; ++w) ss += ov[w] * ov[w];
    float scl[4];
#pragma unroll
    for (int i = 0; i < 4; ++i) scl[i] = __frsqrt_rn(row16_sum(ss[i]) * (1.0f / HD) + EPS);
#pragma unroll
    for (int w = 0; w < 8; ++w) { const float gn = F.gdn_g[hd * HD + 16 * w + cl];
#pragma unroll
        for (int i = 0; i < 4; ++i) { const size_t row = (size_t)(row0 + 4 * q + i);
            const float zb = bf2f(F.PROJ[row * NPROJ + 7168 + hd * HD + 16 * w + cl]);
            F.MIX[row * D + 1024 + hd * HD + 16 * w + cl] = (bf16_t)f2bf(ov[w][i] * scl[i] * gn * siluf_(zb)); } }
}
constexpr int SMP_ST = 61440, SMP_RAW = 126976;
__device__ __forceinline__ void sample_dma(const Frame& F, const float* st, int b, int hd, int colbase, int w, int lane) {
    const unsigned char* ssrc = (const unsigned char*)(st + (size_t)(b * NH + hd) * HD * HD);
    for (int piece = w; piece < 64; piece += 8)
        __builtin_amdgcn_global_load_lds((const unsigned*)(ssrc + piece * 1024 + lane * 16), (LAS unsigned*)(F.lds + SMP_ST + piece * 1024), 16, 0, 0);
    {
        const bf16_t* tsrc = F.PROJ + (size_t)(M_P + b * T_S + 4 * (w & 1) + (lane >> 4)) * NPROJ + colbase + (w >> 1) * 1024 + hd * HD + (lane & 15) * 8;
        __builtin_amdgcn_global_load_lds((const unsigned*)tsrc, (LAS unsigned*)(F.lds + SMP_RAW + w * 1024), 16, 0, 0);
    }
}
constexpr int SM_ST0 = 0, SM_ST1 = 65536, SM_RAW0 = 131072, SM_RAW1 = 139264, SM_PART = 147456;
__device__ __forceinline__ void smm_dma(const Frame& F, int b, int hd, int buf, int w, int lane) {
    const unsigned char* ssrc = (const unsigned char*)(F.stC + (size_t)(b * NH + hd) * HD * HD);
    LAS unsigned char* sdst = F.lds + (buf ? SM_ST1 : SM_ST0);
    for (int piece = w; piece < 64; piece += 8)
        __builtin_amdgcn_global_load_lds((const unsigned*)(ssrc + piece * 1024 + lane * 16), (LAS unsigned*)(sdst + piece * 1024), 16, 0, 0);
    const bf16_t* tsrc = F.PROJ + (size_t)(M_P + b * T_S + 4 * (w & 1) + (lane >> 4)) * NPROJ + (w >> 1) * 1024 + hd * HD + (lane & 15) * 8;
    __builtin_amdgcn_global_load_lds((const unsigned*)tsrc, (LAS unsigned*)(F.lds + (buf ? SM_RAW1 : SM_RAW0) + w * 1024), 16, 0, 0);
}
struct SmpPre { float g0, g1, m0; f32x4 n[4]; float nl0, nl1; };
__device__ __forceinline__ void smm_prefetch(const Frame& F, int b, int hd, int lane, SmpPre& p) {
    const int bh = b * NH + hd; const float* gp = F.GATES + (size_t)(M_P + b * T_S + (lane & 7)) * NGATE;
    p.g0 = gp[hd]; p.g1 = gp[8 + hd]; p.m0 = F.stM[bh];
    const float* np = F.stN + (size_t)bh * HD;
#pragma unroll
    for (int x = 0; x < 4; ++x) p.n[x] = *(const f32x4*)(np + 16 * (lane & 7) + 4 * x);
    p.nl0 = np[lane]; p.nl1 = np[64 + lane];
}
__device__ __forceinline__ void sample_mlstm(Frame& F, int b, int hd, int buf, SmpPre& pre, bool has_next, int nb, int nhd) {
    const int lane = F.lane, w = F.wave, cl = lane & 15, q = lane >> 4, t8 = lane & 7;
    const int row0 = M_P + b * T_S, bh = b * NH + hd;
    asm volatile("s_waitcnt vmcnt(0)" ::: "memory"); __syncthreads();
    const SmpPre cur = pre;
    if (has_next) { smm_dma(F, nb, nhd, buf ^ 1, w, lane); smm_prefetch(F, nb, nhd, lane, pre); }
    const LAS float* ST = (const LAS float*)(F.lds + (buf ? SM_ST1 : SM_ST0));
    const LAS unsigned char* RAW = F.lds + (buf ? SM_RAW1 : SM_RAW0);
    LAS float* s_part = (LAS float*)(F.lds + SM_PART);
    f32x4 C[8];
#pragma unroll
    for (int db = 0; db < 8; ++db)
#pragma unroll
        for (int i = 0; i < 4; ++i) C[db][i] = ST[(16 * db + 4 * q + i) * HD + 16 * w + cl];
    const float lfv = logsigmoidf_(cur.g1 + F.gate_b[NH + hd]), liv = cur.g0 + F.gate_b[hd];
    float bb = lfv;
#pragma unroll
    for (int o = 1; o < 8; o <<= 1) { const float x = __shfl_up(bb, o); if (t8 >= o) bb += x; }
    const float a = liv - bb; float cm = a;
#pragma unroll
    for (int o = 1; o < 8; o <<= 1) { const float x = __shfl_up(cm, o); if (t8 >= o) cm = fmaxf(cm, x); }
    const float Mi = fmaxf(cur.m0, cm), mi = bb + Mi; const float M7 = __shfl(Mi, 7), m7 = __shfl(mi, 7);
    const float dec = expf(cur.m0 - Mi), em = expf(-mi), wlp = expf(a - M7) * QK_SCALE, dC = expf(cur.m0 - M7);
    f32x4 Dt = (f32x4){0.f, 0.f, 0.f, 0.f};
#pragma unroll
    for (int s = 0; s < 4; ++s) { const bf16x8 kf = *(const LAS bf16x8*)(RAW + 2048 + (cl & 7) * 256 + (32 * s + 8 * q) * 2), qf = *(const LAS bf16x8*)(RAW + (cl & 7) * 256 + (32 * s + 8 * q) * 2);
        Dt = __builtin_amdgcn_mfma_f32_16x16x32_bf16(kf, qf, Dt, 0, 0, 0); }
    const float Mt = __shfl(Mi, cl & 7);
    float sp[4]; float rs = 0.f;
#pragma unroll
    for (int i = 0; i < 4; ++i) { const int s = 4 * q + i; const float as = __shfl(a, s & 7); const float x = Dt[i] * QK_SCALE * __expf(as - Mt); sp[i] = (q < 2 && s <= (cl & 7)) ? x : 0.f; rs += sp[i]; }
    rs += __shfl_xor(rs, 16);
    const bf16x8 SPf = __builtin_bit_cast(bf16x8, (u32x4){pk2(sp[0], sp[1]), pk2(sp[2], sp[3]), 0u, 0u});
    float den2e;
    {
        const u32x4 q0 = *(const LAS u32x4*)(RAW + (lane >> 3) * 256 + 32 * t8), q1 = *(const LAS u32x4*)(RAW + (lane >> 3) * 256 + 32 * t8 + 16);
        float acc = ((bflo(q0.x) * cur.n[0].x + bfhi(q0.x) * cur.n[0].y) + (bflo(q0.y) * cur.n[0].z + bfhi(q0.y) * cur.n[0].w)) + ((bflo(q0.z) * cur.n[1].x + bfhi(q0.z) * cur.n[1].y) + (bflo(q0.w) * cur.n[1].z + bfhi(q0.w) * cur.n[1].w));
        acc += ((bflo(q1.x) * cur.n[2].x + bfhi(q1.x) * cur.n[2].y) + (bflo(q1.y) * cur.n[2].z + bfhi(q1.y) * cur.n[2].w)) + ((bflo(q1.z) * cur.n[3].x + bfhi(q1.z) * cur.n[3].y) + (bflo(q1.w) * cur.n[3].z + bfhi(q1.w) * cur.n[3].w));
        acc = row8_sum(acc);
        const float qn = __shfl(acc, 8 * t8), rst = __shfl(rs, t8);
        const float dd = dec * qn + rst, den = fmaxf(fabsf(dd), em);
        den2e = EPS * den * den;
    }
    bf16x8 Qp[4];
#pragma unroll
    for (int s = 0; s < 4; ++s) { const u32x2 lo = *(const LAS u32x2*)(RAW + (cl & 7) * 256 + (32 * s + 4 * q) * 2), hi = *(const LAS u32x2*)(RAW + (cl & 7) * 256 + (32 * s + 16 + 4 * q) * 2);
        Qp[s] = __builtin_bit_cast(bf16x8, (u32x4){lo.x, lo.y, hi.x, hi.y}); }
    float wl4[4];
#pragma unroll
    for (int j = 0; j < 4; ++j) wl4[j] = __shfl(wlp, (4 * q + j) & 7);
    const LAS bf16_t* RK = (const LAS bf16_t*)(RAW + 2048); const LAS bf16_t* RV = (const LAS bf16_t*)(RAW + 4096); const LAS bf16_t* RO = (const LAS bf16_t*)(RAW + 6144);
    bf16x8 VB;
    { unsigned v0 = RV[((4 * q + 0) & 7) * 128 + 16 * w + cl], v1 = RV[((4 * q + 1) & 7) * 128 + 16 * w + cl], v2 = RV[((4 * q + 2) & 7) * 128 + 16 * w + cl], v3 = RV[((4 * q + 3) & 7) * 128 + 16 * w + cl];
      if (q >= 2) { v0 = v1 = v2 = v3 = 0u; }
      VB = __builtin_bit_cast(bf16x8, (u32x4){v0 | (v1 << 16), v2 | (v3 << 16), 0u, 0u}); }
    f32x4 num = (f32x4){0.f, 0.f, 0.f, 0.f};
    {
        bf16x8 Cb[4];
#pragma unroll
        for (int s = 0; s < 4; ++s) Cb[s] = __builtin_bit_cast(bf16x8, (u32x4){pk2(C[2 * s][0], C[2 * s][1]), pk2(C[2 * s][2], C[2 * s][3]), pk2(C[2 * s + 1][0], C[2 * s + 1][1]), pk2(C[2 * s + 1][2], C[2 * s + 1][3])});
#pragma unroll
        for (int s = 0; s < 4; ++s) num = __builtin_amdgcn_mfma_f32_16x16x32_bf16(Qp[s], Cb[s], num, 0, 0, 0);
#pragma unroll
        for (int i = 0; i < 4; ++i) num[i] *= __shfl(dec, (4 * q + i) & 7);
        num = __builtin_amdgcn_mfma_f32_16x16x32_bf16(SPf, VB, num, 0, 0, 0);
    }
    float* oC = F.out + O_SC + (size_t)bh * HD * HD;
#pragma unroll
    for (int db = 0; db < 8; ++db) {
        float kv[4];
#pragma unroll
        for (int j = 0; j < 4; ++j) kv[j] = (q < 2) ? bf2f(RK[((4 * q + j) & 7) * 128 + 16 * db + cl]) * wl4[j] : 0.f;
        const bf16x8 KWf = __builtin_bit_cast(bf16x8, (u32x4){pk2(kv[0], kv[1]), pk2(kv[2], kv[3]), 0u, 0u});
        const f32x4 cn = __builtin_amdgcn_mfma_f32_16x16x32_bf16(KWf, VB, C[db] * dC, 0, 0, 0);
#pragma unroll
        for (int i = 0; i < 4; ++i) oC[(size_t)(16 * db + 4 * q + i) * HD + 16 * w + cl] = cn[i];
    }
    if (w == 0) {
        float n0v = dC * cur.nl0, n1v = dC * cur.nl1;
#pragma unroll
        for (int s = 0; s < 8; ++s) { const float ws = __shfl(wlp, s); n0v += ws * bf2f(RK[s * 128 + lane]); n1v += ws * bf2f(RK[s * 128 + 64 + lane]); }
        F.out[O_SN + (size_t)bh * HD + lane] = n0v; F.out[O_SN + (size_t)bh * HD + 64 + lane] = n1v;
        if (lane == 0) F.out[O_SM + bh] = m7;
    }
    f32x4 ss = num * num;
    ss.x = row16_sum(ss.x); ss.y = row16_sum(ss.y); ss.z = row16_sum(ss.z); ss.w = row16_sum(ss.w);
    if (cl == 0 && q < 2) *(LAS f32x4*)(s_part + w * 8 + 4 * q) = ss;
    __syncthreads();
    if (q < 2) {
        f32x4 tot = (f32x4){0.f, 0.f, 0.f, 0.f};
#pragma unroll
        for (int ww = 0; ww < 8; ++ww) tot += *(const LAS f32x4*)(s_part + ww * 8 + 4 * q);
        const float gn = F.mlstm_g[hd * HD + 16 * w + cl];
#pragma unroll
        for (int i = 0; i < 4; ++i) { const int t = 4 * q + i; const float d2 = __shfl(den2e, t);
            const float y = num[i] * __frsqrt_rn(tot[i] * (1.0f / HD) + d2) * gn * sigmoidf_(bf2f(RO[t * 128 + 16 * w + cl]));
            F.MIX[(size_t)(row0 + t) * D + hd * HD + 16 * w + cl] = (bf16_t)f2bf(y); }
    }
}
struct SmpPreG { float g0, g1, h0, h1, h2; };
__device__ __forceinline__ void sample_gdn(Frame& F, int b, int hd, SmpPreG& pre, bool has_next, int nb, int nhd) {
    LAS float* sQ = (LAS float*)(F.lds); LAS float* sK = sQ + 1024; LAS float* sV = sK + 1024; LAS float* sZ = sV + 1024; LAS float* sKs = sZ + 1024; LAS float* sU = sKs + 1024;
    LAS float* sPartK = sU + 1024;
    LAS float* sPartQ = sPartK + 4096;
    LAS float* sKK = sPartQ + 4096;
    LAS float* sQKr = sKK + 64;
    LAS float* sA = sQKr + 64;
    LAS float* sQKd = sA + 64;
    LAS float* sSc = sQKd + 64;
    LAS float* sNorm = sSc + 64;
    const int tid = F.tid, e = tid & 127, q4 = tid >> 7, lane = F.lane, w = F.wave;
    const int row0 = M_P + b * T_S, bh = b * NH + hd;
    asm volatile("s_waitcnt vmcnt(0)" ::: "memory"); __syncthreads();
    float S[32];
#pragma unroll
    for (int dd = 0; dd < 32; ++dd) S[dd] = ((const LAS float*)(F.lds + SMP_ST))[(32 * q4 + dd) * HD + e];
    if (tid < 384) {
        const int arr = tid >> 7, ch = arr * 1024 + hd * HD + e;
        float h0 = pre.h0, h1 = pre.h1, h2 = pre.h2;
        const float w0 = F.conv_w[ch], w1 = F.conv_w[CCONV + ch], w2 = F.conv_w[2 * CCONV + ch], w3 = F.conv_w[3 * CCONV + ch];
        float u[8];
#pragma unroll
        for (int t = 0; t < 8; ++t) u[t] = bf2f(((const LAS bf16_t*)(F.lds + SMP_RAW))[arr * 1024 + t * 128 + e]);
        LAS float* dst = sQ + arr * 1024 + e;
#pragma unroll
        for (int t = 0; t < 8; ++t) { const float cvv = ((w0 * h0 + w1 * h1) + w2 * h2) + w3 * u[t]; h0 = h1; h1 = h2; h2 = u[t]; dst[t * 128] = siluf_(cvv); }
        float* oc = F.out + O_SCONV + (size_t)b * 3 * CCONV + ch; oc[0] = h0; oc[CCONV] = h1; oc[2 * CCONV] = h2;
    } else {
#pragma unroll
        for (int t = 0; t < 8; ++t) sZ[t * 128 + e] = bf2f(((const LAS bf16_t*)(F.lds + SMP_RAW))[3 * 1024 + t * 128 + e]);
    }
    if (w == 0) {
        const int t = lane & 7;
        float G = -expf(F.A_log[hd]) * softplusf_(pre.g0 + F.dt_bias[hd]);
#pragma unroll
        for (int o = 1; o < 8; o <<= 1) { const float x = __shfl_up(G, o); if (t >= o) G += x; }
        if (lane < 8) { sSc[t] = G; sSc[8 + t] = sigmoidf_(pre.g1); sSc[16 + t] = expf(G); }
    }
    __syncthreads();
    if (has_next) {
        sample_dma(F, F.stS, nb, nhd, 4096, w, lane);
        if (w == 0) { const float* gp = F.GATES + (size_t)(M_P + nb * T_S + (lane & 7)) * NGATE; pre.g0 = gp[16 + nhd]; pre.g1 = gp[24 + nhd]; }
        if (tid < 384) { const float* cv = F.stConv + (size_t)nb * 3 * CCONV + (tid >> 7) * 1024 + nhd * HD + e; pre.h0 = cv[0]; pre.h1 = cv[CCONV]; pre.h2 = cv[2 * CCONV]; }
    }
    if (w == 0) {
        const int r16 = lane & 15, kq = lane >> 4;
        const LAS float* arow = (r16 < 8 ? sQ : sK) + (r16 & 7) * 128; const LAS float* brow = (r16 < 8 ? sK : sQ) + (r16 & 7) * 128;
        f32x4 acc = (f32x4){0.f, 0.f, 0.f, 0.f};
#pragma unroll
        for (int s = 0; s < 4; ++s) {
            const f32x4 a0 = *(const LAS f32x4*)(arow + 32 * s + 8 * kq), a1 = *(const LAS f32x4*)(arow + 32 * s + 8 * kq + 4);
            const f32x4 b0 = *(const LAS f32x4*)(brow + 32 * s + 8 * kq), b1 = *(const LAS f32x4*)(brow + 32 * s + 8 * kq + 4);
            const bf16x8 af = __builtin_bit_cast(bf16x8, (u32x4){pk2(a0.x, a0.y), pk2(a0.z, a0.w), pk2(a1.x, a1.y), pk2(a1.z, a1.w)});
            const bf16x8 bfr = __builtin_bit_cast(bf16x8, (u32x4){pk2(b0.x, b0.y), pk2(b0.z, b0.w), pk2(b1.x, b1.y), pk2(b1.z, b1.w)});
            acc = __builtin_amdgcn_mfma_f32_16x16x32_bf16(af, bfr, acc, 0, 0, 0);
        }
#pragma unroll
        for (int i = 0; i < 4; ++i) { const int R = 4 * kq + i, c = r16;
            if (R < 8 && c < 8) sQKr[R * 8 + c] = acc[i];
            if (R >= 8 && c < 8) { sKK[(R - 8) * 8 + c] = acc[i]; if (R - 8 == c) sSc[32 + c] = 1.0f / sqrtf(acc[i] + EPS); }
            if (R < 8 && c >= 8 && R == c - 8) sSc[24 + R] = 1.0f / sqrtf(acc[i] + EPS); }
    }
    {
        float pk[8], pq[8];
#pragma unroll
        for (int t = 0; t < 8; ++t) { pk[t] = 0.f; pq[t] = 0.f; }
#pragma unroll
        for (int d4 = 0; d4 < 8; ++d4)
#pragma unroll
            for (int t = 0; t < 8; ++t) { const f32x4 kv = *(const LAS f32x4*)(sK + t * 128 + 32 * q4 + 4 * d4), qv = *(const LAS f32x4*)(sQ + t * 128 + 32 * q4 + 4 * d4);
                pk[t] += (kv.x * S[4 * d4] + kv.y * S[4 * d4 + 1]) + (kv.z * S[4 * d4 + 2] + kv.w * S[4 * d4 + 3]);
                pq[t] += (qv.x * S[4 * d4] + qv.y * S[4 * d4 + 1]) + (qv.z * S[4 * d4 + 2] + qv.w * S[4 * d4 + 3]); }
#pragma unroll
        for (int t = 0; t < 8; ++t) { sPartK[(q4 * 8 + t) * 128 + e] = pk[t]; sPartQ[(q4 * 8 + t) * 128 + e] = pq[t]; }
    }
    __syncthreads();
    if (w == 0) {
        const int t = lane >> 3, s = lane & 7; const float dec = expf(sSc[t] - sSc[s]);
        sA[lane] = (s < t) ? sSc[8 + t] * dec * sSc[32 + t] * sSc[32 + s] * sKK[lane] : 0.f;
        sQKd[lane] = (s <= t) ? sSc[24 + t] * QK_SCALE * sSc[32 + s] * dec * sQKr[lane] : 0.f;
    }
    {
        const float G7 = sSc[7];
#pragma unroll
        for (int x = 0; x < 2; ++x) { const int idx = tid + 512 * x, s = idx >> 7; sKs[idx] = sK[idx] * (expf(G7 - sSc[s]) * sSc[32 + s]); }
    }
    __syncthreads();
    float ov[8];
    if (tid < 128) {
        float u[8];
#pragma unroll
        for (int t = 0; t < 8; ++t) {
            const float kS = ((sPartK[(0 * 8 + t) * 128 + e] + sPartK[(1 * 8 + t) * 128 + e]) + (sPartK[(2 * 8 + t) * 128 + e] + sPartK[(3 * 8 + t) * 128 + e])) * sSc[32 + t];
            float ut = sSc[8 + t] * (sV[t * 128 + e] - sSc[16 + t] * kS);
#pragma unroll
            for (int s = 0; s < 8; ++s) if (s < t) ut -= sA[t * 8 + s] * u[s];
            u[t] = ut; sU[t * 128 + e] = ut;
            float o = ((sPartQ[(0 * 8 + t) * 128 + e] + sPartQ[(1 * 8 + t) * 128 + e]) + (sPartQ[(2 * 8 + t) * 128 + e] + sPartQ[(3 * 8 + t) * 128 + e])) * (sSc[16 + t] * sSc[24 + t] * QK_SCALE);
#pragma unroll
            for (int s = 0; s < 8; ++s) if (s <= t) o += sQKd[t * 8 + s] * u[s];
            ov[t] = o;
            const float ss = wave_sum(o * o);
            if (lane == 0) sNorm[w * 8 + t] = ss;
        }
    }
    __syncthreads();
    {
        const float gL = sSc[23];
        float uu[8];
#pragma unroll
        for (int s = 0; s < 8; ++s) uu[s] = sU[s * 128 + e];
#pragma unroll
        for (int d4 = 0; d4 < 8; ++d4) {
            f32x4 acc = (f32x4){S[4 * d4], S[4 * d4 + 1], S[4 * d4 + 2], S[4 * d4 + 3]} * gL;
#pragma unroll
            for (int s = 0; s < 8; ++s) acc += *(const LAS f32x4*)(sKs + s * 128 + 32 * q4 + 4 * d4) * uu[s];
            S[4 * d4] = acc.x; S[4 * d4 + 1] = acc.y; S[4 * d4 + 2] = acc.z; S[4 * d4 + 3] = acc.w;
        }
        float* oS = F.out + O_SS + (size_t)bh * HD * HD;
#pragma unroll
        for (int dd = 0; dd < 32; ++dd) oS[(size_t)(32 * q4 + dd) * HD + e] = S[dd];
    }
    if (tid < 128) {
        const float gn = F.gdn_g[hd * HD + e];
#pragma unroll
        for (int t = 0; t < 8; ++t) { const float tot = sNorm[t] + sNorm[8 + t];
            const float y = ov[t] * (1.0f / sqrtf(tot * (1.0f / HD) + EPS)) * gn * siluf_(sZ[t * 128 + e]);
            F.MIX[(size_t)(row0 + t) * D + 1024 + hd * HD + e] = (bf16_t)f2bf(y); }
    }
    __syncthreads();
}

constexpr int S1_CW_OFF = 8 * 19456;
static_assert(S1_CW_OFF + 1536 * 4 <= LDSCTL_OFF, "S1 conv-weight area");
__device__ __forceinline__ void p4_scan_s1(Frame& F) {
    LAS float* scr = (LAS float*)(F.lds + F.wave * 19456);
    {
        const int hd = ((4 * (int)blockIdx.x) >> 5) & 7; LAS float* cwl = (LAS float*)(F.lds + S1_CW_OFF);
        for (int x = F.tid; x < 1536; x += NTHREADS) { const int mt = x >> 9, tap = (x >> 7) & 3, ch = x & 127; cwl[x] = F.conv_w[tap * CCONV + mt * 1024 + hd * HD + ch]; }
        __syncthreads();
    }
    if (F.wave >= 4) { const int u = 4 * (int)blockIdx.x + (F.wave - 4); if (u < 1024) s1_mlstm_unit(F, u, scr); }
    else { const int u = 4 * (int)blockIdx.x + F.wave; if (u < 1024) s1_gdn_unit(F, u, scr); }
}
__device__ __forceinline__ void p4_scan_s2(Frame& F) {
    const int w = blockIdx.x;
    if (w < 32) s2_mlstm_chain(F, w);
    else if (w < 64) s2_gdn_chain(F, w - 32);
    else {
        const int stride = (int)gridDim.x - 64, first = w - 64, wv = F.wave, lane = F.lane, tid = F.tid, e = tid & 127;
        {
            int idx = first;
            if (idx < 1024) {
                SmpPre pre; smm_dma(F, idx >> 3, idx & 7, 0, wv, lane); smm_prefetch(F, idx >> 3, idx & 7, lane, pre);
                int buf = 0;
                for (; idx < 1024; idx += stride, buf ^= 1) { const int nidx = idx + stride; sample_mlstm(F, idx >> 3, idx & 7, buf, pre, nidx < 1024, nidx >> 3, nidx & 7); }
                asm volatile("s_waitcnt vmcnt(0)" ::: "memory"); __syncthreads();
            }
        }
        {
            int idx = first; while (idx < 1024) idx += stride; idx -= 1024;
            if (idx < 1024) {
                SmpPreG pre; pre.g0 = pre.g1 = pre.h0 = pre.h1 = pre.h2 = 0.f;
                { const int b = idx >> 3, hd = idx & 7; sample_dma(F, F.stS, b, hd, 4096, wv, lane);
                  if (wv == 0) { const float* gp = F.GATES + (size_t)(M_P + b * T_S + (lane & 7)) * NGATE; pre.g0 = gp[16 + hd]; pre.g1 = gp[24 + hd]; }
                  if (tid < 384) { const float* cv = F.stConv + (size_t)b * 3 * CCONV + (tid >> 7) * 1024 + hd * HD + e; pre.h0 = cv[0]; pre.h1 = cv[CCONV]; pre.h2 = cv[2 * CCONV]; } }
                for (; idx < 1024; idx += stride) { const int nidx = idx + stride; sample_gdn(F, idx >> 3, idx & 7, pre, nidx < 1024, nidx >> 3, nidx & 7); }
            }
        }
    }
}

template <int MIXER  >
__device__ __forceinline__ void s3_dma(const Frame& F, int unit, LAS unsigned char* dst, int w, int lane) {
    const unsigned char* sn = MIXER == 0 ? (const unsigned char*)F.HB + (size_t)unit * SNAPM : (const unsigned char*)F.X1 + (size_t)unit * SNAPG;
    const unsigned char* rec = MIXER == 0 ? F.IMGM + (size_t)unit * MREC : F.IMGG + (size_t)unit * GREC;
    for (int piece = w; piece < 50; piece += 8) {
        const unsigned char* s = piece < 32 ? sn + piece * 1024 : piece < 48 ? (MIXER == 0 ? rec + MR_VT + (piece - 32) * 1024 : sn + piece * 1024)
                                 : piece == 48 ? (MIXER == 0 ? sn + 32768 : rec + GR_SC) : rec + (MIXER == 0 ? MR_SC : GR_SC);
        __builtin_amdgcn_global_load_lds((const unsigned*)(s + lane * 16), (LAS unsigned*)(dst + piece * 1024), 16, 0, 0); }
}
template <int MIXER>
__device__ __forceinline__ void s3_prefetch(const Frame& F, int unit, int tb, int wh, int lane, bf16x8 (&fq)[4], bf16x8 (&fs)[2], unsigned (&gt)[16]) {
    const unsigned char* rec = MIXER == 0 ? F.IMGM + (size_t)unit * MREC : F.IMGG + (size_t)unit * GREC;
#pragma unroll
    for (int x = 0; x < 4; ++x) fq[x] = *(const bf16x8*)(rec + (MIXER == 0 ? MR_QI : GR_QG) + (tb * 4 + x) * 1024 + lane * 16);
#pragma unroll
    for (int x = 0; x < 2; ++x) fs[x] = *(const bf16x8*)(rec + (MIXER == 0 ? MR_SP : GR_QK) + (tb * 2 + x) * 1024 + lane * 16);
    const int c = unit & 31, bh = unit >> 5, hd = bh & 7, b = bh >> 3, row0 = b * T_P + 64 * c + 16 * tb, cl = lane & 15, q = lane >> 4;
#pragma unroll
    for (int x = 0; x < 4; ++x)
#pragma unroll
        for (int i = 0; i < 4; ++i) gt[x * 4 + i] = F.PROJ[(size_t)(row0 + 4 * q + i) * NPROJ + (MIXER == 0 ? 3072 : 7168) + hd * HD + 16 * (4 * wh + x) + cl];
}
template <int MIXER>
__device__ __forceinline__ void s3_wg(Frame& F, int u0) {
    const int lane = F.lane, wv = F.wave, cl = lane & 15, q = lane >> 4, tb = wv & 3, wh = wv >> 2;
    constexpr int IMG = 51200;
    LAS unsigned char* const buf0 = F.lds; LAS unsigned char* const buf1 = F.lds + IMG;
    LAS float* const s_part = (LAS float*)(F.lds + 2 * IMG);
    bf16x8 fq[4], fs[2], fqn[4], fsn[2]; unsigned gt[16], gtn[16];
    u32x2 yv[4]; size_t yoff = 0; bool ypend = false;
    s3_dma<MIXER>(F, u0, buf0, wv, lane);
    s3_prefetch<MIXER>(F, u0, tb, wh, lane, fq, fs, gt);
    asm volatile("s_waitcnt vmcnt(0)" ::: "memory"); __syncthreads();
#pragma unroll 1
    for (int k = 0; k < 8; ++k) {
        const int unit = u0 + k;
        LAS unsigned char* const cur = (k & 1) ? buf1 : buf0; LAS unsigned char* const nxt = (k & 1) ? buf0 : buf1;
        const int c = unit & 31, bh = unit >> 5, hd = bh & 7, b = bh >> 3, row0 = b * T_P + 64 * c + 16 * tb;
        if (ypend) {
#pragma unroll
            for (int x = 0; x < 4; ++x) { bf16_t* o = F.MIX + yoff + 16 * x;
                o[0] = (bf16_t)(yv[x].x & 0xffffu); o[D] = (bf16_t)(yv[x].x >> 16); o[2 * D] = (bf16_t)(yv[x].y & 0xffffu); o[3 * D] = (bf16_t)(yv[x].y >> 16); } }
        if (k + 1 < 8) { s3_dma<MIXER>(F, unit + 1, nxt, wv, lane); s3_prefetch<MIXER>(F, unit + 1, tb, wh, lane, fqn, fsn, gtn); }
        const LAS float* sc = (const LAS float*)(cur + (MIXER == 0 ? 50176 : 49152)) + 16 * tb;
        float den2e = EPS;
        if (MIXER == 0) {
            const LAS float* np = (const LAS float*)(cur + 49152);
            float acc = 0.f;
#pragma unroll
            for (int s = 0; s < 4; ++s) { const f32x4 n0 = *(const LAS f32x4*)(np + 32 * s + 4 * q), n1 = *(const LAS f32x4*)(np + 32 * s + 16 + 4 * q); const u32x4 qv = __builtin_bit_cast(u32x4, fq[s]);
                acc += ((bflo(qv.x) * n0.x + bfhi(qv.x) * n0.y) + (bflo(qv.y) * n0.z + bfhi(qv.y) * n0.w)) + ((bflo(qv.z) * n1.x + bfhi(qv.z) * n1.y) + (bflo(qv.w) * n1.z + bfhi(qv.w) * n1.w)); }
            acc += __shfl_xor(acc, 16); acc += __shfl_xor(acc, 32);
            const float dd = sc[cl] * acc + sc[128 + cl], den = fmaxf(fabsf(dd), sc[64 + cl]);
            den2e = EPS * den * den;
        }
        const f32x4 rsc = *(const LAS f32x4*)(sc + 4 * q);
        const bf16x8 fs1 = (tb >= 2) ? fs[1] : (bf16x8){0, 0, 0, 0, 0, 0, 0, 0};
        f32x4 num[4];
#pragma unroll
        for (int x = 0; x < 4; ++x) { const int w = 4 * wh + x;
            bf16x8 Bf[4], Vf[2];
#pragma unroll
            for (int s = 0; s < 4; ++s) Bf[s] = *(const LAS bf16x8*)(cur + ((w * 4 + s) * 64 + lane) * 16);
#pragma unroll
            for (int s = 0; s < 2; ++s) Vf[s] = *(const LAS bf16x8*)(cur + 32768 + ((w * 2 + s) * 64 + lane) * 16);
            f32x4 a0 = (f32x4){0.f, 0.f, 0.f, 0.f};
#pragma unroll
            for (int s = 0; s < 4; ++s) a0 = __builtin_amdgcn_mfma_f32_16x16x32_bf16(fq[s], Bf[s], a0, 0, 0, 0);
            a0 = a0 * rsc;
            a0 = __builtin_amdgcn_mfma_f32_16x16x32_bf16(fs[0], Vf[0], a0, 0, 0, 0);
            a0 = __builtin_amdgcn_mfma_f32_16x16x32_bf16(fs1, Vf[1], a0, 0, 0, 0);
            num[x] = a0; }
        f32x4 ss = (num[0] * num[0] + num[1] * num[1]) + (num[2] * num[2] + num[3] * num[3]);
        ss.x = row16_sum(ss.x); ss.y = row16_sum(ss.y); ss.z = row16_sum(ss.z); ss.w = row16_sum(ss.w);
        if (cl == 0) *(LAS f32x4*)(s_part + wv * 16 + 4 * q) = ss;
        __syncthreads();
        const f32x4 tot = ss + *(const LAS f32x4*)(s_part + (wv ^ 4) * 16 + 4 * q);
        float scl[4];
#pragma unroll
        for (int i = 0; i < 4; ++i) { const float d2 = MIXER == 0 ? __shfl(den2e, 4 * q + i) : EPS; scl[i] = __frsqrt_rn(tot[i] * (1.0f / HD) + d2); }
#pragma unroll
        for (int x = 0; x < 4; ++x) { const int w = 4 * wh + x; const float gn = (MIXER == 0 ? F.mlstm_g : F.gdn_g)[hd * HD + 16 * w + cl];
            float y[4];
#pragma unroll
            for (int i = 0; i < 4; ++i) { const float g = bflo(gt[x * 4 + i]); y[i] = num[x][i] * scl[i] * gn * (MIXER == 0 ? sigmoidf_(g) : siluf_(g)); }
            yv[x] = (u32x2){pk2(y[0], y[1]), pk2(y[2], y[3])}; }
        yoff = (size_t)(row0 + 4 * q) * D + MIXER * 1024 + hd * HD + 64 * wh + cl; ypend = true;
        asm volatile("s_waitcnt vmcnt(0)" ::: "memory"); __syncthreads();
#pragma unroll
        for (int x = 0; x < 4; ++x) fq[x] = fqn[x];
        fs[0] = fsn[0]; fs[1] = fsn[1];
#pragma unroll
        for (int x = 0; x < 16; ++x) gt[x] = gtn[x];
    }
#pragma unroll
    for (int x = 0; x < 4; ++x) { bf16_t* o = F.MIX + yoff + 16 * x;
        o[0] = (bf16_t)(yv[x].x & 0xffffu); o[D] = (bf16_t)(yv[x].x >> 16); o[2 * D] = (bf16_t)(yv[x].y & 0xffffu); o[3 * D] = (bf16_t)(yv[x].y >> 16); }
}
__device__ __forceinline__ void p4_scan_s3(Frame& F) {
    const int g = blockIdx.x;
    if (g < 128) s3_wg<0>(F, g * 8); else s3_wg<1>(F, (g - 128) * 8);
}

#ifndef PROBE_REPEAT
#define PROBE_REPEAT -1
#endif
__device__ __forceinline__ void ph1(Frame& F) { p1_modgemv(F); p1_transposes(F); }

template <int MODE>
__device__ __forceinline__ void norm_finish(const f32x4 (&v)[8], const f32x4 (&gg)[8], const f32x4 (&sh)[8], const f32x4 (&sc)[8], bf16_t* ob, float* of, int lane) {
    float s = 0.f;
#pragma unroll
    for (int j = 0; j < 8; ++j) s += (v[j].x * v[j].x + v[j].y * v[j].y) + (v[j].z * v[j].z + v[j].w * v[j].w);
    const float rstd = 1.0f / sqrtf(wave_sum(s) * (1.0f / D) + EPS);
#pragma unroll
    for (int j = 0; j < 8; ++j) { const f32x4 y = (v[j] * rstd * gg[j]) * (sc[j] + 1.0f) + sh[j];
        if (MODE == 10) ((f32x4*)of)[lane + 64 * j] = y; else { u32x2 w; w.x = pk2(y.x, y.y); w.y = pk2(y.z, y.w); ((u32x2*)ob)[lane + 64 * j] = w; } }
}
template <int MODE>
__device__ __forceinline__ void norm_phase(Frame& F) {
    const int lane = F.lane;
    const float* gsrc = MODE == 2 ? F.norm1 : (MODE == 7 ? F.norm2 : F.normf);
    f32x4 gg[8], sh[8], sc[8], v[8], vn[8];
#pragma unroll
    for (int j = 0; j < 8; ++j) gg[j] = ((const f32x4*)gsrc)[lane + 64 * j];
    {
        const int r0 = 4 * F.gw, gb = r0 >> 11;
        const float* md = MODE == 10 ? F.MODF + (size_t)gb * MODFW : F.MOD + (size_t)gb * MODW + (MODE == 7 ? 3 * D : 0);
        const float* src = MODE == 2 ? F.xp : (MODE == 7 ? F.X1 : F.out + O_Y);
#pragma unroll
        for (int j = 0; j < 8; ++j) { sh[j] = ((const f32x4*)md)[lane + 64 * j]; sc[j] = ((const f32x4*)(md + D))[lane + 64 * j]; }
#pragma unroll
        for (int j = 0; j < 8; ++j) v[j] = ((const f32x4*)(src + (size_t)r0 * D))[lane + 64 * j];
#pragma unroll
        for (int k = 0; k < 4; ++k) {
            if (k < 3) {
#pragma unroll
                for (int j = 0; j < 8; ++j) vn[j] = ((const f32x4*)(src + (size_t)(r0 + k + 1) * D))[lane + 64 * j]; }
            norm_finish<MODE>(v, gg, sh, sc, F.HB + (size_t)(r0 + k) * D, F.out + O_Y + (size_t)(r0 + k) * D, lane);
#pragma unroll
            for (int j = 0; j < 8; ++j) v[j] = vn[j];
        }
    }
    if (F.gw < M_S) {
        const int r = M_P + F.gw, gb = row_gb(r);
        const float* md = MODE == 10 ? F.MODF + (size_t)gb * MODFW : F.MOD + (size_t)gb * MODW + (MODE == 7 ? 3 * D : 0);
#pragma unroll
        for (int j = 0; j < 8; ++j) { sh[j] = ((const f32x4*)md)[lane + 64 * j]; sc[j] = ((const f32x4*)(md + D))[lane + 64 * j]; }
        if (MODE == 2) {
#pragma unroll
            for (int j = 0; j < 8; ++j) v[j] = ((const f32x4*)(F.xs + (size_t)F.gw * D))[lane + 64 * j];
        } else {
            const float* part = (const float*)F.IMGM; const int pmx = F.gw >> 8, rr = F.gw & 255;
            const float* base = MODE == 7 ? F.xs + (size_t)F.gw * D : F.X1 + (size_t)r * D;
            const float* gate = F.MOD + (size_t)gb * MODW + (MODE == 7 ? 2 * D : 5 * D);
#pragma unroll
            for (int jh = 0; jh < 4; ++jh) {
                f32x4 t[2][8];
#pragma unroll
                for (int j = 0; j < 2; ++j)
#pragma unroll
                    for (int ks = 0; ks < 8; ++ks) t[j][ks] = *(const f32x4*)(part + ((size_t)(ks * 32 + pmx * 8 + 2 * jh + j) * 256 + rr) * 256 + 4 * lane);
#pragma unroll
                for (int j = 0; j < 2; ++j) { const f32x4 s = ((t[j][0] + t[j][1]) + (t[j][2] + t[j][3])) + ((t[j][4] + t[j][5]) + (t[j][6] + t[j][7]));
                    const f32x4 bs = ((const f32x4*)base)[lane + 64 * (2 * jh + j)], g = ((const f32x4*)gate)[lane + 64 * (2 * jh + j)];
                    v[2 * jh + j] = bs + g * s; }
            }
            if (MODE == 7) {
#pragma unroll
                for (int j = 0; j < 8; ++j) ((f32x4*)(F.X1 + (size_t)r * D))[lane + 64 * j] = v[j]; }
        }
        norm_finish<MODE>(v, gg, sh, sc, F.HB + (size_t)r * D, F.out + O_Y + (size_t)r * D, lane);
    }
}
__device__ __forceinline__ void ph2(Frame& F) { norm_phase<2>(F); }
__device__ __forceinline__ void ph7(Frame& F) { norm_phase<7>(F); }
__device__ __forceinline__ void ph10(Frame& F) { norm_phase<10>(F); }
__device__ __forceinline__ void ph3(Frame& F) {
    p3_gates(F);
    asm volatile("s_waitcnt vmcnt(0) lgkmcnt(0)" ::: "memory"); __syncthreads();
    pg8::Gemm g{F.HB, F.WIN, M, NPROJ, D}; pg8::StaticOrder S; S.init(M, NPROJ, D, gridDim.x, (int)blockIdx.x);
    pg8::EpiBf16<0> E{F.PROJ, NPROJ};
    pg8::gemm_phase<pg8::EpiBf16<0>, pg8::StaticOrder, true, true>(F.lds + RING_OFF, g, S, E);
}
__device__ __forceinline__ void ph6(Frame& F) {
    pg8::Gemm g{F.MIX, F.WOUT, M, D, D}; pg8::SplitOrder S; S.init(D, (int)blockIdx.x);
    pg8::EpiRes E{F.xp, F.xs, M_P, F.MOD + 2 * D, MODW, F.X1, D, (float*)F.IMGM};
    pg8::gemm_phase<pg8::EpiRes, pg8::SplitOrder, true, true>(F.lds + RING_OFF, g, S, E);
}
__device__ __forceinline__ void ph8(Frame& F) {
    pg8::Gemm g{F.HB, F.WUP, M, DFF, D}; pg8::StaticOrder S; S.init(M, DFF, D, gridDim.x, (int)blockIdx.x);
    pg8::EpiBf16<1> E{F.PROJ, DFF};
    pg8::gemm_phase<pg8::EpiBf16<1>, pg8::StaticOrder, true, true>(F.lds + RING_OFF, g, S, E);
}
__device__ __forceinline__ void ph9(Frame& F) {
    pg8::Gemm g{F.PROJ, F.WDOWN, M, D, DFF}; pg8::SplitOrder S; S.init(DFF, (int)blockIdx.x);
    pg8::EpiRes E{F.X1, F.X1, M, F.MOD + 5 * D, MODW, F.out + O_Y, D, (float*)F.IMGM};
    pg8::gemm_phase<pg8::EpiRes, pg8::SplitOrder, true, true>(F.lds + RING_OFF, g, S, E);
}

struct Args { const float* in[26]; float* out; unsigned char* ws; int ph_lo, ph_hi; };
constexpr int NPHASE = 12;
__global__ void __launch_bounds__(NTHREADS, 2) fwd_kernel(Args args) {
    extern __shared__ __attribute__((aligned(16))) unsigned char lds[];
    Frame F;
    F.lds = (LAS unsigned char*)lds;
    F.tid = threadIdx.x; F.lane = F.tid & 63; F.wave = __builtin_amdgcn_readfirstlane(F.tid >> 6);
    F.gw = blockIdx.x * NWAVES + F.wave; F.ngw = gridDim.x * NWAVES;
    F.xp = args.in[0]; F.xs = args.in[1]; F.stC = args.in[2]; F.stN = args.in[3]; F.stM = args.in[4]; F.stS = args.in[5]; F.stConv = args.in[6]; F.cp = args.in[7]; F.cs = args.in[8];
    F.ada_w = args.in[9]; F.ada_b = args.in[10]; F.norm1 = args.in[11]; F.w_in = args.in[12]; F.gate_b = args.in[13]; F.mlstm_g = args.in[14]; F.conv_w = args.in[15]; F.A_log = args.in[16];
    F.dt_bias = args.in[17]; F.gdn_g = args.in[18]; F.w_out = args.in[19]; F.norm2 = args.in[20]; F.w_up = args.in[21]; F.w_down = args.in[22]; F.adaf_w = args.in[23]; F.adaf_b = args.in[24]; F.normf = args.in[25];
    F.out = args.out;
    unsigned char* ws = args.ws;
    F.SCB = (bf16_t*)(ws + WS_SCB); F.WIN = (bf16_t*)(ws + WS_WIN); F.WOUT = (bf16_t*)(ws + WS_WOUT); F.WUP = (bf16_t*)(ws + WS_WUP); F.WDOWN = (bf16_t*)(ws + WS_WDOWN);
    F.HB = (bf16_t*)(ws + WS_HB); F.MIX = (bf16_t*)(ws + WS_MIX); F.PROJ = (bf16_t*)(ws + WS_PROJ);
    F.IMGM = ws + WS_IMGM; F.IMGG = ws + WS_IMGG; F.MOD = (float*)(ws + WS_MOD); F.MODF = (float*)(ws + WS_MODF); F.GATES = (float*)(ws + WS_GATES); F.X1 = (float*)(ws + WS_X1);

    for (int u = F.tid; u < (LDS_BYTES - LDSCTL_OFF) / 4; u += NTHREADS) ((LAS unsigned*)(F.lds + LDSCTL_OFF))[u] = 0u;
    __syncthreads();
    XcdBarrier bar; bar.bar = (unsigned*)(ws + WS_CTL) + CW_BAR; bar.x = 0; bar.st = nullptr;
#if MK_ONE_LAUNCH
    bar = xcd_barrier_post((unsigned*)(ws + WS_CTL) + CW_BAR, (volatile LAS unsigned*)(F.lds + MISC_OFF) + 8);
#define GRID_BAR() xcd_barrier(bar)
#else
#define GRID_BAR() do { } while (0)
#endif
    const int lo = args.ph_lo, hi = args.ph_hi;
#define IN(k) (lo <= (k) && (k) < hi)
#define BOTH(k) (IN(k) && IN((k) + 1))

#define RUN(k, body) if (IN(k)) { body; if (PROBE_REPEAT == (k)) { GRID_BAR(); body; } if (BOTH(k)) GRID_BAR(); }
    RUN(0, p0_silu(F))
    RUN(1, ph1(F))
    RUN(2, ph2(F))
    RUN(3, ph3(F))
    RUN(4, p4_scan_s1(F))
    RUN(5, p4_scan_s2(F))
    RUN(6, p4_scan_s3(F))
    RUN(7, ph6(F))
    RUN(8, ph7(F))
    RUN(9, ph8(F))
    RUN(10, ph9(F))
    RUN(11, ph10(F))
#undef RUN
#undef IN
#undef BOTH
}

extern "C" void kernel_launch(void* const* d_in, const int* in_sizes, int n_in, void* d_out, int out_size, void* d_ws, size_t ws_size, hipStream_t stream) {
    static int ok = 0;
    if (ok == 0) {
        if (n_in != 26 || (size_t)out_size != O_END || ws_size < WS_END) { fprintf(stderr, "kernel_launch: unexpected shapes: n_in %d out %d ws %zu\n", n_in, out_size, ws_size); ok = -1; return; }
        if (hipFuncSetAttribute((const void*)fwd_kernel, hipFuncAttributeMaxDynamicSharedMemorySize, LDS_BYTES) != hipSuccess) { fprintf(stderr, "kernel_launch: hipFuncSetAttribute failed\n"); ok = -1; return; }
        int dev = 0, cus = 0, per_cu = 0;
        (void)hipGetDevice(&dev); (void)hipDeviceGetAttribute(&cus, hipDeviceAttributeMultiprocessorCount, dev);
        (void)hipOccupancyMaxActiveBlocksPerMultiprocessor(&per_cu, (const void*)fwd_kernel, NTHREADS, LDS_BYTES);
        if (cus != GRID || per_cu < 1) fprintf(stderr, "kernel_launch: note: %d CUs, %d blocks/CU reported; launching %d workgroups\n", cus, per_cu, GRID);
        (void)hipGetLastError();
        ok = 1;
    }
    if (ok < 0) return;
    (void)hipMemsetAsync((char*)d_ws + WS_CTL, 0, CTL_ZERO_BYTES, stream);
    Args a{};
    for (int i = 0; i < 26; ++i) a.in[i] = (const float*)d_in[i];
    a.out = (float*)d_out; a.ws = (unsigned char*)d_ws;
#if MK_ONE_LAUNCH
    a.ph_lo = 0; a.ph_hi = NPHASE;
    hipLaunchKernelGGL(fwd_kernel, dim3(GRID), dim3(NTHREADS), LDS_BYTES, stream, a);
#else
    for (int p = 0; p < NPHASE; ++p) { a.ph_lo = p; a.ph_hi = p + 1; hipLaunchKernelGGL(fwd_kernel, dim3(GRID), dim3(NTHREADS), LDS_BYTES, stream, a); }
#endif
}
```
